# Optimizing an MI355X kernel written in HIP

```python
import math
import jax
import jax.numpy as jnp
from jax import lax
import numpy as np

D_MODEL = 2048
BATCH = 4
SEQ = 2048
DEPTH = 4

PLE_DIM = 256
RMS_EPS = 1e-6
Q_BLOCK = 128
SCAN_CHUNK = 64
ROPE_THETA = 10000.0

DIFF_HEADS = 4
DIFF_QK = 64
DIFF_V = 128
DIFF_WIDTH = DIFF_HEADS * DIFF_V

HGRN_HEADS = 4
HGRN_DK = 128
HGRN_DV = 128
HGRN_WIDTH = HGRN_HEADS * HGRN_DV

MLA_HEADS = 4
MLA_NOPE = 128
MLA_ROPE = 64
MLA_V = 128
MLA_Q_RANK = 384
MLA_KV_RANK = 256
MLA_WIDTH = MLA_HEADS * MLA_V

MLSTM_HEADS = 4
MLSTM_DQK = 64
MLSTM_DV = 128
MLSTM_CONV = 4
MLSTM_WIDTH = MLSTM_HEADS * MLSTM_DV

D_MIX = DIFF_WIDTH + HGRN_WIDTH + MLA_WIDTH + MLSTM_WIDTH

IN_SIZES = (
    DIFF_HEADS * 2 * DIFF_QK, DIFF_HEADS * 2 * DIFF_QK, DIFF_HEADS * DIFF_V,
    HGRN_HEADS * HGRN_DK, HGRN_HEADS * HGRN_DK, HGRN_HEADS * HGRN_DV, HGRN_HEADS * HGRN_DV,
    MLA_Q_RANK, MLA_KV_RANK, MLA_ROPE,
    MLSTM_HEADS * MLSTM_DQK, MLSTM_HEADS * MLSTM_DQK, MLSTM_HEADS * MLSTM_DV,
    MLSTM_HEADS, MLSTM_HEADS, MLSTM_HEADS * MLSTM_DV,
)
IN_COLS = sum(IN_SIZES)

PEER_HEADS = 8
PEER_N_KEYS = 128
PEER_N_EXPERTS = PEER_N_KEYS * PEER_N_KEYS
PEER_KEY_DIM = 128
PEER_TOPK = 16
PEER_TOKEN_BLOCK = 64

kernel_name = 'hybrid_diffattn_hgrn2_mla_mlstm_peer'


def rmsnorm(x, g):
    xf = x.astype(jnp.float32)
    y = xf * lax.rsqrt(jnp.mean(xf * xf, axis=-1, keepdims=True) + RMS_EPS)
    return (y * g.astype(jnp.float32)).astype(x.dtype)


def head_rmsnorm(y, g):
    return rmsnorm(y, g.reshape(y.shape[-2], y.shape[-1]))


def rope(x, positions):
    half = x.shape[-1] // 2
    inv = ROPE_THETA ** (-jnp.arange(half, dtype=jnp.float32) / half)
    ang = positions.astype(jnp.float32)[:, :, None, None] * inv
    cos, sin = jnp.cos(ang), jnp.sin(ang)
    xf = x.astype(jnp.float32)
    x1, x2 = xf[..., :half], xf[..., half:]
    return jnp.concatenate([x1 * cos - x2 * sin, x2 * cos + x1 * sin], axis=-1).astype(x.dtype)


def causal_conv(x, w, b):
    c = x.shape[-1]
    y = lax.conv_general_dilated(x, w[:, None, :].astype(x.dtype), window_strides=(1,),
                                 padding=((w.shape[0] - 1, 0),),
                                 dimension_numbers=('NWC', 'WIO', 'NWC'),
                                 feature_group_count=c)
    return y + b.astype(x.dtype)


def causal_attention_blocked(q, k, v, scale):
    B, H, S, dk = q.shape
    dv = v.shape[-1]
    nb = S // Q_BLOCK
    qb = q.reshape(B, H, nb, Q_BLOCK, dk).transpose(2, 0, 1, 3, 4)
    k_pos = jnp.arange(S)

    def block(args):
        q_i, i = args
        s = jnp.einsum('bhqd,bhkd->bhqk', q_i, k).astype(jnp.float32) * scale
        q_pos = i * Q_BLOCK + jnp.arange(Q_BLOCK)
        s = jnp.where(k_pos[None, :] <= q_pos[:, None], s, -jnp.inf)
        pr = jax.nn.softmax(s, axis=-1)
        return jnp.einsum('bhqk,bhkd->bhqd', pr.astype(v.dtype), v)

    o = lax.map(block, (qb, jnp.arange(nb)))
    return o.transpose(1, 2, 0, 3, 4).reshape(B, H, S, dv)


def diff_attention_blocked(q, k, v, lam, scale):
    B, H, _, S, d = q.shape
    dv = v.shape[-1]
    nb = S // Q_BLOCK
    qb = q.reshape(B, H, 2, nb, Q_BLOCK, d).transpose(3, 0, 1, 2, 4, 5)
    k_pos = jnp.arange(S)

    def block(args):
        q_i, i = args
        s = jnp.einsum('bhmqd,bhmkd->bhmqk', q_i, k).astype(jnp.float32) * scale
        q_pos = i * Q_BLOCK + jnp.arange(Q_BLOCK)
        s = jnp.where(k_pos[None, :] <= q_pos[:, None], s, -jnp.inf)
        pr = jax.nn.softmax(s, axis=-1)
        a = pr[:, :, 0] - lam * pr[:, :, 1]
        return jnp.einsum('bhqk,bhkd->bhqd', a.astype(v.dtype), v)

    o = lax.map(block, (qb, jnp.arange(nb)))
    return o.transpose(1, 2, 0, 3, 4).reshape(B, H, S, dv)


def gla_chunked(q, k, v, log_f):
    B, H, S, dk = q.shape
    dv = v.shape[-1]
    nc = S // SCAN_CHUNK
    chunks = lambda t: t.reshape(B, H, nc, SCAN_CHUNK, t.shape[-1]).transpose(2, 0, 1, 3, 4)
    causal = jnp.tril(jnp.ones((SCAN_CHUNK, SCAN_CHUNK), dtype=bool))[None, None, :, :, None]

    def step(state, inp):
        qc, kc, vc, gc = inp
        b = jnp.cumsum(gc, axis=2)
        inter = jnp.einsum('bhtd,bhde->bhte', qc * jnp.exp(b), state)
        rel = b[:, :, :, None, :] - b[:, :, None, :, :]
        decay = jnp.exp(jnp.where(causal, rel, -jnp.inf))
        scores = jnp.einsum('bhtd,bhsd,bhtsd->bhts', qc, kc, decay)
        intra = jnp.einsum('bhts,bhse->bhte', scores, vc)
        b_last = b[:, :, -1:, :]
        new_state = (jnp.exp(b_last[:, :, 0, :])[..., None] * state
                     + jnp.einsum('bhsd,bhse->bhde', kc * jnp.exp(b_last - b), vc))
        return new_state, inter + intra

    state0 = jnp.zeros((B, H, dk, dv), jnp.float32)
    _, o = lax.scan(step, state0, (chunks(q), chunks(k), chunks(v), chunks(log_f)))
    return o.transpose(1, 2, 0, 3, 4).reshape(B, H, S, dv)


def mlstm_chunked(q, k, v, log_i, log_f):
    B, H, S, dqk = q.shape
    dv = v.shape[-1]
    nc = S // SCAN_CHUNK
    chunks4 = lambda t: t.reshape(B, H, nc, SCAN_CHUNK, t.shape[-1]).transpose(2, 0, 1, 3, 4)
    chunks3 = lambda t: t.reshape(B, H, nc, SCAN_CHUNK).transpose(2, 0, 1, 3)
    causal = jnp.tril(jnp.ones((SCAN_CHUNK, SCAN_CHUNK), dtype=bool))[None, None]

    def step(carry, inp):
        c_st, n_st, m_st = carry
        qc, kc, vc, lic, lfc = inp
        b = jnp.cumsum(lfc, axis=-1)
        dmat = jnp.where(causal, b[..., :, None] - b[..., None, :] + lic[..., None, :], -jnp.inf)
        inter_log = b + m_st[..., None]
        m_t = jnp.maximum(inter_log, jnp.max(dmat, axis=-1))
        w_intra = jnp.exp(dmat - m_t[..., None])
        w_inter = jnp.exp(inter_log - m_t)
        s = jnp.einsum('bhtd,bhsd->bhts', qc, kc) * w_intra
        num = (w_inter[..., None] * jnp.einsum('bhtd,bhde->bhte', qc, c_st)
               + jnp.einsum('bhts,bhse->bhte', s, vc))
        den = w_inter * jnp.einsum('bhtd,bhd->bht', qc, n_st) + jnp.sum(s, axis=-1)
        h = num / jnp.maximum(jnp.abs(den), jnp.exp(-m_t))[..., None]
        b_last = b[..., -1]
        log_s = b_last[..., None] - b + lic
        m_new = jnp.maximum(b_last + m_st, jnp.max(log_s, axis=-1))
        carry_scale = jnp.exp(b_last + m_st - m_new)
        ws = jnp.exp(log_s - m_new[..., None])
        c_new = carry_scale[..., None, None] * c_st + jnp.einsum('bhs,bhsd,bhse->bhde', ws, kc, vc)
        n_new = carry_scale[..., None] * n_st + jnp.einsum('bhs,bhsd->bhd', ws, kc)
        return (c_new, n_new, m_new), h

    carry0 = (jnp.zeros((B, H, dqk, dv), jnp.float32),
              jnp.zeros((B, H, dqk), jnp.float32),
              jnp.zeros((B, H), jnp.float32))
    _, o = lax.scan(step, carry0, (chunks4(q), chunks4(k), chunks4(v), chunks3(log_i), chunks3(log_f)))
    return o.transpose(1, 2, 0, 3, 4).reshape(B, H, S, dv)


def diff_mixer(z_q, z_k, z_v, lam_vecs, norm_g, lambda_init):
    B, S, _ = z_q.shape
    qk_heads = lambda a: a.reshape(B, S, DIFF_HEADS, 2, DIFF_QK).transpose(0, 2, 3, 1, 4)
    v = z_v.reshape(B, S, DIFF_HEADS, DIFF_V).transpose(0, 2, 1, 3)
    lv = lam_vecs.astype(jnp.float32)
    lam = jnp.exp(jnp.sum(lv[0] * lv[1])) - jnp.exp(jnp.sum(lv[2] * lv[3])) + lambda_init
    o = diff_attention_blocked(qk_heads(z_q), qk_heads(z_k), v, lam, DIFF_QK ** -0.5)
    o = head_rmsnorm(o.transpose(0, 2, 1, 3), norm_g) * (1.0 - lambda_init)
    return o.reshape(B, S, DIFF_WIDTH)


def hgrn2_mixer(z_q, z_f, z_v, z_g, lb, norm_g):
    B, S, _ = z_q.shape
    heads = lambda a, d: a.reshape(B, S, HGRN_HEADS, d).transpose(0, 2, 1, 3).astype(jnp.float32)
    q = heads(z_q, HGRN_DK) * HGRN_DK ** -0.5
    zf = heads(z_f, HGRN_DK)
    lb_h = lb.reshape(HGRN_HEADS, 1, HGRN_DK)
    k = (1.0 - lb_h) * jax.nn.sigmoid(-zf)
    log_f = jnp.logaddexp(jnp.log(lb_h), jnp.log1p(-lb_h) + jax.nn.log_sigmoid(zf))
    v = heads(z_v, HGRN_DV)
    o = gla_chunked(q, k, v, log_f).transpose(0, 2, 1, 3)
    g = jax.nn.silu(z_g.reshape(B, S, HGRN_HEADS, HGRN_DV).astype(jnp.float32))
    return (head_rmsnorm(o, norm_g) * g).reshape(B, S, HGRN_WIDTH)


def mla_mixer(z_cq, z_ckv, z_kr, q_norm, kv_norm, w_uq, w_ukv, positions):
    B, S, _ = z_cq.shape
    q = (rmsnorm(z_cq, q_norm) @ w_uq).reshape(B, S, MLA_HEADS, MLA_NOPE + MLA_ROPE)
    q = jnp.concatenate([q[..., :MLA_NOPE], rope(q[..., MLA_NOPE:], positions)], axis=-1)
    kv = (rmsnorm(z_ckv, kv_norm) @ w_ukv).reshape(B, S, MLA_HEADS, MLA_NOPE + MLA_V)
    k_rope = jnp.broadcast_to(rope(z_kr[:, :, None, :], positions), (B, S, MLA_HEADS, MLA_ROPE))
    k = jnp.concatenate([kv[..., :MLA_NOPE], k_rope], axis=-1)
    v = kv[..., MLA_NOPE:]
    t = lambda a: a.transpose(0, 2, 1, 3)
    o = causal_attention_blocked(t(q), t(k), t(v), (MLA_NOPE + MLA_ROPE) ** -0.5)
    return t(o).reshape(B, S, MLA_WIDTH)


def mlstm_mixer(z_q, z_k, z_v, z_i, z_f, z_o, conv_w, conv_b, gate_b, norm_g):
    B, S, _ = z_q.shape
    hw = MLSTM_HEADS * MLSTM_DQK
    qk = jax.nn.silu(causal_conv(jnp.concatenate([z_q, z_k], axis=-1), conv_w, conv_b)).astype(jnp.float32)
    heads = lambda a, d: a.reshape(B, S, MLSTM_HEADS, d).transpose(0, 2, 1, 3).astype(jnp.float32)
    q = heads(qk[..., :hw], MLSTM_DQK) * MLSTM_DQK ** -0.5
    k = heads(qk[..., hw:], MLSTM_DQK)
    v = heads(z_v, MLSTM_DV)
    gb = gate_b.astype(jnp.float32)
    log_i = (z_i.astype(jnp.float32) + gb[0]).transpose(0, 2, 1)
    log_f = jax.nn.log_sigmoid(z_f.astype(jnp.float32) + gb[1]).transpose(0, 2, 1)
    h = mlstm_chunked(q, k, v, log_i, log_f).transpose(0, 2, 1, 3)
    o = jax.nn.sigmoid(z_o.reshape(B, S, MLSTM_HEADS, MLSTM_DV).astype(jnp.float32))
    return (head_rmsnorm(h, norm_g) * o).reshape(B, S, MLSTM_WIDTH)


def peer_ffn(h, w_q, subkeys, u_tab, v_tab):
    B, S, D = h.shape
    T = B * S
    xt = h.reshape(T, D)
    q = (xt @ w_q).reshape(T, PEER_HEADS, 2, PEER_KEY_DIM)
    scores = jnp.einsum('thcd,hckd->thck', q, subkeys).astype(jnp.float32)
    s_top, i_top = lax.top_k(scores, PEER_TOPK)
    cand = (s_top[:, :, 0, :, None] + s_top[:, :, 1, None, :]).reshape(T, PEER_HEADS, PEER_TOPK * PEER_TOPK)
    cand_idx = (i_top[:, :, 0, :, None] * PEER_N_KEYS + i_top[:, :, 1, None, :]).reshape(T, PEER_HEADS, PEER_TOPK * PEER_TOPK)
    best, pos = lax.top_k(cand, PEER_TOPK)
    idx = jnp.take_along_axis(cand_idx, pos, axis=-1)
    gates = jax.nn.softmax(best, axis=-1)
    nb = T // PEER_TOKEN_BLOCK

    def block(args):
        xb, ib, gb = args
        act = jax.nn.gelu(jnp.einsum('td,ted->te', xb, u_tab[ib]).astype(jnp.float32), approximate=False)
        return jnp.einsum('te,ted->td', (gb * act).astype(xb.dtype), v_tab[ib])

    y = lax.map(block, (xt.reshape(nb, PEER_TOKEN_BLOCK, D),
                        idx.reshape(nb, PEER_TOKEN_BLOCK, PEER_HEADS * PEER_TOPK),
                        gates.reshape(nb, PEER_TOKEN_BLOCK, PEER_HEADS * PEER_TOPK)))
    return y.reshape(B, S, D)


def setup_inputs(seed: int = 0) -> dict:
    key = jax.random.key(seed)
    ks = jax.random.split(key, 32)
    f32 = jnp.float32
    L = DEPTH

    def nrm(k, shape, scale):
        return scale * jax.random.normal(k, shape, f32)

    def gain(k, shape):
        return 1.0 + 0.1 * jax.random.normal(k, shape, f32)

    positions = (jax.random.randint(ks[2], (BATCH, 1), 0, 4096, dtype=jnp.int32)
                 + jnp.arange(SEQ, dtype=jnp.int32)[None, :])
    mlstm_gate_b = jnp.stack([nrm(ks[15], (L, MLSTM_HEADS), 0.1),
                              3.0 + nrm(ks[16], (L, MLSTM_HEADS), 0.5)], axis=1)
    return {
        'x': nrm(ks[0], (BATCH, SEQ, D_MODEL), 1.0),
        'p': nrm(ks[1], (DEPTH, BATCH, SEQ, PLE_DIM), 1.0),
        'positions': positions,
        'ln_mix': gain(ks[3], (L, D_MODEL)),
        'w_in': nrm(ks[4], (L, D_MODEL, IN_COLS), D_MODEL ** -0.5),
        'diff_lambda': nrm(ks[5], (L, 4, DIFF_QK), 0.1),
        'diff_norm': gain(ks[6], (L, DIFF_WIDTH)),
        'hgrn_lb_logits': nrm(ks[7], (L, HGRN_HEADS * HGRN_DK), 0.1),
        'hgrn_norm': gain(ks[8], (L, HGRN_WIDTH)),
        'mla_q_norm': gain(ks[9], (L, MLA_Q_RANK)),
        'mla_kv_norm': gain(ks[10], (L, MLA_KV_RANK)),
        'mla_w_uq': nrm(ks[11], (L, MLA_Q_RANK, MLA_HEADS * (MLA_NOPE + MLA_ROPE)), MLA_Q_RANK ** -0.5),
        'mla_w_ukv': nrm(ks[12], (L, MLA_KV_RANK, MLA_HEADS * (MLA_NOPE + MLA_V)), MLA_KV_RANK ** -0.5),
        'mlstm_conv_w': nrm(ks[13], (L, MLSTM_CONV, 2 * MLSTM_HEADS * MLSTM_DQK), MLSTM_CONV ** -0.5),
        'mlstm_conv_b': nrm(ks[14], (L, 2 * MLSTM_HEADS * MLSTM_DQK), 0.01),
        'mlstm_gate_b': mlstm_gate_b,
        'mlstm_norm': gain(ks[17], (L, MLSTM_WIDTH)),
        'group_gain': gain(ks[18], (L, D_MIX)),
        'w_out': nrm(ks[19], (L, D_MIX, D_MODEL), D_MIX ** -0.5),
        'ln_ffn': gain(ks[20], (L, D_MODEL)),
        'peer_w_q': nrm(ks[21], (L, D_MODEL, PEER_HEADS * 2 * PEER_KEY_DIM), D_MODEL ** -0.5),
        'peer_subkeys': nrm(ks[22], (L, PEER_HEADS, 2, PEER_N_KEYS, PEER_KEY_DIM), PEER_KEY_DIM ** -0.5),
        'peer_u': nrm(ks[23], (L, PEER_N_EXPERTS, D_MODEL), D_MODEL ** -0.5),
        'peer_v': nrm(ks[24], (L, PEER_N_EXPERTS, D_MODEL), 0.25),
        'ln_ple': gain(ks[25], (L, D_MODEL)),
        'ple_w_gate': nrm(ks[26], (L, D_MODEL, D_MODEL), D_MODEL ** -0.5),
        'ple_w_proj': nrm(ks[27], (L, PLE_DIM, D_MODEL), PLE_DIM ** -0.5),
        'ln_final': gain(ks[28], (D_MODEL,)),
    }


def reference(x, p, positions, ln_mix, w_in, diff_lambda, diff_norm, hgrn_lb_logits, hgrn_norm,
              mla_q_norm, mla_kv_norm, mla_w_uq, mla_w_ukv, mlstm_conv_w, mlstm_conv_b, mlstm_gate_b,
              mlstm_norm, group_gain, w_out, ln_ffn, peer_w_q, peer_subkeys, peer_u, peer_v,
              ln_ple, ple_w_gate, ple_w_proj, ln_final):
    lbs = jnp.cumsum(jax.nn.softmax(hgrn_lb_logits.astype(jnp.float32), axis=0), axis=0)
    lbs = lbs - lbs[:1]
    split_at = np.cumsum(IN_SIZES)[:-1].tolist()
    h = x
    for i in range(DEPTH):
        hn = rmsnorm(h, ln_mix[i])
        z = hn @ w_in[i]
        (d_q, d_k, d_v, g_q, g_f, g_v, g_g, m_cq, m_ckv, m_kr,
         l_q, l_k, l_v, l_i, l_f, l_o) = jnp.split(z, split_at, axis=-1)
        lambda_init = 0.8 - 0.6 * math.exp(-0.3 * i)
        y_diff = diff_mixer(d_q, d_k, d_v, diff_lambda[i], diff_norm[i], lambda_init)
        y_hgrn = hgrn2_mixer(g_q, g_f, g_v, g_g, lbs[i], hgrn_norm[i])
        y_mla = mla_mixer(m_cq, m_ckv, m_kr, mla_q_norm[i], mla_kv_norm[i], mla_w_uq[i], mla_w_ukv[i], positions)
        y_mlstm = mlstm_mixer(l_q, l_k, l_v, l_i, l_f, l_o, mlstm_conv_w[i], mlstm_conv_b[i],
                              mlstm_gate_b[i], mlstm_norm[i])
        y = jnp.concatenate([y_diff, y_hgrn, y_mla, y_mlstm], axis=-1).astype(x.dtype) * group_gain[i]
        h = h + y @ w_out[i]
        h = h + peer_ffn(rmsnorm(h, ln_ffn[i]), peer_w_q[i], peer_subkeys[i], peer_u[i], peer_v[i])
        gate = jax.nn.sigmoid(rmsnorm(h, ln_ple[i]) @ ple_w_gate[i])
        h = h + gate * (p[i] @ ple_w_proj[i])
    return rmsnorm(h, ln_final)
```

```cpp
#include <hip/hip_runtime.h>
#include <cstdio>
#include <cstdint>

#define GAS __attribute__((address_space(1)))
#define LAS __attribute__((address_space(3)))
typedef unsigned short bf16_t;
typedef short bf16x8 __attribute__((ext_vector_type(8)));
typedef float f32x4 __attribute__((ext_vector_type(4)));
typedef unsigned u32x4 __attribute__((ext_vector_type(4)));
typedef unsigned u32x2 __attribute__((ext_vector_type(2)));
typedef float f32x2_t __attribute__((ext_vector_type(2)));
typedef float v16f_t __attribute__((ext_vector_type(16)));
typedef float v32f_t __attribute__((ext_vector_type(32)));
typedef unsigned v6u_t __attribute__((ext_vector_type(6)));
constexpr int EROW = 1536;
constexpr int VROW = 1024;

constexpr int D = 2048, BATCH = 4, SEQ = 2048, T = BATCH * SEQ, DEPTH = 4, PLE = 256;
constexpr int IN_COLS = 5832, NZ = 5888;
constexpr int ZC_DQ = 0, ZC_DK = 512, ZC_DV = 1024, ZC_GQ = 1536, ZC_GF = 2048, ZC_GV = 2560, ZC_GG = 3072, ZC_MCQ = 3584, ZC_MCKV = 3968, ZC_MKR = 4224,
              ZC_LQ = 4288, ZC_LK = 4544, ZC_LV = 4800, ZC_LO = 5312, ZC_LI = 5824, ZC_LF = 5828;
constexpr int NEXP = 16384;
constexpr float EPS = 1e-6f;
constexpr int NWAVES = 8, NTHREADS = 512;

constexpr size_t MiB = 1u << 20;
constexpr size_t al(size_t x) { return (x + 255) & ~(size_t)255; }
constexpr size_t WS_CTL = 0, CTL_BYTES = 2 * MiB;
constexpr size_t CTL_BAR = 0;
constexpr size_t CTL_CVQ = 32 * 1024;
constexpr size_t CTL_SSQA = 64 * 1024;
constexpr size_t CTL_SSQB = CTL_SSQA + 5 * T * 8;
constexpr size_t CTL_MQS = CTL_SSQB + 4 * T * 8;
constexpr size_t CTL_MKVS = CTL_MQS + 4 * T * 8;
constexpr size_t CTL_SSQC = CTL_MKVS + 4 * T * 8;
static_assert(CTL_SSQC + 4 * T * 4 <= 1536 * 1024, "ctl");
constexpr size_t WS_WIN = CTL_BYTES;
constexpr size_t WS_WOUT = WS_WIN + al((size_t)DEPTH * NZ * D * 2);
constexpr size_t WS_WQ = WS_WOUT + al((size_t)DEPTH * D * D * 2);
constexpr size_t WS_WG = WS_WQ + al((size_t)DEPTH * D * D * 2);
constexpr size_t WS_WP = WS_WG + al((size_t)DEPTH * D * D * 2);
constexpr size_t WS_WUQ = WS_WP + al((size_t)DEPTH * D * PLE * 2);
constexpr size_t WS_WUKV = WS_WUQ + al((size_t)DEPTH * 768 * 384 * 2);
constexpr size_t WS_UB = WS_WUKV + al((size_t)DEPTH * 1024 * 256 * 2);
constexpr size_t WS_VB = WS_UB + al((size_t)DEPTH * NEXP * D * 2);
constexpr size_t WS_PB = WS_VB + al((size_t)DEPTH * NEXP * D * 2);
constexpr size_t WS_CS = WS_PB + al((size_t)DEPTH * T * PLE * 2);
constexpr size_t WS_LBS = WS_CS + al((size_t)T * 32 * 2 * 4);
constexpr size_t WS_H = WS_LBS + al((size_t)DEPTH * 512 * 4);
constexpr size_t WS_HB = WS_H + al((size_t)T * D * 4);
constexpr size_t WS_Z = WS_HB + 2 * al((size_t)T * D * 2);
constexpr size_t WS_QM = WS_Z + al((size_t)T * NZ * 2);
constexpr size_t WS_KVM = WS_QM + al((size_t)T * 768 * 2);
constexpr size_t WS_KRM = WS_KVM + al((size_t)T * 1024 * 2);
constexpr size_t WS_Y = WS_KRM + al((size_t)T * 64 * 2);
constexpr size_t WS_QP = WS_Y + al((size_t)T * D * 2);
constexpr size_t WS_QB = WS_QP;
constexpr size_t WS_PR = WS_QP + al((size_t)T * D * 4);
constexpr size_t WS_PIDX = WS_PR + al((size_t)T * D * 4);
constexpr size_t WS_PGATE = WS_PIDX + al((size_t)T * 128 * 4);
constexpr size_t WS_GQ = WS_PGATE + al((size_t)T * 128 * 4);
constexpr size_t WS_GK = WS_GQ + al((size_t)T * 512 * 4);
constexpr size_t WS_GF = WS_GK + al((size_t)T * 512 * 4);
constexpr size_t WS_OG = WS_GF + al((size_t)T * 512 * 4);
constexpr size_t WS_LQK = WS_OG + al((size_t)T * 512 * 4);
constexpr size_t WS_LIF = WS_LQK + al((size_t)T * 512 * 4);
constexpr size_t WS_OL = WS_LIF + al((size_t)T * 8 * 4);
constexpr size_t WS_O1 = WS_OL + al((size_t)T * 512 * 4);
constexpr size_t WS_PRM = WS_O1 + al((size_t)T * 512 * 4);
constexpr int PRM_L = 4608, PRM_CW = 0, PRM_CB = 2048, PRM_GB = 2560, PRM_DL = 2576, PRM_DN = 2832, PRM_HN = 3344, PRM_MN = 3856, PRM_FIN = DEPTH * PRM_L;
constexpr size_t WS_SKB = WS_PRM + al((size_t)(PRM_FIN + D) * 4);
constexpr size_t WS_SU = WS_SKB + al((size_t)DEPTH * 8 * 2 * 128 * 128 * 2);
constexpr size_t WS_SV = WS_SU + al((size_t)DEPTH * NEXP * 4);
constexpr int NSEG = 2, SEGC = SEQ / 64 / NSEG;
constexpr size_t WS_QTG = WS_SV + al((size_t)DEPTH * NEXP * 4);
constexpr size_t WS_QTL = WS_QTG + al((size_t)16 * SEQ * 128 * 2);
constexpr size_t WS_SCL = WS_QTL + al((size_t)16 * SEQ * 64 * 2);
constexpr size_t WS_SIB = WS_SCL + al((size_t)16 * SEQ * 4 * 4);
constexpr size_t WS_SIF = WS_SIB + al((size_t)2 * 16 * NSEG * 128 * 128 * 2);
constexpr size_t WS_SIM = WS_SIF + al((size_t)2 * 16 * NSEG * 128 * 128 * 4);
constexpr size_t WS_END = WS_SIM + al((size_t)16 * NSEG * 128 * 4);
constexpr size_t CTL_SEGF = 1536 * 1024;
static_assert(CTL_SEGF + DEPTH * 2 * 16 * NSEG * 64 <= CTL_BYTES, "ctl segf");

typedef float f32x2v_t __attribute__((ext_vector_type(2)));
typedef __bf16 bf16x2v_t __attribute__((ext_vector_type(2)));
__device__ __forceinline__ unsigned pk2(float lo, float hi) { const bf16x2v_t r = __builtin_convertvector((f32x2v_t){lo, hi}, bf16x2v_t); return __builtin_bit_cast(unsigned, r); }
__device__ __forceinline__ unsigned f2bf(float f) { return pk2(f, 0.f) & 0xffffu; }
__device__ __forceinline__ float bf2f(unsigned short b) { return __builtin_bit_cast(float, ((unsigned)b) << 16); }
__device__ __forceinline__ float bflo(unsigned w) { return __builtin_bit_cast(float, w << 16); }
__device__ __forceinline__ float bfhi(unsigned w) { return __builtin_bit_cast(float, w & 0xffff0000u); }
#define DPP_F(v, ctrl) __builtin_bit_cast(float, __builtin_amdgcn_update_dpp(0, __builtin_bit_cast(int, (v)), (ctrl), 0xF, 0xF, false))
__device__ __forceinline__ float rdlane_f(float v, int l) { return __builtin_bit_cast(float, __builtin_amdgcn_readlane(__builtin_bit_cast(int, v), l)); }
__device__ __forceinline__ float wave_sum(float v) {
    v += DPP_F(v, 0xB1); v += DPP_F(v, 0x4E); v += DPP_F(v, 0x141); v += DPP_F(v, 0x140);
    return (rdlane_f(v, 0) + rdlane_f(v, 16)) + (rdlane_f(v, 32) + rdlane_f(v, 48));
}
__device__ __forceinline__ float wave_max(float v) {
    v = fmaxf(v, DPP_F(v, 0xB1)); v = fmaxf(v, DPP_F(v, 0x4E)); v = fmaxf(v, DPP_F(v, 0x141)); v = fmaxf(v, DPP_F(v, 0x140));
    return fmaxf(fmaxf(rdlane_f(v, 0), rdlane_f(v, 16)), fmaxf(rdlane_f(v, 32), rdlane_f(v, 48)));
}
__device__ __forceinline__ int bperm_i(int src, int v) { return __builtin_amdgcn_ds_bpermute(src << 2, v); }
__device__ __forceinline__ float bperm_f(int src, float v) { return __builtin_bit_cast(float, __builtin_amdgcn_ds_bpermute(src << 2, __builtin_bit_cast(int, v))); }
typedef unsigned long long u64;
__device__ __forceinline__ int lane_id_fresh() { int l; asm volatile("v_mbcnt_lo_u32_b32 %0, -1, 0\n\tv_mbcnt_hi_u32_b32 %0, -1, %0" : "=v"(l)); return l; }
__device__ __forceinline__ void ssq_add(u64* p, float s) { atomicAdd(p, (u64)(s * 16777216.f)); }
__device__ __forceinline__ float ssq_get(const u64* p) { return (float)(*p) * (1.f / 16777216.f); }
__device__ __forceinline__ float rcpf_(float x) { return __builtin_amdgcn_rcpf(x); }
__device__ __forceinline__ float sigmoidf_(float x) { return rcpf_(1.f + __expf(-x)); }

namespace pg8 {
constexpr int BM = 256, BK = 64, HALF = 128, HTB = HALF * BK * 2, STAGE_BYTES = 8 * HTB, NXCD = 8, WGM = 8;
__host__ __device__ __forceinline__ int lds_byte(int r, int c) { const int st = (r >> 4) * 2 + (c >> 5), rr = r & 15, cc = c & 31, ob = rr * 64 + cc * 2; return st * 1024 + (ob ^ (((ob >> 9) & 1) << 5)); }
__host__ __device__ __forceinline__ void stage_rc(int b, int& R, int& C) { const int st = b / 1024, sb = b % 1024, swz = sb ^ (((sb >> 9) & 1) << 5); R = (st >> 1) * 16 + swz / 64; C = (st & 1) * 32 + (swz % 64) / 2; }
__host__ __device__ __forceinline__ int perm32(int rho) { const int n = rho >> 4, i = rho & 15; return 8 * (i >> 2) + 4 * n + (i & 3); }
struct Unit { int pm, pn; };
struct Gemm { const bf16_t* A; const bf16_t* Bt; int M, N, K, lda, ldb; };
struct StaticOrder {
    int nM, nN, nwg, G, c;
    __host__ __device__ void init(int M, int N, int G_, int c_) { nM = M / BM; nN = N / BM; nwg = nM * nN; G = G_; c = c_; }
    __host__ __device__ bool next(int i, Unit& u) const {
        const long L = (long)i * G + c; if (L >= nwg) return false;
        int wgid = (int)L; { const int q = nwg / NXCD, r = nwg % NXCD, xcd = wgid % NXCD, off = wgid / NXCD; wgid = (xcd < r ? xcd * (q + 1) : r * (q + 1) + (xcd - r) * q) + off; }
        const int nig = WGM * nN, gid = wgid / nig, fm = gid * WGM, gsz = (nM - fm) < WGM ? (nM - fm) : WGM;
        u.pm = fm + ((wgid % nig) % gsz); u.pn = (wgid % nig) / gsz; return true;
    }
    __device__ __forceinline__ void a_ready(const Unit&) const {}
    __device__ __forceinline__ void done(const Unit&) const {}
};
template <class Epi, class Sched, bool ALIGN_EPI = false, bool SP2 = false>
__device__ __forceinline__ void gemm_phase(LAS unsigned char* lds, const Gemm g, const Sched& S, const Epi& E, int wave_s) {
    const int tid = wave_s * 64 + lane_id_fresh(), wid = wave_s, lane = tid & 63, wr = wid >> 2, wc = wid & 3, fr = lane & 15, fq = lane >> 4;
    const int K = g.K, nt = K / BK;
    unsigned voffA[2], voffB[2];
#pragma unroll
    for (int i = 0; i < 2; ++i) { int R, C; stage_rc(tid * 16 + i * 8192, R, C); const int Rb = Epi::PERM ? ((R & ~31) + perm32(R & 31)) : R;
        voffA[i] = (unsigned)(R * g.lda + C) * 2u; voffB[i] = (unsigned)(Rb * g.ldb + C) * 2u; }
    const size_t kstep = (size_t)(BK * 2);
    const size_t hstepA = (size_t)HALF * g.lda * 2, hstepB = (size_t)HALF * g.ldb * 2;
    const size_t tstepA = 2 * hstepA, tstepB = 2 * hstepB;
    const unsigned ldsw = (unsigned)wid * 1024u;
    const int aoff = lds_byte(wr * 64 + fr, fq * 8), boff = lds_byte(wc * 32 + fr, fq * 8);
#define PG8_SA(b, h) (((b) * 2 + (h)) * HTB)
#define PG8_SB(b, h) ((4 + (b) * 2 + (h)) * HTB)
#define PG8_STAGE(bufoff, gbase, voff) do { _Pragma("unroll") for (int _i = 0; _i < 2; ++_i) \
        __builtin_amdgcn_global_load_lds((const unsigned*)((const char*)(gbase) + (voff)[_i]), (LAS unsigned*)(lds + (bufoff) + ldsw + _i * 8192), 16, 0, 0); } while (0)
#define PG8_LDA(dst, b, h) do { _Pragma("unroll") for (int m = 0; m < 4; ++m) _Pragma("unroll") for (int k = 0; k < 2; ++k) dst[m][k] = *(const LAS bf16x8*)(lds + PG8_SA(b, h) + aoff + m * 2048 + k * 1024); } while (0)
#define PG8_LDB(dst, b, h) do { _Pragma("unroll") for (int n = 0; n < 2; ++n) _Pragma("unroll") for (int k = 0; k < 2; ++k) dst[n][k] = *(const LAS bf16x8*)(lds + PG8_SB(b, h) + boff + n * 2048 + k * 1024); } while (0)
#define PG8_MMA(ai, bj, At, Bt) do { __builtin_amdgcn_s_setprio(1); _Pragma("unroll") for (int m = 0; m < 4; ++m) _Pragma("unroll") for (int n = 0; n < 2; ++n) _Pragma("unroll") for (int k = 0; k < 2; ++k) \
        acc[ai][bj][m][n] = __builtin_amdgcn_mfma_f32_16x16x32_bf16(Bt[n][k], At[m][k], acc[ai][bj][m][n], 0, 0, 0); __builtin_amdgcn_s_setprio(0); } while (0)
#define PG8_WAIT_V(n) asm volatile("s_waitcnt vmcnt(" #n ")" ::: "memory")
#define PG8_WAIT_L(n) asm volatile("s_waitcnt lgkmcnt(" #n ")" ::: "memory")
#define PG8_BAR __builtin_amdgcn_s_barrier()
#define PG8_SCHED __builtin_amdgcn_sched_barrier(0)
    Unit cur, nxt; int ui = 0;
    if (!S.next(0, cur)) return;
    f32x4 acc[2][2][4][2];
#pragma unroll
    for (int a = 0; a < 2; ++a)
#pragma unroll
        for (int b = 0; b < 2; ++b)
#pragma unroll
            for (int m = 0; m < 4; ++m)
#pragma unroll
                for (int n = 0; n < 2; ++n) acc[a][b][m][n] = (f32x4){0.f, 0.f, 0.f, 0.f};
    bf16x8 At[4][2], B0[2][2], B1[2][2];
    const char* cA = (const char*)g.A + (size_t)cur.pm * tstepA; const char* cB = (const char*)g.Bt + (size_t)cur.pn * tstepB;
    S.a_ready(cur);
    if constexpr (SP2) {
        PG8_STAGE(PG8_SB(0, 0), cB, voffB); PG8_STAGE(PG8_SB(0, 1), cB + hstepB, voffB); PG8_STAGE(PG8_SA(0, 0), cA, voffA); PG8_STAGE(PG8_SA(0, 1), cA + hstepA, voffA);
        if (wr == 1) PG8_BAR;
        PG8_WAIT_V(2); PG8_BAR;
        PG8_STAGE(PG8_SB(1, 0), cB + kstep, voffB); PG8_STAGE(PG8_SA(1, 0), cA + kstep, voffA); PG8_STAGE(PG8_SB(1, 1), cB + hstepB + kstep, voffB);
        PG8_WAIT_V(6); PG8_BAR;
    } else {
        PG8_STAGE(PG8_SB(0, 0), cB, voffB); PG8_STAGE(PG8_SA(0, 0), cA, voffA); PG8_STAGE(PG8_SB(0, 1), cB + hstepB, voffB); PG8_STAGE(PG8_SA(0, 1), cA + hstepA, voffA);
        if (wr == 1) PG8_BAR;
        PG8_WAIT_V(4); PG8_BAR;
        PG8_STAGE(PG8_SB(1, 0), cB + kstep, voffB); PG8_STAGE(PG8_SA(1, 0), cA + kstep, voffA); PG8_STAGE(PG8_SB(1, 1), cB + hstepB + kstep, voffB);
        PG8_WAIT_V(6); PG8_BAR;
    }
    for (;;) {
        const bool has_next = S.next(ui + 1, nxt);
        const char* nA = has_next ? (const char*)g.A + (size_t)nxt.pm * tstepA : cA; const char* nB = has_next ? (const char*)g.Bt + (size_t)nxt.pn * tstepB : cB;
        for (int t = 0; t < nt; t += 2) {
            const bool last = (t == nt - 2);
            const char* a1 = cA + (size_t)(t + 1) * kstep;
            const char* a2 = last ? nA : cA + (size_t)(t + 2) * kstep; const char* b2 = last ? nB : cB + (size_t)(t + 2) * kstep;
            const char* a3 = a2 + kstep; const char* b3 = b2 + kstep;
            if (last && has_next) S.a_ready(nxt);
            if constexpr (SP2) {
            PG8_LDB(B0, 0, 0); PG8_LDB(B1, 0, 1); PG8_SCHED; PG8_LDA(At, 0, 0); PG8_STAGE(PG8_SA(1, 1), a1 + hstepA, voffA);
            PG8_WAIT_V(8); PG8_WAIT_L(0); PG8_BAR; PG8_MMA(0, 0, At, B0); PG8_MMA(0, 1, At, B1); PG8_BAR; PG8_SCHED;
            PG8_LDA(At, 0, 1); PG8_STAGE(PG8_SB(0, 0), b2, voffB); PG8_STAGE(PG8_SB(0, 1), b2 + hstepB, voffB); PG8_STAGE(PG8_SA(0, 0), a2, voffA);
            PG8_WAIT_V(8); PG8_WAIT_L(0); PG8_BAR; PG8_MMA(1, 0, At, B0); PG8_MMA(1, 1, At, B1); PG8_BAR; PG8_SCHED;
            PG8_LDB(B0, 1, 0); PG8_LDB(B1, 1, 1); PG8_SCHED; PG8_LDA(At, 1, 0); PG8_STAGE(PG8_SA(0, 1), a2 + hstepA, voffA);
            PG8_WAIT_V(8); PG8_WAIT_L(0); PG8_BAR; PG8_MMA(0, 0, At, B0); PG8_MMA(0, 1, At, B1); PG8_BAR; PG8_SCHED;
            PG8_LDA(At, 1, 1); PG8_STAGE(PG8_SB(1, 0), b3, voffB); PG8_STAGE(PG8_SB(1, 1), b3 + hstepB, voffB); PG8_STAGE(PG8_SA(1, 0), a3, voffA);
            PG8_WAIT_V(8); PG8_WAIT_L(0); PG8_BAR; PG8_MMA(1, 0, At, B0); PG8_MMA(1, 1, At, B1); PG8_BAR; PG8_SCHED;
            } else {
            PG8_LDB(B0, 0, 0); PG8_SCHED; PG8_LDA(At, 0, 0); PG8_STAGE(PG8_SA(1, 1), a1 + hstepA, voffA);
            PG8_WAIT_L(8); PG8_BAR; PG8_WAIT_L(0); PG8_MMA(0, 0, At, B0); PG8_BAR; PG8_SCHED;
            PG8_LDB(B1, 0, 1); PG8_STAGE(PG8_SB(0, 0), b2, voffB);
            PG8_BAR; PG8_WAIT_L(0); PG8_MMA(0, 1, At, B1); PG8_BAR;
            PG8_LDA(At, 0, 1); PG8_STAGE(PG8_SA(0, 0), a2, voffA);
            PG8_BAR; PG8_WAIT_L(0); PG8_MMA(1, 0, At, B0); PG8_BAR; PG8_SCHED;
            PG8_STAGE(PG8_SB(0, 1), b2 + hstepB, voffB);
            PG8_WAIT_V(6); PG8_BAR; PG8_MMA(1, 1, At, B1); PG8_BAR;
            PG8_LDB(B0, 1, 0); PG8_SCHED; PG8_LDA(At, 1, 0); PG8_STAGE(PG8_SA(0, 1), a2 + hstepA, voffA);
            PG8_WAIT_L(8); PG8_BAR; PG8_WAIT_L(0); PG8_MMA(0, 0, At, B0); PG8_BAR; PG8_SCHED;
            PG8_LDB(B1, 1, 1); PG8_STAGE(PG8_SB(1, 0), b3, voffB);
            PG8_BAR; PG8_WAIT_L(0); PG8_MMA(0, 1, At, B1); PG8_BAR;
            PG8_LDA(At, 1, 1); PG8_STAGE(PG8_SA(1, 0), a3, voffA);
            PG8_BAR; PG8_WAIT_L(0); PG8_MMA(1, 0, At, B0); PG8_BAR; PG8_SCHED;
            PG8_STAGE(PG8_SB(1, 1), b3 + hstepB, voffB);
            PG8_WAIT_V(6); PG8_BAR; PG8_MMA(1, 1, At, B1); PG8_BAR;
            }
        }
        if constexpr (ALIGN_EPI) { if (wr == 0) PG8_BAR; }
        if constexpr (!Epi::AFTER_DRAIN) { E(acc, cur, wr, wc, fr, fq); S.done(cur); }
        if (!has_next) break;
#pragma unroll
        for (int a = 0; a < 2; ++a)
#pragma unroll
            for (int b = 0; b < 2; ++b)
#pragma unroll
                for (int m = 0; m < 4; ++m)
#pragma unroll
                    for (int n = 0; n < 2; ++n) acc[a][b][m][n] = (f32x4){0.f, 0.f, 0.f, 0.f};
        cur = nxt; cA = nA; cB = nB; ++ui;
        if constexpr (ALIGN_EPI) { if (wr == 1) PG8_BAR; }
    }
    PG8_WAIT_V(0);
    if constexpr (!ALIGN_EPI) { if (wr == 0) PG8_BAR; }
    PG8_BAR;
    if constexpr (Epi::AFTER_DRAIN) { E.fused(acc, cur, wr, wc, fr, fq, lds, wid, lane); S.done(cur); }
#undef PG8_SA
#undef PG8_SB
#undef PG8_STAGE
#undef PG8_LDA
#undef PG8_LDB
#undef PG8_MMA
#undef PG8_WAIT_V
#undef PG8_WAIT_L
#undef PG8_BAR
#undef PG8_SCHED
}
}

#define EPI_ROWS(ai, m) (u.pm * 256 + (ai) * 128 + wr * 64 + (m) * 16 + fr)
#define EPI_COL0 (u.pn * 256 + wc * 32 + 8 * fq)
typedef const f32x4 (&AccT)[2][2][4][2];

__device__ __forceinline__ float fq_sum(float v, int lane) { v += bperm_f(lane ^ 16, v); v += bperm_f(lane ^ 32, v); return v; }

struct EpiZ {
    static constexpr bool PERM = true, AFTER_DRAIN = false;
    bf16_t* Z; const u64* ssq; u64* mqs; u64* mkvs;
    __device__ __forceinline__ void operator()(AccT acc, const pg8::Unit& u, int wr, int wc, int fr, int fq) const {
        const int col0 = EPI_COL0;
#pragma unroll
        for (int ai = 0; ai < 2; ++ai)
#pragma unroll
            for (int m = 0; m < 4; ++m) {
                const int row = EPI_ROWS(ai, m); const float rs = rsqrtf(ssq_get(ssq + row) * (1.f / D) + EPS);
                float sq = 0.f, skv = 0.f;
#pragma unroll
                for (int bj = 0; bj < 2; ++bj) {
                    const f32x4 v0 = acc[ai][bj][m][0] * rs, v1 = acc[ai][bj][m][1] * rs;
                    u32x4 w; w.x = pk2(v0[0], v0[1]); w.y = pk2(v0[2], v0[3]); w.z = pk2(v1[0], v1[1]); w.w = pk2(v1[2], v1[3]);
                    *(u32x4*)(Z + (size_t)row * NZ + col0 + bj * 128) = w;
                    const float s2 = v0[0] * v0[0] + v0[1] * v0[1] + v0[2] * v0[2] + v0[3] * v0[3] + v1[0] * v1[0] + v1[1] * v1[1] + v1[2] * v1[2] + v1[3] * v1[3];
                    const int cb = u.pn * 256 + bj * 128;
                    if (cb >= ZC_MCQ && cb < ZC_MCKV) sq += s2;
                    if (cb >= ZC_MCKV && cb < ZC_MKR) skv += s2;
                }
                if (u.pn >= 14 && u.pn <= 16) {
                    sq = fq_sum(sq, fr + 16 * fq); skv = fq_sum(skv, fr + 16 * fq);
                    if (fq == 0) { if (u.pn <= 15) ssq_add(mqs + row, sq); if (u.pn >= 15) ssq_add(mkvs + row, skv); }
                }
            }
    }
};
struct EpiBf16s {
    static constexpr bool PERM = true, AFTER_DRAIN = false;
    bf16_t* O; int ldo; const u64* ssq; float inv_n;
    __device__ __forceinline__ void operator()(AccT acc, const pg8::Unit& u, int wr, int wc, int fr, int fq) const {
        const int col0 = EPI_COL0;
#pragma unroll
        for (int ai = 0; ai < 2; ++ai)
#pragma unroll
            for (int m = 0; m < 4; ++m) {
                const int row = EPI_ROWS(ai, m); const float rs = ssq ? rsqrtf(ssq_get(ssq + row) * inv_n + EPS) : 1.f;
#pragma unroll
                for (int bj = 0; bj < 2; ++bj) {
                    const f32x4 v0 = acc[ai][bj][m][0] * rs, v1 = acc[ai][bj][m][1] * rs;
                    u32x4 w; w.x = pk2(v0[0], v0[1]); w.y = pk2(v0[2], v0[3]); w.z = pk2(v1[0], v1[1]); w.w = pk2(v1[2], v1[3]);
                    *(u32x4*)(O + (size_t)row * ldo + col0 + bj * 128) = w;
                }
            }
    }
};
struct EpiRes {
    static constexpr bool PERM = true, AFTER_DRAIN = false;
    bf16_t* HB; u64* ssq;
    __device__ __forceinline__ void operator()(AccT acc, const pg8::Unit& u, int wr, int wc, int fr, int fq) const {
        const int col0 = EPI_COL0;
#pragma unroll
        for (int ai = 0; ai < 2; ++ai)
#pragma unroll
            for (int m = 0; m < 4; ++m) {
                const int row = EPI_ROWS(ai, m); float s2 = 0.f;
#pragma unroll
                for (int bj = 0; bj < 2; ++bj) {
                    bf16_t* hp = HB + (size_t)row * D + col0 + bj * 128;
                    const u32x4 hw = *(const u32x4*)hp;
                    const f32x4 v0 = (f32x4){bflo(hw[0]), bfhi(hw[0]), bflo(hw[1]), bfhi(hw[1])} + acc[ai][bj][m][0], v1 = (f32x4){bflo(hw[2]), bfhi(hw[2]), bflo(hw[3]), bfhi(hw[3])} + acc[ai][bj][m][1];
                    u32x4 w; w.x = pk2(v0[0], v0[1]); w.y = pk2(v0[2], v0[3]); w.z = pk2(v1[0], v1[1]); w.w = pk2(v1[2], v1[3]);
                    *(u32x4*)hp = w;
                    s2 += v0[0] * v0[0] + v0[1] * v0[1] + v0[2] * v0[2] + v0[3] * v0[3] + v1[0] * v1[0] + v1[1] * v1[1] + v1[2] * v1[2] + v1[3] * v1[3];
                }
                s2 = fq_sum(s2, fr + 16 * fq);
                if (fq == 0) ssq_add(ssq + row, s2);
            }
    }
};
struct EpiF32s {
    static constexpr bool PERM = true, AFTER_DRAIN = false;
    float* C; const u64* ssq;
    __device__ __forceinline__ void operator()(AccT acc, const pg8::Unit& u, int wr, int wc, int fr, int fq) const {
        const int col0 = EPI_COL0;
#pragma unroll
        for (int ai = 0; ai < 2; ++ai)
#pragma unroll
            for (int m = 0; m < 4; ++m) {
                const int row = EPI_ROWS(ai, m); const float rs = ssq ? rsqrtf(ssq_get(ssq + row) * (1.f / D) + EPS) : 1.f;
#pragma unroll
                for (int bj = 0; bj < 2; ++bj) {
                    float* cp = C + (size_t)row * D + col0 + bj * 128;
                    *(f32x4*)cp = acc[ai][bj][m][0] * rs; *(f32x4*)(cp + 4) = acc[ai][bj][m][1] * rs;
                }
            }
    }
};
struct EpiPle {
    static constexpr bool PERM = true, AFTER_DRAIN = false;
    const bf16_t* HBin; bf16_t* HBout; const bf16_t* PR; const float* ssq_in; u64* ssq_out;
    __device__ __forceinline__ void operator()(AccT acc, const pg8::Unit& u, int wr, int wc, int fr, int fq) const {
        const int col0 = EPI_COL0;
#pragma unroll
        for (int ai = 0; ai < 2; ++ai)
#pragma unroll
            for (int m = 0; m < 4; ++m) {
                const int row = EPI_ROWS(ai, m); const float rs = rsqrtf(ssq_in[row] * (1.f / D) + EPS); float s2 = 0.f;
#pragma unroll
                for (int bj = 0; bj < 2; ++bj) {
                    const size_t o = (size_t)row * D + col0 + bj * 128;
                    const u32x4 hw = *(const u32x4*)(HBin + o), pw = *(const u32x4*)(PR + o);
                    f32x4 v0 = (f32x4){bflo(hw[0]), bfhi(hw[0]), bflo(hw[1]), bfhi(hw[1])}, v1 = (f32x4){bflo(hw[2]), bfhi(hw[2]), bflo(hw[3]), bfhi(hw[3])};
                    const f32x4 p0 = (f32x4){bflo(pw[0]), bfhi(pw[0]), bflo(pw[1]), bfhi(pw[1])}, p1 = (f32x4){bflo(pw[2]), bfhi(pw[2]), bflo(pw[3]), bfhi(pw[3])};
#pragma unroll
                    for (int j = 0; j < 4; ++j) { v0[j] += sigmoidf_(acc[ai][bj][m][0][j] * rs) * p0[j]; v1[j] += sigmoidf_(acc[ai][bj][m][1][j] * rs) * p1[j]; }
                    u32x4 w; w.x = pk2(v0[0], v0[1]); w.y = pk2(v0[2], v0[3]); w.z = pk2(v1[0], v1[1]); w.w = pk2(v1[2], v1[3]);
                    *(u32x4*)(HBout + o) = w;
                    s2 += v0[0] * v0[0] + v0[1] * v0[1] + v0[2] * v0[2] + v0[3] * v0[3] + v1[0] * v1[0] + v1[1] * v1[1] + v1[2] * v1[2] + v1[3] * v1[3];
                }
                s2 = fq_sum(s2, fr + 16 * fq);
                if (fq == 0) ssq_add(ssq_out + row, s2);
            }
    }
};

__device__ __forceinline__ int f2ord(float f) { const int b = __builtin_bit_cast(int, f); return b >= 0 ? b : (b ^ 0x7FFFFFFF); }
__device__ __forceinline__ float ord2f(int k) { const int b = k >= 0 ? k : (k ^ 0x7FFFFFFF); return __builtin_bit_cast(float, b); }
__device__ __forceinline__ int row16_max(int v) {
    v = max(v, __builtin_amdgcn_update_dpp(v, v, 0xB1, 0xF, 0xF, false)); v = max(v, __builtin_amdgcn_update_dpp(v, v, 0x4E, 0xF, 0xF, false));
    v = max(v, __builtin_amdgcn_update_dpp(v, v, 0x141, 0xF, 0xF, false)); v = max(v, __builtin_amdgcn_update_dpp(v, v, 0x140, 0xF, 0xF, false));
    return v;
}
__device__ __forceinline__ float row16_sum(float v) {
    v += __builtin_bit_cast(float, __builtin_amdgcn_update_dpp(0, __builtin_bit_cast(int, v), 0xB1, 0xF, 0xF, false)); v += __builtin_bit_cast(float, __builtin_amdgcn_update_dpp(0, __builtin_bit_cast(int, v), 0x4E, 0xF, 0xF, false));
    v += __builtin_bit_cast(float, __builtin_amdgcn_update_dpp(0, __builtin_bit_cast(int, v), 0x141, 0xF, 0xF, false)); v += __builtin_bit_cast(float, __builtin_amdgcn_update_dpp(0, __builtin_bit_cast(int, v), 0x140, 0xF, 0xF, false));
    return v;
}
__device__ __forceinline__ void peer_topk_mfma(LAS unsigned char* lds, int wid, const bf16_t* QB, const bf16_t* SKB, int* PIDX, float* PG, int pm, int pn) {
    constexpr int SQL = 272, L_SK = 0;
    const int lane = lane_id_fresh(), tid = wid * 64 + lane, l15 = lane & 15, g = lane >> 4;
    int tk[2][2][4];
#pragma unroll
    for (int c = 0; c < 2; ++c) {
        const bf16_t* sk = SKB + ((size_t)(pn * 2 + c) * 128) * 128;
#pragma unroll
        for (int i = 0; i < 4; ++i) { const int id = tid + 512 * i, n = id >> 4, dc = id & 15; *(LAS u32x4*)(lds + L_SK + n * SQL + dc * 16) = *(const u32x4*)(sk + n * 128 + dc * 8); }
        bf16x8 af[2][4];
#pragma unroll
        for (int rt = 0; rt < 2; ++rt)
#pragma unroll
            for (int ks = 0; ks < 4; ++ks) af[rt][ks] = *(const bf16x8*)(QB + (size_t)(pm * 256 + 32 * wid + 16 * rt + l15) * D + pn * 256 + c * 128 + 32 * ks + 8 * g);
        __syncthreads();
        int key[2][8][4];
#pragma unroll
        for (int nt = 0; nt < 8; ++nt) {
            f32x4 sc0 = (f32x4){0.f, 0.f, 0.f, 0.f}, sc1 = (f32x4){0.f, 0.f, 0.f, 0.f};
#pragma unroll
            for (int ks = 0; ks < 4; ++ks) {
                const bf16x8 bfr = *(const LAS bf16x8*)(lds + L_SK + (16 * nt + l15) * SQL + (32 * ks + 8 * g) * 2);
                sc0 = __builtin_amdgcn_mfma_f32_16x16x32_bf16(af[0][ks], bfr, sc0, 0, 0, 0);
                sc1 = __builtin_amdgcn_mfma_f32_16x16x32_bf16(af[1][ks], bfr, sc1, 0, 0, 0);
            }
#pragma unroll
            for (int r = 0; r < 4; ++r) { key[0][nt][r] = (f2ord(sc0[r]) & ~127) | (127 - (16 * nt + l15)); key[1][nt][r] = (f2ord(sc1[r]) & ~127) | (127 - (16 * nt + l15)); }
        }
        __syncthreads();
#pragma unroll
        for (int rt = 0; rt < 2; ++rt)
#pragma unroll
            for (int r = 0; r < 4; ++r) {
#define SK_(i) key[rt][i][r]
#define CE_(i, j) do { const int hi_ = max(SK_(i), SK_(j)), lo_ = min(SK_(i), SK_(j)); SK_(i) = hi_; SK_(j) = lo_; } while (0)
                CE_(0, 1); CE_(2, 3); CE_(4, 5); CE_(6, 7); CE_(0, 2); CE_(1, 3); CE_(4, 6); CE_(5, 7); CE_(1, 2); CE_(5, 6);
                CE_(0, 4); CE_(1, 5); CE_(2, 6); CE_(3, 7); CE_(2, 4); CE_(3, 5); CE_(1, 2); CE_(3, 4); CE_(5, 6);
                int mine = 0;
#pragma unroll 1
                for (int k = 0; k < 16; ++k) {
                    const int v = row16_max(SK_(0));
                    if (l15 == k) mine = v;
                    const bool won = (SK_(0) == v);
#pragma unroll
                    for (int nt = 0; nt < 7; ++nt) SK_(nt) = won ? SK_(nt + 1) : SK_(nt);
                    SK_(7) = won ? (int)0x80000000 : SK_(7);
                }
#undef CE_
#undef SK_
                tk[c][rt][r] = mine;
            }
    }
    int ci_[4], cj_[4]; bool cv_[4];
    ci_[0] = 0; cj_[0] = l15; cv_[0] = true;
    ci_[1] = l15 < 8 ? 1 : (l15 < 13 ? 2 : 3); cj_[1] = l15 < 8 ? l15 : (l15 < 13 ? l15 - 8 : l15 - 13); cv_[1] = true;
    ci_[2] = l15 == 0 ? 3 : (l15 < 4 ? 4 : (l15 < 6 ? 5 : (l15 < 8 ? 6 : (l15 < 10 ? 7 : l15 - 2))));
    cj_[2] = l15 == 0 ? 3 : (l15 < 4 ? l15 - 1 : (l15 < 6 ? l15 - 4 : (l15 < 8 ? l15 - 6 : (l15 < 10 ? l15 - 8 : 0)))); cv_[2] = true;
    ci_[3] = 14 + (l15 & 1); cj_[3] = 0; cv_[3] = l15 < 2;
#pragma unroll
    for (int rt = 0; rt < 2; ++rt)
#pragma unroll
        for (int r = 0; r < 4; ++r) {
            int ck[4];
#pragma unroll
            for (int q = 0; q < 4; ++q) {
                const float s0 = ord2f(bperm_i((lane & 48) + ci_[q], tk[0][rt][r]) & ~127), s1 = ord2f(bperm_i((lane & 48) + cj_[q], tk[1][rt][r]) & ~127);
                ck[q] = cv_[q] ? ((f2ord(s0 + s1) & ~255) | (255 - (16 * ci_[q] + cj_[q]))) : (int)0x80000000;
            }
            int mine = 0;
            for (int k = 0; k < 16; ++k) {
                int v = max(max(ck[0], ck[1]), max(ck[2], ck[3]));
                v = row16_max(v);
                if (l15 == k) mine = v;
#pragma unroll
                for (int q = 0; q < 4; ++q) ck[q] = (ck[q] == v) ? (int)0x80000000 : ck[q];
            }
            const int pos = 255 - (mine & 255), ci = pos >> 4, cj = pos & 15;
            const int i0 = 127 - (bperm_i((lane & 48) + ci, tk[0][rt][r]) & 127), i1 = 127 - (bperm_i((lane & 48) + cj, tk[1][rt][r]) & 127);
            const float bv = ord2f(mine & ~255), b0 = ord2f(bperm_i(lane & 48, mine) & ~255);
            const float ex = __expf(bv - b0), sum = row16_sum(ex);
            const size_t o = (size_t)(pm * 256 + 32 * wid + 16 * rt + 4 * g + r) * 128 + pn * 16 + l15;
            PIDX[o] = i0 * 128 + i1; PG[o] = ex * rcpf_(sum);
        }
}

#define XB_TMO      128
#define XB_XCNT(j)  (256  + 64 * (j))
#define XB_XSUB(j)  (1280 + 64 * (j))
#define XB_XGEN(j)  (2304 + 64 * (j))
#define XB_TOP      3328
#define XB_TOPGEN   3392
#define XCD_BAR_WORDS 3456
#define XB_SPIN_CAP (1u << 18)
__device__ __forceinline__ unsigned xb_ld(unsigned* p)              { return __hip_atomic_load(p, __ATOMIC_RELAXED, __HIP_MEMORY_SCOPE_AGENT); }
__device__ __forceinline__ unsigned xb_add(unsigned* p, unsigned v) { return __hip_atomic_fetch_add(p, v, __ATOMIC_RELAXED, __HIP_MEMORY_SCOPE_AGENT); }
__device__ __forceinline__ unsigned xb_xcc_id() { return (unsigned)__builtin_amdgcn_s_getreg((3 << 11) | 20) & 0xFu; }
#define XB_SPIN(cond, bar) do { unsigned _sp = 0; while (cond) { __builtin_amdgcn_s_sleep(1); \
    if ((++_sp & 255u) == 0u) { if (xb_ld(&(bar)[XB_TMO])) break; if (_sp > XB_SPIN_CAP) { atomicAdd(&(bar)[XB_TMO], 1u); break; } } } } while (0)
struct XcdBarrier { unsigned* bar; unsigned x; volatile LAS unsigned* st; };
__device__ __forceinline__ XcdBarrier xcd_barrier_post(unsigned* bar, volatile LAS unsigned* st) {
    XcdBarrier b; b.bar = bar; b.x = xb_xcc_id(); b.st = st;
    if (threadIdx.x == 0) (void)xb_add(&bar[XB_XCNT(b.x)], 1u);
    return b;
}
__device__ __forceinline__ void xcd_barrier_complete(unsigned* bar, unsigned x, unsigned& nloc, unsigned& nx) {
    const unsigned G = gridDim.x * gridDim.y * gridDim.z;
    unsigned sum, cnt, mine, sp = 0u;
    for (;;) {
        sum = 0u; cnt = 0u; mine = 0u;
#pragma unroll
        for (unsigned j = 0; j < 16; ++j) { const unsigned c = xb_ld(&bar[XB_XCNT(j)]); sum += c; cnt += (c > 0u) ? 1u : 0u; mine = (j == x) ? c : mine; }
        if (sum == G) break;
        __builtin_amdgcn_s_sleep(1);
        if ((++sp & 255u) == 0u) { if (xb_ld(&bar[XB_TMO])) break; if (sp > XB_SPIN_CAP) { atomicAdd(&bar[XB_TMO], 1u); break; } }
    }
    nloc = mine > 0u ? mine : 1u; nx = cnt > 0u ? cnt : 1u;
}
__device__ __forceinline__ void xcd_barrier(const XcdBarrier& b, int wave_s) {
    asm volatile("s_waitcnt vmcnt(0)" ::: "memory");
    __syncthreads();
    if (wave_s == 0 && lane_id_fresh() == 0) {
        unsigned* bar = b.bar;
        __builtin_amdgcn_s_waitcnt(0);
        unsigned nloc = b.st[0], nx = b.st[1];
        if (nloc == 0u) { xcd_barrier_complete(bar, b.x, nloc, nx); b.st[0] = nloc; b.st[1] = nx; }
        const unsigned old = xb_add(&bar[XB_XSUB(b.x)], 1u);
        const unsigned gen = old / nloc;
        if (old + 1u == (gen + 1u) * nloc) {
            __builtin_amdgcn_fence(__ATOMIC_RELEASE, "agent");
            asm volatile("s_waitcnt vmcnt(0)" ::: "memory");
            const unsigned og = xb_add(&bar[XB_TOP], 1u);
            const unsigned tg = og / nx;
            if (og + 1u == (tg + 1u) * nx) xb_add(&bar[XB_TOPGEN], 1u);
            else XB_SPIN(xb_ld(&bar[XB_TOPGEN]) == tg, bar);
            __builtin_amdgcn_fence(__ATOMIC_ACQUIRE, "agent");
            xb_add(&bar[XB_XGEN(b.x)], 1u);
            asm volatile("s_waitcnt vmcnt(0)" ::: "memory");
        } else {
            XB_SPIN(xb_ld(&bar[XB_XGEN(b.x)]) == gen, bar);
            __builtin_amdgcn_fence(__ATOMIC_ACQUIRE, "agent");
            asm volatile("s_waitcnt vmcnt(0)" ::: "memory");
        }
    }
    __syncthreads();
}

constexpr int RING_BYTES = 131072, MISC_OFF = RING_BYTES + 320, LDS_BYTES = 147456;
struct Args { const float* in[28]; float* out; unsigned char* ws; int ph_lo, ph_hi; };
enum { I_X = 0, I_P, I_POS, I_LN_MIX, I_W_IN, I_DIFF_LAMBDA, I_DIFF_NORM, I_HGRN_LB, I_HGRN_NORM, I_MLA_QN, I_MLA_KVN, I_MLA_WUQ, I_MLA_WUKV, I_CONV_W, I_CONV_B, I_GATE_B,
       I_MLSTM_NORM, I_GROUP_GAIN, I_W_OUT, I_LN_FFN, I_PEER_WQ, I_PEER_SUBKEYS, I_PEER_U, I_PEER_V, I_LN_PLE, I_PLE_WGATE, I_PLE_WPROJ, I_LN_FINAL };

struct Frame {
    LAS unsigned char* lds; unsigned char* ws; const Args* a;
    int tid, lane, wave, G, gw, ngw, bid;
};

__device__ __forceinline__ int cmap_win(int n) {
    if (n < ZC_MKR) return n;
    if (n < ZC_LQ) { const int j = n - ZC_MKR; return ZC_MKR + (j >> 1) + 32 * (j & 1); }
    if (n < ZC_LO) return n;
    if (n < ZC_LI) return 5320 + (n - ZC_LO);
    if (n < ZC_LF) return 5312 + (n - ZC_LI);
    if (n < IN_COLS) return 5316 + (n - ZC_LF);
    return -1;
}
__device__ __forceinline__ int cmap_uq(int n) { const int hd = n / 192, r = n % 192; if (r < 128) return n; const int j = r - 128; return hd * 192 + 128 + (j >> 1) + 32 * (j & 1); }

template <int MAP>
__device__ __forceinline__ void transpose_item(const float* W, int K, int Nsrc, int Ndst, const float* gain, bf16_t* WT, LAS float* scr_, int item, int lane) {
    LAS unsigned char* scr = (LAS unsigned char*)scr_;
    const int nblk = Ndst / 64, kb = item / nblk, nb = item % nblk, k0 = 64 * kb, n0 = 64 * nb;
    const int nq = (lane & 15) * 4, kr = lane >> 4;
    if (MAP == 0 || (MAP == 1 && (n0 + 64 <= ZC_MKR || (n0 >= ZC_LQ && n0 + 64 <= ZC_LO)))) {
        f32x4 tv[16]; float gk[16];
#pragma unroll
        for (int i = 0; i < 16; ++i) tv[i] = *(const f32x4*)(W + (size_t)(k0 + kr + 4 * i) * Nsrc + n0 + nq);
        if (gain) {
#pragma unroll
            for (int i = 0; i < 16; ++i) gk[i] = gain[k0 + kr + 4 * i];
        } else {
#pragma unroll
            for (int i = 0; i < 16; ++i) gk[i] = 1.f;
        }
#pragma unroll
        for (int i = 0; i < 16; ++i) { const int kk = kr + 4 * i; const f32x4 v = tv[i] * gk[i];
#pragma unroll
            for (int e = 0; e < 4; ++e) *(LAS bf16_t*)(scr + (nq + e) * 144 + kk * 2) = (bf16_t)f2bf(v[e]); }
    } else {
        int src[4];
#pragma unroll
        for (int e = 0; e < 4; ++e) src[e] = (MAP == 1) ? cmap_win(n0 + nq + e) : cmap_uq(n0 + nq + e);
        const int s0 = src[0] > 0 ? src[0] : 0, s1 = src[1] > 0 ? src[1] : 0, s2 = src[2] > 0 ? src[2] : 0, s3 = src[3] > 0 ? src[3] : 0;
        float ts[16][4], gk[16];
#pragma unroll
        for (int i = 0; i < 16; ++i) { const float* wr = W + (size_t)(k0 + kr + 4 * i) * Nsrc; ts[i][0] = wr[s0]; ts[i][1] = wr[s1]; ts[i][2] = wr[s2]; ts[i][3] = wr[s3]; }
        if (gain) {
#pragma unroll
            for (int i = 0; i < 16; ++i) gk[i] = gain[k0 + kr + 4 * i];
        } else {
#pragma unroll
            for (int i = 0; i < 16; ++i) gk[i] = 1.f;
        }
#pragma unroll
        for (int i = 0; i < 16; ++i) { const int kk = kr + 4 * i;
#pragma unroll
            for (int e = 0; e < 4; ++e) { const float v = (src[e] >= 0) ? ts[i][e] * gk[i] : 0.f; *(LAS bf16_t*)(scr + (nq + e) * 144 + kk * 2) = (bf16_t)f2bf(v); } }
    }
    asm volatile("s_waitcnt lgkmcnt(0)" ::: "memory");
#pragma unroll
    for (int j = 0; j < 8; ++j) { const int n = (lane >> 3) + 8 * j, c = lane & 7; *(u32x4*)(WT + (size_t)(n0 + n) * K + k0 + 8 * c) = *(const LAS u32x4*)(scr + n * 144 + c * 16); }
    asm volatile("s_waitcnt lgkmcnt(0)" ::: "memory");
}

constexpr int CV_TAB = 4096, CV_WIN = CV_TAB + 736, CV_WOUT = CV_WIN + 256, CV_WQ = CV_WOUT + 256, CV_WG = CV_WQ + 256, CV_WP = CV_WG + 32, CV_UQ = CV_WP + 18, CV_UKV = CV_UQ + 16,
              CV_P = CV_UKV + 128, NCONV = CV_P + 16;
__device__ __forceinline__ bool conv_early(int item) { return (item >= CV_TAB && item < CV_WIN) || (item >= CV_WP && item < CV_UKV); }
__device__ __forceinline__ void convert_item(Frame& F, int l, int item, int lane) {
    const Args& a = *F.a; unsigned char* ws = F.ws;
    LAS float* scr = (LAS float*)(F.lds + F.wave * 16384);
    if (item < CV_TAB) {
        const int tab = item >> 11, r0 = l * NEXP + (item & 2047) * 8;
        const float* SRC = a.in[tab ? I_PEER_V : I_PEER_U]; unsigned char* DST = ws + (tab ? WS_VB : WS_UB); float* SC = (float*)(ws + (tab ? WS_SV : WS_SU));
        const float* gF = a.in[I_LN_FFN] + l * D;
        f32x4 gv[8];
#pragma unroll
        for (int q = 0; q < 8; ++q) { gv[q] = (f32x4){1.f, 1.f, 1.f, 1.f}; if (tab == 0) gv[q] = *(const f32x4*)(gF + q * 256 + lane * 4); }
        float mysc = 1.f;
        f32x4 nx[2][8];
#pragma unroll
        for (int k = 0; k < 2; ++k)
#pragma unroll
            for (int q = 0; q < 8; ++q) nx[k][q] = *(const f32x4*)(SRC + (size_t)(r0 + k) * D + q * 256 + lane * 4);
#pragma unroll
        for (int rr = 0; rr < 8; ++rr) {
            const int row = r0 + rr; f32x4 v[8]; float am = 0.f;
#pragma unroll
            for (int q = 0; q < 8; ++q) v[q] = nx[rr & 1][q];
            if (rr + 2 < 8) {
#pragma unroll
                for (int q = 0; q < 8; ++q) nx[rr & 1][q] = *(const f32x4*)(SRC + (size_t)(row + 2) * D + q * 256 + lane * 4);
            }
#pragma unroll
            for (int q = 0; q < 8; ++q) {
                v[q] *= gv[q];
                am = fmaxf(am, fmaxf(fmaxf(fabsf(v[q][0]), fabsf(v[q][1])), fmaxf(fabsf(v[q][2]), fabsf(v[q][3]))));
            }
            am = wave_max(am);
            const float sc = am > 0.f ? am * (1.f / 6.f) : 1.f, inv = 1.f / sc;
            u32x4 pk;
#pragma unroll
            for (int q2 = 0; q2 < 4; ++q2) { unsigned w = 0;
                w = __builtin_amdgcn_cvt_scalef32_pk_fp4_f32(w, v[2 * q2][0] * inv, v[2 * q2][1] * inv, 1.0f, 0);
                w = __builtin_amdgcn_cvt_scalef32_pk_fp4_f32(w, v[2 * q2][2] * inv, v[2 * q2][3] * inv, 1.0f, 1);
                w = __builtin_amdgcn_cvt_scalef32_pk_fp4_f32(w, v[2 * q2 + 1][0] * inv, v[2 * q2 + 1][1] * inv, 1.0f, 2);
                w = __builtin_amdgcn_cvt_scalef32_pk_fp4_f32(w, v[2 * q2 + 1][2] * inv, v[2 * q2 + 1][3] * inv, 1.0f, 3);
                pk[q2] = w; }
            *(u32x4*)(DST + (size_t)row * VROW + lane * 16) = pk;
            mysc = (lane == rr) ? sc : mysc;
        }
        if (lane < 8) SC[r0 + lane] = mysc;
        return;
    }
#define CV_TR(MAP, base, WI, GI, K_, NS_, ND_, WSOFF) do { const int i0_ = (item - (base)) * 4; const float* W_ = a.in[WI] + (size_t)l * (K_) * (NS_); const float* g_ = (GI) >= 0 ? a.in[(GI) >= 0 ? (GI) : 0] + l * (K_) : nullptr; \
        bf16_t* WT_ = (bf16_t*)(ws + (WSOFF)) + (size_t)l * (ND_) * (K_); _Pragma("unroll 1") for (int j_ = 0; j_ < 4; ++j_) if (i0_ + j_ < ((K_) / 64) * ((ND_) / 64)) transpose_item<MAP>(W_, K_, NS_, ND_, g_, WT_, scr, i0_ + j_, lane); } while (0)
    if (item < CV_WIN) { CV_TR(1, CV_TAB, I_W_IN, I_LN_MIX, D, IN_COLS, NZ, WS_WIN); return; }
    if (item < CV_WOUT) { CV_TR(0, CV_WIN, I_W_OUT, I_GROUP_GAIN, D, D, D, WS_WOUT); return; }
    if (item < CV_WQ) { CV_TR(0, CV_WOUT, I_PEER_WQ, I_LN_FFN, D, D, D, WS_WQ); return; }
    if (item < CV_WG) { CV_TR(0, CV_WQ, I_PLE_WGATE, I_LN_PLE, D, D, D, WS_WG); return; }
    if (item < CV_WP) { CV_TR(0, CV_WG, I_PLE_WPROJ, -1, PLE, D, D, WS_WP); return; }
    if (item < CV_UQ) { CV_TR(2, CV_WP, I_MLA_WUQ, I_MLA_QN, 384, 768, 768, WS_WUQ); return; }
    if (item < CV_UKV) { CV_TR(0, CV_UQ, I_MLA_WUKV, I_MLA_KVN, 256, 1024, 1024, WS_WUKV); return; }
#undef CV_TR
    if (item < CV_P) {
        const size_t e0 = (size_t)l * T * PLE + (size_t)(item - CV_UKV) * 16384; const float* Pp = a.in[I_P]; bf16_t* PB = (bf16_t*)(ws + WS_PB);
#pragma unroll 1
        for (int i0 = 0; i0 < 32; i0 += 8) {
            f32x4 va[8], vb[8];
#pragma unroll
            for (int i = 0; i < 8; ++i) { const size_t e = e0 + (size_t)(i0 + i) * 512 + lane * 8; va[i] = *(const f32x4*)(Pp + e); vb[i] = *(const f32x4*)(Pp + e + 4); }
#pragma unroll
            for (int i = 0; i < 8; ++i) { const size_t e = e0 + (size_t)(i0 + i) * 512 + lane * 8;
                u32x4 w; w.x = pk2(va[i][0], va[i][1]); w.y = pk2(va[i][2], va[i][3]); w.z = pk2(vb[i][0], vb[i][1]); w.w = pk2(vb[i][2], vb[i][3]); *(u32x4*)(PB + e) = w; }
        }
        return;
    }
    {
        const size_t e0 = (size_t)l * 8 * 2 * 128 * 128 + (size_t)(item - CV_P) * 16384; const float* sk = a.in[I_PEER_SUBKEYS]; bf16_t* skb = (bf16_t*)(ws + WS_SKB);
#pragma unroll 1
        for (int i0 = 0; i0 < 32; i0 += 8) {
            f32x4 va[8], vb[8];
#pragma unroll
            for (int i = 0; i < 8; ++i) { const size_t e = e0 + (size_t)(i0 + i) * 512 + lane * 8; va[i] = *(const f32x4*)(sk + e); vb[i] = *(const f32x4*)(sk + e + 4); }
#pragma unroll
            for (int i = 0; i < 8; ++i) { const size_t e = e0 + (size_t)(i0 + i) * 512 + lane * 8;
                u32x4 w; w.x = pk2(va[i][0], va[i][1]); w.y = pk2(va[i][2], va[i][3]); w.z = pk2(vb[i][0], vb[i][1]); w.w = pk2(vb[i][2], vb[i][3]); *(u32x4*)(skb + e) = w; }
        }
    }
}
__device__ __forceinline__ void convert_layers(Frame& F, int l0, int l1, int gw, int NGW, bool early_only) {
    const int lane = lane_id_fresh();
    for (int l = l0; l < l1; ++l)
#pragma unroll 1
        for (int it = gw; it < NCONV; it += NGW) if (!early_only || conv_early(it)) convert_item(F, l, it, lane);
}
__device__ __forceinline__ void convert_layer_queue(Frame& F, int l, unsigned* ctr) {
    const int lane = lane_id_fresh();
#pragma unroll 1
    for (;;) {
        unsigned it = 0;
        if (lane == 0) it = __hip_atomic_fetch_add(ctr, 1u, __ATOMIC_RELAXED, __HIP_MEMORY_SCOPE_AGENT);
        it = __builtin_amdgcn_readfirstlane(it);
        if (it >= (unsigned)NCONV) break;
        const int ll = conv_early((int)it) ? l + 1 : l;
        if (ll < DEPTH) convert_item(F, ll, (int)it, lane);
    }
}

__device__ __forceinline__ void prologue(Frame& F) {
    const Args& a = *F.a; unsigned char* ws = F.ws;
    const int gw = F.gw, NGW = F.ngw, lane = F.lane;
    const size_t gt = (size_t)blockIdx.x * NTHREADS + F.tid, GT = (size_t)F.G * NTHREADS;
    if (F.G == 256) convert_layers(F, 0, 1, gw, NGW, true);
    else convert_layers(F, 0, DEPTH, gw, NGW, false);
    {
        const float* X = a.in[I_X]; bf16_t* HB = (bf16_t*)(ws + WS_HB); u64* ssq = (u64*)(ws + WS_CTL + CTL_SSQA);
        for (int t = gw; t < T; t += NGW) {
            float s2 = 0.f;
            f32x4 xa[4], xb[4];
#pragma unroll
            for (int c = 0; c < 4; ++c) { const size_t o = (size_t)t * D + c * 512 + lane * 8; xa[c] = *(const f32x4*)(X + o); xb[c] = *(const f32x4*)(X + o + 4); }
#pragma unroll
            for (int c = 0; c < 4; ++c) {
                const size_t o = (size_t)t * D + c * 512 + lane * 8;
                const f32x4 v0 = xa[c], v1 = xb[c];
                u32x4 w; w.x = pk2(v0[0], v0[1]); w.y = pk2(v0[2], v0[3]); w.z = pk2(v1[0], v1[1]); w.w = pk2(v1[2], v1[3]);
                *(u32x4*)(HB + o) = w;
                s2 += v0[0] * v0[0] + v0[1] * v0[1] + v0[2] * v0[2] + v0[3] * v0[3] + v1[0] * v1[0] + v1[1] * v1[1] + v1[2] * v1[2] + v1[3] * v1[3];
            }
            s2 = wave_sum(s2);
            if (lane == 0) ssq[t] = (u64)(s2 * 16777216.f);
        }
    }
    {
        const int* pos = (const int*)a.in[I_POS]; float* cs = (float*)(ws + WS_CS);
        for (size_t i = gt; i < (size_t)T * 32; i += GT) {
            const int t = (int)(i / 32), j = (int)(i % 32);
            const float inv = powf(10000.0f, -(float)j / 32.0f);
            const float ang = (float)pos[t] * inv;
            const double rev = (double)ang * 0.15915494309189535;
            const float fr = (float)(rev - rint(rev));
            cs[i * 2] = __builtin_amdgcn_cosf(fr); cs[i * 2 + 1] = __builtin_amdgcn_sinf(fr);
        }
    }
    {
        float* prm = (float*)(ws + WS_PRM);
#define PRM_COPY(IDX, OFF, N) do { const float* src_ = a.in[IDX]; for (size_t i = gt; i < (size_t)DEPTH * (N); i += GT) { const int l_ = (int)(i / (N)), o_ = (int)(i % (N)); prm[l_ * PRM_L + (OFF) + o_] = src_[i]; } } while (0)
        PRM_COPY(I_CONV_W, PRM_CW, 2048); PRM_COPY(I_CONV_B, PRM_CB, 512); PRM_COPY(I_GATE_B, PRM_GB, 8); PRM_COPY(I_DIFF_LAMBDA, PRM_DL, 256);
        PRM_COPY(I_DIFF_NORM, PRM_DN, 512); PRM_COPY(I_HGRN_NORM, PRM_HN, 512); PRM_COPY(I_MLSTM_NORM, PRM_MN, 512);
#undef PRM_COPY
        for (size_t i = gt; i < (size_t)D; i += GT) prm[PRM_FIN + i] = a.in[I_LN_FINAL][i];
    }
    if (blockIdx.x == 0) {
        const float* lg = a.in[I_HGRN_LB]; float* lbs = (float*)(ws + WS_LBS);
        for (int c = F.tid; c < 512; c += NTHREADS) {
            float v[DEPTH], mx = -1e30f;
#pragma unroll
            for (int l = 0; l < DEPTH; ++l) { v[l] = lg[l * 512 + c]; mx = fmaxf(mx, v[l]); }
            float s = 0.f;
#pragma unroll
            for (int l = 0; l < DEPTH; ++l) { v[l] = expf(v[l] - mx); s += v[l]; }
            float cum = 0.f; float first = 0.f;
#pragma unroll
            for (int l = 0; l < DEPTH; ++l) { cum += v[l] / s; if (l == 0) first = cum; lbs[l * 512 + c] = cum - first; }
        }
    }
}

__device__ __forceinline__ void mix_prep(Frame& F, int l) {
    unsigned char* ws = F.ws;
    const bf16_t* Z = (const bf16_t*)(ws + WS_Z);
    const size_t gt = (size_t)F.bid * NTHREADS + F.tid, GT = (size_t)F.G * NTHREADS;
    bf16_t* KR = (bf16_t*)(ws + WS_KRM); const float* cs = (const float*)(ws + WS_CS);
    for (size_t i = gt; i < (size_t)T * 32; i += GT) {
        const int t = (int)(i / 32), j = (int)(i % 32);
        const float x1 = bf2f(Z[(size_t)t * NZ + ZC_MKR + 2 * j]), x2 = bf2f(Z[(size_t)t * NZ + ZC_MKR + 2 * j + 1]);
        const float c = cs[i * 2], sn = cs[i * 2 + 1];
        *(unsigned*)(KR + (size_t)t * 64 + 2 * j) = pk2(x1 * c - x2 * sn, x2 * c + x1 * sn);
    }
}

typedef float f32x16 __attribute__((ext_vector_type(16)));
typedef short s16x4 __attribute__((ext_vector_type(4)));
__device__ __forceinline__ int crow(int r, int hi) { return (r & 3) + 8 * (r >> 2) + 4 * hi; }
template <int OFF> __device__ __forceinline__ s16x4 tr_read(unsigned addr) { s16x4 r; asm volatile("ds_read_b64_tr_b16 %0, %1 offset:%2" : "=&v"(r) : "v"(addr), "i"(OFF) : "memory"); return r; }
constexpr int ATT_SV = 320;
template <int D0, int BLK, int KS> __device__ __forceinline__ bf16x8 v_frag(unsigned vaddr) {
    const s16x4 lo = tr_read<(32 * BLK + 16 * KS) * ATT_SV + 64 * D0>(vaddr), hi = tr_read<(32 * BLK + 16 * KS + 8) * ATT_SV + 64 * D0>(vaddr);
    return (bf16x8){lo[0], lo[1], lo[2], lo[3], hi[0], hi[1], hi[2], hi[3]};
}
__device__ __forceinline__ bf16x8 pack8(const f32x16& p, int base) {
    u32x4 w; w.x = pk2(p[base + 0], p[base + 1]); w.y = pk2(p[base + 2], p[base + 3]); w.z = pk2(p[base + 4], p[base + 5]); w.w = pk2(p[base + 6], p[base + 7]);
    return __builtin_bit_cast(bf16x8, w);
}
template <int D0> __device__ __forceinline__ void pv_block(f32x16& o, unsigned vaddr, bf16x8 p00, bf16x8 p01, bf16x8 p10, bf16x8 p11) {
    const bf16x8 a00 = v_frag<D0, 0, 0>(vaddr), a01 = v_frag<D0, 0, 1>(vaddr), a10 = v_frag<D0, 1, 0>(vaddr), a11 = v_frag<D0, 1, 1>(vaddr);
    asm volatile("s_waitcnt lgkmcnt(0)" ::: "memory"); __builtin_amdgcn_sched_barrier(0);
    o = __builtin_amdgcn_mfma_f32_32x32x16_bf16(a00, p00, o, 0, 0, 0);
    o = __builtin_amdgcn_mfma_f32_32x32x16_bf16(a01, p01, o, 0, 0, 0);
    o = __builtin_amdgcn_mfma_f32_32x32x16_bf16(a10, p10, o, 0, 0, 0);
    o = __builtin_amdgcn_mfma_f32_32x32x16_bf16(a11, p11, o, 0, 0, 0);
}
template <int MODE>
__device__ __forceinline__ void attn_unit(Frame& F, int l, int b, int h, int qb) {
    constexpr int DK = MODE ? 192 : 64, NS = DK / 16, SK = DK * 2 + 16, KBYTES = 64 * SK, VBYTES = 64 * ATT_SV, BUFB = KBYTES + VBYTES, KCH = DK / 8, NKC = (64 * KCH) / 512;
    constexpr int NMAP = MODE ? 1 : 2;
    constexpr float SCALE = MODE ? 0.07216878364870322f : 0.125f, C = SCALE * 1.4426950408889634f;
    unsigned char* ws = F.ws;
    const bf16_t* Z = (const bf16_t*)(ws + WS_Z); const bf16_t* QM = (const bf16_t*)(ws + WS_QM); const bf16_t* KVM = (const bf16_t*)(ws + WS_KVM); const bf16_t* KRM = (const bf16_t*)(ws + WS_KRM);
    bf16_t* Y = (bf16_t*)(ws + WS_Y);
    const int w = F.wave, lane = lane_id_fresh(), tid = w * 64 + lane, r32 = lane & 31, hi = lane >> 5;
    const int q0 = qb * 256, qw = q0 + 32 * w, ntiles = 4 * (qb + 1);
    const size_t rowb = (size_t)b * SEQ;
    const unsigned lds0 = (unsigned)(uintptr_t)F.lds;
    const unsigned kaddr = lds0 + r32 * SK + 16 * hi;
    const unsigned vaddr = lds0 + KBYTES + (((lane & 15) >> 2) + 4 * hi) * ATT_SV + (16 * ((lane >> 4) & 1) + 4 * (lane & 3)) * 2;
    float* O1 = (float*)(ws + WS_O1) + (rowb + qw + r32) * 512 + h * 128 + 4 * hi;
    for (int mp = 0; mp < NMAP; ++mp) {
        bf16x8 qf[NS];
        {
            const bf16_t* qp = MODE ? QM + (rowb + qw + r32) * 768 + h * 192 + 8 * hi : Z + (rowb + qw + r32) * NZ + ZC_DQ + h * 128 + mp * 64 + 8 * hi;
#pragma unroll
            for (int s = 0; s < NS; ++s) qf[s] = *(const bf16x8*)(qp + 16 * s);
            if (MODE == 1) {
                const float* csq = (const float*)(ws + WS_CS) + (rowb + qw + r32) * 64 + 8 * hi;
#pragma unroll
                for (int s = 8; s < NS; ++s) {
                    const f32x4 ca = *(const f32x4*)(csq + 16 * (s - 8)), cb = *(const f32x4*)(csq + 16 * (s - 8) + 4);
                    const u32x4 w = __builtin_bit_cast(u32x4, qf[s]); u32x4 o;
                    { const float x1 = bflo(w[0]), x2 = bfhi(w[0]); o[0] = pk2(x1 * ca[0] - x2 * ca[1], x2 * ca[0] + x1 * ca[1]); }
                    { const float x1 = bflo(w[1]), x2 = bfhi(w[1]); o[1] = pk2(x1 * ca[2] - x2 * ca[3], x2 * ca[2] + x1 * ca[3]); }
                    { const float x1 = bflo(w[2]), x2 = bfhi(w[2]); o[2] = pk2(x1 * cb[0] - x2 * cb[1], x2 * cb[0] + x1 * cb[1]); }
                    { const float x1 = bflo(w[3]), x2 = bfhi(w[3]); o[3] = pk2(x1 * cb[2] - x2 * cb[3], x2 * cb[2] + x1 * cb[3]); }
                    qf[s] = __builtin_bit_cast(bf16x8, o);
                }
            }
        }
        f32x16 o[4];
#pragma unroll
        for (int d = 0; d < 4; ++d) o[d] = (f32x16){};
        float m_run = -1e30f, l_run = 0.f;
        u32x4 kst[NKC], vst[2];
#define ATT_LOAD(j) do { const int k0_ = 64 * (j); \
            _Pragma("unroll") for (int i_ = 0; i_ < NKC; ++i_) { const int c_ = tid + 512 * i_, row_ = c_ / KCH, cc_ = c_ % KCH; \
                const bf16_t* src_ = MODE ? (cc_ < 16 ? KVM + (rowb + k0_ + row_) * 1024 + h * 256 + cc_ * 8 : KRM + (rowb + k0_ + row_) * 64 + (cc_ - 16) * 8) \
                                          : Z + (rowb + k0_ + row_) * NZ + ZC_DK + h * 128 + mp * 64 + cc_ * 8; \
                kst[i_] = *(const u32x4*)src_; } \
            _Pragma("unroll") for (int i_ = 0; i_ < 2; ++i_) { const int c_ = tid + 512 * i_, row_ = c_ >> 4, cc_ = c_ & 15; \
                const bf16_t* src_ = MODE ? KVM + (rowb + k0_ + row_) * 1024 + h * 256 + 128 + cc_ * 8 : Z + (rowb + k0_ + row_) * NZ + ZC_DV + h * 128 + cc_ * 8; \
                vst[i_] = *(const u32x4*)src_; } } while (0)
#define ATT_WRITE(buf) do { \
            _Pragma("unroll") for (int i_ = 0; i_ < NKC; ++i_) { const int c_ = tid + 512 * i_, row_ = c_ / KCH, cc_ = c_ % KCH; *(LAS u32x4*)(F.lds + (buf) * BUFB + row_ * SK + cc_ * 16) = kst[i_]; } \
            _Pragma("unroll") for (int i_ = 0; i_ < 2; ++i_) { const int c_ = tid + 512 * i_, row_ = c_ >> 4, cc_ = c_ & 15; *(LAS u32x4*)(F.lds + (buf) * BUFB + KBYTES + row_ * ATT_SV + cc_ * 16) = vst[i_]; } } while (0)
        ATT_LOAD(0); ATT_WRITE(0);
        __builtin_amdgcn_s_waitcnt(0x0F70);
        __syncthreads();
        for (int j = 0; j < ntiles; ++j) {
            const int k0 = 64 * j; const unsigned bo = (unsigned)(j & 1) * BUFB;
            if (j + 1 < ntiles) ATT_LOAD(j + 1);
            if (k0 <= qw + 31) {
                f32x16 p0 = (f32x16){}, p1 = (f32x16){};
#pragma unroll
                for (int s = 0; s < NS; ++s) {
                    const bf16x8 a0 = *(const LAS bf16x8*)(uintptr_t)(kaddr + bo + 32 * s), a1 = *(const LAS bf16x8*)(uintptr_t)(kaddr + bo + 32 * SK + 32 * s);
                    p0 = __builtin_amdgcn_mfma_f32_32x32x16_bf16(a0, qf[s], p0, 0, 0, 0);
                    p1 = __builtin_amdgcn_mfma_f32_32x32x16_bf16(a1, qf[s], p1, 0, 0, 0);
                }
                if (k0 + 63 > qw) {
                    const int qi = qw + r32;
#pragma unroll
                    for (int r = 0; r < 16; ++r) { const int key = k0 + crow(r, hi); if (key > qi) p0[r] = -1e30f; if (key + 32 > qi) p1[r] = -1e30f; }
                }
                float pmax = p0[0];
#pragma unroll
                for (int r = 1; r < 16; ++r) pmax = fmaxf(pmax, p0[r]);
#pragma unroll
                for (int r = 0; r < 16; ++r) pmax = fmaxf(pmax, p1[r]);
                pmax = fmaxf(pmax, bperm_f(lane ^ 32, pmax));
                const float mn = fmaxf(m_run, pmax), alpha = __builtin_amdgcn_exp2f((m_run - mn) * C), mnC = -mn * C; m_run = mn;
                float ps = 0.f;
#pragma unroll
                for (int r = 0; r < 16; ++r) { p0[r] = __builtin_amdgcn_exp2f(fmaf(p0[r], C, mnC)); p1[r] = __builtin_amdgcn_exp2f(fmaf(p1[r], C, mnC)); ps += p0[r] + p1[r]; }
                ps += bperm_f(lane ^ 32, ps);
                l_run = l_run * alpha + ps;
                if (!__all(alpha == 1.f)) {
#pragma unroll
                    for (int d = 0; d < 4; ++d) o[d] *= alpha;
                }
                const bf16x8 p00 = pack8(p0, 0), p01 = pack8(p0, 8), p10 = pack8(p1, 0), p11 = pack8(p1, 8);
                pv_block<0>(o[0], vaddr + bo, p00, p01, p10, p11); pv_block<1>(o[1], vaddr + bo, p00, p01, p10, p11);
                pv_block<2>(o[2], vaddr + bo, p00, p01, p10, p11); pv_block<3>(o[3], vaddr + bo, p00, p01, p10, p11);
            }
            if (j + 1 < ntiles) ATT_WRITE((j + 1) & 1);
            __syncthreads();
        }
#undef ATT_LOAD
#undef ATT_WRITE
        const float il = rcpf_(l_run);
        if (MODE == 0 && mp == 0) {
#pragma unroll
            for (int d = 0; d < 4; ++d)
#pragma unroll
                for (int r4 = 0; r4 < 4; ++r4) *(f32x4*)(O1 + 32 * d + 8 * r4) = (f32x4){o[d][4 * r4] * il, o[d][4 * r4 + 1] * il, o[d][4 * r4 + 2] * il, o[d][4 * r4 + 3] * il};
        } else {
            const size_t yrow = (rowb + qw + r32) * D + (MODE ? 1024 : 0) + h * 128 + 4 * hi;
            if (MODE == 0) {
                const float* lv = (const float*)(ws + WS_PRM) + l * PRM_L + PRM_DL;
                const float s01 = wave_sum(lv[lane] * lv[64 + lane]), s23 = wave_sum(lv[128 + lane] * lv[192 + lane]);
                const float lam_init = 0.8f - 0.6f * __expf(-0.3f * (float)l);
                const float lam = __expf(s01) - __expf(s23) + lam_init;
                const float il2 = lam * il; float ss = 0.f;
#pragma unroll
                for (int d = 0; d < 4; ++d)
#pragma unroll
                    for (int r4 = 0; r4 < 4; ++r4) { const f32x4 a1 = *(const f32x4*)(O1 + 32 * d + 8 * r4);
#pragma unroll
                        for (int e = 0; e < 4; ++e) { const float x = a1[e] - o[d][4 * r4 + e] * il2; o[d][4 * r4 + e] = x; ss += x * x; } }
                ss += bperm_f(lane ^ 32, ss);
                const float rn = rsqrtf(ss * (1.f / 128.f) + EPS) * (1.f - lam_init);
                const float* g = (const float*)(ws + WS_PRM) + l * PRM_L + PRM_DN + h * 128 + 4 * hi;
#pragma unroll
                for (int d = 0; d < 4; ++d)
#pragma unroll
                    for (int r4 = 0; r4 < 4; ++r4) {
                        const f32x4 gg = *(const f32x4*)(g + 32 * d + 8 * r4);
                        u32x2 wv; wv.x = pk2(o[d][4 * r4] * rn * gg[0], o[d][4 * r4 + 1] * rn * gg[1]); wv.y = pk2(o[d][4 * r4 + 2] * rn * gg[2], o[d][4 * r4 + 3] * rn * gg[3]);
                        *(u32x2*)(Y + yrow + 32 * d + 8 * r4) = wv;
                    }
            } else {
#pragma unroll
                for (int d = 0; d < 4; ++d)
#pragma unroll
                    for (int r4 = 0; r4 < 4; ++r4) {
                        u32x2 wv; wv.x = pk2(o[d][4 * r4] * il, o[d][4 * r4 + 1] * il); wv.y = pk2(o[d][4 * r4 + 2] * il, o[d][4 * r4 + 3] * il);
                        *(u32x2*)(Y + yrow + 32 * d + 8 * r4) = wv;
                    }
            }
        }
    }
}
__device__ __forceinline__ void attn_fast(Frame& F, int l) {
    const int first = F.bid - 32 * NSEG;
#pragma unroll 1
    for (int i_ = 0; i_ < 2; ++i_) { const int u = i_ ? 255 - first : first;
        const int qb = 7 - (u >> 5), mode = (u >> 4) & 1, b = (u >> 2) & 3, h = u & 3;
        if (mode == 0) attn_unit<0>(F, l, b, h, qb); else attn_unit<1>(F, l, b, h, qb);
    }
}

typedef float f32x4_t __attribute__((ext_vector_type(4)));
template <int KIND>
__device__ __forceinline__ void scan_unit(Frame& F, int l, int b, int h, int seg) {
    constexpr int DK = KIND ? 64 : 128, NKS = DK / 32, NDT = DK / 16, SQ = DK * 2 + 16, SA = 144;
    constexpr int L_QT = 0, L_KT = 64 * SQ, L_KTT = 128 * SQ, L_VT = L_KTT + DK * SA, L_AT = L_VT + 128 * SA, L_ST = L_AT + 64 * SA, L_TAB = L_ST + 128 * SQ;
    constexpr int T_ER = L_TAB, T_EC = T_ER + 512, T_PS = T_EC + 512, T_QS = T_PS + 2048, T_KS = T_QS + 256, T_MT = T_KS + 256, T_NP = T_MT + 256, T_SC = T_NP + 256, T_DEN = T_SC + 64;
    static_assert(T_DEN + 8 * 256 <= RING_BYTES, "scan LDS");
    unsigned char* ws = F.ws;
    const bf16_t* Z = (const bf16_t*)(ws + WS_Z);
    float* OUT = (float*)(ws + (KIND ? WS_OL : WS_OG));
    const float* prm = (const float*)(ws + WS_PRM) + l * PRM_L;
    LAS unsigned char* lds = F.lds;
    const int w = F.wave, lane = lane_id_fresh(), tid = w * 64 + lane, l15 = lane & 15, g = lane >> 4;
    const int ch = tid & 127, part = tid >> 7, i0 = 16 * part;
    if (w == 2 || w == 3) { const int rt = (w == 2) ? 0 : 2;
#pragma unroll
        for (int r = 0; r < 4; ++r) *(LAS bf16_t*)(lds + L_AT + (16 * rt + 4 * g + r) * SA + (16 * (rt + 1) + l15) * 2) = 0; }
    f32x4 st[NDT];
#pragma unroll
    for (int d = 0; d < NDT; ++d) st[d] = (f32x4){0.f, 0.f, 0.f, 0.f};
    float m_prev = 0.f, np_reg = 0.f, colsum = 0.f, bseg = 0.f;
    float cumlog = 0.f;
    const int bh = b * 4 + h;
    bf16_t* QTS = (bf16_t*)(ws + (KIND ? WS_QTL : WS_QTG)) + (size_t)bh * SEQ * DK;
    float* SCL = (float*)(ws + WS_SCL) + (size_t)bh * SEQ * 4;
    const float lb = KIND ? 0.f : ((const float*)(ws + WS_LBS))[l * 512 + h * 128 + ch];
    unsigned zA[16], zB[16], vr[16], gA = 0, gB = 0;
#define SCAN_LOAD(cc) do { const size_t r0_ = (size_t)b * SEQ + 64 * (cc); \
        if (KIND == 0) { const bf16_t* zr_ = Z + (r0_ + i0) * NZ + h * 128 + ch; \
            _Pragma("unroll") for (int j = 0; j < 16; ++j) { zA[j] = zr_[j * NZ + ZC_GF]; zB[j] = zr_[j * NZ + ZC_GQ]; } } \
        else { const int cidx_ = (ch < 64) ? h * 64 + ch : 256 + h * 64 + (ch - 64); const bf16_t* zc_ = Z + (r0_ + i0) * NZ + ZC_LQ + cidx_; \
            _Pragma("unroll") for (int j = 0; j < 16; ++j) zA[j] = zc_[j * NZ]; \
            if (!((cc) == 0 && part == 0)) { zB[0] = zc_[-3 * NZ]; zB[1] = zc_[-2 * NZ]; zB[2] = zc_[-1 * NZ]; } \
            if (w == 0) { const bf16_t* zg_ = Z + (r0_ + lane) * NZ + h; gA = zg_[ZC_LI]; gB = zg_[ZC_LF]; } } \
        { const bf16_t* zv_ = Z + (r0_ + i0) * NZ + (KIND ? ZC_LV : ZC_GV) + h * 128 + ch; \
            _Pragma("unroll") for (int j = 0; j < 16; ++j) vr[j] = zv_[j * NZ]; } } while (0)
    SCAN_LOAD(seg * SEGC);
#pragma unroll 1
    for (int c = seg * SEGC; c < (seg + 1) * SEGC; ++c) {
        const size_t row0 = (size_t)b * SEQ + 64 * c;
        float qv[16], kv[16], lf[16];
        if (KIND == 0) {
            float run = 0.f;
#pragma unroll
            for (int j = 0; j < 16; ++j) {
                const float zf = fmaxf(bf2f((bf16_t)zA[j]), -30.f), zq = bf2f((bf16_t)zB[j]);
                const float ez = __expf(-zf), sg = rcpf_(1.f + ez), sgn = ez * sg;
                run += __logf(lb + (1.f - lb) * sg); lf[j] = run; qv[j] = zq * 0.08838834764831845f; kv[j] = (1.f - lb) * sgn;
            }
            *(LAS float*)(lds + T_PS + (part * 128 + ch) * 4) = run;
        } else {
            const int cidx = (ch < 64) ? h * 64 + ch : 256 + h * 64 + (ch - 64);
            const float w0 = prm[PRM_CW + cidx], w1 = prm[PRM_CW + 512 + cidx], w2 = prm[PRM_CW + 1024 + cidx], w3 = prm[PRM_CW + 1536 + cidx], cb = prm[PRM_CB + cidx];
            const bool first = (c == 0 && part == 0);
            float x0 = first ? 0.f : bf2f((bf16_t)zB[0]), x1 = first ? 0.f : bf2f((bf16_t)zB[1]), x2 = first ? 0.f : bf2f((bf16_t)zB[2]);
#pragma unroll
            for (int j = 0; j < 16; ++j) {
                const float x3 = bf2f((bf16_t)zA[j]);
                float v = cb + x0 * w0 + x1 * w1 + x2 * w2 + x3 * w3; v = v * rcpf_(1.f + __expf(-v));
                qv[j] = (ch < 64) ? v * 0.125f : v; x0 = x1; x1 = x2; x2 = x3;
            }
            if (w == 0) {
                const float li = bf2f((bf16_t)gA) + prm[PRM_GB + h], zf = bf2f((bf16_t)gB) + prm[PRM_GB + 4 + h];
                const float lfv = fminf(zf, 0.f) - __logf(1.f + __expf(-fabsf(zf)));
                float bb = lfv;
#pragma unroll
                for (int o = 1; o < 64; o <<= 1) { const float t_ = bperm_f(lane - o, bb); if (lane >= o) bb += t_; }
                const float a_ = li - bb; float cm = a_;
#pragma unroll
                for (int o = 1; o < 64; o <<= 1) { const float t_ = bperm_f(lane - o, cm); if (lane >= o) cm = fmaxf(cm, t_); }
                const float M = fmaxf(m_prev, cm), MC = rdlane_f(M, 63), bC = rdlane_f(bb, 63);
                *(LAS float*)(lds + T_QS + lane * 4) = __expf(MC - M); *(LAS float*)(lds + T_KS + lane * 4) = __expf(a_ - MC); *(LAS float*)(lds + T_MT + lane * 4) = bb + M;
                if (seg > 0) { float* sp_ = SCL + (size_t)(64 * c + lane) * 4; sp_[1] = bb + M; sp_[2] = bseg + bb; }
                bseg += bC;
                const float cs = __expf(m_prev - MC);
                np_reg = cs * (np_reg + colsum);
                *(LAS float*)(lds + T_NP + lane * 4) = np_reg;
                if (lane == 0) *(LAS float*)(lds + T_SC) = cs;
                m_prev = bC + MC;
            }
        }
        __syncthreads();
        {
            unsigned ktt[8];
            if (KIND == 0) {
                const float p0 = *(LAS float*)(lds + T_PS + ch * 4), p1 = *(LAS float*)(lds + T_PS + (128 + ch) * 4), p2 = *(LAS float*)(lds + T_PS + (256 + ch) * 4), p3 = *(LAS float*)(lds + T_PS + (384 + ch) * 4);
                const float r_ = p0 + p1, off = (part > 0 ? p0 : 0.f) + (part > 1 ? p1 : 0.f) + (part > 2 ? p2 : 0.f);
                if (part == 0) { *(LAS float*)(lds + T_ER + ch * 4) = __expf(r_); *(LAS float*)(lds + T_EC + ch * 4) = __expf(p2 + p3); }
                const float eseg = (seg > 0) ? __expf(r_ + cumlog) : 0.f;
                bf16_t* qg_ = QTS + (size_t)(64 * c + i0) * DK + ch;
                cumlog += (p0 + p1) + (p2 + p3);
#pragma unroll
                for (int j = 0; j < 16; ++j) {
                    const float x = fminf(fmaxf(off + lf[j] - r_, -80.f), 80.f);
                    const float qt = qv[j] * __expf(x), kt = kv[j] * __expf(-x);
                    *(LAS bf16_t*)(lds + L_QT + (i0 + j) * SQ + ch * 2) = (bf16_t)f2bf(qt);
                    if (seg > 0) qg_[j * DK] = (bf16_t)f2bf(qt * eseg);
                    const unsigned kb_ = f2bf(kt);
                    *(LAS bf16_t*)(lds + L_KT + (i0 + j) * SQ + ch * 2) = (bf16_t)kb_;
                    if (j & 1) ktt[j >> 1] |= kb_ << 16; else ktt[j >> 1] = kb_;
                }
                *(LAS u32x4*)(lds + L_KTT + ch * SA + i0 * 2) = (u32x4){ktt[0], ktt[1], ktt[2], ktt[3]};
                *(LAS u32x4*)(lds + L_KTT + ch * SA + i0 * 2 + 16) = (u32x4){ktt[4], ktt[5], ktt[6], ktt[7]};
            } else {
#pragma unroll
                for (int j = 0; j < 16; ++j) {
                    const float fs = *(LAS float*)(lds + ((ch < 64) ? T_QS : T_KS) + (i0 + j) * 4);
                    const unsigned vb_ = f2bf(qv[j] * fs);
                    if (ch < 64) { *(LAS bf16_t*)(lds + L_QT + (i0 + j) * SQ + ch * 2) = (bf16_t)vb_; if (seg > 0) QTS[(size_t)(64 * c + i0 + j) * DK + ch] = (bf16_t)f2bf(qv[j]); }
                    else *(LAS bf16_t*)(lds + L_KT + (i0 + j) * SQ + (ch - 64) * 2) = (bf16_t)vb_;
                    if (j & 1) ktt[j >> 1] |= vb_ << 16; else ktt[j >> 1] = vb_;
                }
                if (ch >= 64) {
                    *(LAS u32x4*)(lds + L_KTT + (ch - 64) * SA + i0 * 2) = (u32x4){ktt[0], ktt[1], ktt[2], ktt[3]};
                    *(LAS u32x4*)(lds + L_KTT + (ch - 64) * SA + i0 * 2 + 16) = (u32x4){ktt[4], ktt[5], ktt[6], ktt[7]};
                }
            }
            *(LAS u32x4*)(lds + L_VT + ch * SA + i0 * 2) = (u32x4){vr[0] | (vr[1] << 16), vr[2] | (vr[3] << 16), vr[4] | (vr[5] << 16), vr[6] | (vr[7] << 16)};
            *(LAS u32x4*)(lds + L_VT + ch * SA + i0 * 2 + 16) = (u32x4){vr[8] | (vr[9] << 16), vr[10] | (vr[11] << 16), vr[12] | (vr[13] << 16), vr[14] | (vr[15] << 16)};
        }
        __syncthreads();
        for (int ti = w; ti < 10; ti += 8) {
            const int rt = (int)((0x3333222110ull >> (4 * ti)) & 15), ct = (int)((0x3210210100ull >> (4 * ti)) & 15);
            f32x4 acc = (f32x4){0.f, 0.f, 0.f, 0.f};
#pragma unroll
            for (int ks = 0; ks < NKS; ++ks) {
                const bf16x8 af = *(const LAS bf16x8*)(lds + L_QT + (16 * rt + l15) * SQ + (32 * ks + 8 * g) * 2), bfr = *(const LAS bf16x8*)(lds + L_KT + (16 * ct + l15) * SQ + (32 * ks + 8 * g) * 2);
                acc = __builtin_amdgcn_mfma_f32_16x16x32_bf16(af, bfr, acc, 0, 0, 0);
            }
#pragma unroll
            for (int r = 0; r < 4; ++r) { const int t_ = 16 * rt + 4 * g + r, s_ = 16 * ct + l15; *(LAS bf16_t*)(lds + L_AT + t_ * SA + s_ * 2) = (bf16_t)f2bf(s_ <= t_ ? acc[r] : 0.f); }
        }
        {
            const float cs = KIND ? *(LAS float*)(lds + T_SC) : 1.f;
#pragma unroll
            for (int d = 0; d < NDT; ++d) {
                if (KIND == 0) st[d] *= *(const LAS f32x4*)(lds + T_ER + (16 * d + 4 * g) * 4); else st[d] *= cs;
                u32x2 pk; pk.x = pk2(st[d][0], st[d][1]); pk.y = pk2(st[d][2], st[d][3]);
                *(LAS u32x2*)(lds + L_ST + (16 * w + l15) * SQ + (16 * d + 4 * g) * 2) = pk;
            }
        }
        __syncthreads();
        { const int cn_ = (c + 1 < SEQ / 64) ? c + 1 : c; SCAN_LOAD(cn_); }
        __builtin_amdgcn_sched_barrier(0);
        bf16x8 sfr[NKS], vfr[2];
#pragma unroll
        for (int ks = 0; ks < NKS; ++ks) sfr[ks] = *(const LAS bf16x8*)(lds + L_ST + (16 * w + l15) * SQ + (32 * ks + 8 * g) * 2);
#pragma unroll
        for (int ks = 0; ks < 2; ++ks) vfr[ks] = *(const LAS bf16x8*)(lds + L_VT + (16 * w + l15) * SA + (32 * ks + 8 * g) * 2);
        if (KIND == 1) {
            float dn = 0.f;
#pragma unroll
            for (int d8 = 0; d8 < 8; ++d8) { const u32x4 qw_ = *(const LAS u32x4*)(lds + L_QT + lane * SQ + d8 * 16); const f32x4 n0 = *(const LAS f32x4*)(lds + T_NP + d8 * 32), n1 = *(const LAS f32x4*)(lds + T_NP + d8 * 32 + 16);
                dn += bflo(qw_[0]) * n0[0] + bfhi(qw_[0]) * n0[1] + bflo(qw_[1]) * n0[2] + bfhi(qw_[1]) * n0[3] + bflo(qw_[2]) * n1[0] + bfhi(qw_[2]) * n1[1] + bflo(qw_[3]) * n1[2] + bfhi(qw_[3]) * n1[3]; }
#pragma unroll
            for (int s8 = 0; s8 < 8; ++s8) { const u32x4 aw_ = *(const LAS u32x4*)(lds + L_AT + lane * SA + s8 * 16);
#pragma unroll
                for (int e = 0; e < 4; ++e) { const int s_ = 8 * s8 + 2 * e; dn += (s_ <= lane ? bflo(aw_[e]) : 0.f) + (s_ + 1 <= lane ? bfhi(aw_[e]) : 0.f); } }
            *(LAS float*)(lds + T_DEN + (w * 64 + lane) * 4) = dn;
            if (w == 0 && seg > 0) SCL[(size_t)(64 * c + lane) * 4] = dn;
            if (w == 0) {
                float cs_ = 0.f;
                for (int s_ = 0; s_ < 64; ++s_) cs_ += bf2f(*(const LAS bf16_t*)(lds + L_KT + s_ * SQ + lane * 2));
                colsum = cs_;
            }
        }
#pragma unroll
        for (int rt = 0; rt < 4; ++rt) {
            f32x4 o = (f32x4){0.f, 0.f, 0.f, 0.f};
#pragma unroll
            for (int ks = 0; ks < NKS; ++ks) o = __builtin_amdgcn_mfma_f32_16x16x32_bf16(*(const LAS bf16x8*)(lds + L_QT + (16 * rt + l15) * SQ + (32 * ks + 8 * g) * 2), sfr[ks], o, 0, 0, 0);
#pragma unroll
            for (int ks = 0; ks < 2; ++ks) if (2 * ks <= rt) o = __builtin_amdgcn_mfma_f32_16x16x32_bf16(*(const LAS bf16x8*)(lds + L_AT + (16 * rt + l15) * SA + (32 * ks + 8 * g) * 2), vfr[ks], o, 0, 0, 0);
            float* op = OUT + (row0 + 16 * rt + 4 * g) * 512 + h * 128 + 16 * w + l15;
            if (KIND == 1) {
                const f32x4 dn = *(const LAS f32x4*)(lds + T_DEN + (w * 64 + 16 * rt + 4 * g) * 4), mt = *(const LAS f32x4*)(lds + T_MT + (16 * rt + 4 * g) * 4);
#pragma unroll
                for (int r = 0; r < 4; ++r) op[r * 512] = (seg > 0) ? o[r] : o[r] * rcpf_(fmaxf(fabsf(dn[r]), __expf(-mt[r])));
            } else {
#pragma unroll
                for (int r = 0; r < 4; ++r) op[r * 512] = o[r];
            }
        }
#pragma unroll
        for (int d = 0; d < NDT; ++d) {
#pragma unroll
            for (int ks = 0; ks < 2; ++ks) st[d] = __builtin_amdgcn_mfma_f32_16x16x32_bf16(*(const LAS bf16x8*)(lds + L_KTT + (16 * d + l15) * SA + (32 * ks + 8 * g) * 2), vfr[ks], st[d], 0, 0, 0);
            if (KIND == 0) st[d] *= *(const LAS f32x4*)(lds + T_EC + (16 * d + 4 * g) * 4);
        }
        __syncthreads();
    }
#undef SCAN_LOAD
    if (seg < NSEG - 1) {
        float* SIF = (float*)(ws + WS_SIF) + (size_t)((KIND * 16 + bh) * NSEG) * 16384;
        bf16_t* SIB = (bf16_t*)(ws + WS_SIB) + (size_t)((KIND * 16 + bh) * NSEG) * 16384;
        float* SIM = (float*)(ws + WS_SIM) + (size_t)(bh * NSEG) * 128;
        unsigned* flg = (unsigned*)(ws + WS_CTL + CTL_SEGF) + (size_t)(((l * 2 + KIND) * 16 + bh) * NSEG) * 16;
        if (KIND == 0 && part == 0) *(LAS float*)(lds + T_PS + ch * 4) = cumlog;
        if (seg > 0) {
            if (w == 0) { unsigned spins = 0; while (__builtin_amdgcn_readfirstlane(__hip_atomic_load(flg + seg * 16, __ATOMIC_RELAXED, __HIP_MEMORY_SCOPE_AGENT)) == 0u && ++spins < (1u << 22)) __builtin_amdgcn_s_sleep(2); }
            __syncthreads();
            __builtin_amdgcn_fence(__ATOMIC_ACQUIRE, "agent");
        }
        if (KIND == 1 && w == 0) {
            const float n_loc = np_reg + colsum; float m_new = m_prev, al_ = 1.f, be_ = 0.f, n_init = 0.f;
            if (seg > 0) { const float m_init = SIM[seg * 128 + 64]; n_init = SIM[seg * 128 + lane]; m_new = fmaxf(m_prev, bseg + m_init); al_ = __expf(m_prev - m_new); be_ = __expf(bseg + m_init - m_new); }
            __hip_atomic_store(SIM + (seg + 1) * 128 + lane, al_ * n_loc + be_ * n_init, __ATOMIC_RELAXED, __HIP_MEMORY_SCOPE_AGENT);
            if (lane == 0) { __hip_atomic_store(SIM + (seg + 1) * 128 + 64, m_new, __ATOMIC_RELAXED, __HIP_MEMORY_SCOPE_AGENT); if (seg > 0) { *(LAS float*)(lds + T_SC) = al_; *(LAS float*)(lds + T_SC + 4) = be_; } }
        }
        __syncthreads();
        float al_ = 1.f, be_ = 0.f;
        if (KIND == 1 && seg > 0) { al_ = *(LAS float*)(lds + T_SC); be_ = *(LAS float*)(lds + T_SC + 4); }
#pragma unroll
        for (int d = 0; d < NDT; ++d) {
            f32x4 val = st[d];
            if (seg > 0) {
                const f32x4 prev = *(const f32x4*)(SIF + (size_t)seg * 16384 + (16 * w + l15) * 128 + 16 * d + 4 * g);
                if (KIND == 0) { const f32x4 cl_ = *(const LAS f32x4*)(lds + T_PS + (16 * d + 4 * g) * 4);
#pragma unroll
                    for (int r = 0; r < 4; ++r) val[r] += __expf(cl_[r]) * prev[r]; }
                else val = al_ * val + be_ * prev;
            }
            const size_t o_ = (size_t)(seg + 1) * 16384 + (16 * w + l15) * 128 + 16 * d + 4 * g;
            __hip_atomic_store((u64*)(SIF + o_), (u64)__builtin_bit_cast(unsigned, val[0]) | ((u64)__builtin_bit_cast(unsigned, val[1]) << 32), __ATOMIC_RELAXED, __HIP_MEMORY_SCOPE_AGENT);
            __hip_atomic_store((u64*)(SIF + o_ + 2), (u64)__builtin_bit_cast(unsigned, val[2]) | ((u64)__builtin_bit_cast(unsigned, val[3]) << 32), __ATOMIC_RELAXED, __HIP_MEMORY_SCOPE_AGENT);
            __hip_atomic_store((u64*)(SIB + o_), (u64)pk2(val[0], val[1]) | ((u64)pk2(val[2], val[3]) << 32), __ATOMIC_RELAXED, __HIP_MEMORY_SCOPE_AGENT);
        }
        asm volatile("s_waitcnt vmcnt(0)" ::: "memory");
        __syncthreads();
        if (tid == 0) __hip_atomic_store(flg + (seg + 1) * 16, 1u, __ATOMIC_RELAXED, __HIP_MEMORY_SCOPE_AGENT);
    }
}

template <int KIND>
__device__ __forceinline__ void norm_unit(Frame& F, int l, int b, int h, int rb, int seg) {
    constexpr int DK = KIND ? 64 : 128, NKS = DK / 32;
    unsigned char* ws = F.ws;
    const int lane = lane_id_fresh(), l15 = lane & 15, g = lane >> 4, bh = b * 4 + h;
    const size_t trow = (size_t)b * SEQ + 32 * rb;
    const float* prm = (const float*)(ws + WS_PRM) + l * PRM_L + (KIND ? PRM_MN : PRM_HN) + h * 128 + 4 * g;
    const bf16_t* Zg = (const bf16_t*)(ws + WS_Z) + (trow + l15) * NZ + (KIND ? ZC_LO : ZC_GG) + h * 128 + 4 * g;
    const float* OUT = (const float*)(ws + (KIND ? WS_OL : WS_OG)) + (trow + l15) * 512 + h * 128 + 4 * g;
    bf16_t* Y = (bf16_t*)(ws + WS_Y) + (trow + l15) * D + (KIND ? 1536 : 512) + h * 128 + 4 * g;
    f32x4 acc[2][8];
#pragma unroll
    for (int rt = 0; rt < 2; ++rt)
#pragma unroll
        for (int vt = 0; vt < 8; ++vt) acc[rt][vt] = (f32x4){0.f, 0.f, 0.f, 0.f};
    float ea[2] = {1.f, 1.f}, eb[2] = {0.f, 0.f}, inv[2] = {1.f, 1.f};
    f32x4 ov[2][8];
#pragma unroll
    for (int rt = 0; rt < 2; ++rt)
#pragma unroll
        for (int vt = 0; vt < 8; ++vt) ov[rt][vt] = *(const f32x4*)(OUT + (size_t)(16 * rt) * 512 + 16 * vt);
    __builtin_amdgcn_sched_barrier(0);
    if (seg > 0) {
        const bf16_t* SIB = (const bf16_t*)(ws + WS_SIB) + (size_t)((KIND * 16 + bh) * NSEG + seg) * 16384;
        const bf16_t* QTS = (const bf16_t*)(ws + (KIND ? WS_QTL : WS_QTG)) + ((size_t)bh * SEQ + 32 * rb + l15) * DK + 8 * g;
        bf16x8 qf[2][NKS];
#pragma unroll
        for (int rt = 0; rt < 2; ++rt)
#pragma unroll
            for (int ks = 0; ks < NKS; ++ks) qf[rt][ks] = *(const bf16x8*)(QTS + (size_t)(16 * rt) * DK + 32 * ks);
#pragma unroll
        for (int v2 = 0; v2 < 8; v2 += 2) {
            bf16x8 af[2][NKS];
#pragma unroll
            for (int vv = 0; vv < 2; ++vv)
#pragma unroll
                for (int ks = 0; ks < NKS; ++ks) af[vv][ks] = *(const bf16x8*)(SIB + (16 * (v2 + vv) + l15) * 128 + 32 * ks + 8 * g);
            __builtin_amdgcn_sched_barrier(0);
#pragma unroll
            for (int vv = 0; vv < 2; ++vv)
#pragma unroll
                for (int ks = 0; ks < NKS; ++ks)
#pragma unroll
                    for (int rt = 0; rt < 2; ++rt) acc[rt][v2 + vv] = __builtin_amdgcn_mfma_f32_16x16x32_bf16(af[vv][ks], qf[rt][ks], acc[rt][v2 + vv], 0, 0, 0);
        }
        if (KIND == 1) {
            const float* SIM = (const float*)(ws + WS_SIM) + (size_t)(bh * NSEG + seg) * 128;
            const float m_init = SIM[64];
            f32x4 nq[2] = {(f32x4){0.f, 0.f, 0.f, 0.f}, (f32x4){0.f, 0.f, 0.f, 0.f}};
#pragma unroll
            for (int ks = 0; ks < NKS; ++ks) { const f32x4 n0 = *(const f32x4*)(SIM + 32 * ks + 8 * g), n1 = *(const f32x4*)(SIM + 32 * ks + 8 * g + 4);
                const u32x4 nw = (u32x4){pk2(n0[0], n0[1]), pk2(n0[2], n0[3]), pk2(n1[0], n1[1]), pk2(n1[2], n1[3])}; const bf16x8 nfr = __builtin_bit_cast(bf16x8, nw);
#pragma unroll
                for (int rt = 0; rt < 2; ++rt) nq[rt] = __builtin_amdgcn_mfma_f32_16x16x32_bf16(nfr, qf[rt][ks], nq[rt], 0, 0, 0); }
#pragma unroll
            for (int rt = 0; rt < 2; ++rt) {
                const f32x4 sc = *(const f32x4*)((const float*)(ws + WS_SCL) + ((size_t)bh * SEQ + 32 * rb + 16 * rt + l15) * 4);
                const float mi = sc[2] + m_init, mp = fmaxf(sc[1], mi); ea[rt] = __expf(sc[1] - mp); eb[rt] = __expf(mi - mp);
                inv[rt] = rcpf_(fmaxf(fabsf(sc[0] * ea[rt] + nq[rt][0] * eb[rt]), __expf(-mp)));
            }
        }
    }
    u32x2 zv[2][8]; f32x4 gnv[8];
#pragma unroll
    for (int vt = 0; vt < 8; ++vt) { gnv[vt] = *(const f32x4*)(prm + 16 * vt);
#pragma unroll
        for (int rt = 0; rt < 2; ++rt) zv[rt][vt] = *(const u32x2*)(Zg + (size_t)(16 * rt) * NZ + 16 * vt); }
    __builtin_amdgcn_sched_barrier(0);
#pragma unroll
    for (int rt = 0; rt < 2; ++rt) {
        float ss = 0.f;
#pragma unroll
        for (int vt = 0; vt < 8; ++vt) {
            const f32x4 o = ov[rt][vt];
            if (KIND == 0) acc[rt][vt] += o; else acc[rt][vt] = (o * ea[rt] + acc[rt][vt] * eb[rt]) * inv[rt];
            ss += acc[rt][vt][0] * acc[rt][vt][0] + acc[rt][vt][1] * acc[rt][vt][1] + acc[rt][vt][2] * acc[rt][vt][2] + acc[rt][vt][3] * acc[rt][vt][3];
        }
        ss += bperm_f(lane ^ 16, ss); ss += bperm_f(lane ^ 32, ss);
        const float r = rsqrtf(ss * (1.f / 128.f) + EPS);
#pragma unroll
        for (int vt = 0; vt < 8; ++vt) {
            const u32x2 zw = zv[rt][vt]; const f32x4 gn = gnv[vt];
            const float z0 = bflo(zw[0]), z1 = bfhi(zw[0]), z2 = bflo(zw[1]), z3 = bfhi(zw[1]);
            const float s0 = sigmoidf_(z0), s1 = sigmoidf_(z1), s2 = sigmoidf_(z2), s3 = sigmoidf_(z3);
            const f32x4 a = acc[rt][vt];
            u32x2 wv; wv.x = pk2(a[0] * r * gn[0] * (KIND ? s0 : z0 * s0), a[1] * r * gn[1] * (KIND ? s1 : z1 * s1)); wv.y = pk2(a[2] * r * gn[2] * (KIND ? s2 : z2 * s2), a[3] * r * gn[3] * (KIND ? s3 : z3 * s3));
            *(u32x2*)(Y + (size_t)(16 * rt) * D + 16 * vt) = wv;
        }
    }
}
__device__ __forceinline__ void scan_norm(Frame& F, int l) {
#pragma unroll 1
    for (int u = F.bid; u < 256; u += F.G) {
        const int b = u >> 6, rb = u & 63, seg = rb / (64 / NSEG), h = F.wave >> 1;
        if (F.wave & 1) norm_unit<1>(F, l, b, h, rb, seg); else norm_unit<0>(F, l, b, h, rb, seg);
    }
}

__device__ __forceinline__ v32f_t ld_row6(const unsigned char* rowp, int lane) {
    const u32x4 a = *(const u32x4*)(rowp + lane * 16); const u32x2 b = *(const u32x2*)(rowp + 1024 + lane * 8);
    const v6u_t p = (v6u_t){a[0], a[1], a[2], a[3], b[0], b[1]};
    return __builtin_amdgcn_cvt_scalef32_pk32_f32_fp6(p, 1.0f);
}
__device__ __forceinline__ float sw32_add(float a, float b) { asm volatile("s_nop 1\n\tv_permlane32_swap_b32 %0, %1\n\ts_nop 1" : "+v"(a), "+v"(b)); return a + b; }
__device__ __forceinline__ float sw16_add(float a, float b) { asm volatile("s_nop 1\n\tv_permlane16_swap_b32 %0, %1\n\ts_nop 1" : "+v"(a), "+v"(b)); return a + b; }
__device__ __forceinline__ float reduce8(const float (&p)[8], int lane) {
    const float q0 = sw16_add(sw32_add(p[0], p[1]), sw32_add(p[2], p[3])), q1 = sw16_add(sw32_add(p[4], p[5]), sw32_add(p[6], p[7]));
    const float t0 = q0 + DPP_F(q0, 0x128), t1 = q1 + DPP_F(q1, 0x128);
    float t = (lane & 8) ? t1 : t0;
    t += DPP_F(t, 0xB1); t += DPP_F(t, 0x4E); t += DPP_F(t, 0x141);
    return t;
}
__device__ __forceinline__ void peer_gather(Frame& F, int l) {
    constexpr int NF = 16;
    unsigned char* ws = F.ws;
    const unsigned char* U4 = ws + WS_UB + (size_t)l * NEXP * VROW; const unsigned char* V4 = ws + WS_VB + (size_t)l * NEXP * VROW;
    const float* SU = (const float*)(ws + WS_SU) + l * NEXP; const float* SV = (const float*)(ws + WS_SV) + l * NEXP;
    const int* PIDX = (const int*)(ws + WS_PIDX); const float* PG = (const float*)(ws + WS_PGATE);
    bf16_t* HB = (bf16_t*)(ws + WS_HB) + (size_t)(l & 1) * T * D;
    const u64* ssqB = (const u64*)(ws + WS_CTL + CTL_SSQB) + l * T; float* ssqC = (float*)(ws + WS_CTL + CTL_SSQC) + l * T;
    const int lane = F.lane;
    LAS float* cl = (LAS float*)(F.lds + F.wave * 512);
    int emap;
    { float lab[8];
#pragma unroll
      for (int k = 0; k < 8; ++k) lab[k] = (float)k * (1.f / 64.f);
      emap = (int)(reduce8(lab, lane) + 0.5f); }
    for (int t = F.gw; t < T; t += F.ngw) {
        float x[32];
#pragma unroll
        for (int q = 0; q < 8; ++q) { const u32x2 w = *(const u32x2*)(HB + (size_t)t * D + q * 256 + lane * 4);
            x[4 * q] = bflo(w[0]); x[4 * q + 1] = bfhi(w[0]); x[4 * q + 2] = bflo(w[1]); x[4 * q + 3] = bfhi(w[1]); }
        const float rs = rsqrtf(ssq_get(ssqB + t) * (1.f / D) + EPS);
        const int myidx0 = PIDX[(size_t)t * 128 + lane], myidx1 = PIDX[(size_t)t * 128 + 64 + lane];
        const float mys0 = SU[myidx0] * rs, mys1 = SU[myidx1] * rs;
        const float myg0 = PG[(size_t)t * 128 + lane] * SV[myidx0], myg1 = PG[(size_t)t * 128 + 64 + lane] * SV[myidx1];
#pragma unroll 1
        for (int e0 = 0; e0 < 128; e0 += NF) {
            u32x4 uw[NF];
#pragma unroll
            for (int k = 0; k < NF; ++k) { const int e = e0 + k; const int idx = __builtin_amdgcn_readlane(e < 64 ? myidx0 : myidx1, e & 63); uw[k] = *(const u32x4*)(U4 + (size_t)idx * VROW + lane * 16); }
#pragma unroll
            for (int b8 = 0; b8 < NF / 8; ++b8) {
                float part[8];
#pragma unroll
                for (int k = 0; k < 8; ++k) {
                    const int kk = b8 * 8 + k; float s_ = 0.f;
#pragma unroll
                    for (int q2 = 0; q2 < 4; ++q2) {
                        const f32x2_t d0 = __builtin_amdgcn_cvt_scalef32_pk_f32_fp4(uw[kk][q2], 1.0f, 0), d1 = __builtin_amdgcn_cvt_scalef32_pk_f32_fp4(uw[kk][q2], 1.0f, 1);
                        const f32x2_t d2 = __builtin_amdgcn_cvt_scalef32_pk_f32_fp4(uw[kk][q2], 1.0f, 2), d3 = __builtin_amdgcn_cvt_scalef32_pk_f32_fp4(uw[kk][q2], 1.0f, 3);
                        s_ += x[8 * q2] * d0[0] + x[8 * q2 + 1] * d0[1] + x[8 * q2 + 2] * d1[0] + x[8 * q2 + 3] * d1[1] + x[8 * q2 + 4] * d2[0] + x[8 * q2 + 5] * d2[1] + x[8 * q2 + 6] * d3[0] + x[8 * q2 + 7] * d3[1];
                    }
                    part[k] = s_;
                    if (kk + 1 < NF) asm volatile("" : "+v"(uw[kk + 1]) : "v"(s_));
                }
                const float dot = reduce8(part, lane);
                const int eb = e0 + b8 * 8 + emap;
                const float pre = dot * bperm_f(eb & 63, e0 < 64 ? mys0 : mys1);
                const float act = 0.5f * pre * (1.f + erff(pre * 0.7071067811865476f));
                const float cf = act * bperm_f(eb & 63, e0 < 64 ? myg0 : myg1);
                if ((lane & 7) == 0) cl[eb] = cf;
            }
        }
        asm volatile("s_waitcnt lgkmcnt(0)" ::: "memory");
        const float c0 = cl[lane], c1 = cl[64 + lane];
        float y[32];
#pragma unroll
        for (int i = 0; i < 32; ++i) y[i] = 0.f;
#pragma unroll 1
        for (int e0 = 0; e0 < 128; e0 += NF) {
            u32x4 vw[NF];
#pragma unroll
            for (int k = 0; k < NF; ++k) { const int e = e0 + k; const int idx = __builtin_amdgcn_readlane(e < 64 ? myidx0 : myidx1, e & 63); vw[k] = *(const u32x4*)(V4 + (size_t)idx * VROW + lane * 16); }
#pragma unroll
            for (int k = 0; k < NF; ++k) {
                const int e = e0 + k; const float ce = rdlane_f(e < 64 ? c0 : c1, e & 63);
#pragma unroll
                for (int q2 = 0; q2 < 4; ++q2) {
                    const f32x2_t d0 = __builtin_amdgcn_cvt_scalef32_pk_f32_fp4(vw[k][q2], 1.0f, 0), d1 = __builtin_amdgcn_cvt_scalef32_pk_f32_fp4(vw[k][q2], 1.0f, 1);
                    const f32x2_t d2 = __builtin_amdgcn_cvt_scalef32_pk_f32_fp4(vw[k][q2], 1.0f, 2), d3 = __builtin_amdgcn_cvt_scalef32_pk_f32_fp4(vw[k][q2], 1.0f, 3);
                    y[8 * q2] += ce * d0[0]; y[8 * q2 + 1] += ce * d0[1]; y[8 * q2 + 2] += ce * d1[0]; y[8 * q2 + 3] += ce * d1[1];
                    y[8 * q2 + 4] += ce * d2[0]; y[8 * q2 + 5] += ce * d2[1]; y[8 * q2 + 6] += ce * d3[0]; y[8 * q2 + 7] += ce * d3[1];
                }
                if (k + 1 < NF) asm volatile("" : "+v"(vw[k + 1]) : "v"(y[0]), "v"(y[31]));
            }
        }
        float s2 = 0.f;
#pragma unroll
        for (int q = 0; q < 8; ++q) {
            const float v0 = x[4 * q] + y[4 * q], v1 = x[4 * q + 1] + y[4 * q + 1], v2 = x[4 * q + 2] + y[4 * q + 2], v3 = x[4 * q + 3] + y[4 * q + 3];
            *(u32x2*)(HB + (size_t)t * D + q * 256 + lane * 4) = (u32x2){pk2(v0, v1), pk2(v2, v3)};
            s2 += v0 * v0 + v1 * v1 + v2 * v2 + v3 * v3;
        }
        s2 = wave_sum(s2);
        if (lane == 0) ssqC[t] = s2;
    }
}

__device__ __forceinline__ void final_norm(Frame& F) {
    const Args& a = *F.a; unsigned char* ws = F.ws;
    const bf16_t* HB = (const bf16_t*)(ws + WS_HB) + (size_t)(DEPTH & 1) * T * D; const u64* ssq = (const u64*)(ws + WS_CTL + CTL_SSQA) + 4 * T; const float* g = (const float*)(ws + WS_PRM) + PRM_FIN;
    const int lane = F.lane;
    for (int t = F.gw; t < T; t += F.ngw) {
        const float rs = rsqrtf(ssq_get(ssq + t) * (1.f / D) + EPS);
#pragma unroll
        for (int c = 0; c < 4; ++c) { const size_t o = (size_t)t * D + c * 512 + lane * 8; const u32x4 hw = *(const u32x4*)(HB + o); const f32x4 g0 = *(const f32x4*)(g + c * 512 + lane * 8), g1 = *(const f32x4*)(g + c * 512 + lane * 8 + 4);
            *(f32x4*)(a.out + o) = (f32x4){bflo(hw[0]), bfhi(hw[0]), bflo(hw[1]), bfhi(hw[1])} * rs * g0; *(f32x4*)(a.out + o + 4) = (f32x4){bflo(hw[2]), bfhi(hw[2]), bflo(hw[3]), bfhi(hw[3])} * rs * g1; }
    }
}

constexpr int PH_PER_LAYER = 10, N_PHASES = 2 + DEPTH * PH_PER_LAYER;
template <int PH>
__device__ __forceinline__ void run_phase(Frame& F0, int l) {
    Frame F = F0; { int bid_ = blockIdx.x, wv_ = F0.wave; asm volatile("" : "+s"(bid_), "+s"(wv_));
      F.bid = bid_; F.wave = wv_; F.lane = lane_id_fresh(); F.tid = wv_ * 64 + F.lane; F.gw = bid_ * NWAVES + wv_;
      size_t z_ = 0; asm volatile("" : "+s"(z_)); F.ws = F0.ws + z_; }
    unsigned char* ws = F.ws;
    bf16_t* const HBc = (bf16_t*)(ws + WS_HB) + (size_t)(l & 1) * T * D; bf16_t* const HBn = (bf16_t*)(ws + WS_HB) + (size_t)((l + 1) & 1) * T * D;
    if constexpr (PH == 100) prologue(F);
    if constexpr (PH == 101) final_norm(F);
    if constexpr (PH == 0) {
        pg8::Gemm g{HBc, (const bf16_t*)(ws + WS_WIN) + (size_t)l * NZ * D, T, NZ, D, D, D}; pg8::StaticOrder S; S.init(T, NZ, F.G, F.bid);
        EpiZ E{(bf16_t*)(ws + WS_Z), (const u64*)(ws + WS_CTL + CTL_SSQA) + l * T, (u64*)(ws + WS_CTL + CTL_MQS) + l * T, (u64*)(ws + WS_CTL + CTL_MKVS) + l * T};
        pg8::gemm_phase<EpiZ, pg8::StaticOrder, true, true>(F.lds, g, S, E, F.wave);
    }
    if constexpr (PH == 1) {
        mix_prep(F, l);
        { pg8::Gemm g{(const bf16_t*)(ws + WS_Z) + ZC_MCQ, (const bf16_t*)(ws + WS_WUQ) + (size_t)l * 768 * 384, T, 768, 384, NZ, 384}; pg8::StaticOrder S; S.init(T, 768, F.G, F.bid);
          EpiBf16s E{(bf16_t*)(ws + WS_QM), 768, (const u64*)(ws + WS_CTL + CTL_MQS) + l * T, 1.f / 384.f};
          pg8::gemm_phase<EpiBf16s, pg8::StaticOrder, true, true>(F.lds, g, S, E, F.wave); }
        __syncthreads();
        { pg8::Gemm g{(const bf16_t*)(ws + WS_Z) + ZC_MCKV, (const bf16_t*)(ws + WS_WUKV) + (size_t)l * 1024 * 256, T, 1024, 256, NZ, 256}; pg8::StaticOrder S; S.init(T, 1024, F.G, (int)((F.bid + 128) % F.G));
          EpiBf16s E{(bf16_t*)(ws + WS_KVM), 1024, (const u64*)(ws + WS_CTL + CTL_MKVS) + l * T, 1.f / 256.f};
          pg8::gemm_phase<EpiBf16s, pg8::StaticOrder, true, true>(F.lds, g, S, E, F.wave); }
    }
    if constexpr (PH == 3) {
        if (F.bid < 32 * NSEG) { const int bhs = F.bid % (16 * NSEG), b = bhs / (4 * NSEG), h = (bhs / NSEG) & 3, seg = bhs % NSEG; if (F.bid < 16 * NSEG) scan_unit<0>(F, l, b, h, seg); else scan_unit<1>(F, l, b, h, seg); }
        else if (F.bid < 32 * NSEG + 128) attn_fast(F, l);
        if (F.G == 256) { __syncthreads(); convert_layer_queue(F, l, (unsigned*)(ws + WS_CTL + CTL_CVQ) + 64 * l); }
    }
    if constexpr (PH == 4) scan_norm(F, l);
    if constexpr (PH == 5) {
        pg8::Gemm g{(const bf16_t*)(ws + WS_Y), (const bf16_t*)(ws + WS_WOUT) + (size_t)l * D * D, T, D, D, D, D}; pg8::StaticOrder S; S.init(T, D, F.G, F.bid);
        EpiRes E{HBc, (u64*)(ws + WS_CTL + CTL_SSQB) + l * T};
        pg8::gemm_phase<EpiRes, pg8::StaticOrder, true, true>(F.lds, g, S, E, F.wave);
    }
    if constexpr (PH == 6) {
        { pg8::Gemm g{HBc, (const bf16_t*)(ws + WS_WQ) + (size_t)l * D * D, T, D, D, D, D}; pg8::StaticOrder S; S.init(T, D, F.G, F.bid);
          EpiBf16s E{(bf16_t*)(ws + WS_QB), D, (const u64*)(ws + WS_CTL + CTL_SSQB) + l * T, 1.f / D};
          pg8::gemm_phase<EpiBf16s, pg8::StaticOrder, true, true>(F.lds, g, S, E, F.wave);
          pg8::Unit u;
          if (S.next(0, u)) {
              asm volatile("s_waitcnt vmcnt(0)" ::: "memory"); __syncthreads();
              __builtin_amdgcn_fence(__ATOMIC_ACQUIRE, "agent"); asm volatile("s_waitcnt vmcnt(0)" ::: "memory");
              peer_topk_mfma(F.lds, F.wave, (const bf16_t*)(ws + WS_QB), (const bf16_t*)(ws + WS_SKB) + (size_t)l * 8 * 2 * 128 * 128, (int*)(ws + WS_PIDX), (float*)(ws + WS_PGATE), u.pm, u.pn);
          } }
        __syncthreads();
        { pg8::Gemm g{(const bf16_t*)(ws + WS_PB) + (size_t)l * T * PLE, (const bf16_t*)(ws + WS_WP) + (size_t)l * D * PLE, T, D, PLE, PLE, PLE}; pg8::StaticOrder S; S.init(T, D, F.G, F.bid);
          EpiBf16s E{(bf16_t*)(ws + WS_PR), D, nullptr, 0.f};
          pg8::gemm_phase<EpiBf16s, pg8::StaticOrder, true, true>(F.lds, g, S, E, F.wave); }
    }
    if constexpr (PH == 8) peer_gather(F, l);
    if constexpr (PH == 9) {
        pg8::Gemm g{HBc, (const bf16_t*)(ws + WS_WG) + (size_t)l * D * D, T, D, D, D, D}; pg8::StaticOrder S; S.init(T, D, F.G, F.bid);
        EpiPle E{HBc, HBn, (const bf16_t*)(ws + WS_PR), (const float*)(ws + WS_CTL + CTL_SSQC) + l * T, (u64*)(ws + WS_CTL + CTL_SSQA) + (l + 1) * T};
        pg8::gemm_phase<EpiPle, pg8::StaticOrder, true, true>(F.lds, g, S, E, F.wave);
    }
}
__global__ void __launch_bounds__(NTHREADS, 2) mega(Args args) {
    extern __shared__ __attribute__((aligned(16))) unsigned char lds_raw[];
    Frame F; F.lds = (LAS unsigned char*)lds_raw; F.ws = args.ws; F.a = &args;
    F.tid = threadIdx.x; F.lane = F.tid & 63; F.wave = __builtin_amdgcn_readfirstlane(F.tid >> 6); F.G = gridDim.x;
    F.gw = blockIdx.x * NWAVES + F.wave; F.ngw = F.G * NWAVES; F.bid = blockIdx.x;
    volatile LAS unsigned* misc = (volatile LAS unsigned*)(F.lds + MISC_OFF);
    if (F.tid < 32) misc[F.tid] = 0u;
    __syncthreads();
    (void)xcd_barrier_post((unsigned*)(args.ws + WS_CTL + CTL_BAR), misc + 8);
#define GRID_BAR() do { XcdBarrier b_; b_.bar = (unsigned*)(args.ws + WS_CTL + CTL_BAR); b_.x = xb_xcc_id(); b_.st = (volatile LAS unsigned*)(F.lds + MISC_OFF) + 8; xcd_barrier(b_, F.wave); } while (0)
    run_phase<100>(F, 0); GRID_BAR();
    for (int l = 0; l < DEPTH; ++l) {
        run_phase<0>(F, l); GRID_BAR();
        run_phase<1>(F, l); GRID_BAR();
        run_phase<3>(F, l); GRID_BAR();
        run_phase<4>(F, l); GRID_BAR();
        run_phase<5>(F, l); GRID_BAR();
        run_phase<6>(F, l); GRID_BAR();
        run_phase<8>(F, l); GRID_BAR();
        run_phase<9>(F, l); GRID_BAR();
    }
    run_phase<101>(F, 0);
#undef GRID_BAR
}

extern "C" void kernel_launch(void* const* d_in, const int* in_sizes, int n_in, void* d_out, int out_size, void* d_ws, size_t ws_size, hipStream_t stream) {
    static int grid = 0;
    if (grid == 0) {
        if (n_in != 28 || out_size != T * D || ws_size < WS_END) { fprintf(stderr, "kernel_launch: unexpected shapes (n_in %d out %d ws %zu need %zu)\n", n_in, out_size, ws_size, (size_t)WS_END); grid = -1; return; }
        if (hipFuncSetAttribute((const void*)mega, hipFuncAttributeMaxDynamicSharedMemorySize, LDS_BYTES) != hipSuccess) { fprintf(stderr, "kernel_launch: hipFuncSetAttribute failed\n"); grid = -1; return; }
        int dev = 0, cus = 0, per_cu = 0; (void)hipGetDevice(&dev); (void)hipDeviceGetAttribute(&cus, hipDeviceAttributeMultiprocessorCount, dev);
        if (hipOccupancyMaxActiveBlocksPerMultiprocessor(&per_cu, (const void*)mega, NTHREADS, LDS_BYTES) != hipSuccess || per_cu < 1) { fprintf(stderr, "kernel_launch: occupancy query says %d blocks per CU\n", per_cu); (void)hipGetLastError(); }
        grid = cus > 0 ? cus : 256;
    }
    if (grid < 0) return;
    (void)hipMemsetAsync((char*)d_ws + WS_CTL, 0, CTL_BYTES, stream);
    Args a{};
    for (int i = 0; i < 28; ++i) a.in[i] = (const float*)d_in[i];
    a.out = (float*)d_out; a.ws = (unsigned char*)d_ws;
    hipLaunchKernelGGL(mega, dim3(grid), dim3(NTHREADS), LDS_BYTES, stream, a);
}
```

```cpp
#include <hip/hip_runtime.h>
#include <cstdio>
#include <cstdint>

#define GAS __attribute__((address_space(1)))
#define LAS __attribute__((address_space(3)))
typedef unsigned short bf16_t;
typedef short bf16x8 __attribute__((ext_vector_type(8)));
typedef float f32x4 __attribute__((ext_vector_type(4)));
typedef unsigned u32x4 __attribute__((ext_vector_type(4)));
typedef unsigned u32x2 __attribute__((ext_vector_type(2)));
typedef float f32x2_t __attribute__((ext_vector_type(2)));
typedef float v16f_t __attribute__((ext_vector_type(16)));
typedef float v32f_t __attribute__((ext_vector_type(32)));
typedef unsigned v6u_t __attribute__((ext_vector_type(6)));
constexpr int EROW = 1536;
constexpr int VROW = 1024;

constexpr int D = 2048, BATCH = 4, SEQ = 2048, T = BATCH * SEQ, DEPTH = 4, PLE = 256;
constexpr int IN_COLS = 5832, NZ = 5888;
constexpr int ZC_DQ = 0, ZC_DK = 512, ZC_DV = 1024, ZC_GQ = 1536, ZC_GF = 2048, ZC_GV = 2560, ZC_GG = 3072, ZC_MCQ = 3584, ZC_MCKV = 3968, ZC_MKR = 4224,
              ZC_LQ = 4288, ZC_LK = 4544, ZC_LV = 4800, ZC_LO = 5312, ZC_LI = 5824, ZC_LF = 5828;
constexpr int NEXP = 16384;
constexpr float EPS = 1e-6f;
constexpr int NWAVES = 8, NTHREADS = 512;

constexpr size_t MiB = 1u << 20;
constexpr size_t al(size_t x) { return (x + 255) & ~(size_t)255; }
constexpr size_t WS_CTL = 0, CTL_BYTES = 2 * MiB;
constexpr size_t CTL_BAR = 0;
constexpr size_t CTL_CVQ = 32 * 1024;
constexpr size_t CTL_SSQA = 64 * 1024;
constexpr size_t CTL_SSQB = CTL_SSQA + 5 * T * 8;
constexpr size_t CTL_MQS = CTL_SSQB + 4 * T * 8;
constexpr size_t CTL_MKVS = CTL_MQS + 4 * T * 8;
constexpr size_t CTL_SSQC = CTL_MKVS + 4 * T * 8;
static_assert(CTL_SSQC + 4 * T * 4 <= 1536 * 1024, "ctl");
constexpr size_t WS_WIN = CTL_BYTES;
constexpr size_t WS_WOUT = WS_WIN + al((size_t)DEPTH * NZ * D * 2);
constexpr size_t WS_WQ = WS_WOUT + al((size_t)DEPTH * D * D * 2);
constexpr size_t WS_WG = WS_WQ + al((size_t)DEPTH * D * D * 2);
constexpr size_t WS_WP = WS_WG + al((size_t)DEPTH * D * D * 2);
constexpr size_t WS_WUQ = WS_WP + al((size_t)DEPTH * D * PLE * 2);
constexpr size_t WS_WUKV = WS_WUQ + al((size_t)DEPTH * 768 * 384 * 2);
constexpr size_t WS_UB = WS_WUKV + al((size_t)DEPTH * 1024 * 256 * 2);
constexpr size_t WS_VB = WS_UB + al((size_t)DEPTH * NEXP * D * 2);
constexpr size_t WS_PB = WS_VB + al((size_t)DEPTH * NEXP * D * 2);
constexpr size_t WS_CS = WS_PB + al((size_t)DEPTH * T * PLE * 2);
constexpr size_t WS_LBS = WS_CS + al((size_t)T * 32 * 2 * 4);
constexpr size_t WS_H = WS_LBS + al((size_t)DEPTH * 512 * 4);
constexpr size_t WS_HB = WS_H + al((size_t)T * D * 4);
constexpr size_t WS_Z = WS_HB + 2 * al((size_t)T * D * 2);
constexpr size_t WS_QM = WS_Z + al((size_t)T * NZ * 2);
constexpr size_t WS_KVM = WS_QM + al((size_t)T * 768 * 2);
constexpr size_t WS_KRM = WS_KVM + al((size_t)T * 1024 * 2);
constexpr size_t WS_Y = WS_KRM + al((size_t)T * 64 * 2);
constexpr size_t WS_QP = WS_Y + al((size_t)T * D * 2);
constexpr size_t WS_QB = WS_QP;
constexpr size_t WS_PR = WS_QP + al((size_t)T * D * 4);
constexpr size_t WS_PIDX = WS_PR + al((size_t)T * D * 4);
constexpr size_t WS_PGATE = WS_PIDX + al((size_t)T * 128 * 4);
constexpr size_t WS_GQ = WS_PGATE + al((size_t)T * 128 * 4);
constexpr size_t WS_GK = WS_GQ + al((size_t)T * 512 * 4);
constexpr size_t WS_GF = WS_GK + al((size_t)T * 512 * 4);
constexpr size_t WS_OG = WS_GF + al((size_t)T * 512 * 4);
constexpr size_t WS_LQK = WS_OG + al((size_t)T * 512 * 4);
constexpr size_t WS_LIF = WS_LQK + al((size_t)T * 512 * 4);
constexpr size_t WS_OL = WS_LIF + al((size_t)T * 8 * 4);
constexpr size_t WS_O1 = WS_OL + al((size_t)T * 512 * 4);
constexpr size_t WS_PRM = WS_O1 + al((size_t)T * 512 * 4);
constexpr int PRM_L = 4608, PRM_CW = 0, PRM_CB = 2048, PRM_GB = 2560, PRM_DL = 2576, PRM_DN = 2832, PRM_HN = 3344, PRM_MN = 3856, PRM_FIN = DEPTH * PRM_L;
constexpr size_t WS_SKB = WS_PRM + al((size_t)(PRM_FIN + D) * 4);
constexpr size_t WS_SU = WS_SKB + al((size_t)DEPTH * 8 * 2 * 128 * 128 * 2);
constexpr size_t WS_SV = WS_SU + al((size_t)DEPTH * NEXP * 4);
constexpr int NSEG = 2, SEGC = SEQ / 64 / NSEG;
constexpr size_t WS_QTG = WS_SV + al((size_t)DEPTH * NEXP * 4);
constexpr size_t WS_QTL = WS_QTG + al((size_t)16 * SEQ * 128 * 2);
constexpr size_t WS_SCL = WS_QTL + al((size_t)16 * SEQ * 64 * 2);
constexpr size_t WS_SIB = WS_SCL + al((size_t)16 * SEQ * 4 * 4);
constexpr size_t WS_SIF = WS_SIB + al((size_t)2 * 16 * NSEG * 128 * 128 * 2);
constexpr size_t WS_SIM = WS_SIF + al((size_t)2 * 16 * NSEG * 128 * 128 * 4);
constexpr size_t WS_END = WS_SIM + al((size_t)16 * NSEG * 128 * 4);
constexpr size_t CTL_SEGF = 1536 * 1024;
static_assert(CTL_SEGF + DEPTH * 2 * 16 * NSEG * 64 <= CTL_BYTES, "ctl segf");

typedef float f32x2v_t __attribute__((ext_vector_type(2)));
typedef __bf16 bf16x2v_t __attribute__((ext_vector_type(2)));
__device__ __forceinline__ unsigned pk2(float lo, float hi) { const bf16x2v_t r = __builtin_convertvector((f32x2v_t){lo, hi}, bf16x2v_t); return __builtin_bit_cast(unsigned, r); }
__device__ __forceinline__ unsigned f2bf(float f) { return pk2(f, 0.f) & 0xffffu; }
__device__ __forceinline__ float bf2f(unsigned short b) { return __builtin_bit_cast(float, ((unsigned)b) << 16); }
__device__ __forceinline__ float bflo(unsigned w) { return __builtin_bit_cast(float, w << 16); }
__device__ __forceinline__ float bfhi(unsigned w) { return __builtin_bit_cast(float, w & 0xffff0000u); }
#define DPP_F(v, ctrl) __builtin_bit_cast(float, __builtin_amdgcn_update_dpp(0, __builtin_bit_cast(int, (v)), (ctrl), 0xF, 0xF, false))
__device__ __forceinline__ float rdlane_f(float v, int l) { return __builtin_bit_cast(float, __builtin_amdgcn_readlane(__builtin_bit_cast(int, v), l)); }
__device__ __forceinline__ float wave_sum(float v) {
    v += DPP_F(v, 0xB1); v += DPP_F(v, 0x4E); v += DPP_F(v, 0x141); v += DPP_F(v, 0x140);
    return (rdlane_f(v, 0) + rdlane_f(v, 16)) + (rdlane_f(v, 32) + rdlane_f(v, 48));
}
__device__ __forceinline__ float wave_max(float v) {
    v = fmaxf(v, DPP_F(v, 0xB1)); v = fmaxf(v, DPP_F(v, 0x4E)); v = fmaxf(v, DPP_F(v, 0x141)); v = fmaxf(v, DPP_F(v, 0x140));
    return fmaxf(fmaxf(rdlane_f(v, 0), rdlane_f(v, 16)), fmaxf(rdlane_f(v, 32), rdlane_f(v, 48)));
}
__device__ __forceinline__ int bperm_i(int src, int v) { return __builtin_amdgcn_ds_bpermute(src << 2, v); }
__device__ __forceinline__ float bperm_f(int src, float v) { return __builtin_bit_cast(float, __builtin_amdgcn_ds_bpermute(src << 2, __builtin_bit_cast(int, v))); }
typedef unsigned long long u64;
__device__ __forceinline__ int lane_id_fresh() { int l; asm volatile("v_mbcnt_lo_u32_b32 %0, -1, 0\n\tv_mbcnt_hi_u32_b32 %0, -1, %0" : "=v"(l)); return l; }
__device__ __forceinline__ void ssq_add(u64* p, float s) { atomicAdd(p, (u64)(s * 16777216.f)); }
__device__ __forceinline__ float ssq_get(const u64* p) { return (float)(*p) * (1.f / 16777216.f); }
__device__ __forceinline__ float rcpf_(float x) { return __builtin_amdgcn_rcpf(x); }
__device__ __forceinline__ float sigmoidf_(float x) { return rcpf_(1.f + __expf(-x)); }

namespace pg8 {
constexpr int BM = 256, BK = 64, HALF = 128, HTB = HALF * BK * 2, STAGE_BYTES = 8 * HTB, NXCD = 8, WGM = 8;
__host__ __device__ __forceinline__ int lds_byte(int r, int c) { const int st = (r >> 4) * 2 + (c >> 5), rr = r & 15, cc = c & 31, ob = rr * 64 + cc * 2; return st * 1024 + (ob ^ (((ob >> 9) & 1) << 5)); }
__host__ __device__ __forceinline__ void stage_rc(int b, int& R, int& C) { const int st = b / 1024, sb = b % 1024, swz = sb ^ (((sb >> 9) & 1) << 5); R = (st >> 1) * 16 + swz / 64; C = (st & 1) * 32 + (swz % 64) / 2; }
__host__ __device__ __forceinline__ int perm32(int rho) { const int n = rho >> 4, i = rho & 15; return 8 * (i >> 2) + 4 * n + (i & 3); }
struct Unit { int pm, pn; };
struct Gemm { const bf16_t* A; const bf16_t* Bt; int M, N, K, lda, ldb; };
struct StaticOrder {
    int nM, nN, nwg, G, c;
    __host__ __device__ void init(int M, int N, int G_, int c_) { nM = M / BM; nN = N / BM; nwg = nM * nN; G = G_; c = c_; }
    __host__ __device__ bool next(int i, Unit& u) const {
        const long L = (long)i * G + c; if (L >= nwg) return false;
        int wgid = (int)L; { const int q = nwg / NXCD, r = nwg % NXCD, xcd = wgid % NXCD, off = wgid / NXCD; wgid = (xcd < r ? xcd * (q + 1) : r * (q + 1) + (xcd - r) * q) + off; }
        const int nig = WGM * nN, gid = wgid / nig, fm = gid * WGM, gsz = (nM - fm) < WGM ? (nM - fm) : WGM;
        u.pm = fm + ((wgid % nig) % gsz); u.pn = (wgid % nig) / gsz; return true;
    }
    __device__ __forceinline__ void a_ready(const Unit&) const {}
    __device__ __forceinline__ void done(const Unit&) const {}
};
template <class Epi, class Sched, bool ALIGN_EPI = false, bool SP2 = false>
__device__ __forceinline__ void gemm_phase(LAS unsigned char* lds, const Gemm g, const Sched& S, const Epi& E, int wave_s) {
    const int tid = wave_s * 64 + lane_id_fresh(), wid = wave_s, lane = tid & 63, wr = wid >> 2, wc = wid & 3, fr = lane & 15, fq = lane >> 4;
    const int K = g.K, nt = K / BK;
    unsigned voffA[2], voffB[2];
#pragma unroll
    for (int i = 0; i < 2; ++i) { int R, C; stage_rc(tid * 16 + i * 8192, R, C); const int Rb = Epi::PERM ? ((R & ~31) + perm32(R & 31)) : R;
        voffA[i] = (unsigned)(R * g.lda + C) * 2u; voffB[i] = (unsigned)(Rb * g.ldb + C) * 2u; }
    const size_t kstep = (size_t)(BK * 2);
    const size_t hstepA = (size_t)HALF * g.lda * 2, hstepB = (size_t)HALF * g.ldb * 2;
    const size_t tstepA = 2 * hstepA, tstepB = 2 * hstepB;
    const unsigned ldsw = (unsigned)wid * 1024u;
    const int aoff = lds_byte(wr * 64 + fr, fq * 8), boff = lds_byte(wc * 32 + fr, fq * 8);
#define PG8_SA(b, h) (((b) * 2 + (h)) * HTB)
#define PG8_SB(b, h) ((4 + (b) * 2 + (h)) * HTB)
#define PG8_STAGE(bufoff, gbase, voff) do { _Pragma("unroll") for (int _i = 0; _i < 2; ++_i) \
        __builtin_amdgcn_global_load_lds((const unsigned*)((const char*)(gbase) + (voff)[_i]), (LAS unsigned*)(lds + (bufoff) + ldsw + _i * 8192), 16, 0, 0); } while (0)
#define PG8_LDA(dst, b, h) do { _Pragma("unroll") for (int m = 0; m < 4; ++m) _Pragma("unroll") for (int k = 0; k < 2; ++k) dst[m][k] = *(const LAS bf16x8*)(lds + PG8_SA(b, h) + aoff + m * 2048 + k * 1024); } while (0)
#define PG8_LDB(dst, b, h) do { _Pragma("unroll") for (int n = 0; n < 2; ++n) _Pragma("unroll") for (int k = 0; k < 2; ++k) dst[n][k] = *(const LAS bf16x8*)(lds + PG8_SB(b, h) + boff + n * 2048 + k * 1024); } while (0)
#define PG8_MMA(ai, bj, At, Bt) do { __builtin_amdgcn_s_setprio(1); _Pragma("unroll") for (int m = 0; m < 4; ++m) _Pragma("unroll") for (int n = 0; n < 2; ++n) _Pragma("unroll") for (int k = 0; k < 2; ++k) \
        acc[ai][bj][m][n] = __builtin_amdgcn_mfma_f32_16x16x32_bf16(Bt[n][k], At[m][k], acc[ai][bj][m][n], 0, 0, 0); __builtin_amdgcn_s_setprio(0); } while (0)
#define PG8_WAIT_V(n) asm volatile("s_waitcnt vmcnt(" #n ")" ::: "memory")
#define PG8_WAIT_L(n) asm volatile("s_waitcnt lgkmcnt(" #n ")" ::: "memory")
#define PG8_BAR __builtin_amdgcn_s_barrier()
#define PG8_SCHED __builtin_amdgcn_sched_barrier(0)
    Unit cur, nxt; int ui = 0;
    if (!S.next(0, cur)) return;
    f32x4 acc[2][2][4][2];
#pragma unroll
    for (int a = 0; a < 2; ++a)
#pragma unroll
        for (int b = 0; b < 2; ++b)
#pragma unroll
            for (int m = 0; m < 4; ++m)
#pragma unroll
                for (int n = 0; n < 2; ++n) acc[a][b][m][n] = (f32x4){0.f, 0.f, 0.f, 0.f};
    bf16x8 At[4][2], B0[2][2], B1[2][2];
    const char* cA = (const char*)g.A + (size_t)cur.pm * tstepA; const char* cB = (const char*)g.Bt + (size_t)cur.pn * tstepB;
    S.a_ready(cur);
    if constexpr (SP2) {
        PG8_STAGE(PG8_SB(0, 0), cB, voffB); PG8_STAGE(PG8_SB(0, 1), cB + hstepB, voffB); PG8_STAGE(PG8_SA(0, 0), cA, voffA); PG8_STAGE(PG8_SA(0, 1), cA + hstepA, voffA);
        if (wr == 1) PG8_BAR;
        PG8_WAIT_V(2); PG8_BAR;
        PG8_STAGE(PG8_SB(1, 0), cB + kstep, voffB); PG8_STAGE(PG8_SA(1, 0), cA + kstep, voffA); PG8_STAGE(PG8_SB(1, 1), cB + hstepB + kstep, voffB);
        PG8_WAIT_V(6); PG8_BAR;
    } else {
        PG8_STAGE(PG8_SB(0, 0), cB, voffB); PG8_STAGE(PG8_SA(0, 0), cA, voffA); PG8_STAGE(PG8_SB(0, 1), cB + hstepB, voffB); PG8_STAGE(PG8_SA(0, 1), cA + hstepA, voffA);
        if (wr == 1) PG8_BAR;
        PG8_WAIT_V(4); PG8_BAR;
        PG8_STAGE(PG8_SB(1, 0), cB + kstep, voffB); PG8_STAGE(PG8_SA(1, 0), cA + kstep, voffA); PG8_STAGE(PG8_SB(1, 1), cB + hstepB + kstep, voffB);
        PG8_WAIT_V(6); PG8_BAR;
    }
    for (;;) {
        const bool has_next = S.next(ui + 1, nxt);
        const char* nA = has_next ? (const char*)g.A + (size_t)nxt.pm * tstepA : cA; const char* nB = has_next ? (const char*)g.Bt + (size_t)nxt.pn * tstepB : cB;
        for (int t = 0; t < nt; t += 2) {
            const bool last = (t == nt - 2);
            const char* a1 = cA + (size_t)(t + 1) * kstep;
            const char* a2 = last ? nA : cA + (size_t)(t + 2) * kstep; const char* b2 = last ? nB : cB + (size_t)(t + 2) * kstep;
            const char* a3 = a2 + kstep; const char* b3 = b2 + kstep;
            if (last && has_next) S.a_ready(nxt);
            if constexpr (SP2) {
            PG8_LDB(B0, 0, 0); PG8_LDB(B1, 0, 1); PG8_SCHED; PG8_LDA(At, 0, 0); PG8_STAGE(PG8_SA(1, 1), a1 + hstepA, voffA);
            PG8_WAIT_V(8); PG8_WAIT_L(0); PG8_BAR; PG8_MMA(0, 0, At, B0); PG8_MMA(0, 1, At, B1); PG8_BAR; PG8_SCHED;
            PG8_LDA(At, 0, 1); PG8_STAGE(PG8_SB(0, 0), b2, voffB); PG8_STAGE(PG8_SB(0, 1), b2 + hstepB, voffB); PG8_STAGE(PG8_SA(0, 0), a2, voffA);
            PG8_WAIT_V(8); PG8_WAIT_L(0); PG8_BAR; PG8_MMA(1, 0, At, B0); PG8_MMA(1, 1, At, B1); PG8_BAR; PG8_SCHED;
            PG8_LDB(B0, 1, 0); PG8_LDB(B1, 1, 1); PG8_SCHED; PG8_LDA(At, 1, 0); PG8_STAGE(PG8_SA(0, 1), a2 + hstepA, voffA);
            PG8_WAIT_V(8); PG8_WAIT_L(0); PG8_BAR; PG8_MMA(0, 0, At, B0); PG8_MMA(0, 1, At, B1); PG8_BAR; PG8_SCHED;
            PG8_LDA(At, 1, 1); PG8_STAGE(PG8_SB(1, 0), b3, voffB); PG8_STAGE(PG8_SB(1, 1), b3 + hstepB, voffB); PG8_STAGE(PG8_SA(1, 0), a3, voffA);
            PG8_WAIT_V(8); PG8_WAIT_L(0); PG8_BAR; PG8_MMA(1, 0, At, B0); PG8_MMA(1, 1, At, B1); PG8_BAR; PG8_SCHED;
            } else {
            PG8_LDB(B0, 0, 0); PG8_SCHED; PG8_LDA(At, 0, 0); PG8_STAGE(PG8_SA(1, 1), a1 + hstepA, voffA);
            PG8_WAIT_L(8); PG8_BAR; PG8_WAIT_L(0); PG8_MMA(0, 0, At, B0); PG8_BAR; PG8_SCHED;
            PG8_LDB(B1, 0, 1); PG8_STAGE(PG8_SB(0, 0), b2, voffB);
            PG8_BAR; PG8_WAIT_L(0); PG8_MMA(0, 1, At, B1); PG8_BAR;
            PG8_LDA(At, 0, 1); PG8_STAGE(PG8_SA(0, 0), a2, voffA);
            PG8_BAR; PG8_WAIT_L(0); PG8_MMA(1, 0, At, B0); PG8_BAR; PG8_SCHED;
            PG8_STAGE(PG8_SB(0, 1), b2 + hstepB, voffB);
            PG8_WAIT_V(6); PG8_BAR; PG8_MMA(1, 1, At, B1); PG8_BAR;
            PG8_LDB(B0, 1, 0); PG8_SCHED; PG8_LDA(At, 1, 0); PG8_STAGE(PG8_SA(0, 1), a2 + hstepA, voffA);
            PG8_WAIT_L(8); PG8_BAR; PG8_WAIT_L(0); PG8_MMA(0, 0, At, B0); PG8_BAR; PG8_SCHED;
            PG8_LDB(B1, 1, 1); PG8_STAGE(PG8_SB(1, 0), b3, voffB);
            PG8_BAR; PG8_WAIT_L(0); PG8_MMA(0, 1, At, B1); PG8_BAR;
            PG8_LDA(At, 1, 1); PG8_STAGE(PG8_SA(1, 0), a3, voffA);
            PG8_BAR; PG8_WAIT_L(0); PG8_MMA(1, 0, At, B0); PG8_BAR; PG8_SCHED;
            PG8_STAGE(PG8_SB(1, 1), b3 + hstepB, voffB);
            PG8_WAIT_V(6); PG8_BAR; PG8_MMA(1, 1, At, B1); PG8_BAR;
            }
        }
        if constexpr (ALIGN_EPI) { if (wr == 0) PG8_BAR; }
        if constexpr (!Epi::AFTER_DRAIN) { E(acc, cur, wr, wc, fr, fq); S.done(cur); }
        if (!has_next) break;
#pragma unroll
        for (int a = 0; a < 2; ++a)
#pragma unroll
            for (int b = 0; b < 2; ++b)
#pragma unroll
                for (int m = 0; m < 4; ++m)
#pragma unroll
                    for (int n = 0; n < 2; ++n) acc[a][b][m][n] = (f32x4){0.f, 0.f, 0.f, 0.f};
        cur = nxt; cA = nA; cB = nB; ++ui;
        if constexpr (ALIGN_EPI) { if (wr == 1) PG8_BAR; }
    }
    PG8_WAIT_V(0);
    if constexpr (!ALIGN_EPI) { if (wr == 0) PG8_BAR; }
    PG8_BAR;
    if constexpr (Epi::AFTER_DRAIN) { E.fused(acc, cur, wr, wc, fr, fq, lds, wid, lane); S.done(cur); }
#undef PG8_SA
#undef PG8_SB
#undef PG8_STAGE
#undef PG8_LDA
#undef PG8_LDB
#undef PG8_MMA
#undef PG8_WAIT_V
#undef PG8_WAIT_L
#undef PG8_BAR
#undef PG8_SCHED
}
}

#define EPI_ROWS(ai, m) (u.pm * 256 + (ai) * 128 + wr * 64 + (m) * 16 + fr)
#define EPI_COL0 (u.pn * 256 + wc * 32 + 8 * fq)
typedef const f32x4 (&AccT)[2][2][4][2];

__device__ __forceinline__ float fq_sum(float v, int lane) { v += bperm_f(lane ^ 16, v); v += bperm_f(lane ^ 32, v); return v; }

struct EpiZ {
    static constexpr bool PERM = true, AFTER_DRAIN = false;
    bf16_t* Z; const u64* ssq; u64* mqs; u64* mkvs;
    __device__ __forceinline__ void operator()(AccT acc, const pg8::Unit& u, int wr, int wc, int fr, int fq) const {
        const int col0 = EPI_COL0;
#pragma unroll
        for (int ai = 0; ai < 2; ++ai)
#pragma unroll
            for (int m = 0; m < 4; ++m) {
                const int row = EPI_ROWS(ai, m); const float rs = rsqrtf(ssq_get(ssq + row) * (1.f / D) + EPS);
                float sq = 0.f, skv = 0.f;
#pragma unroll
                for (int bj = 0; bj < 2; ++bj) {
                    const f32x4 v0 = acc[ai][bj][m][0] * rs, v1 = acc[ai][bj][m][1] * rs;
                    u32x4 w; w.x = pk2(v0[0], v0[1]); w.y = pk2(v0[2], v0[3]); w.z = pk2(v1[0], v1[1]); w.w = pk2(v1[2], v1[3]);
                    *(u32x4*)(Z + (size_t)row * NZ + col0 + bj * 128) = w;
                    const float s2 = v0[0] * v0[0] + v0[1] * v0[1] + v0[2] * v0[2] + v0[3] * v0[3] + v1[0] * v1[0] + v1[1] * v1[1] + v1[2] * v1[2] + v1[3] * v1[3];
                    const int cb = u.pn * 256 + bj * 128;
                    if (cb >= ZC_MCQ && cb < ZC_MCKV) sq += s2;
                    if (cb >= ZC_MCKV && cb < ZC_MKR) skv += s2;
                }
                if (u.pn >= 14 && u.pn <= 16) {
                    sq = fq_sum(sq, fr + 16 * fq); skv = fq_sum(skv, fr + 16 * fq);
                    if (fq == 0) { if (u.pn <= 15) ssq_add(mqs + row, sq); if (u.pn >= 15) ssq_add(mkvs + row, skv); }
                }
            }
    }
};
struct EpiBf16s {
    static constexpr bool PERM = true, AFTER_DRAIN = false;
    bf16_t* O; int ldo; const u64* ssq; float inv_n;
    __device__ __forceinline__ void operator()(AccT acc, const pg8::Unit& u, int wr, int wc, int fr, int fq) const {
        const int col0 = EPI_COL0;
#pragma unroll
        for (int ai = 0; ai < 2; ++ai)
#pragma unroll
            for (int m = 0; m < 4; ++m) {
                const int row = EPI_ROWS(ai, m); const float rs = ssq ? rsqrtf(ssq_get(ssq + row) * inv_n + EPS) : 1.f;
#pragma unroll
                for (int bj = 0; bj < 2; ++bj) {
                    const f32x4 v0 = acc[ai][bj][m][0] * rs, v1 = acc[ai][bj][m][1] * rs;
                    u32x4 w; w.x = pk2(v0[0], v0[1]); w.y = pk2(v0[2], v0[3]); w.z = pk2(v1[0], v1[1]); w.w = pk2(v1[2], v1[3]);
                    *(u32x4*)(O + (size_t)row * ldo + col0 + bj * 128) = w;
                }
            }
    }
};
struct EpiRes {
    static constexpr bool PERM = true, AFTER_DRAIN = false;
    bf16_t* HB; u64* ssq;
    __device__ __forceinline__ void operator()(AccT acc, const pg8::Unit& u, int wr, int wc, int fr, int fq) const {
        const int col0 = EPI_COL0;
#pragma unroll
        for (int ai = 0; ai < 2; ++ai)
#pragma unroll
            for (int m = 0; m < 4; ++m) {
                const int row = EPI_ROWS(ai, m); float s2 = 0.f;
#pragma unroll
                for (int bj = 0; bj < 2; ++bj) {
                    bf16_t* hp = HB + (size_t)row * D + col0 + bj * 128;
                    const u32x4 hw = *(const u32x4*)hp;
                    const f32x4 v0 = (f32x4){bflo(hw[0]), bfhi(hw[0]), bflo(hw[1]), bfhi(hw[1])} + acc[ai][bj][m][0], v1 = (f32x4){bflo(hw[2]), bfhi(hw[2]), bflo(hw[3]), bfhi(hw[3])} + acc[ai][bj][m][1];
                    u32x4 w; w.x = pk2(v0[0], v0[1]); w.y = pk2(v0[2], v0[3]); w.z = pk2(v1[0], v1[1]); w.w = pk2(v1[2], v1[3]);
                    *(u32x4*)hp = w;
                    s2 += v0[0] * v0[0] + v0[1] * v0[1] + v0[2] * v0[2] + v0[3] * v0[3] + v1[0] * v1[0] + v1[1] * v1[1] + v1[2] * v1[2] + v1[3] * v1[3];
                }
                s2 = fq_sum(s2, fr + 16 * fq);
                if (fq == 0) ssq_add(ssq + row, s2);
            }
    }
};
struct EpiF32s {
    static constexpr bool PERM = true, AFTER_DRAIN = false;
    float* C; const u64* ssq;
    __device__ __forceinline__ void operator()(AccT acc, const pg8::Unit& u, int wr, int wc, int fr, int fq) const {
        const int col0 = EPI_COL0;
#pragma unroll
        for (int ai = 0; ai < 2; ++ai)
#pragma unroll
            for (int m = 0; m < 4; ++m) {
                const int row = EPI_ROWS(ai, m); const float rs = ssq ? rsqrtf(ssq_get(ssq + row) * (1.f / D) + EPS) : 1.f;
#pragma unroll
                for (int bj = 0; bj < 2; ++bj) {
                    float* cp = C + (size_t)row * D + col0 + bj * 128;
                    *(f32x4*)cp = acc[ai][bj][m][0] * rs; *(f32x4*)(cp + 4) = acc[ai][bj][m][1] * rs;
                }
            }
    }
};
struct EpiPle {
    static constexpr bool PERM = true, AFTER_DRAIN = false;
    const bf16_t* HBin; bf16_t* HBout; const bf16_t* PR; const float* ssq_in; u64* ssq_out;
    __device__ __forceinline__ void operator()(AccT acc, const pg8::Unit& u, int wr, int wc, int fr, int fq) const {
        const int col0 = EPI_COL0;
#pragma unroll
        for (int ai = 0; ai < 2; ++ai)
#pragma unroll
            for (int m = 0; m < 4; ++m) {
                const int row = EPI_ROWS(ai, m); const float rs = rsqrtf(ssq_in[row] * (1.f / D) + EPS); float s2 = 0.f;
#pragma unroll
                for (int bj = 0; bj < 2; ++bj) {
                    const size_t o = (size_t)row * D + col0 + bj * 128;
                    const u32x4 hw = *(const u32x4*)(HBin + o), pw = *(const u32x4*)(PR + o);
                    f32x4 v0 = (f32x4){bflo(hw[0]), bfhi(hw[0]), bflo(hw[1]), bfhi(hw[1])}, v1 = (f32x4){bflo(hw[2]), bfhi(hw[2]), bflo(hw[3]), bfhi(hw[3])};
                    const f32x4 p0 = (f32x4){bflo(pw[0]), bfhi(pw[0]), bflo(pw[1]), bfhi(pw[1])}, p1 = (f32x4){bflo(pw[2]), bfhi(pw[2]), bflo(pw[3]), bfhi(pw[3])};
#pragma unroll
                    for (int j = 0; j < 4; ++j) { v0[j] += sigmoidf_(acc[ai][bj][m][0][j] * rs) * p0[j]; v1[j] += sigmoidf_(acc[ai][bj][m][1][j] * rs) * p1[j]; }
                    u32x4 w; w.x = pk2(v0[0], v0[1]); w.y = pk2(v0[2], v0[3]); w.z = pk2(v1[0], v1[1]); w.w = pk2(v1[2], v1[3]);
                    *(u32x4*)(HBout + o) = w;
                    s2 += v0[0] * v0[0] + v0[1] * v0[1] + v0[2] * v0[2] + v0[3] * v0[3] + v1[0] * v1[0] + v1[1] * v1[1] + v1[2] * v1[2] + v1[3] * v1[3];
                }
                s2 = fq_sum(s2, fr + 16 * fq);
                if (fq == 0) ssq_add(ssq_out + row, s2);
            }
    }
};

__device__ __forceinline__ int f2ord(float f) { const int b = __builtin_bit_cast(int, f); return b >= 0 ? b : (b ^ 0x7FFFFFFF); }
__device__ __forceinline__ float ord2f(int k) { const int b = k >= 0 ? k : (k ^ 0x7FFFFFFF); return __builtin_bit_cast(float, b); }
__device__ __forceinline__ int row16_max(int v) {
    v = max(v, __builtin_amdgcn_update_dpp(v, v, 0xB1, 0xF, 0xF, false)); v = max(v, __builtin_amdgcn_update_dpp(v, v, 0x4E, 0xF, 0xF, false));
    v = max(v, __builtin_amdgcn_update_dpp(v, v, 0x141, 0xF, 0xF, false)); v = max(v, __builtin_amdgcn_update_dpp(v, v, 0x140, 0xF, 0xF, false));
    return v;
}
__device__ __forceinline__ float row16_sum(float v) {
    v += __builtin_bit_cast(float, __builtin_amdgcn_update_dpp(0, __builtin_bit_cast(int, v), 0xB1, 0xF, 0xF, false)); v += __builtin_bit_cast(float, __builtin_amdgcn_update_dpp(0, __builtin_bit_cast(int, v), 0x4E, 0xF, 0xF, false));
    v += __builtin_bit_cast(float, __builtin_amdgcn_update_dpp(0, __builtin_bit_cast(int, v), 0x141, 0xF, 0xF, false)); v += __builtin_bit_cast(float, __builtin_amdgcn_update_dpp(0, __builtin_bit_cast(int, v), 0x140, 0xF, 0xF, false));
    return v;
}
__device__ __forceinline__ void peer_topk_mfma(LAS unsigned char* lds, int wid, const bf16_t* QB, const bf16_t* SKB, int* PIDX, float* PG, int pm, int pn) {
    constexpr int SQL = 272, L_SK = 0;
    const int lane = lane_id_fresh(), tid = wid * 64 + lane, l15 = lane & 15, g = lane >> 4;
    int tk[2][2][4];
#pragma unroll
    for (int c = 0; c < 2; ++c) {
        const bf16_t* sk = SKB + ((size_t)(pn * 2 + c) * 128) * 128;
#pragma unroll
        for (int i = 0; i < 4; ++i) { const int id = tid + 512 * i, n = id >> 4, dc = id & 15; *(LAS u32x4*)(lds + L_SK + n * SQL + dc * 16) = *(const u32x4*)(sk + n * 128 + dc * 8); }
        bf16x8 af[2][4];
#pragma unroll
        for (int rt = 0; rt < 2; ++rt)
#pragma unroll
            for (int ks = 0; ks < 4; ++ks) af[rt][ks] = *(const bf16x8*)(QB + (size_t)(pm * 256 + 32 * wid + 16 * rt + l15) * D + pn * 256 + c * 128 + 32 * ks + 8 * g);
        __syncthreads();
        int key[2][8][4];
#pragma unroll
        for (int nt = 0; nt < 8; ++nt) {
            f32x4 sc0 = (f32x4){0.f, 0.f, 0.f, 0.f}, sc1 = (f32x4){0.f, 0.f, 0.f, 0.f};
#pragma unroll
            for (int ks = 0; ks < 4; ++ks) {
                const bf16x8 bfr = *(const LAS bf16x8*)(lds + L_SK + (16 * nt + l15) * SQL + (32 * ks + 8 * g) * 2);
                sc0 = __builtin_amdgcn_mfma_f32_16x16x32_bf16(af[0][ks], bfr, sc0, 0, 0, 0);
                sc1 = __builtin_amdgcn_mfma_f32_16x16x32_bf16(af[1][ks], bfr, sc1, 0, 0, 0);
            }
#pragma unroll
            for (int r = 0; r < 4; ++r) { key[0][nt][r] = (f2ord(sc0[r]) & ~127) | (127 - (16 * nt + l15)); key[1][nt][r] = (f2ord(sc1[r]) & ~127) | (127 - (16 * nt + l15)); }
        }
        __syncthreads();
#pragma unroll
        for (int rt = 0; rt < 2; ++rt)
#pragma unroll
            for (int r = 0; r < 4; ++r) {
#define SK_(i) key[rt][i][r]
#define CE_(i, j) do { const int hi_ = max(SK_(i), SK_(j)), lo_ = min(SK_(i), SK_(j)); SK_(i) = hi_; SK_(j) = lo_; } while (0)
                CE_(0, 1); CE_(2, 3); CE_(4, 5); CE_(6, 7); CE_(0, 2); CE_(1, 3); CE_(4, 6); CE_(5, 7); CE_(1, 2); CE_(5, 6);
                CE_(0, 4); CE_(1, 5); CE_(2, 6); CE_(3, 7); CE_(2, 4); CE_(3, 5); CE_(1, 2); CE_(3, 4); CE_(5, 6);
                int mine = 0;
#pragma unroll 1
                for (int k = 0; k < 16; ++k) {
                    const int v = row16_max(SK_(0));
                    if (l15 == k) mine = v;
                    const bool won = (SK_(0) == v);
#pragma unroll
                    for (int nt = 0; nt < 7; ++nt) SK_(nt) = won ? SK_(nt + 1) : SK_(nt);
                    SK_(7) = won ? (int)0x80000000 : SK_(7);
                }
#undef CE_
#undef SK_
                tk[c][rt][r] = mine;
            }
    }
    int ci_[4], cj_[4]; bool cv_[4];
    ci_[0] = 0; cj_[0] = l15; cv_[0] = true;
    ci_[1] = l15 < 8 ? 1 : (l15 < 13 ? 2 : 3); cj_[1] = l15 < 8 ? l15 : (l15 < 13 ? l15 - 8 : l15 - 13); cv_[1] = true;
    ci_[2] = l15 == 0 ? 3 : (l15 < 4 ? 4 : (l15 < 6 ? 5 : (l15 < 8 ? 6 : (l15 < 10 ? 7 : l15 - 2))));
    cj_[2] = l15 == 0 ? 3 : (l15 < 4 ? l15 - 1 : (l15 < 6 ? l15 - 4 : (l15 < 8 ? l15 - 6 : (l15 < 10 ? l15 - 8 : 0)))); cv_[2] = true;
    ci_[3] = 14 + (l15 & 1); cj_[3] = 0; cv_[3] = l15 < 2;
#pragma unroll
    for (int rt = 0; rt < 2; ++rt)
#pragma unroll
        for (int r = 0; r < 4; ++r) {
            int ck[4];
#pragma unroll
            for (int q = 0; q < 4; ++q) {
                const float s0 = ord2f(bperm_i((lane & 48) + ci_[q], tk[0][rt][r]) & ~127), s1 = ord2f(bperm_i((lane & 48) + cj_[q], tk[1][rt][r]) & ~127);
                ck[q] = cv_[q] ? ((f2ord(s0 + s1) & ~255) | (255 - (16 * ci_[q] + cj_[q]))) : (int)0x80000000;
            }
            int mine = 0;
            for (int k = 0; k < 16; ++k) {
                int v = max(max(ck[0], ck[1]), max(ck[2], ck[3]));
                v = row16_max(v);
                if (l15 == k) mine = v;
#pragma unroll
                for (int q = 0; q < 4; ++q) ck[q] = (ck[q] == v) ? (int)0x80000000 : ck[q];
            }
            const int pos = 255 - (mine & 255), ci = pos >> 4, cj = pos & 15;
            const int i0 = 127 - (bperm_i((lane & 48) + ci, tk[0][rt][r]) & 127), i1 = 127 - (bperm_i((lane & 48) + cj, tk[1][rt][r]) & 127);
            const float bv = ord2f(mine & ~255), b0 = ord2f(bperm_i(lane & 48, mine) & ~255);
            const float ex = __expf(bv - b0), sum = row16_sum(ex);
            const size_t o = (size_t)(pm * 256 + 32 * wid + 16 * rt + 4 * g + r) * 128 + pn * 16 + l15;
            PIDX[o] = i0 * 128 + i1; PG[o] = ex * rcpf_(sum);
        }
}

#define XB_TMO      128
#define XB_XCNT(j)  (256  + 64 * (j))
#define XB_XSUB(j)  (1280 + 64 * (j))
#define XB_XGEN(j)  (2304 + 64 * (j))
#define XB_TOP      3328
#define XB_TOPGEN   3392
#define XCD_BAR_WORDS 3456
#define XB_SPIN_CAP (1u << 18)
__device__ __forceinline__ unsigned xb_ld(unsigned* p)              { return __hip_atomic_load(p, __ATOMIC_RELAXED, __HIP_MEMORY_SCOPE_AGENT); }
__device__ __forceinline__ unsigned xb_add(unsigned* p, unsigned v) { return __hip_atomic_fetch_add(p, v, __ATOMIC_RELAXED, __HIP_MEMORY_SCOPE_AGENT); }
__device__ __forceinline__ unsigned xb_xcc_id() { return (unsigned)__builtin_amdgcn_s_getreg((3 << 11) | 20) & 0xFu; }
#define XB_SPIN(cond, bar) do { unsigned _sp = 0; while (cond) { __builtin_amdgcn_s_sleep(1); \
    if ((++_sp & 255u) == 0u) { if (xb_ld(&(bar)[XB_TMO])) break; if (_sp > XB_SPIN_CAP) { atomicAdd(&(bar)[XB_TMO], 1u); break; } } } } while (0)
struct XcdBarrier { unsigned* bar; unsigned x; volatile LAS unsigned* st; };
__device__ __forceinline__ XcdBarrier xcd_barrier_post(unsigned* bar, volatile LAS unsigned* st) {
    XcdBarrier b; b.bar = bar; b.x = xb_xcc_id(); b.st = st;
    if (threadIdx.x == 0) (void)xb_add(&bar[XB_XCNT(b.x)], 1u);
    return b;
}
__device__ __forceinline__ void xcd_barrier_complete(unsigned* bar, unsigned x, unsigned& nloc, unsigned& nx) {
    const unsigned G = gridDim.x * gridDim.y * gridDim.z;
    unsigned sum, cnt, mine, sp = 0u;
    for (;;) {
        sum = 0u; cnt = 0u; mine = 0u;
#pragma unroll
        for (unsigned j = 0; j < 16; ++j) { const unsigned c = xb_ld(&bar[XB_XCNT(j)]); sum += c; cnt += (c > 0u) ? 1u : 0u; mine = (j == x) ? c : mine; }
        if (sum == G) break;
        __builtin_amdgcn_s_sleep(1);
        if ((++sp & 255u) == 0u) { if (xb_ld(&bar[XB_TMO])) break; if (sp > XB_SPIN_CAP) { atomicAdd(&bar[XB_TMO], 1u); break; } }
    }
    nloc = mine > 0u ? mine : 1u; nx = cnt > 0u ? cnt : 1u;
}
__device__ __forceinline__ void xcd_barrier(const XcdBarrier& b, int wave_s) {
    asm volatile("s_waitcnt vmcnt(0)" ::: "memory");
    __syncthreads();
    if (wave_s == 0 && lane_id_fresh() == 0) {
        unsigned* bar = b.bar;
        __builtin_amdgcn_s_waitcnt(0);
        unsigned nloc = b.st[0], nx = b.st[1];
        if (nloc == 0u) { xcd_barrier_complete(bar, b.x, nloc, nx); b.st[0] = nloc; b.st[1] = nx; }
        const unsigned old = xb_add(&bar[XB_XSUB(b.x)], 1u);
        const unsigned gen = old / nloc;
        if (old + 1u == (gen + 1u) * nloc) {
            __builtin_amdgcn_fence(__ATOMIC_RELEASE, "agent");
            asm volatile("s_waitcnt vmcnt(0)" ::: "memory");
            const unsigned og = xb_add(&bar[XB_TOP], 1u);
            const unsigned tg = og / nx;
            if (og + 1u == (tg + 1u) * nx) xb_add(&bar[XB_TOPGEN], 1u);
            else XB_SPIN(xb_ld(&bar[XB_TOPGEN]) == tg, bar);
            __builtin_amdgcn_fence(__ATOMIC_ACQUIRE, "agent");
            xb_add(&bar[XB_XGEN(b.x)], 1u);
            asm volatile("s_waitcnt vmcnt(0)" ::: "memory");
        } else {
            XB_SPIN(xb_ld(&bar[XB_XGEN(b.x)]) == gen, bar);
            __builtin_amdgcn_fence(__ATOMIC_ACQUIRE, "agent");
            asm volatile("s_waitcnt vmcnt(0)" ::: "memory");
        }
    }
    __syncthreads();
}

constexpr int RING_BYTES = 131072, MISC_OFF = RING_BYTES + 320, LDS_BYTES = 147456;
struct Args { const float* in[28]; float* out; unsigned char* ws; int ph_lo, ph_hi; };
enum { I_X = 0, I_P, I_POS, I_LN_MIX, I_W_IN, I_DIFF_LAMBDA, I_DIFF_NORM, I_HGRN_LB, I_HGRN_NORM, I_MLA_QN, I_MLA_KVN, I_MLA_WUQ, I_MLA_WUKV, I_CONV_W, I_CONV_B, I_GATE_B,
       I_MLSTM_NORM, I_GROUP_GAIN, I_W_OUT, I_LN_FFN, I_PEER_WQ, I_PEER_SUBKEYS, I_PEER_U, I_PEER_V, I_LN_PLE, I_PLE_WGATE, I_PLE_WPROJ, I_LN_FINAL };

struct Frame {
    LAS unsigned char* lds; unsigned char* ws; const Args* a;
    int tid, lane, wave, G, gw, ngw, bid;
};

__device__ __forceinline__ int cmap_win(int n) {
    if (n < ZC_MKR) return n;
    if (n < ZC_LQ) { const int j = n - ZC_MKR; return ZC_MKR + (j >> 1) + 32 * (j & 1); }
    if (n < ZC_LO) return n;
    if (n < ZC_LI) return 5320 + (n - ZC_LO);
    if (n < ZC_LF) return 5312 + (n - ZC_LI);
    if (n < IN_COLS) return 5316 + (n - ZC_LF);
    return -1;
}
__device__ __forceinline__ int cmap_uq(int n) { const int hd = n / 192, r = n % 192; if (r < 128) return n; const int j = r - 128; return hd * 192 + 128 + (j >> 1) + 32 * (j & 1); }

template <int MAP>
__device__ __forceinline__ void transpose_item(const float* W, int K, int Nsrc, int Ndst, const float* gain, bf16_t* WT, LAS float* scr_, int item, int lane) {
    LAS unsigned char* scr = (LAS unsigned char*)scr_;
    const int nblk = Ndst / 64, kb = item / nblk, nb = item % nblk, k0 = 64 * kb, n0 = 64 * nb;
    const int nq = (lane & 15) * 4, kr = lane >> 4;
    if (MAP == 0 || (MAP == 1 && (n0 + 64 <= ZC_MKR || (n0 >= ZC_LQ && n0 + 64 <= ZC_LO)))) {
        f32x4 tv[16]; float gk[16];
#pragma unroll
        for (int i = 0; i < 16; ++i) tv[i] = *(const f32x4*)(W + (size_t)(k0 + kr + 4 * i) * Nsrc + n0 + nq);
        if (gain) {
#pragma unroll
            for (int i = 0; i < 16; ++i) gk[i] = gain[k0 + kr + 4 * i];
        } else {
#pragma unroll
            for (int i = 0; i < 16; ++i) gk[i] = 1.f;
        }
#pragma unroll
        for (int i = 0; i < 16; ++i) { const int kk = kr + 4 * i; const f32x4 v = tv[i] * gk[i];
#pragma unroll
            for (int e = 0; e < 4; ++e) *(LAS bf16_t*)(scr + (nq + e) * 144 + kk * 2) = (bf16_t)f2bf(v[e]); }
    } else {
        int src[4];
#pragma unroll
        for (int e = 0; e < 4; ++e) src[e] = (MAP == 1) ? cmap_win(n0 + nq + e) : cmap_uq(n0 + nq + e);
        const int s0 = src[0] > 0 ? src[0] : 0, s1 = src[1] > 0 ? src[1] : 0, s2 = src[2] > 0 ? src[2] : 0, s3 = src[3] > 0 ? src[3] : 0;
        float ts[16][4], gk[16];
#pragma unroll
        for (int i = 0; i < 16; ++i) { const float* wr = W + (size_t)(k0 + kr + 4 * i) * Nsrc; ts[i][0] = wr[s0]; ts[i][1] = wr[s1]; ts[i][2] = wr[s2]; ts[i][3] = wr[s3]; }
        if (gain) {
#pragma unroll
            for (int i = 0; i < 16; ++i) gk[i] = gain[k0 + kr + 4 * i];
        } else {
#pragma unroll
            for (int i = 0; i < 16; ++i) gk[i] = 1.f;
        }
#pragma unroll
        for (int i = 0; i < 16; ++i) { const int kk = kr + 4 * i;
#pragma unroll
            for (int e = 0; e < 4; ++e) { const float v = (src[e] >= 0) ? ts[i][e] * gk[i] : 0.f; *(LAS bf16_t*)(scr + (nq + e) * 144 + kk * 2) = (bf16_t)f2bf(v); } }
    }
    asm volatile("s_waitcnt lgkmcnt(0)" ::: "memory");
#pragma unroll
    for (int j = 0; j < 8; ++j) { const int n = (lane >> 3) + 8 * j, c = lane & 7; *(u32x4*)(WT + (size_t)(n0 + n) * K + k0 + 8 * c) = *(const LAS u32x4*)(scr + n * 144 + c * 16); }
    asm volatile("s_waitcnt lgkmcnt(0)" ::: "memory");
}

constexpr int CV_TAB = 4096, CV_WIN = CV_TAB + 736, CV_WOUT = CV_WIN + 256, CV_WQ = CV_WOUT + 256, CV_WG = CV_WQ + 256, CV_WP = CV_WG + 32, CV_UQ = CV_WP + 18, CV_UKV = CV_UQ + 16,
              CV_P = CV_UKV + 128, NCONV = CV_P + 16;
__device__ __forceinline__ bool conv_early(int item) { return (item >= CV_TAB && item < CV_WIN) || (item >= CV_WP && item < CV_UKV); }
__device__ __forceinline__ void convert_item(Frame& F, int l, int item, int lane) {
    const Args& a = *F.a; unsigned char* ws = F.ws;
    LAS float* scr = (LAS float*)(F.lds + F.wave * 16384);
    if (item < CV_TAB) {
        const int tab = item >> 11, r0 = l * NEXP + (item & 2047) * 8;
        const float* SRC = a.in[tab ? I_PEER_V : I_PEER_U]; unsigned char* DST = ws + (tab ? WS_VB : WS_UB); float* SC = (float*)(ws + (tab ? WS_SV : WS_SU));
        const float* gF = a.in[I_LN_FFN] + l * D;
        f32x4 gv[8];
#pragma unroll
        for (int q = 0; q < 8; ++q) { gv[q] = (f32x4){1.f, 1.f, 1.f, 1.f}; if (tab == 0) gv[q] = *(const f32x4*)(gF + q * 256 + lane * 4); }
        float mysc = 1.f;
        f32x4 nx[2][8];
#pragma unroll
        for (int k = 0; k < 2; ++k)
#pragma unroll
            for (int q = 0; q < 8; ++q) nx[k][q] = *(const f32x4*)(SRC + (size_t)(r0 + k) * D + q * 256 + lane * 4);
#pragma unroll
        for (int rr = 0; rr < 8; ++rr) {
            const int row = r0 + rr; f32x4 v[8]; float am = 0.f;
#pragma unroll
            for (int q = 0; q < 8; ++q) v[q] = nx[rr & 1][q];
            if (rr + 2 < 8) {
#pragma unroll
                for (int q = 0; q < 8; ++q) nx[rr & 1][q] = *(const f32x4*)(SRC + (size_t)(row + 2) * D + q * 256 + lane * 4);
            }
#pragma unroll
            for (int q = 0; q < 8; ++q) {
                v[q] *= gv[q];
                am = fmaxf(am, fmaxf(fmaxf(fabsf(v[q][0]), fabsf(v[q][1])), fmaxf(fabsf(v[q][2]), fabsf(v[q][3]))));
            }
            am = wave_max(am);
            const float sc = am > 0.f ? am * (1.f / 6.f) : 1.f, inv = 1.f / sc;
            u32x4 pk;
#pragma unroll
            for (int q2 = 0; q2 < 4; ++q2) { unsigned w = 0;
                w = __builtin_amdgcn_cvt_scalef32_pk_fp4_f32(w, v[2 * q2][0] * inv, v[2 * q2][1] * inv, 1.0f, 0);
                w = __builtin_amdgcn_cvt_scalef32_pk_fp4_f32(w, v[2 * q2][2] * inv, v[2 * q2][3] * inv, 1.0f, 1);
                w = __builtin_amdgcn_cvt_scalef32_pk_fp4_f32(w, v[2 * q2 + 1][0] * inv, v[2 * q2 + 1][1] * inv, 1.0f, 2);
                w = __builtin_amdgcn_cvt_scalef32_pk_fp4_f32(w, v[2 * q2 + 1][2] * inv, v[2 * q2 + 1][3] * inv, 1.0f, 3);
                pk[q2] = w; }
            *(u32x4*)(DST + (size_t)row * VROW + lane * 16) = pk;
            mysc = (lane == rr) ? sc : mysc;
        }
        if (lane < 8) SC[r0 + lane] = mysc;
        return;
    }
#define CV_TR(MAP, base, WI, GI, K_, NS_, ND_, WSOFF) do { const int i0_ = (item - (base)) * 4; const float* W_ = a.in[WI] + (size_t)l * (K_) * (NS_); const float* g_ = (GI) >= 0 ? a.in[(GI) >= 0 ? (GI) : 0] + l * (K_) : nullptr; \
        bf16_t* WT_ = (bf16_t*)(ws + (WSOFF)) + (size_t)l * (ND_) * (K_); _Pragma("unroll 1") for (int j_ = 0; j_ < 4; ++j_) if (i0_ + j_ < ((K_) / 64) * ((ND_) / 64)) transpose_item<MAP>(W_, K_, NS_, ND_, g_, WT_, scr, i0_ + j_, lane); } while (0)
    if (item < CV_WIN) { CV_TR(1, CV_TAB, I_W_IN, I_LN_MIX, D, IN_COLS, NZ, WS_WIN); return; }
    if (item < CV_WOUT) { CV_TR(0, CV_WIN, I_W_OUT, I_GROUP_GAIN, D, D, D, WS_WOUT); return; }
    if (item < CV_WQ) { CV_TR(0, CV_WOUT, I_PEER_WQ, I_LN_FFN, D, D, D, WS_WQ); return; }
    if (item < CV_WG) { CV_TR(0, CV_WQ, I_PLE_WGATE, I_LN_PLE, D, D, D, WS_WG); return; }
    if (item < CV_WP) { CV_TR(0, CV_WG, I_PLE_WPROJ, -1, PLE, D, D, WS_WP); return; }
    if (item < CV_UQ) { CV_TR(2, CV_WP, I_MLA_WUQ, I_MLA_QN, 384, 768, 768, WS_WUQ); return; }
    if (item < CV_UKV) { CV_TR(0, CV_UQ, I_MLA_WUKV, I_MLA_KVN, 256, 1024, 1024, WS_WUKV); return; }
#undef CV_TR
    if (item < CV_P) {
        const size_t e0 = (size_t)l * T * PLE + (size_t)(item - CV_UKV) * 16384; const float* Pp = a.in[I_P]; bf16_t* PB = (bf16_t*)(ws + WS_PB);
#pragma unroll 4
        for (int i = 0; i < 32; ++i) { const size_t e = e0 + (size_t)i * 512 + lane * 8; const f32x4 v0 = *(const f32x4*)(Pp + e), v1 = *(const f32x4*)(Pp + e + 4);
            u32x4 w; w.x = pk2(v0[0], v0[1]); w.y = pk2(v0[2], v0[3]); w.z = pk2(v1[0], v1[1]); w.w = pk2(v1[2], v1[3]); *(u32x4*)(PB + e) = w; }
        return;
    }
    {
        const size_t e0 = (size_t)l * 8 * 2 * 128 * 128 + (size_t)(item - CV_P) * 16384; const float* sk = a.in[I_PEER_SUBKEYS]; bf16_t* skb = (bf16_t*)(ws + WS_SKB);
#pragma unroll 4
        for (int i = 0; i < 32; ++i) { const size_t e = e0 + (size_t)i * 512 + lane * 8; const f32x4 v0 = *(const f32x4*)(sk + e), v1 = *(const f32x4*)(sk + e + 4);
            u32x4 w; w.x = pk2(v0[0], v0[1]); w.y = pk2(v0[2], v0[3]); w.z = pk2(v1[0], v1[1]); w.w = pk2(v1[2], v1[3]); *(u32x4*)(skb + e) = w; }
    }
}
__device__ __forceinline__ void convert_layers(Frame& F, int l0, int l1, int gw, int NGW, bool early_only) {
    const int lane = lane_id_fresh();
    for (int l = l0; l < l1; ++l)
#pragma unroll 1
        for (int it = gw; it < NCONV; it += NGW) if (!early_only || conv_early(it)) convert_item(F, l, it, lane);
}
__device__ __forceinline__ void convert_layer_queue(Frame& F, int l, unsigned* ctr) {
    const int lane = lane_id_fresh();
#pragma unroll 1
    for (;;) {
        unsigned it = 0;
        if (lane == 0) it = __hip_atomic_fetch_add(ctr, 1u, __ATOMIC_RELAXED, __HIP_MEMORY_SCOPE_AGENT);
        it = __builtin_amdgcn_readfirstlane(it);
        if (it >= (unsigned)NCONV) break;
        const int ll = conv_early((int)it) ? l + 1 : l;
        if (ll < DEPTH) convert_item(F, ll, (int)it, lane);
    }
}

__device__ __forceinline__ void prologue(Frame& F) {
    const Args& a = *F.a; unsigned char* ws = F.ws;
    const int gw = F.gw, NGW = F.ngw, lane = F.lane;
    const size_t gt = (size_t)blockIdx.x * NTHREADS + F.tid, GT = (size_t)F.G * NTHREADS;
    if (F.G == 256) convert_layers(F, 0, 1, gw, NGW, true);
    else convert_layers(F, 0, DEPTH, gw, NGW, false);
    {
        const float* X = a.in[I_X]; bf16_t* HB = (bf16_t*)(ws + WS_HB); u64* ssq = (u64*)(ws + WS_CTL + CTL_SSQA);
        for (int t = gw; t < T; t += NGW) {
            float s2 = 0.f;
#pragma unroll
            for (int c = 0; c < 4; ++c) {
                const size_t o = (size_t)t * D + c * 512 + lane * 8;
                const f32x4 v0 = *(const f32x4*)(X + o), v1 = *(const f32x4*)(X + o + 4);
                u32x4 w; w.x = pk2(v0[0], v0[1]); w.y = pk2(v0[2], v0[3]); w.z = pk2(v1[0], v1[1]); w.w = pk2(v1[2], v1[3]);
                *(u32x4*)(HB + o) = w;
                s2 += v0[0] * v0[0] + v0[1] * v0[1] + v0[2] * v0[2] + v0[3] * v0[3] + v1[0] * v1[0] + v1[1] * v1[1] + v1[2] * v1[2] + v1[3] * v1[3];
            }
            s2 = wave_sum(s2);
            if (lane == 0) ssq[t] = (u64)(s2 * 16777216.f);
        }
    }
    {
        const int* pos = (const int*)a.in[I_POS]; float* cs = (float*)(ws + WS_CS);
        for (size_t i = gt; i < (size_t)T * 32; i += GT) {
            const int t = (int)(i / 32), j = (int)(i % 32);
            const float inv = powf(10000.0f, -(float)j / 32.0f);
            const float ang = (float)pos[t] * inv;
            const double rev = (double)ang * 0.15915494309189535;
            const float fr = (float)(rev - rint(rev));
            cs[i * 2] = __builtin_amdgcn_cosf(fr); cs[i * 2 + 1] = __builtin_amdgcn_sinf(fr);
        }
    }
    {
        float* prm = (float*)(ws + WS_PRM);
#define PRM_COPY(IDX, OFF, N) do { const float* src_ = a.in[IDX]; for (size_t i = gt; i < (size_t)DEPTH * (N); i += GT) { const int l_ = (int)(i / (N)), o_ = (int)(i % (N)); prm[l_ * PRM_L + (OFF) + o_] = src_[i]; } } while (0)
        PRM_COPY(I_CONV_W, PRM_CW, 2048); PRM_COPY(I_CONV_B, PRM_CB, 512); PRM_COPY(I_GATE_B, PRM_GB, 8); PRM_COPY(I_DIFF_LAMBDA, PRM_DL, 256);
        PRM_COPY(I_DIFF_NORM, PRM_DN, 512); PRM_COPY(I_HGRN_NORM, PRM_HN, 512); PRM_COPY(I_MLSTM_NORM, PRM_MN, 512);
#undef PRM_COPY
        for (size_t i = gt; i < (size_t)D; i += GT) prm[PRM_FIN + i] = a.in[I_LN_FINAL][i];
    }
    if (blockIdx.x == 0) {
        const float* lg = a.in[I_HGRN_LB]; float* lbs = (float*)(ws + WS_LBS);
        for (int c = F.tid; c < 512; c += NTHREADS) {
            float v[DEPTH], mx = -1e30f;
#pragma unroll
            for (int l = 0; l < DEPTH; ++l) { v[l] = lg[l * 512 + c]; mx = fmaxf(mx, v[l]); }
            float s = 0.f;
#pragma unroll
            for (int l = 0; l < DEPTH; ++l) { v[l] = expf(v[l] - mx); s += v[l]; }
            float cum = 0.f; float first = 0.f;
#pragma unroll
            for (int l = 0; l < DEPTH; ++l) { cum += v[l] / s; if (l == 0) first = cum; lbs[l * 512 + c] = cum - first; }
        }
    }
}

__device__ __forceinline__ void mix_prep(Frame& F, int l) {
    unsigned char* ws = F.ws;
    const bf16_t* Z = (const bf16_t*)(ws + WS_Z);
    const size_t gt = (size_t)F.bid * NTHREADS + F.tid, GT = (size_t)F.G * NTHREADS;
    bf16_t* KR = (bf16_t*)(ws + WS_KRM); const float* cs = (const float*)(ws + WS_CS);
    for (size_t i = gt; i < (size_t)T * 32; i += GT) {
        const int t = (int)(i / 32), j = (int)(i % 32);
        const float x1 = bf2f(Z[(size_t)t * NZ + ZC_MKR + 2 * j]), x2 = bf2f(Z[(size_t)t * NZ + ZC_MKR + 2 * j + 1]);
        const float c = cs[i * 2], sn = cs[i * 2 + 1];
        *(unsigned*)(KR + (size_t)t * 64 + 2 * j) = pk2(x1 * c - x2 * sn, x2 * c + x1 * sn);
    }
}

typedef float f32x16 __attribute__((ext_vector_type(16)));
typedef short s16x4 __attribute__((ext_vector_type(4)));
__device__ __forceinline__ int crow(int r, int hi) { return (r & 3) + 8 * (r >> 2) + 4 * hi; }
template <int OFF> __device__ __forceinline__ s16x4 tr_read(unsigned addr) { s16x4 r; asm volatile("ds_read_b64_tr_b16 %0, %1 offset:%2" : "=&v"(r) : "v"(addr), "i"(OFF) : "memory"); return r; }
constexpr int ATT_SV = 320;
template <int D0, int BLK, int KS> __device__ __forceinline__ bf16x8 v_frag(unsigned vaddr) {
    const s16x4 lo = tr_read<(32 * BLK + 16 * KS) * ATT_SV + 64 * D0>(vaddr), hi = tr_read<(32 * BLK + 16 * KS + 8) * ATT_SV + 64 * D0>(vaddr);
    return (bf16x8){lo[0], lo[1], lo[2], lo[3], hi[0], hi[1], hi[2], hi[3]};
}
__device__ __forceinline__ bf16x8 pack8(const f32x16& p, int base) {
    u32x4 w; w.x = pk2(p[base + 0], p[base + 1]); w.y = pk2(p[base + 2], p[base + 3]); w.z = pk2(p[base + 4], p[base + 5]); w.w = pk2(p[base + 6], p[base + 7]);
    return __builtin_bit_cast(bf16x8, w);
}
template <int D0> __device__ __forceinline__ void pv_block(f32x16& o, unsigned vaddr, bf16x8 p00, bf16x8 p01, bf16x8 p10, bf16x8 p11) {
    const bf16x8 a00 = v_frag<D0, 0, 0>(vaddr), a01 = v_frag<D0, 0, 1>(vaddr), a10 = v_frag<D0, 1, 0>(vaddr), a11 = v_frag<D0, 1, 1>(vaddr);
    asm volatile("s_waitcnt lgkmcnt(0)" ::: "memory"); __builtin_amdgcn_sched_barrier(0);
    o = __builtin_amdgcn_mfma_f32_32x32x16_bf16(a00, p00, o, 0, 0, 0);
    o = __builtin_amdgcn_mfma_f32_32x32x16_bf16(a01, p01, o, 0, 0, 0);
    o = __builtin_amdgcn_mfma_f32_32x32x16_bf16(a10, p10, o, 0, 0, 0);
    o = __builtin_amdgcn_mfma_f32_32x32x16_bf16(a11, p11, o, 0, 0, 0);
}
template <int MODE>
__device__ __forceinline__ void attn_unit(Frame& F, int l, int b, int h, int qb) {
    constexpr int DK = MODE ? 192 : 64, NS = DK / 16, SK = DK * 2 + 16, KBYTES = 64 * SK, VBYTES = 64 * ATT_SV, BUFB = KBYTES + VBYTES, KCH = DK / 8, NKC = (64 * KCH) / 512;
    constexpr int NMAP = MODE ? 1 : 2;
    constexpr float SCALE = MODE ? 0.07216878364870322f : 0.125f, C = SCALE * 1.4426950408889634f;
    unsigned char* ws = F.ws;
    const bf16_t* Z = (const bf16_t*)(ws + WS_Z); const bf16_t* QM = (const bf16_t*)(ws + WS_QM); const bf16_t* KVM = (const bf16_t*)(ws + WS_KVM); const bf16_t* KRM = (const bf16_t*)(ws + WS_KRM);
    bf16_t* Y = (bf16_t*)(ws + WS_Y);
    const int w = F.wave, lane = lane_id_fresh(), tid = w * 64 + lane, r32 = lane & 31, hi = lane >> 5;
    const int q0 = qb * 256, qw = q0 + 32 * w, ntiles = 4 * (qb + 1);
    const size_t rowb = (size_t)b * SEQ;
    const unsigned lds0 = (unsigned)(uintptr_t)F.lds;
    const unsigned kaddr = lds0 + r32 * SK + 16 * hi;
    const unsigned vaddr = lds0 + KBYTES + (((lane & 15) >> 2) + 4 * hi) * ATT_SV + (16 * ((lane >> 4) & 1) + 4 * (lane & 3)) * 2;
    float* O1 = (float*)(ws + WS_O1) + (rowb + qw + r32) * 512 + h * 128 + 4 * hi;
    for (int mp = 0; mp < NMAP; ++mp) {
        bf16x8 qf[NS];
        {
            const bf16_t* qp = MODE ? QM + (rowb + qw + r32) * 768 + h * 192 + 8 * hi : Z + (rowb + qw + r32) * NZ + ZC_DQ + h * 128 + mp * 64 + 8 * hi;
#pragma unroll
            for (int s = 0; s < NS; ++s) qf[s] = *(const bf16x8*)(qp + 16 * s);
            if (MODE == 1) {
                const float* csq = (const float*)(ws + WS_CS) + (rowb + qw + r32) * 64 + 8 * hi;
#pragma unroll
                for (int s = 8; s < NS; ++s) {
                    const f32x4 ca = *(const f32x4*)(csq + 16 * (s - 8)), cb = *(const f32x4*)(csq + 16 * (s - 8) + 4);
                    const u32x4 w = __builtin_bit_cast(u32x4, qf[s]); u32x4 o;
                    { const float x1 = bflo(w[0]), x2 = bfhi(w[0]); o[0] = pk2(x1 * ca[0] - x2 * ca[1], x2 * ca[0] + x1 * ca[1]); }
                    { const float x1 = bflo(w[1]), x2 = bfhi(w[1]); o[1] = pk2(x1 * ca[2] - x2 * ca[3], x2 * ca[2] + x1 * ca[3]); }
                    { const float x1 = bflo(w[2]), x2 = bfhi(w[2]); o[2] = pk2(x1 * cb[0] - x2 * cb[1], x2 * cb[0] + x1 * cb[1]); }
                    { const float x1 = bflo(w[3]), x2 = bfhi(w[3]); o[3] = pk2(x1 * cb[2] - x2 * cb[3], x2 * cb[2] + x1 * cb[3]); }
                    qf[s] = __builtin_bit_cast(bf16x8, o);
                }
            }
        }
        f32x16 o[4];
#pragma unroll
        for (int d = 0; d < 4; ++d) o[d] = (f32x16){};
        float m_run = -1e30f, l_run = 0.f;
        u32x4 kst[NKC], vst[2];
#define ATT_LOAD(j) do { const int k0_ = 64 * (j); \
            _Pragma("unroll") for (int i_ = 0; i_ < NKC; ++i_) { const int c_ = tid + 512 * i_, row_ = c_ / KCH, cc_ = c_ % KCH; \
                const bf16_t* src_ = MODE ? (cc_ < 16 ? KVM + (rowb + k0_ + row_) * 1024 + h * 256 + cc_ * 8 : KRM + (rowb + k0_ + row_) * 64 + (cc_ - 16) * 8) \
                                          : Z + (rowb + k0_ + row_) * NZ + ZC_DK + h * 128 + mp * 64 + cc_ * 8; \
                kst[i_] = *(const u32x4*)src_; } \
            _Pragma("unroll") for (int i_ = 0; i_ < 2; ++i_) { const int c_ = tid + 512 * i_, row_ = c_ >> 4, cc_ = c_ & 15; \
                const bf16_t* src_ = MODE ? KVM + (rowb + k0_ + row_) * 1024 + h * 256 + 128 + cc_ * 8 : Z + (rowb + k0_ + row_) * NZ + ZC_DV + h * 128 + cc_ * 8; \
                vst[i_] = *(const u32x4*)src_; } } while (0)
#define ATT_WRITE(buf) do { \
            _Pragma("unroll") for (int i_ = 0; i_ < NKC; ++i_) { const int c_ = tid + 512 * i_, row_ = c_ / KCH, cc_ = c_ % KCH; *(LAS u32x4*)(F.lds + (buf) * BUFB + row_ * SK + cc_ * 16) = kst[i_]; } \
            _Pragma("unroll") for (int i_ = 0; i_ < 2; ++i_) { const int c_ = tid + 512 * i_, row_ = c_ >> 4, cc_ = c_ & 15; *(LAS u32x4*)(F.lds + (buf) * BUFB + KBYTES + row_ * ATT_SV + cc_ * 16) = vst[i_]; } } while (0)
        ATT_LOAD(0); ATT_WRITE(0);
        __builtin_amdgcn_s_waitcnt(0x0F70);
        __syncthreads();
        for (int j = 0; j < ntiles; ++j) {
            const int k0 = 64 * j; const unsigned bo = (unsigned)(j & 1) * BUFB;
            if (j + 1 < ntiles) ATT_LOAD(j + 1);
            if (k0 <= qw + 31) {
                f32x16 p0 = (f32x16){}, p1 = (f32x16){};
#pragma unroll
                for (int s = 0; s < NS; ++s) {
                    const bf16x8 a0 = *(const LAS bf16x8*)(uintptr_t)(kaddr + bo + 32 * s), a1 = *(const LAS bf16x8*)(uintptr_t)(kaddr + bo + 32 * SK + 32 * s);
                    p0 = __builtin_amdgcn_mfma_f32_32x32x16_bf16(a0, qf[s], p0, 0, 0, 0);
                    p1 = __builtin_amdgcn_mfma_f32_32x32x16_bf16(a1, qf[s], p1, 0, 0, 0);
                }
                if (k0 + 63 > qw) {
                    const int qi = qw + r32;
#pragma unroll
                    for (int r = 0; r < 16; ++r) { const int key = k0 + crow(r, hi); if (key > qi) p0[r] = -1e30f; if (key + 32 > qi) p1[r] = -1e30f; }
                }
                float pmax = p0[0];
#pragma unroll
                for (int r = 1; r < 16; ++r) pmax = fmaxf(pmax, p0[r]);
#pragma unroll
                for (int r = 0; r < 16; ++r) pmax = fmaxf(pmax, p1[r]);
                pmax = fmaxf(pmax, bperm_f(lane ^ 32, pmax));
                const float mn = fmaxf(m_run, pmax), alpha = __builtin_amdgcn_exp2f((m_run - mn) * C), mnC = -mn * C; m_run = mn;
                float ps = 0.f;
#pragma unroll
                for (int r = 0; r < 16; ++r) { p0[r] = __builtin_amdgcn_exp2f(fmaf(p0[r], C, mnC)); p1[r] = __builtin_amdgcn_exp2f(fmaf(p1[r], C, mnC)); ps += p0[r] + p1[r]; }
                ps += bperm_f(lane ^ 32, ps);
                l_run = l_run * alpha + ps;
                if (!__all(alpha == 1.f)) {
#pragma unroll
                    for (int d = 0; d < 4; ++d) o[d] *= alpha;
                }
                const bf16x8 p00 = pack8(p0, 0), p01 = pack8(p0, 8), p10 = pack8(p1, 0), p11 = pack8(p1, 8);
                pv_block<0>(o[0], vaddr + bo, p00, p01, p10, p11); pv_block<1>(o[1], vaddr + bo, p00, p01, p10, p11);
                pv_block<2>(o[2], vaddr + bo, p00, p01, p10, p11); pv_block<3>(o[3], vaddr + bo, p00, p01, p10, p11);
            }
            if (j + 1 < ntiles) ATT_WRITE((j + 1) & 1);
            __syncthreads();
        }
#undef ATT_LOAD
#undef ATT_WRITE
        const float il = rcpf_(l_run);
        if (MODE == 0 && mp == 0) {
#pragma unroll
            for (int d = 0; d < 4; ++d)
#pragma unroll
                for (int r4 = 0; r4 < 4; ++r4) *(f32x4*)(O1 + 32 * d + 8 * r4) = (f32x4){o[d][4 * r4] * il, o[d][4 * r4 + 1] * il, o[d][4 * r4 + 2] * il, o[d][4 * r4 + 3] * il};
        } else {
            const size_t yrow = (rowb + qw + r32) * D + (MODE ? 1024 : 0) + h * 128 + 4 * hi;
            if (MODE == 0) {
                const float* lv = (const float*)(ws + WS_PRM) + l * PRM_L + PRM_DL;
                const float s01 = wave_sum(lv[lane] * lv[64 + lane]), s23 = wave_sum(lv[128 + lane] * lv[192 + lane]);
                const float lam_init = 0.8f - 0.6f * __expf(-0.3f * (float)l);
                const float lam = __expf(s01) - __expf(s23) + lam_init;
                const float il2 = lam * il; float ss = 0.f;
#pragma unroll
                for (int d = 0; d < 4; ++d)
#pragma unroll
                    for (int r4 = 0; r4 < 4; ++r4) { const f32x4 a1 = *(const f32x4*)(O1 + 32 * d + 8 * r4);
#pragma unroll
                        for (int e = 0; e < 4; ++e) { const float x = a1[e] - o[d][4 * r4 + e] * il2; o[d][4 * r4 + e] = x; ss += x * x; } }
                ss += bperm_f(lane ^ 32, ss);
                const float rn = rsqrtf(ss * (1.f / 128.f) + EPS) * (1.f - lam_init);
                const float* g = (const float*)(ws + WS_PRM) + l * PRM_L + PRM_DN + h * 128 + 4 * hi;
#pragma unroll
                for (int d = 0; d < 4; ++d)
#pragma unroll
                    for (int r4 = 0; r4 < 4; ++r4) {
                        const f32x4 gg = *(const f32x4*)(g + 32 * d + 8 * r4);
                        u32x2 wv; wv.x = pk2(o[d][4 * r4] * rn * gg[0], o[d][4 * r4 + 1] * rn * gg[1]); wv.y = pk2(o[d][4 * r4 + 2] * rn * gg[2], o[d][4 * r4 + 3] * rn * gg[3]);
                        *(u32x2*)(Y + yrow + 32 * d + 8 * r4) = wv;
                    }
            } else {
#pragma unroll
                for (int d = 0; d < 4; ++d)
#pragma unroll
                    for (int r4 = 0; r4 < 4; ++r4) {
                        u32x2 wv; wv.x = pk2(o[d][4 * r4] * il, o[d][4 * r4 + 1] * il); wv.y = pk2(o[d][4 * r4 + 2] * il, o[d][4 * r4 + 3] * il);
                        *(u32x2*)(Y + yrow + 32 * d + 8 * r4) = wv;
                    }
            }
        }
    }
}
__device__ __forceinline__ void attn_fast(Frame& F, int l) {
    const int first = F.bid - 32 * NSEG;
#pragma unroll 1
    for (int i_ = 0; i_ < 2; ++i_) { const int u = i_ ? 255 - first : first;
        const int qb = 7 - (u >> 5), mode = (u >> 4) & 1, b = (u >> 2) & 3, h = u & 3;
        if (mode == 0) attn_unit<0>(F, l, b, h, qb); else attn_unit<1>(F, l, b, h, qb);
    }
}

typedef float f32x4_t __attribute__((ext_vector_type(4)));
template <int KIND>
__device__ __forceinline__ void scan_unit(Frame& F, int l, int b, int h, int seg) {
    constexpr int DK = KIND ? 64 : 128, NKS = DK / 32, NDT = DK / 16, SQ = DK * 2 + 16, SA = 144;
    constexpr int L_QT = 0, L_KT = 64 * SQ, L_KTT = 128 * SQ, L_VT = L_KTT + DK * SA, L_AT = L_VT + 128 * SA, L_ST = L_AT + 64 * SA, L_TAB = L_ST + 128 * SQ;
    constexpr int T_ER = L_TAB, T_EC = T_ER + 512, T_PS = T_EC + 512, T_QS = T_PS + 2048, T_KS = T_QS + 256, T_MT = T_KS + 256, T_NP = T_MT + 256, T_SC = T_NP + 256, T_DEN = T_SC + 64, T_BS = T_DEN + 8 * 256;
    static_assert(T_BS + 256 <= RING_BYTES, "scan LDS");
    unsigned char* ws = F.ws;
    const bf16_t* Z = (const bf16_t*)(ws + WS_Z);
    float* OUT = (float*)(ws + (KIND ? WS_OL : WS_OG));
    const float* prm = (const float*)(ws + WS_PRM) + l * PRM_L;
    LAS unsigned char* lds = F.lds;
    const int w = F.wave, lane = lane_id_fresh(), tid = w * 64 + lane, l15 = lane & 15, g = lane >> 4;
    const int ch = tid & 127, part = tid >> 7, i0 = 16 * part;
    if (w == 2 || w == 3) { const int rt = (w == 2) ? 0 : 2;
#pragma unroll
        for (int r = 0; r < 4; ++r) *(LAS bf16_t*)(lds + L_AT + (16 * rt + 4 * g + r) * SA + (16 * (rt + 1) + l15) * 2) = 0; }
    f32x4 st[NDT];
#pragma unroll
    for (int d = 0; d < NDT; ++d) st[d] = (f32x4){0.f, 0.f, 0.f, 0.f};
    float m_prev = 0.f, np_reg = 0.f, colsum = 0.f, bseg = 0.f;
    float cumlog = 0.f;
    const int bh = b * 4 + h;
    bf16_t* QTS = (bf16_t*)(ws + (KIND ? WS_QTL : WS_QTG)) + (size_t)bh * SEQ * DK;
    float* SCL = (float*)(ws + WS_SCL) + (size_t)bh * SEQ * 4;
    const float lb = KIND ? 0.f : ((const float*)(ws + WS_LBS))[l * 512 + h * 128 + ch];
    unsigned zA[16], zB[16], vr[16], gA = 0, gB = 0;
#define SCAN_LOAD(cc) do { const size_t r0_ = (size_t)b * SEQ + 64 * (cc); \
        if (KIND == 0) { const bf16_t* zr_ = Z + (r0_ + i0) * NZ + h * 128 + ch; \
            _Pragma("unroll") for (int j = 0; j < 16; ++j) { zA[j] = zr_[j * NZ + ZC_GF]; zB[j] = zr_[j * NZ + ZC_GQ]; } } \
        else { const int cidx_ = (ch < 64) ? h * 64 + ch : 256 + h * 64 + (ch - 64); const bf16_t* zc_ = Z + (r0_ + i0) * NZ + ZC_LQ + cidx_; \
            _Pragma("unroll") for (int j = 0; j < 16; ++j) zA[j] = zc_[j * NZ]; \
            if (!((cc) == 0 && part == 0)) { zB[0] = zc_[-3 * NZ]; zB[1] = zc_[-2 * NZ]; zB[2] = zc_[-1 * NZ]; } \
            if (w == 0) { const bf16_t* zg_ = Z + (r0_ + lane) * NZ + h; gA = zg_[ZC_LI]; gB = zg_[ZC_LF]; } } \
        { const bf16_t* zv_ = Z + (r0_ + i0) * NZ + (KIND ? ZC_LV : ZC_GV) + h * 128 + ch; \
            _Pragma("unroll") for (int j = 0; j < 16; ++j) vr[j] = zv_[j * NZ]; } } while (0)
    SCAN_LOAD(seg * SEGC);
    float cw0 = 0.f, cw1 = 0.f, cw2 = 0.f, cw3 = 0.f, cbias = 0.f, gbi = 0.f, gbf = 0.f;
    if (KIND == 1) { const int cidx = (ch < 64) ? h * 64 + ch : 256 + h * 64 + (ch - 64);
        cw0 = prm[PRM_CW + cidx]; cw1 = prm[PRM_CW + 512 + cidx]; cw2 = prm[PRM_CW + 1024 + cidx]; cw3 = prm[PRM_CW + 1536 + cidx]; cbias = prm[PRM_CB + cidx]; gbi = prm[PRM_GB + h]; gbf = prm[PRM_GB + 4 + h]; }
#pragma unroll 1
    for (int c = seg * SEGC; c < (seg + 1) * SEGC; ++c) {
        const size_t row0 = (size_t)b * SEQ + 64 * c;
        float qv[16], kv[16], lf[16];
        if (KIND == 0) {
            float run = 0.f;
#pragma unroll
            for (int j = 0; j < 16; ++j) {
                const float zf = fmaxf(bf2f((bf16_t)zA[j]), -30.f), zq = bf2f((bf16_t)zB[j]);
                const float ez = __expf(-zf), sg = rcpf_(1.f + ez), sgn = ez * sg;
                run += __logf(lb + (1.f - lb) * sg); lf[j] = run; qv[j] = zq * 0.08838834764831845f; kv[j] = (1.f - lb) * sgn;
            }
            *(LAS float*)(lds + T_PS + (part * 128 + ch) * 4) = run;
        } else {
            const float w0 = cw0, w1 = cw1, w2 = cw2, w3 = cw3, cb = cbias;
            const bool first = (c == 0 && part == 0);
            float x0 = first ? 0.f : bf2f((bf16_t)zB[0]), x1 = first ? 0.f : bf2f((bf16_t)zB[1]), x2 = first ? 0.f : bf2f((bf16_t)zB[2]);
#pragma unroll
            for (int j = 0; j < 16; ++j) {
                const float x3 = bf2f((bf16_t)zA[j]);
                float v = cb + x0 * w0 + x1 * w1 + x2 * w2 + x3 * w3; v = v * rcpf_(1.f + __expf(-v));
                qv[j] = (ch < 64) ? v * 0.125f : v; x0 = x1; x1 = x2; x2 = x3;
            }
            if (w == 0) {
                const float li = bf2f((bf16_t)gA) + gbi, zf = bf2f((bf16_t)gB) + gbf;
                const float lfv = fminf(zf, 0.f) - __logf(1.f + __expf(-fabsf(zf)));
                float bb = lfv;
#pragma unroll
                for (int o = 1; o < 64; o <<= 1) { const float t_ = bperm_f(lane - o, bb); if (lane >= o) bb += t_; }
                const float a_ = li - bb; float cm = a_;
#pragma unroll
                for (int o = 1; o < 64; o <<= 1) { const float t_ = bperm_f(lane - o, cm); if (lane >= o) cm = fmaxf(cm, t_); }
                const float M = fmaxf(m_prev, cm), MC = rdlane_f(M, 63), bC = rdlane_f(bb, 63);
                *(LAS float*)(lds + T_QS + lane * 4) = __expf(MC - M); *(LAS float*)(lds + T_KS + lane * 4) = __expf(a_ - MC); *(LAS float*)(lds + T_MT + lane * 4) = bb + M;
                *(LAS float*)(lds + T_BS + lane * 4) = bseg + bb;
                bseg += bC;
                const float cs = __expf(m_prev - MC);
                np_reg = cs * (np_reg + colsum);
                *(LAS float*)(lds + T_NP + lane * 4) = np_reg;
                if (lane == 0) *(LAS float*)(lds + T_SC) = cs;
                m_prev = bC + MC;
            }
        }
        __syncthreads();
        {
            unsigned ktt[8];
            *(LAS u32x4*)(lds + L_VT + ch * SA + i0 * 2) = (u32x4){vr[0] | (vr[1] << 16), vr[2] | (vr[3] << 16), vr[4] | (vr[5] << 16), vr[6] | (vr[7] << 16)};
            *(LAS u32x4*)(lds + L_VT + ch * SA + i0 * 2 + 16) = (u32x4){vr[8] | (vr[9] << 16), vr[10] | (vr[11] << 16), vr[12] | (vr[13] << 16), vr[14] | (vr[15] << 16)};
            if (KIND == 0) {
                const float p0 = *(LAS float*)(lds + T_PS + ch * 4), p1 = *(LAS float*)(lds + T_PS + (128 + ch) * 4), p2 = *(LAS float*)(lds + T_PS + (256 + ch) * 4), p3 = *(LAS float*)(lds + T_PS + (384 + ch) * 4);
                const float r_ = p0 + p1, off = (part > 0 ? p0 : 0.f) + (part > 1 ? p1 : 0.f) + (part > 2 ? p2 : 0.f);
                if (part == 0) { *(LAS float*)(lds + T_ER + ch * 4) = __expf(r_); *(LAS float*)(lds + T_EC + ch * 4) = __expf(p2 + p3); }
                const float eseg = __expf(r_ + cumlog);
                bf16_t* qg_ = QTS + (size_t)(64 * c + i0) * DK + ch;
                cumlog += (p0 + p1) + (p2 + p3);
#pragma unroll
                for (int j = 0; j < 16; ++j) {
                    const float x = fminf(fmaxf(off + lf[j] - r_, -80.f), 80.f);
                    const float qt = qv[j] * __expf(x), kt = kv[j] * __expf(-x);
                    *(LAS bf16_t*)(lds + L_QT + (i0 + j) * SQ + ch * 2) = (bf16_t)f2bf(qt);
                    qg_[j * DK] = (bf16_t)f2bf(qt * eseg);
                    const unsigned kb_ = f2bf(kt);
                    *(LAS bf16_t*)(lds + L_KT + (i0 + j) * SQ + ch * 2) = (bf16_t)kb_;
                    if (j & 1) ktt[j >> 1] |= kb_ << 16; else ktt[j >> 1] = kb_;
                }
                *(LAS u32x4*)(lds + L_KTT + ch * SA + i0 * 2) = (u32x4){ktt[0], ktt[1], ktt[2], ktt[3]};
                *(LAS u32x4*)(lds + L_KTT + ch * SA + i0 * 2 + 16) = (u32x4){ktt[4], ktt[5], ktt[6], ktt[7]};
            } else {
#pragma unroll
                for (int j = 0; j < 16; ++j) {
                    const float fs = *(LAS float*)(lds + ((ch < 64) ? T_QS : T_KS) + (i0 + j) * 4);
                    const unsigned vb_ = f2bf(qv[j] * fs);
                    if (ch < 64) { *(LAS bf16_t*)(lds + L_QT + (i0 + j) * SQ + ch * 2) = (bf16_t)vb_; QTS[(size_t)(64 * c + i0 + j) * DK + ch] = (bf16_t)f2bf(qv[j]); }
                    else *(LAS bf16_t*)(lds + L_KT + (i0 + j) * SQ + (ch - 64) * 2) = (bf16_t)vb_;
                    if (j & 1) ktt[j >> 1] |= vb_ << 16; else ktt[j >> 1] = vb_;
                }
                if (ch >= 64) {
                    *(LAS u32x4*)(lds + L_KTT + (ch - 64) * SA + i0 * 2) = (u32x4){ktt[0], ktt[1], ktt[2], ktt[3]};
                    *(LAS u32x4*)(lds + L_KTT + (ch - 64) * SA + i0 * 2 + 16) = (u32x4){ktt[4], ktt[5], ktt[6], ktt[7]};
                }
            }
        }
        __syncthreads();
        for (int ti = w; ti < 10; ti += 8) {
            const int rt = (int)((0x3333222110ull >> (4 * ti)) & 15), ct = (int)((0x3210210100ull >> (4 * ti)) & 15);
            f32x4 acc = (f32x4){0.f, 0.f, 0.f, 0.f};
#pragma unroll
            for (int ks = 0; ks < NKS; ++ks) {
                const bf16x8 af = *(const LAS bf16x8*)(lds + L_QT + (16 * rt + l15) * SQ + (32 * ks + 8 * g) * 2), bfr = *(const LAS bf16x8*)(lds + L_KT + (16 * ct + l15) * SQ + (32 * ks + 8 * g) * 2);
                acc = __builtin_amdgcn_mfma_f32_16x16x32_bf16(af, bfr, acc, 0, 0, 0);
            }
#pragma unroll
            for (int r = 0; r < 4; ++r) { const int t_ = 16 * rt + 4 * g + r, s_ = 16 * ct + l15; *(LAS bf16_t*)(lds + L_AT + t_ * SA + s_ * 2) = (bf16_t)f2bf(s_ <= t_ ? acc[r] : 0.f); }
        }
        {
            const float cs = KIND ? *(LAS float*)(lds + T_SC) : 1.f;
#pragma unroll
            for (int d = 0; d < NDT; ++d) {
                if (KIND == 0) st[d] *= *(const LAS f32x4*)(lds + T_ER + (16 * d + 4 * g) * 4); else st[d] *= cs;
                u32x2 pk; pk.x = pk2(st[d][0], st[d][1]); pk.y = pk2(st[d][2], st[d][3]);
                *(LAS u32x2*)(lds + L_ST + (16 * w + l15) * SQ + (16 * d + 4 * g) * 2) = pk;
            }
        }
        __syncthreads();
        { const int cn_ = (c + 1 < SEQ / 64) ? c + 1 : c; SCAN_LOAD(cn_); }
        __builtin_amdgcn_sched_barrier(0);
        bf16x8 sfr[NKS], vfr[2];
#pragma unroll
        for (int ks = 0; ks < NKS; ++ks) sfr[ks] = *(const LAS bf16x8*)(lds + L_ST + (16 * w + l15) * SQ + (32 * ks + 8 * g) * 2);
#pragma unroll
        for (int ks = 0; ks < 2; ++ks) vfr[ks] = *(const LAS bf16x8*)(lds + L_VT + (16 * w + l15) * SA + (32 * ks + 8 * g) * 2);
        if (KIND == 1) {
            float dn = 0.f;
#pragma unroll
            for (int d8 = 0; d8 < 8; ++d8) { const u32x4 qw_ = *(const LAS u32x4*)(lds + L_QT + lane * SQ + d8 * 16); const f32x4 n0 = *(const LAS f32x4*)(lds + T_NP + d8 * 32), n1 = *(const LAS f32x4*)(lds + T_NP + d8 * 32 + 16);
                dn += bflo(qw_[0]) * n0[0] + bfhi(qw_[0]) * n0[1] + bflo(qw_[1]) * n0[2] + bfhi(qw_[1]) * n0[3] + bflo(qw_[2]) * n1[0] + bfhi(qw_[2]) * n1[1] + bflo(qw_[3]) * n1[2] + bfhi(qw_[3]) * n1[3]; }
#pragma unroll
            for (int s8 = 0; s8 < 8; ++s8) { const u32x4 aw_ = *(const LAS u32x4*)(lds + L_AT + lane * SA + s8 * 16);
#pragma unroll
                for (int e = 0; e < 4; ++e) { const int s_ = 8 * s8 + 2 * e; dn += (s_ <= lane ? bflo(aw_[e]) : 0.f) + (s_ + 1 <= lane ? bfhi(aw_[e]) : 0.f); } }
            *(LAS float*)(lds + T_DEN + (w * 64 + lane) * 4) = dn;
            *(f32x4*)(SCL + (size_t)(64 * c + lane) * 4) = (f32x4){dn, *(LAS float*)(lds + T_MT + lane * 4), *(LAS float*)(lds + T_BS + lane * 4), 0.f};
            if (w == 0) {
                float cs_ = 0.f;
                for (int s_ = 0; s_ < 64; ++s_) cs_ += bf2f(*(const LAS bf16_t*)(lds + L_KT + s_ * SQ + lane * 2));
                colsum = cs_;
            }
        }
#pragma unroll
        for (int rt = 0; rt < 4; ++rt) {
            f32x4 o = (f32x4){0.f, 0.f, 0.f, 0.f};
#pragma unroll
            for (int ks = 0; ks < NKS; ++ks) o = __builtin_amdgcn_mfma_f32_16x16x32_bf16(*(const LAS bf16x8*)(lds + L_QT + (16 * rt + l15) * SQ + (32 * ks + 8 * g) * 2), sfr[ks], o, 0, 0, 0);
#pragma unroll
            for (int ks = 0; ks < 2; ++ks) if (2 * ks <= rt) o = __builtin_amdgcn_mfma_f32_16x16x32_bf16(*(const LAS bf16x8*)(lds + L_AT + (16 * rt + l15) * SA + (32 * ks + 8 * g) * 2), vfr[ks], o, 0, 0, 0);
            float* op = OUT + (row0 + 16 * rt + 4 * g) * 512 + h * 128 + 16 * w + l15;
            if (KIND == 1) {
                const f32x4 dn = *(const LAS f32x4*)(lds + T_DEN + (w * 64 + 16 * rt + 4 * g) * 4), mt = *(const LAS f32x4*)(lds + T_MT + (16 * rt + 4 * g) * 4);
#pragma unroll
                for (int r = 0; r < 4; ++r) op[r * 512] = (seg > 0) ? o[r] : o[r] * rcpf_(fmaxf(fabsf(dn[r]), __expf(-mt[r])));
            } else {
#pragma unroll
                for (int r = 0; r < 4; ++r) op[r * 512] = o[r];
            }
        }
#pragma unroll
        for (int d = 0; d < NDT; ++d) {
#pragma unroll
            for (int ks = 0; ks < 2; ++ks) st[d] = __builtin_amdgcn_mfma_f32_16x16x32_bf16(*(const LAS bf16x8*)(lds + L_KTT + (16 * d + l15) * SA + (32 * ks + 8 * g) * 2), vfr[ks], st[d], 0, 0, 0);
            if (KIND == 0) st[d] *= *(const LAS f32x4*)(lds + T_EC + (16 * d + 4 * g) * 4);
        }
        __syncthreads();
    }
#undef SCAN_LOAD
    if (seg < NSEG - 1) {
        float* SIF = (float*)(ws + WS_SIF) + (size_t)((KIND * 16 + bh) * NSEG) * 16384;
        bf16_t* SIB = (bf16_t*)(ws + WS_SIB) + (size_t)((KIND * 16 + bh) * NSEG) * 16384;
        float* SIM = (float*)(ws + WS_SIM) + (size_t)(bh * NSEG) * 128;
        unsigned* flg = (unsigned*)(ws + WS_CTL + CTL_SEGF) + (size_t)(((l * 2 + KIND) * 16 + bh) * NSEG) * 16;
        if (KIND == 0 && part == 0) *(LAS float*)(lds + T_PS + ch * 4) = cumlog;
        if (seg > 0) {
            if (w == 0) { unsigned spins = 0; while (__builtin_amdgcn_readfirstlane(__hip_atomic_load(flg + seg * 16, __ATOMIC_RELAXED, __HIP_MEMORY_SCOPE_AGENT)) == 0u && ++spins < (1u << 22)) __builtin_amdgcn_s_sleep(2); }
            __syncthreads();
            __builtin_amdgcn_fence(__ATOMIC_ACQUIRE, "agent");
        }
        if (KIND == 1 && w == 0) {
            const float n_loc = np_reg + colsum; float m_new = m_prev, al_ = 1.f, be_ = 0.f, n_init = 0.f;
            if (seg > 0) { const float m_init = SIM[seg * 128 + 64]; n_init = SIM[seg * 128 + lane]; m_new = fmaxf(m_prev, bseg + m_init); al_ = __expf(m_prev - m_new); be_ = __expf(bseg + m_init - m_new); }
            __hip_atomic_store(SIM + (seg + 1) * 128 + lane, al_ * n_loc + be_ * n_init, __ATOMIC_RELAXED, __HIP_MEMORY_SCOPE_AGENT);
            if (lane == 0) { __hip_atomic_store(SIM + (seg + 1) * 128 + 64, m_new, __ATOMIC_RELAXED, __HIP_MEMORY_SCOPE_AGENT); if (seg > 0) { *(LAS float*)(lds + T_SC) = al_; *(LAS float*)(lds + T_SC + 4) = be_; } }
        }
        __syncthreads();
        float al_ = 1.f, be_ = 0.f;
        if (KIND == 1 && seg > 0) { al_ = *(LAS float*)(lds + T_SC); be_ = *(LAS float*)(lds + T_SC + 4); }
#pragma unroll
        for (int d = 0; d < NDT; ++d) {
            f32x4 val = st[d];
            if (seg > 0) {
                const f32x4 prev = *(const f32x4*)(SIF + (size_t)seg * 16384 + (16 * w + l15) * 128 + 16 * d + 4 * g);
                if (KIND == 0) { const f32x4 cl_ = *(const LAS f32x4*)(lds + T_PS + (16 * d + 4 * g) * 4);
#pragma unroll
                    for (int r = 0; r < 4; ++r) val[r] += __expf(cl_[r]) * prev[r]; }
                else val = al_ * val + be_ * prev;
            }
            const size_t o_ = (size_t)(seg + 1) * 16384 + (16 * w + l15) * 128 + 16 * d + 4 * g;
            __hip_atomic_store((u64*)(SIF + o_), (u64)__builtin_bit_cast(unsigned, val[0]) | ((u64)__builtin_bit_cast(unsigned, val[1]) << 32), __ATOMIC_RELAXED, __HIP_MEMORY_SCOPE_AGENT);
            __hip_atomic_store((u64*)(SIF + o_ + 2), (u64)__builtin_bit_cast(unsigned, val[2]) | ((u64)__builtin_bit_cast(unsigned, val[3]) << 32), __ATOMIC_RELAXED, __HIP_MEMORY_SCOPE_AGENT);
            __hip_atomic_store((u64*)(SIB + o_), (u64)pk2(val[0], val[1]) | ((u64)pk2(val[2], val[3]) << 32), __ATOMIC_RELAXED, __HIP_MEMORY_SCOPE_AGENT);
        }
        asm volatile("s_waitcnt vmcnt(0)" ::: "memory");
        __syncthreads();
        if (tid == 0) __hip_atomic_store(flg + (seg + 1) * 16, 1u, __ATOMIC_RELAXED, __HIP_MEMORY_SCOPE_AGENT);
    }
}

template <int KIND>
__device__ __forceinline__ void norm_unit(Frame& F, int l, int b, int h, int rb, int seg) {
    constexpr int DK = KIND ? 64 : 128, NKS = DK / 32;
    unsigned char* ws = F.ws;
    const int lane = lane_id_fresh(), l15 = lane & 15, g = lane >> 4, bh = b * 4 + h;
    const size_t trow = (size_t)b * SEQ + 32 * rb;
    const float* prm = (const float*)(ws + WS_PRM) + l * PRM_L + (KIND ? PRM_MN : PRM_HN) + h * 128 + 4 * g;
    const bf16_t* Zg = (const bf16_t*)(ws + WS_Z) + (trow + l15) * NZ + (KIND ? ZC_LO : ZC_GG) + h * 128 + 4 * g;
    const float* OUT = (const float*)(ws + (KIND ? WS_OL : WS_OG)) + (trow + l15) * 512 + h * 128 + 4 * g;
    bf16_t* Y = (bf16_t*)(ws + WS_Y) + (trow + l15) * D + (KIND ? 1536 : 512) + h * 128 + 4 * g;
    f32x4 acc[2][8];
#pragma unroll
    for (int rt = 0; rt < 2; ++rt)
#pragma unroll
        for (int vt = 0; vt < 8; ++vt) acc[rt][vt] = (f32x4){0.f, 0.f, 0.f, 0.f};
    float ea[2] = {1.f, 1.f}, eb[2] = {0.f, 0.f}, inv[2] = {1.f, 1.f};
    f32x4 ov[2][8];
#pragma unroll
    for (int rt = 0; rt < 2; ++rt)
#pragma unroll
        for (int vt = 0; vt < 8; ++vt) ov[rt][vt] = *(const f32x4*)(OUT + (size_t)(16 * rt) * 512 + 16 * vt);
    __builtin_amdgcn_sched_barrier(0);
    if (seg > 0) {
        const bf16_t* SIB = (const bf16_t*)(ws + WS_SIB) + (size_t)((KIND * 16 + bh) * NSEG + seg) * 16384;
        const bf16_t* QTS = (const bf16_t*)(ws + (KIND ? WS_QTL : WS_QTG)) + ((size_t)bh * SEQ + 32 * rb + l15) * DK + 8 * g;
        bf16x8 qf[2][NKS];
#pragma unroll
        for (int rt = 0; rt < 2; ++rt)
#pragma unroll
            for (int ks = 0; ks < NKS; ++ks) qf[rt][ks] = *(const bf16x8*)(QTS + (size_t)(16 * rt) * DK + 32 * ks);
#pragma unroll
        for (int v2 = 0; v2 < 8; v2 += 2) {
            bf16x8 af[2][NKS];
#pragma unroll
            for (int vv = 0; vv < 2; ++vv)
#pragma unroll
                for (int ks = 0; ks < NKS; ++ks) af[vv][ks] = *(const bf16x8*)(SIB + (16 * (v2 + vv) + l15) * 128 + 32 * ks + 8 * g);
            __builtin_amdgcn_sched_barrier(0);
#pragma unroll
            for (int vv = 0; vv < 2; ++vv)
#pragma unroll
                for (int ks = 0; ks < NKS; ++ks)
#pragma unroll
                    for (int rt = 0; rt < 2; ++rt) acc[rt][v2 + vv] = __builtin_amdgcn_mfma_f32_16x16x32_bf16(af[vv][ks], qf[rt][ks], acc[rt][v2 + vv], 0, 0, 0);
        }
        if (KIND == 1) {
            const float* SIM = (const float*)(ws + WS_SIM) + (size_t)(bh * NSEG + seg) * 128;
            const float m_init = SIM[64];
            f32x4 nq[2] = {(f32x4){0.f, 0.f, 0.f, 0.f}, (f32x4){0.f, 0.f, 0.f, 0.f}};
#pragma unroll
            for (int ks = 0; ks < NKS; ++ks) { const f32x4 n0 = *(const f32x4*)(SIM + 32 * ks + 8 * g), n1 = *(const f32x4*)(SIM + 32 * ks + 8 * g + 4);
                const u32x4 nw = (u32x4){pk2(n0[0], n0[1]), pk2(n0[2], n0[3]), pk2(n1[0], n1[1]), pk2(n1[2], n1[3])}; const bf16x8 nfr = __builtin_bit_cast(bf16x8, nw);
#pragma unroll
                for (int rt = 0; rt < 2; ++rt) nq[rt] = __builtin_amdgcn_mfma_f32_16x16x32_bf16(nfr, qf[rt][ks], nq[rt], 0, 0, 0); }
#pragma unroll
            for (int rt = 0; rt < 2; ++rt) {
                const f32x4 sc = *(const f32x4*)((const float*)(ws + WS_SCL) + ((size_t)bh * SEQ + 32 * rb + 16 * rt + l15) * 4);
                const float mi = sc[2] + m_init, mp = fmaxf(sc[1], mi); ea[rt] = __expf(sc[1] - mp); eb[rt] = __expf(mi - mp);
                inv[rt] = rcpf_(fmaxf(fabsf(sc[0] * ea[rt] + nq[rt][0] * eb[rt]), __expf(-mp)));
            }
        }
    }
    u32x2 zv[2][8]; f32x4 gnv[8];
#pragma unroll
    for (int vt = 0; vt < 8; ++vt) { gnv[vt] = *(const f32x4*)(prm + 16 * vt);
#pragma unroll
        for (int rt = 0; rt < 2; ++rt) zv[rt][vt] = *(const u32x2*)(Zg + (size_t)(16 * rt) * NZ + 16 * vt); }
    __builtin_amdgcn_sched_barrier(0);
#pragma unroll
    for (int rt = 0; rt < 2; ++rt) {
        float ss = 0.f;
#pragma unroll
        for (int vt = 0; vt < 8; ++vt) {
            const f32x4 o = ov[rt][vt];
            if (KIND == 0) acc[rt][vt] += o; else acc[rt][vt] = (o * ea[rt] + acc[rt][vt] * eb[rt]) * inv[rt];
            ss += acc[rt][vt][0] * acc[rt][vt][0] + acc[rt][vt][1] * acc[rt][vt][1] + acc[rt][vt][2] * acc[rt][vt][2] + acc[rt][vt][3] * acc[rt][vt][3];
        }
        ss += bperm_f(lane ^ 16, ss); ss += bperm_f(lane ^ 32, ss);
        const float r = rsqrtf(ss * (1.f / 128.f) + EPS);
#pragma unroll
        for (int vt = 0; vt < 8; ++vt) {
            const u32x2 zw = zv[rt][vt]; const f32x4 gn = gnv[vt];
            const float z0 = bflo(zw[0]), z1 = bfhi(zw[0]), z2 = bflo(zw[1]), z3 = bfhi(zw[1]);
            const float s0 = sigmoidf_(z0), s1 = sigmoidf_(z1), s2 = sigmoidf_(z2), s3 = sigmoidf_(z3);
            const f32x4 a = acc[rt][vt];
            u32x2 wv; wv.x = pk2(a[0] * r * gn[0] * (KIND ? s0 : z0 * s0), a[1] * r * gn[1] * (KIND ? s1 : z1 * s1)); wv.y = pk2(a[2] * r * gn[2] * (KIND ? s2 : z2 * s2), a[3] * r * gn[3] * (KIND ? s3 : z3 * s3));
            *(u32x2*)(Y + (size_t)(16 * rt) * D + 16 * vt) = wv;
        }
    }
}
__device__ __forceinline__ void scan_norm(Frame& F, int l) {
#pragma unroll 1
    for (int u = F.bid; u < 256; u += F.G) {
        const int b = u >> 6, rb = u & 63, seg = rb / (64 / NSEG), h = F.wave >> 1;
        if (F.wave & 1) norm_unit<1>(F, l, b, h, rb, seg); else norm_unit<0>(F, l, b, h, rb, seg);
    }
}

__device__ __forceinline__ v32f_t ld_row6(const unsigned char* rowp, int lane) {
    const u32x4 a = *(const u32x4*)(rowp + lane * 16); const u32x2 b = *(const u32x2*)(rowp + 1024 + lane * 8);
    const v6u_t p = (v6u_t){a[0], a[1], a[2], a[3], b[0], b[1]};
    return __builtin_amdgcn_cvt_scalef32_pk32_f32_fp6(p, 1.0f);
}
__device__ __forceinline__ float sw32_add(float a, float b) { asm volatile("s_nop 1\n\tv_permlane32_swap_b32 %0, %1\n\ts_nop 1" : "+v"(a), "+v"(b)); return a + b; }
__device__ __forceinline__ float sw16_add(float a, float b) { asm volatile("s_nop 1\n\tv_permlane16_swap_b32 %0, %1\n\ts_nop 1" : "+v"(a), "+v"(b)); return a + b; }
__device__ __forceinline__ float reduce8(const float (&p)[8], int lane) {
    const float q0 = sw16_add(sw32_add(p[0], p[1]), sw32_add(p[2], p[3])), q1 = sw16_add(sw32_add(p[4], p[5]), sw32_add(p[6], p[7]));
    const float t0 = q0 + DPP_F(q0, 0x128), t1 = q1 + DPP_F(q1, 0x128);
    float t = (lane & 8) ? t1 : t0;
    t += DPP_F(t, 0xB1); t += DPP_F(t, 0x4E); t += DPP_F(t, 0x141);
    return t;
}
__device__ __forceinline__ void peer_gather(Frame& F, int l) {
    constexpr int NF = 16;
    unsigned char* ws = F.ws;
    const unsigned char* U4 = ws + WS_UB + (size_t)l * NEXP * VROW; const unsigned char* V4 = ws + WS_VB + (size_t)l * NEXP * VROW;
    const float* SU = (const float*)(ws + WS_SU) + l * NEXP; const float* SV = (const float*)(ws + WS_SV) + l * NEXP;
    const int* PIDX = (const int*)(ws + WS_PIDX); const float* PG = (const float*)(ws + WS_PGATE);
    bf16_t* HB = (bf16_t*)(ws + WS_HB) + (size_t)(l & 1) * T * D;
    const u64* ssqB = (const u64*)(ws + WS_CTL + CTL_SSQB) + l * T; float* ssqC = (float*)(ws + WS_CTL + CTL_SSQC) + l * T;
    const int lane = F.lane;
    LAS float* cl = (LAS float*)(F.lds + F.wave * 512);
    int emap;
    { float lab[8];
#pragma unroll
      for (int k = 0; k < 8; ++k) lab[k] = (float)k * (1.f / 64.f);
      emap = (int)(reduce8(lab, lane) + 0.5f); }
    for (int t = F.gw; t < T; t += F.ngw) {
        float x[32];
#pragma unroll
        for (int q = 0; q < 8; ++q) { const u32x2 w = *(const u32x2*)(HB + (size_t)t * D + q * 256 + lane * 4);
            x[4 * q] = bflo(w[0]); x[4 * q + 1] = bfhi(w[0]); x[4 * q + 2] = bflo(w[1]); x[4 * q + 3] = bfhi(w[1]); }
        const float rs = rsqrtf(ssq_get(ssqB + t) * (1.f / D) + EPS);
        const int myidx0 = PIDX[(size_t)t * 128 + lane], myidx1 = PIDX[(size_t)t * 128 + 64 + lane];
        const float mys0 = SU[myidx0] * rs, mys1 = SU[myidx1] * rs;
        const float myg0 = PG[(size_t)t * 128 + lane] * SV[myidx0], myg1 = PG[(size_t)t * 128 + 64 + lane] * SV[myidx1];
#pragma unroll 1
        for (int e0 = 0; e0 < 128; e0 += NF) {
            u32x4 uw[NF];
#pragma unroll
            for (int k = 0; k < NF; ++k) { const int e = e0 + k; const int idx = __builtin_amdgcn_readlane(e < 64 ? myidx0 : myidx1, e & 63); uw[k] = *(const u32x4*)(U4 + (size_t)idx * VROW + lane * 16); }
#pragma unroll
            for (int b8 = 0; b8 < NF / 8; ++b8) {
                float part[8];
#pragma unroll
                for (int k = 0; k < 8; ++k) {
                    const int kk = b8 * 8 + k; float s_ = 0.f;
#pragma unroll
                    for (int q2 = 0; q2 < 4; ++q2) {
                        const f32x2_t d0 = __builtin_amdgcn_cvt_scalef32_pk_f32_fp4(uw[kk][q2], 1.0f, 0), d1 = __builtin_amdgcn_cvt_scalef32_pk_f32_fp4(uw[kk][q2], 1.0f, 1);
                        const f32x2_t d2 = __builtin_amdgcn_cvt_scalef32_pk_f32_fp4(uw[kk][q2], 1.0f, 2), d3 = __builtin_amdgcn_cvt_scalef32_pk_f32_fp4(uw[kk][q2], 1.0f, 3);
                        s_ += x[8 * q2] * d0[0] + x[8 * q2 + 1] * d0[1] + x[8 * q2 + 2] * d1[0] + x[8 * q2 + 3] * d1[1] + x[8 * q2 + 4] * d2[0] + x[8 * q2 + 5] * d2[1] + x[8 * q2 + 6] * d3[0] + x[8 * q2 + 7] * d3[1];
                    }
                    part[k] = s_;
                    if (kk + 1 < NF) asm volatile("" : "+v"(uw[kk + 1]) : "v"(s_));
                }
                const float dot = reduce8(part, lane);
                const int eb = e0 + b8 * 8 + emap;
                const float pre = dot * bperm_f(eb & 63, e0 < 64 ? mys0 : mys1);
                const float act = 0.5f * pre * (1.f + erff(pre * 0.7071067811865476f));
                const float cf = act * bperm_f(eb & 63, e0 < 64 ? myg0 : myg1);
                if ((lane & 7) == 0) cl[eb] = cf;
            }
        }
        asm volatile("s_waitcnt lgkmcnt(0)" ::: "memory");
        const float c0 = cl[lane], c1 = cl[64 + lane];
        float y[32];
#pragma unroll
        for (int i = 0; i < 32; ++i) y[i] = 0.f;
#pragma unroll 1
        for (int e0 = 0; e0 < 128; e0 += NF) {
            u32x4 vw[NF];
#pragma unroll
            for (int k = 0; k < NF; ++k) { const int e = e0 + k; const int idx = __builtin_amdgcn_readlane(e < 64 ? myidx0 : myidx1, e & 63); vw[k] = *(const u32x4*)(V4 + (size_t)idx * VROW + lane * 16); }
#pragma unroll
            for (int k = 0; k < NF; ++k) {
                const int e = e0 + k; const float ce = rdlane_f(e < 64 ? c0 : c1, e & 63);
#pragma unroll
                for (int q2 = 0; q2 < 4; ++q2) {
                    const f32x2_t d0 = __builtin_amdgcn_cvt_scalef32_pk_f32_fp4(vw[k][q2], 1.0f, 0), d1 = __builtin_amdgcn_cvt_scalef32_pk_f32_fp4(vw[k][q2], 1.0f, 1);
                    const f32x2_t d2 = __builtin_amdgcn_cvt_scalef32_pk_f32_fp4(vw[k][q2], 1.0f, 2), d3 = __builtin_amdgcn_cvt_scalef32_pk_f32_fp4(vw[k][q2], 1.0f, 3);
                    y[8 * q2] += ce * d0[0]; y[8 * q2 + 1] += ce * d0[1]; y[8 * q2 + 2] += ce * d1[0]; y[8 * q2 + 3] += ce * d1[1];
                    y[8 * q2 + 4] += ce * d2[0]; y[8 * q2 + 5] += ce * d2[1]; y[8 * q2 + 6] += ce * d3[0]; y[8 * q2 + 7] += ce * d3[1];
                }
                if (k + 1 < NF) asm volatile("" : "+v"(vw[k + 1]) : "v"(y[0]), "v"(y[31]));
            }
        }
        float s2 = 0.f;
#pragma unroll
        for (int q = 0; q < 8; ++q) {
            const float v0 = x[4 * q] + y[4 * q], v1 = x[4 * q + 1] + y[4 * q + 1], v2 = x[4 * q + 2] + y[4 * q + 2], v3 = x[4 * q + 3] + y[4 * q + 3];
            *(u32x2*)(HB + (size_t)t * D + q * 256 + lane * 4) = (u32x2){pk2(v0, v1), pk2(v2, v3)};
            s2 += v0 * v0 + v1 * v1 + v2 * v2 + v3 * v3;
        }
        s2 = wave_sum(s2);
        if (lane == 0) ssqC[t] = s2;
    }
}

__device__ __forceinline__ void final_norm(Frame& F) {
    const Args& a = *F.a; unsigned char* ws = F.ws;
    const bf16_t* HB = (const bf16_t*)(ws + WS_HB) + (size_t)(DEPTH & 1) * T * D; const u64* ssq = (const u64*)(ws + WS_CTL + CTL_SSQA) + 4 * T; const float* g = (const float*)(ws + WS_PRM) + PRM_FIN;
    const int lane = F.lane;
    for (int t = F.gw; t < T; t += F.ngw) {
        const float rs = rsqrtf(ssq_get(ssq + t) * (1.f / D) + EPS);
#pragma unroll
        for (int c = 0; c < 4; ++c) { const size_t o = (size_t)t * D + c * 512 + lane * 8; const u32x4 hw = *(const u32x4*)(HB + o); const f32x4 g0 = *(const f32x4*)(g + c * 512 + lane * 8), g1 = *(const f32x4*)(g + c * 512 + lane * 8 + 4);
            *(f32x4*)(a.out + o) = (f32x4){bflo(hw[0]), bfhi(hw[0]), bflo(hw[1]), bfhi(hw[1])} * rs * g0; *(f32x4*)(a.out + o + 4) = (f32x4){bflo(hw[2]), bfhi(hw[2]), bflo(hw[3]), bfhi(hw[3])} * rs * g1; }
    }
}

constexpr int PH_PER_LAYER = 10, N_PHASES = 2 + DEPTH * PH_PER_LAYER;
template <int PH>
__device__ __forceinline__ void run_phase(Frame& F0, int l) {
    Frame F = F0; { int bid_ = blockIdx.x, wv_ = F0.wave; asm volatile("" : "+s"(bid_), "+s"(wv_));
      F.bid = bid_; F.wave = wv_; F.lane = lane_id_fresh(); F.tid = wv_ * 64 + F.lane; F.gw = bid_ * NWAVES + wv_;
      size_t z_ = 0; asm volatile("" : "+s"(z_)); F.ws = F0.ws + z_; }
    unsigned char* ws = F.ws;
    bf16_t* const HBc = (bf16_t*)(ws + WS_HB) + (size_t)(l & 1) * T * D; bf16_t* const HBn = (bf16_t*)(ws + WS_HB) + (size_t)((l + 1) & 1) * T * D;
    if constexpr (PH == 100) prologue(F);
    if constexpr (PH == 101) final_norm(F);
    if constexpr (PH == 0) {
        pg8::Gemm g{HBc, (const bf16_t*)(ws + WS_WIN) + (size_t)l * NZ * D, T, NZ, D, D, D}; pg8::StaticOrder S; S.init(T, NZ, F.G, F.bid);
        EpiZ E{(bf16_t*)(ws + WS_Z), (const u64*)(ws + WS_CTL + CTL_SSQA) + l * T, (u64*)(ws + WS_CTL + CTL_MQS) + l * T, (u64*)(ws + WS_CTL + CTL_MKVS) + l * T};
        pg8::gemm_phase<EpiZ, pg8::StaticOrder, true, true>(F.lds, g, S, E, F.wave);
    }
    if constexpr (PH == 1) {
        mix_prep(F, l);
        { pg8::Gemm g{(const bf16_t*)(ws + WS_Z) + ZC_MCQ, (const bf16_t*)(ws + WS_WUQ) + (size_t)l * 768 * 384, T, 768, 384, NZ, 384}; pg8::StaticOrder S; S.init(T, 768, F.G, F.bid);
          EpiBf16s E{(bf16_t*)(ws + WS_QM), 768, (const u64*)(ws + WS_CTL + CTL_MQS) + l * T, 1.f / 384.f};
          pg8::gemm_phase<EpiBf16s, pg8::StaticOrder, true, true>(F.lds, g, S, E, F.wave); }
        __syncthreads();
        { pg8::Gemm g{(const bf16_t*)(ws + WS_Z) + ZC_MCKV, (const bf16_t*)(ws + WS_WUKV) + (size_t)l * 1024 * 256, T, 1024, 256, NZ, 256}; pg8::StaticOrder S; S.init(T, 1024, F.G, (int)((F.bid + 128) % F.G));
          EpiBf16s E{(bf16_t*)(ws + WS_KVM), 1024, (const u64*)(ws + WS_CTL + CTL_MKVS) + l * T, 1.f / 256.f};
          pg8::gemm_phase<EpiBf16s, pg8::StaticOrder, true, true>(F.lds, g, S, E, F.wave); }
    }
    if constexpr (PH == 3) {
        if (F.bid < 32 * NSEG) { const int bhs = F.bid % (16 * NSEG), b = bhs / (4 * NSEG), h = (bhs / NSEG) & 3, seg = bhs % NSEG; if (F.bid < 16 * NSEG) scan_unit<0>(F, l, b, h, seg); else scan_unit<1>(F, l, b, h, seg); }
        else if (F.bid < 32 * NSEG + 128) attn_fast(F, l);
        if (F.G == 256) { __syncthreads(); convert_layer_queue(F, l, (unsigned*)(ws + WS_CTL + CTL_CVQ) + 64 * l); }
    }
    if constexpr (PH == 4) scan_norm(F, l);
    if constexpr (PH == 5) {
        pg8::Gemm g{(const bf16_t*)(ws + WS_Y), (const bf16_t*)(ws + WS_WOUT) + (size_t)l * D * D, T, D, D, D, D}; pg8::StaticOrder S; S.init(T, D, F.G, F.bid);
        EpiRes E{HBc, (u64*)(ws + WS_CTL + CTL_SSQB) + l * T};
        pg8::gemm_phase<EpiRes, pg8::StaticOrder, true, true>(F.lds, g, S, E, F.wave);
    }
    if constexpr (PH == 6) {
        { pg8::Gemm g{HBc, (const bf16_t*)(ws + WS_WQ) + (size_t)l * D * D, T, D, D, D, D}; pg8::StaticOrder S; S.init(T, D, F.G, F.bid);
          EpiBf16s E{(bf16_t*)(ws + WS_QB), D, (const u64*)(ws + WS_CTL + CTL_SSQB) + l * T, 1.f / D};
          pg8::gemm_phase<EpiBf16s, pg8::StaticOrder, true, true>(F.lds, g, S, E, F.wave);
          pg8::Unit u;
          if (S.next(0, u)) {
              asm volatile("s_waitcnt vmcnt(0)" ::: "memory"); __syncthreads();
              __builtin_amdgcn_fence(__ATOMIC_ACQUIRE, "agent"); asm volatile("s_waitcnt vmcnt(0)" ::: "memory");
              peer_topk_mfma(F.lds, F.wave, (const bf16_t*)(ws + WS_QB), (const bf16_t*)(ws + WS_SKB) + (size_t)l * 8 * 2 * 128 * 128, (int*)(ws + WS_PIDX), (float*)(ws + WS_PGATE), u.pm, u.pn);
          } }
        __syncthreads();
        { pg8::Gemm g{(const bf16_t*)(ws + WS_PB) + (size_t)l * T * PLE, (const bf16_t*)(ws + WS_WP) + (size_t)l * D * PLE, T, D, PLE, PLE, PLE}; pg8::StaticOrder S; S.init(T, D, F.G, F.bid);
          EpiBf16s E{(bf16_t*)(ws + WS_PR), D, nullptr, 0.f};
          pg8::gemm_phase<EpiBf16s, pg8::StaticOrder, true, true>(F.lds, g, S, E, F.wave); }
    }
    if constexpr (PH == 8) peer_gather(F, l);
    if constexpr (PH == 9) {
        pg8::Gemm g{HBc, (const bf16_t*)(ws + WS_WG) + (size_t)l * D * D, T, D, D, D, D}; pg8::StaticOrder S; S.init(T, D, F.G, F.bid);
        EpiPle E{HBc, HBn, (const bf16_t*)(ws + WS_PR), (const float*)(ws + WS_CTL + CTL_SSQC) + l * T, (u64*)(ws + WS_CTL + CTL_SSQA) + (l + 1) * T};
        pg8::gemm_phase<EpiPle, pg8::StaticOrder, true, true>(F.lds, g, S, E, F.wave);
    }
}
__global__ void __launch_bounds__(NTHREADS, 2) mega(Args args) {
    extern __shared__ __attribute__((aligned(16))) unsigned char lds_raw[];
    Frame F; F.lds = (LAS unsigned char*)lds_raw; F.ws = args.ws; F.a = &args;
    F.tid = threadIdx.x; F.lane = F.tid & 63; F.wave = __builtin_amdgcn_readfirstlane(F.tid >> 6); F.G = gridDim.x;
    F.gw = blockIdx.x * NWAVES + F.wave; F.ngw = F.G * NWAVES; F.bid = blockIdx.x;
    volatile LAS unsigned* misc = (volatile LAS unsigned*)(F.lds + MISC_OFF);
    if (F.tid < 32) misc[F.tid] = 0u;
    __syncthreads();
    (void)xcd_barrier_post((unsigned*)(args.ws + WS_CTL + CTL_BAR), misc + 8);
#define GRID_BAR() do { XcdBarrier b_; b_.bar = (unsigned*)(args.ws + WS_CTL + CTL_BAR); b_.x = xb_xcc_id(); b_.st = (volatile LAS unsigned*)(F.lds + MISC_OFF) + 8; xcd_barrier(b_, F.wave); } while (0)
    run_phase<100>(F, 0); GRID_BAR();
    for (int l = 0; l < DEPTH; ++l) {
        run_phase<0>(F, l); GRID_BAR();
        run_phase<1>(F, l); GRID_BAR();
        run_phase<3>(F, l); GRID_BAR();
        run_phase<4>(F, l); GRID_BAR();
        run_phase<5>(F, l); GRID_BAR();
        run_phase<6>(F, l); GRID_BAR();
        run_phase<8>(F, l); GRID_BAR();
        run_phase<9>(F, l); GRID_BAR();
    }
    run_phase<101>(F, 0);
#undef GRID_BAR
}

extern "C" void kernel_launch(void* const* d_in, const int* in_sizes, int n_in, void* d_out, int out_size, void* d_ws, size_t ws_size, hipStream_t stream) {
    static int grid = 0;
    if (grid == 0) {
        if (n_in != 28 || out_size != T * D || ws_size < WS_END) { fprintf(stderr, "kernel_launch: unexpected shapes (n_in %d out %d ws %zu need %zu)\n", n_in, out_size, ws_size, (size_t)WS_END); grid = -1; return; }
        if (hipFuncSetAttribute((const void*)mega, hipFuncAttributeMaxDynamicSharedMemorySize, LDS_BYTES) != hipSuccess) { fprintf(stderr, "kernel_launch: hipFuncSetAttribute failed\n"); grid = -1; return; }
        int dev = 0, cus = 0, per_cu = 0; (void)hipGetDevice(&dev); (void)hipDeviceGetAttribute(&cus, hipDeviceAttributeMultiprocessorCount, dev);
        if (hipOccupancyMaxActiveBlocksPerMultiprocessor(&per_cu, (const void*)mega, NTHREADS, LDS_BYTES) != hipSuccess || per_cu < 1) { fprintf(stderr, "kernel_launch: occupancy query says %d blocks per CU\n", per_cu); (void)hipGetLastError(); }
        grid = cus > 0 ? cus : 256;
    }
    if (grid < 0) return;
    (void)hipMemsetAsync((char*)d_ws + WS_CTL, 0, CTL_BYTES, stream);
    Args a{};
    for (int i = 0; i < 28; ++i) a.in[i] = (const float*)d_in[i];
    a.out = (float*)d_out; a.ws = (unsigned char*)d_ws;
    hipLaunchKernelGGL(mega, dim3(grid), dim3(NTHREADS), LDS_BYTES, stream, a);
}
```

```cpp
#include <hip/hip_runtime.h>
#include <cstdio>
#include <cstdint>

#define GAS __attribute__((address_space(1)))
#define LAS __attribute__((address_space(3)))
typedef unsigned short bf16_t;
typedef short bf16x8 __attribute__((ext_vector_type(8)));
typedef float f32x4 __attribute__((ext_vector_type(4)));
typedef unsigned u32x4 __attribute__((ext_vector_type(4)));
typedef unsigned u32x2 __attribute__((ext_vector_type(2)));
typedef float f32x2_t __attribute__((ext_vector_type(2)));
typedef float v16f_t __attribute__((ext_vector_type(16)));
typedef float v32f_t __attribute__((ext_vector_type(32)));
typedef unsigned v6u_t __attribute__((ext_vector_type(6)));
constexpr int EROW = 1536;
constexpr int VROW = 1024;

constexpr int D = 2048, BATCH = 4, SEQ = 2048, T = BATCH * SEQ, DEPTH = 4, PLE = 256;
constexpr int IN_COLS = 5832, NZ = 5888;
constexpr int ZC_DQ = 0, ZC_DK = 512, ZC_DV = 1024, ZC_GQ = 1536, ZC_GF = 2048, ZC_GV = 2560, ZC_GG = 3072, ZC_MCQ = 3584, ZC_MCKV = 3968, ZC_MKR = 4224,
              ZC_LQ = 4288, ZC_LK = 4544, ZC_LV = 4800, ZC_LO = 5312, ZC_LI = 5824, ZC_LF = 5828;
constexpr int NEXP = 16384;
constexpr float EPS = 1e-6f;
constexpr int NWAVES = 8, NTHREADS = 512;

constexpr size_t MiB = 1u << 20;
constexpr size_t al(size_t x) { return (x + 255) & ~(size_t)255; }
constexpr size_t WS_CTL = 0, CTL_BYTES = 2 * MiB;
constexpr size_t CTL_BAR = 0;
constexpr size_t CTL_CVQ = 32 * 1024;
constexpr size_t CTL_SSQA = 64 * 1024;
constexpr size_t CTL_SSQB = CTL_SSQA + 5 * T * 8;
constexpr size_t CTL_MQS = CTL_SSQB + 4 * T * 8;
constexpr size_t CTL_MKVS = CTL_MQS + 4 * T * 8;
constexpr size_t CTL_SSQC = CTL_MKVS + 4 * T * 8;
static_assert(CTL_SSQC + 4 * T * 4 <= 1536 * 1024, "ctl");
constexpr size_t WS_WIN = CTL_BYTES;
constexpr size_t WS_WOUT = WS_WIN + al((size_t)DEPTH * NZ * D * 2);
constexpr size_t WS_WQ = WS_WOUT + al((size_t)DEPTH * D * D * 2);
constexpr size_t WS_WG = WS_WQ + al((size_t)DEPTH * D * D * 2);
constexpr size_t WS_WP = WS_WG + al((size_t)DEPTH * D * D * 2);
constexpr size_t WS_WUQ = WS_WP + al((size_t)DEPTH * D * PLE * 2);
constexpr size_t WS_WUKV = WS_WUQ + al((size_t)DEPTH * 768 * 384 * 2);
constexpr size_t WS_UB = WS_WUKV + al((size_t)DEPTH * 1024 * 256 * 2);
constexpr size_t WS_VB = WS_UB + al((size_t)DEPTH * NEXP * D * 2);
constexpr size_t WS_PB = WS_VB + al((size_t)DEPTH * NEXP * D * 2);
constexpr size_t WS_CS = WS_PB + al((size_t)DEPTH * T * PLE * 2);
constexpr size_t WS_LBS = WS_CS + al((size_t)T * 32 * 2 * 4);
constexpr size_t WS_H = WS_LBS + al((size_t)DEPTH * 512 * 4);
constexpr size_t WS_HB = WS_H + al((size_t)T * D * 4);
constexpr size_t WS_Z = WS_HB + 2 * al((size_t)T * D * 2);
constexpr size_t WS_QM = WS_Z + al((size_t)T * NZ * 2);
constexpr size_t WS_KVM = WS_QM + al((size_t)T * 768 * 2);
constexpr size_t WS_KRM = WS_KVM + al((size_t)T * 1024 * 2);
constexpr size_t WS_Y = WS_KRM + al((size_t)T * 64 * 2);
constexpr size_t WS_QP = WS_Y + al((size_t)T * D * 2);
constexpr size_t WS_QB = WS_QP;
constexpr size_t WS_PR = WS_QP + al((size_t)T * D * 4);
constexpr size_t WS_PIDX = WS_PR + al((size_t)T * D * 4);
constexpr size_t WS_PGATE = WS_PIDX + al((size_t)T * 128 * 4);
constexpr size_t WS_GQ = WS_PGATE + al((size_t)T * 128 * 4);
constexpr size_t WS_GK = WS_GQ + al((size_t)T * 512 * 4);
constexpr size_t WS_GF = WS_GK + al((size_t)T * 512 * 4);
constexpr size_t WS_OG = WS_GF + al((size_t)T * 512 * 4);
constexpr size_t WS_LQK = WS_OG + al((size_t)T * 512 * 4);
constexpr size_t WS_LIF = WS_LQK + al((size_t)T * 512 * 4);
constexpr size_t WS_OL = WS_LIF + al((size_t)T * 8 * 4);
constexpr size_t WS_O1 = WS_OL + al((size_t)T * 512 * 4);
constexpr size_t WS_PRM = WS_O1 + al((size_t)T * 512 * 4);
constexpr int PRM_L = 4608, PRM_CW = 0, PRM_CB = 2048, PRM_GB = 2560, PRM_DL = 2576, PRM_DN = 2832, PRM_HN = 3344, PRM_MN = 3856, PRM_FIN = DEPTH * PRM_L;
constexpr size_t WS_SKB = WS_PRM + al((size_t)(PRM_FIN + D) * 4);
constexpr size_t WS_SU = WS_SKB + al((size_t)DEPTH * 8 * 2 * 128 * 128 * 2);
constexpr size_t WS_SV = WS_SU + al((size_t)DEPTH * NEXP * 4);
constexpr int NSEG = 2, SEGC = SEQ / 64 / NSEG, NCONVWG = 64;
constexpr size_t WS_QTG = WS_SV + al((size_t)DEPTH * NEXP * 4);
constexpr size_t WS_QTL = WS_QTG + al((size_t)16 * SEQ * 128 * 2);
constexpr size_t WS_SCL = WS_QTL + al((size_t)16 * SEQ * 64 * 2);
constexpr size_t WS_SIB = WS_SCL + al((size_t)16 * SEQ * 4 * 4);
constexpr size_t WS_SIF = WS_SIB + al((size_t)2 * 16 * NSEG * 128 * 128 * 2);
constexpr size_t WS_SIM = WS_SIF + al((size_t)2 * 16 * NSEG * 128 * 128 * 4);
constexpr size_t WS_END = WS_SIM + al((size_t)16 * NSEG * 128 * 4);
constexpr size_t CTL_SEGF = 1536 * 1024;
static_assert(CTL_SEGF + DEPTH * 2 * 16 * NSEG * 64 <= CTL_BYTES, "ctl segf");

typedef float f32x2v_t __attribute__((ext_vector_type(2)));
typedef __bf16 bf16x2v_t __attribute__((ext_vector_type(2)));
__device__ __forceinline__ unsigned pk2(float lo, float hi) { const bf16x2v_t r = __builtin_convertvector((f32x2v_t){lo, hi}, bf16x2v_t); return __builtin_bit_cast(unsigned, r); }
__device__ __forceinline__ unsigned f2bf(float f) { return pk2(f, 0.f) & 0xffffu; }
__device__ __forceinline__ float bf2f(unsigned short b) { return __builtin_bit_cast(float, ((unsigned)b) << 16); }
__device__ __forceinline__ float bflo(unsigned w) { return __builtin_bit_cast(float, w << 16); }
__device__ __forceinline__ float bfhi(unsigned w) { return __builtin_bit_cast(float, w & 0xffff0000u); }
#define DPP_F(v, ctrl) __builtin_bit_cast(float, __builtin_amdgcn_update_dpp(0, __builtin_bit_cast(int, (v)), (ctrl), 0xF, 0xF, false))
__device__ __forceinline__ float rdlane_f(float v, int l) { return __builtin_bit_cast(float, __builtin_amdgcn_readlane(__builtin_bit_cast(int, v), l)); }
__device__ __forceinline__ float wave_sum(float v) {
    v += DPP_F(v, 0xB1); v += DPP_F(v, 0x4E); v += DPP_F(v, 0x141); v += DPP_F(v, 0x140);
    return (rdlane_f(v, 0) + rdlane_f(v, 16)) + (rdlane_f(v, 32) + rdlane_f(v, 48));
}
__device__ __forceinline__ float wave_max(float v) {
    v = fmaxf(v, DPP_F(v, 0xB1)); v = fmaxf(v, DPP_F(v, 0x4E)); v = fmaxf(v, DPP_F(v, 0x141)); v = fmaxf(v, DPP_F(v, 0x140));
    return fmaxf(fmaxf(rdlane_f(v, 0), rdlane_f(v, 16)), fmaxf(rdlane_f(v, 32), rdlane_f(v, 48)));
}
__device__ __forceinline__ int bperm_i(int src, int v) { return __builtin_amdgcn_ds_bpermute(src << 2, v); }
__device__ __forceinline__ float bperm_f(int src, float v) { return __builtin_bit_cast(float, __builtin_amdgcn_ds_bpermute(src << 2, __builtin_bit_cast(int, v))); }
typedef unsigned long long u64;
__device__ __forceinline__ int lane_id_fresh() { int l; asm volatile("v_mbcnt_lo_u32_b32 %0, -1, 0\n\tv_mbcnt_hi_u32_b32 %0, -1, %0" : "=v"(l)); return l; }
__device__ __forceinline__ void ssq_add(u64* p, float s) { atomicAdd(p, (u64)(s * 16777216.f)); }
__device__ __forceinline__ float ssq_get(const u64* p) { return (float)(*p) * (1.f / 16777216.f); }
__device__ __forceinline__ float rcpf_(float x) { return __builtin_amdgcn_rcpf(x); }
__device__ __forceinline__ float sigmoidf_(float x) { return rcpf_(1.f + __expf(-x)); }

namespace pg8 {
constexpr int BM = 256, BK = 64, HALF = 128, HTB = HALF * BK * 2, STAGE_BYTES = 8 * HTB, NXCD = 8, WGM = 8;
__host__ __device__ __forceinline__ int lds_byte(int r, int c) { const int st = (r >> 4) * 2 + (c >> 5), rr = r & 15, cc = c & 31, ob = rr * 64 + cc * 2; return st * 1024 + (ob ^ (((ob >> 9) & 1) << 5)); }
__host__ __device__ __forceinline__ void stage_rc(int b, int& R, int& C) { const int st = b / 1024, sb = b % 1024, swz = sb ^ (((sb >> 9) & 1) << 5); R = (st >> 1) * 16 + swz / 64; C = (st & 1) * 32 + (swz % 64) / 2; }
__host__ __device__ __forceinline__ int perm32(int rho) { const int n = rho >> 4, i = rho & 15; return 8 * (i >> 2) + 4 * n + (i & 3); }
struct Unit { int pm, pn; };
struct Gemm { const bf16_t* A; const bf16_t* Bt; int M, N, K, lda, ldb; };
struct StaticOrder {
    int nM, nN, nwg, G, c;
    __host__ __device__ void init(int M, int N, int G_, int c_) { nM = M / BM; nN = N / BM; nwg = nM * nN; G = G_; c = c_; }
    __host__ __device__ bool next(int i, Unit& u) const {
        const long L = (long)i * G + c; if (L >= nwg) return false;
        int wgid = (int)L; { const int q = nwg / NXCD, r = nwg % NXCD, xcd = wgid % NXCD, off = wgid / NXCD; wgid = (xcd < r ? xcd * (q + 1) : r * (q + 1) + (xcd - r) * q) + off; }
        const int nig = WGM * nN, gid = wgid / nig, fm = gid * WGM, gsz = (nM - fm) < WGM ? (nM - fm) : WGM;
        u.pm = fm + ((wgid % nig) % gsz); u.pn = (wgid % nig) / gsz; return true;
    }
    __device__ __forceinline__ void a_ready(const Unit&) const {}
    __device__ __forceinline__ void done(const Unit&) const {}
};
template <class Epi, class Sched, bool ALIGN_EPI = false, bool SP2 = false>
__device__ __forceinline__ void gemm_phase(LAS unsigned char* lds, const Gemm g, const Sched& S, const Epi& E, int wave_s) {
    const int tid = wave_s * 64 + lane_id_fresh(), wid = wave_s, lane = tid & 63, wr = wid >> 2, wc = wid & 3, fr = lane & 15, fq = lane >> 4;
    const int K = g.K, nt = K / BK;
    unsigned voffA[2], voffB[2];
#pragma unroll
    for (int i = 0; i < 2; ++i) { int R, C; stage_rc(tid * 16 + i * 8192, R, C); const int Rb = Epi::PERM ? ((R & ~31) + perm32(R & 31)) : R;
        voffA[i] = (unsigned)(R * g.lda + C) * 2u; voffB[i] = (unsigned)(Rb * g.ldb + C) * 2u; }
    const size_t kstep = (size_t)(BK * 2);
    const size_t hstepA = (size_t)HALF * g.lda * 2, hstepB = (size_t)HALF * g.ldb * 2;
    const size_t tstepA = 2 * hstepA, tstepB = 2 * hstepB;
    const unsigned ldsw = (unsigned)wid * 1024u;
    const int aoff = lds_byte(wr * 64 + fr, fq * 8), boff = lds_byte(wc * 32 + fr, fq * 8);
#define PG8_SA(b, h) (((b) * 2 + (h)) * HTB)
#define PG8_SB(b, h) ((4 + (b) * 2 + (h)) * HTB)
#define PG8_STAGE(bufoff, gbase, voff) do { _Pragma("unroll") for (int _i = 0; _i < 2; ++_i) \
        __builtin_amdgcn_global_load_lds((const unsigned*)((const char*)(gbase) + (voff)[_i]), (LAS unsigned*)(lds + (bufoff) + ldsw + _i * 8192), 16, 0, 0); } while (0)
#define PG8_LDA(dst, b, h) do { _Pragma("unroll") for (int m = 0; m < 4; ++m) _Pragma("unroll") for (int k = 0; k < 2; ++k) dst[m][k] = *(const LAS bf16x8*)(lds + PG8_SA(b, h) + aoff + m * 2048 + k * 1024); } while (0)
#define PG8_LDB(dst, b, h) do { _Pragma("unroll") for (int n = 0; n < 2; ++n) _Pragma("unroll") for (int k = 0; k < 2; ++k) dst[n][k] = *(const LAS bf16x8*)(lds + PG8_SB(b, h) + boff + n * 2048 + k * 1024); } while (0)
#define PG8_MMA(ai, bj, At, Bt) do { __builtin_amdgcn_s_setprio(1); _Pragma("unroll") for (int m = 0; m < 4; ++m) _Pragma("unroll") for (int n = 0; n < 2; ++n) _Pragma("unroll") for (int k = 0; k < 2; ++k) \
        acc[ai][bj][m][n] = __builtin_amdgcn_mfma_f32_16x16x32_bf16(Bt[n][k], At[m][k], acc[ai][bj][m][n], 0, 0, 0); __builtin_amdgcn_s_setprio(0); } while (0)
#define PG8_WAIT_V(n) asm volatile("s_waitcnt vmcnt(" #n ")" ::: "memory")
#define PG8_WAIT_L(n) asm volatile("s_waitcnt lgkmcnt(" #n ")" ::: "memory")
#define PG8_BAR __builtin_amdgcn_s_barrier()
#define PG8_SCHED __builtin_amdgcn_sched_barrier(0)
    Unit cur, nxt; int ui = 0;
    if (!S.next(0, cur)) return;
    f32x4 acc[2][2][4][2];
#pragma unroll
    for (int a = 0; a < 2; ++a)
#pragma unroll
        for (int b = 0; b < 2; ++b)
#pragma unroll
            for (int m = 0; m < 4; ++m)
#pragma unroll
                for (int n = 0; n < 2; ++n) acc[a][b][m][n] = (f32x4){0.f, 0.f, 0.f, 0.f};
    bf16x8 At[4][2], B0[2][2], B1[2][2];
    const char* cA = (const char*)g.A + (size_t)cur.pm * tstepA; const char* cB = (const char*)g.Bt + (size_t)cur.pn * tstepB;
    S.a_ready(cur);
    if constexpr (SP2) {
        PG8_STAGE(PG8_SB(0, 0), cB, voffB); PG8_STAGE(PG8_SB(0, 1), cB + hstepB, voffB); PG8_STAGE(PG8_SA(0, 0), cA, voffA); PG8_STAGE(PG8_SA(0, 1), cA + hstepA, voffA);
        if (wr == 1) PG8_BAR;
        PG8_WAIT_V(2); PG8_BAR;
        PG8_STAGE(PG8_SB(1, 0), cB + kstep, voffB); PG8_STAGE(PG8_SA(1, 0), cA + kstep, voffA); PG8_STAGE(PG8_SB(1, 1), cB + hstepB + kstep, voffB);
        PG8_WAIT_V(6); PG8_BAR;
    } else {
        PG8_STAGE(PG8_SB(0, 0), cB, voffB); PG8_STAGE(PG8_SA(0, 0), cA, voffA); PG8_STAGE(PG8_SB(0, 1), cB + hstepB, voffB); PG8_STAGE(PG8_SA(0, 1), cA + hstepA, voffA);
        if (wr == 1) PG8_BAR;
        PG8_WAIT_V(4); PG8_BAR;
        PG8_STAGE(PG8_SB(1, 0), cB + kstep, voffB); PG8_STAGE(PG8_SA(1, 0), cA + kstep, voffA); PG8_STAGE(PG8_SB(1, 1), cB + hstepB + kstep, voffB);
        PG8_WAIT_V(6); PG8_BAR;
    }
    for (;;) {
        const bool has_next = S.next(ui + 1, nxt);
        const char* nA = has_next ? (const char*)g.A + (size_t)nxt.pm * tstepA : cA; const char* nB = has_next ? (const char*)g.Bt + (size_t)nxt.pn * tstepB : cB;
        for (int t = 0; t < nt; t += 2) {
            const bool last = (t == nt - 2);
            const char* a1 = cA + (size_t)(t + 1) * kstep;
            const char* a2 = last ? nA : cA + (size_t)(t + 2) * kstep; const char* b2 = last ? nB : cB + (size_t)(t + 2) * kstep;
            const char* a3 = a2 + kstep; const char* b3 = b2 + kstep;
            if (last && has_next) S.a_ready(nxt);
            if constexpr (SP2) {
            PG8_LDB(B0, 0, 0); PG8_LDB(B1, 0, 1); PG8_SCHED; PG8_LDA(At, 0, 0); PG8_STAGE(PG8_SA(1, 1), a1 + hstepA, voffA);
            PG8_WAIT_V(8); PG8_WAIT_L(0); PG8_BAR; PG8_MMA(0, 0, At, B0); PG8_MMA(0, 1, At, B1); PG8_BAR; PG8_SCHED;
            PG8_LDA(At, 0, 1); PG8_STAGE(PG8_SB(0, 0), b2, voffB); PG8_STAGE(PG8_SB(0, 1), b2 + hstepB, voffB); PG8_STAGE(PG8_SA(0, 0), a2, voffA);
            PG8_WAIT_V(8); PG8_WAIT_L(0); PG8_BAR; PG8_MMA(1, 0, At, B0); PG8_MMA(1, 1, At, B1); PG8_BAR; PG8_SCHED;
            PG8_LDB(B0, 1, 0); PG8_LDB(B1, 1, 1); PG8_SCHED; PG8_LDA(At, 1, 0); PG8_STAGE(PG8_SA(0, 1), a2 + hstepA, voffA);
            PG8_WAIT_V(8); PG8_WAIT_L(0); PG8_BAR; PG8_MMA(0, 0, At, B0); PG8_MMA(0, 1, At, B1); PG8_BAR; PG8_SCHED;
            PG8_LDA(At, 1, 1); PG8_STAGE(PG8_SB(1, 0), b3, voffB); PG8_STAGE(PG8_SB(1, 1), b3 + hstepB, voffB); PG8_STAGE(PG8_SA(1, 0), a3, voffA);
            PG8_WAIT_V(8); PG8_WAIT_L(0); PG8_BAR; PG8_MMA(1, 0, At, B0); PG8_MMA(1, 1, At, B1); PG8_BAR; PG8_SCHED;
            } else {
            PG8_LDB(B0, 0, 0); PG8_SCHED; PG8_LDA(At, 0, 0); PG8_STAGE(PG8_SA(1, 1), a1 + hstepA, voffA);
            PG8_WAIT_L(8); PG8_BAR; PG8_WAIT_L(0); PG8_MMA(0, 0, At, B0); PG8_BAR; PG8_SCHED;
            PG8_LDB(B1, 0, 1); PG8_STAGE(PG8_SB(0, 0), b2, voffB);
            PG8_BAR; PG8_WAIT_L(0); PG8_MMA(0, 1, At, B1); PG8_BAR;
            PG8_LDA(At, 0, 1); PG8_STAGE(PG8_SA(0, 0), a2, voffA);
            PG8_BAR; PG8_WAIT_L(0); PG8_MMA(1, 0, At, B0); PG8_BAR; PG8_SCHED;
            PG8_STAGE(PG8_SB(0, 1), b2 + hstepB, voffB);
            PG8_WAIT_V(6); PG8_BAR; PG8_MMA(1, 1, At, B1); PG8_BAR;
            PG8_LDB(B0, 1, 0); PG8_SCHED; PG8_LDA(At, 1, 0); PG8_STAGE(PG8_SA(0, 1), a2 + hstepA, voffA);
            PG8_WAIT_L(8); PG8_BAR; PG8_WAIT_L(0); PG8_MMA(0, 0, At, B0); PG8_BAR; PG8_SCHED;
            PG8_LDB(B1, 1, 1); PG8_STAGE(PG8_SB(1, 0), b3, voffB);
            PG8_BAR; PG8_WAIT_L(0); PG8_MMA(0, 1, At, B1); PG8_BAR;
            PG8_LDA(At, 1, 1); PG8_STAGE(PG8_SA(1, 0), a3, voffA);
            PG8_BAR; PG8_WAIT_L(0); PG8_MMA(1, 0, At, B0); PG8_BAR; PG8_SCHED;
            PG8_STAGE(PG8_SB(1, 1), b3 + hstepB, voffB);
            PG8_WAIT_V(6); PG8_BAR; PG8_MMA(1, 1, At, B1); PG8_BAR;
            }
        }
        if constexpr (ALIGN_EPI) { if (wr == 0) PG8_BAR; }
        if constexpr (!Epi::AFTER_DRAIN) { E(acc, cur, wr, wc, fr, fq); S.done(cur); }
        if (!has_next) break;
#pragma unroll
        for (int a = 0; a < 2; ++a)
#pragma unroll
            for (int b = 0; b < 2; ++b)
#pragma unroll
                for (int m = 0; m < 4; ++m)
#pragma unroll
                    for (int n = 0; n < 2; ++n) acc[a][b][m][n] = (f32x4){0.f, 0.f, 0.f, 0.f};
        cur = nxt; cA = nA; cB = nB; ++ui;
        if constexpr (ALIGN_EPI) { if (wr == 1) PG8_BAR; }
    }
    PG8_WAIT_V(0);
    if constexpr (!ALIGN_EPI) { if (wr == 0) PG8_BAR; }
    PG8_BAR;
    if constexpr (Epi::AFTER_DRAIN) { E.fused(acc, cur, wr, wc, fr, fq, lds, wid, lane); S.done(cur); }
#undef PG8_SA
#undef PG8_SB
#undef PG8_STAGE
#undef PG8_LDA
#undef PG8_LDB
#undef PG8_MMA
#undef PG8_WAIT_V
#undef PG8_WAIT_L
#undef PG8_BAR
#undef PG8_SCHED
}
}

#define EPI_ROWS(ai, m) (u.pm * 256 + (ai) * 128 + wr * 64 + (m) * 16 + fr)
#define EPI_COL0 (u.pn * 256 + wc * 32 + 8 * fq)
typedef const f32x4 (&AccT)[2][2][4][2];

__device__ __forceinline__ float fq_sum(float v, int lane) { v += bperm_f(lane ^ 16, v); v += bperm_f(lane ^ 32, v); return v; }

struct EpiZ {
    static constexpr bool PERM = true, AFTER_DRAIN = false;
    bf16_t* Z; const u64* ssq; u64* mqs; u64* mkvs;
    __device__ __forceinline__ void operator()(AccT acc, const pg8::Unit& u, int wr, int wc, int fr, int fq) const {
        const int col0 = EPI_COL0;
#pragma unroll
        for (int ai = 0; ai < 2; ++ai)
#pragma unroll
            for (int m = 0; m < 4; ++m) {
                const int row = EPI_ROWS(ai, m); const float rs = rsqrtf(ssq_get(ssq + row) * (1.f / D) + EPS);
                float sq = 0.f, skv = 0.f;
#pragma unroll
                for (int bj = 0; bj < 2; ++bj) {
                    const f32x4 v0 = acc[ai][bj][m][0] * rs, v1 = acc[ai][bj][m][1] * rs;
                    u32x4 w; w.x = pk2(v0[0], v0[1]); w.y = pk2(v0[2], v0[3]); w.z = pk2(v1[0], v1[1]); w.w = pk2(v1[2], v1[3]);
                    *(u32x4*)(Z + (size_t)row * NZ + col0 + bj * 128) = w;
                    const float s2 = v0[0] * v0[0] + v0[1] * v0[1] + v0[2] * v0[2] + v0[3] * v0[3] + v1[0] * v1[0] + v1[1] * v1[1] + v1[2] * v1[2] + v1[3] * v1[3];
                    const int cb = u.pn * 256 + bj * 128;
                    if (cb >= ZC_MCQ && cb < ZC_MCKV) sq += s2;
                    if (cb >= ZC_MCKV && cb < ZC_MKR) skv += s2;
                }
                if (u.pn >= 14 && u.pn <= 16) {
                    sq = fq_sum(sq, fr + 16 * fq); skv = fq_sum(skv, fr + 16 * fq);
                    if (fq == 0) { if (u.pn <= 15) ssq_add(mqs + row, sq); if (u.pn >= 15) ssq_add(mkvs + row, skv); }
                }
            }
    }
};
struct EpiBf16s {
    static constexpr bool PERM = true, AFTER_DRAIN = false;
    bf16_t* O; int ldo; const u64* ssq; float inv_n;
    __device__ __forceinline__ void operator()(AccT acc, const pg8::Unit& u, int wr, int wc, int fr, int fq) const {
        const int col0 = EPI_COL0;
#pragma unroll
        for (int ai = 0; ai < 2; ++ai)
#pragma unroll
            for (int m = 0; m < 4; ++m) {
                const int row = EPI_ROWS(ai, m); const float rs = ssq ? rsqrtf(ssq_get(ssq + row) * inv_n + EPS) : 1.f;
#pragma unroll
                for (int bj = 0; bj < 2; ++bj) {
                    const f32x4 v0 = acc[ai][bj][m][0] * rs, v1 = acc[ai][bj][m][1] * rs;
                    u32x4 w; w.x = pk2(v0[0], v0[1]); w.y = pk2(v0[2], v0[3]); w.z = pk2(v1[0], v1[1]); w.w = pk2(v1[2], v1[3]);
                    *(u32x4*)(O + (size_t)row * ldo + col0 + bj * 128) = w;
                }
            }
    }
};
struct EpiRes {
    static constexpr bool PERM = true, AFTER_DRAIN = false;
    bf16_t* HB; u64* ssq;
    __device__ __forceinline__ void operator()(AccT acc, const pg8::Unit& u, int wr, int wc, int fr, int fq) const {
        const int col0 = EPI_COL0;
#pragma unroll
        for (int ai = 0; ai < 2; ++ai)
#pragma unroll
            for (int m = 0; m < 4; ++m) {
                const int row = EPI_ROWS(ai, m); float s2 = 0.f;
#pragma unroll
                for (int bj = 0; bj < 2; ++bj) {
                    bf16_t* hp = HB + (size_t)row * D + col0 + bj * 128;
                    const u32x4 hw = *(const u32x4*)hp;
                    const f32x4 v0 = (f32x4){bflo(hw[0]), bfhi(hw[0]), bflo(hw[1]), bfhi(hw[1])} + acc[ai][bj][m][0], v1 = (f32x4){bflo(hw[2]), bfhi(hw[2]), bflo(hw[3]), bfhi(hw[3])} + acc[ai][bj][m][1];
                    u32x4 w; w.x = pk2(v0[0], v0[1]); w.y = pk2(v0[2], v0[3]); w.z = pk2(v1[0], v1[1]); w.w = pk2(v1[2], v1[3]);
                    *(u32x4*)hp = w;
                    s2 += v0[0] * v0[0] + v0[1] * v0[1] + v0[2] * v0[2] + v0[3] * v0[3] + v1[0] * v1[0] + v1[1] * v1[1] + v1[2] * v1[2] + v1[3] * v1[3];
                }
                s2 = fq_sum(s2, fr + 16 * fq);
                if (fq == 0) ssq_add(ssq + row, s2);
            }
    }
};
struct EpiF32s {
    static constexpr bool PERM = true, AFTER_DRAIN = false;
    float* C; const u64* ssq;
    __device__ __forceinline__ void operator()(AccT acc, const pg8::Unit& u, int wr, int wc, int fr, int fq) const {
        const int col0 = EPI_COL0;
#pragma unroll
        for (int ai = 0; ai < 2; ++ai)
#pragma unroll
            for (int m = 0; m < 4; ++m) {
                const int row = EPI_ROWS(ai, m); const float rs = ssq ? rsqrtf(ssq_get(ssq + row) * (1.f / D) + EPS) : 1.f;
#pragma unroll
                for (int bj = 0; bj < 2; ++bj) {
                    float* cp = C + (size_t)row * D + col0 + bj * 128;
                    *(f32x4*)cp = acc[ai][bj][m][0] * rs; *(f32x4*)(cp + 4) = acc[ai][bj][m][1] * rs;
                }
            }
    }
};
struct EpiPle {
    static constexpr bool PERM = true, AFTER_DRAIN = false;
    const bf16_t* HBin; bf16_t* HBout; const bf16_t* PR; const float* ssq_in; u64* ssq_out;
    __device__ __forceinline__ void operator()(AccT acc, const pg8::Unit& u, int wr, int wc, int fr, int fq) const {
        const int col0 = EPI_COL0;
#pragma unroll
        for (int ai = 0; ai < 2; ++ai)
#pragma unroll
            for (int m = 0; m < 4; ++m) {
                const int row = EPI_ROWS(ai, m); const float rs = rsqrtf(ssq_in[row] * (1.f / D) + EPS); float s2 = 0.f;
#pragma unroll
                for (int bj = 0; bj < 2; ++bj) {
                    const size_t o = (size_t)row * D + col0 + bj * 128;
                    const u32x4 hw = *(const u32x4*)(HBin + o), pw = *(const u32x4*)(PR + o);
                    f32x4 v0 = (f32x4){bflo(hw[0]), bfhi(hw[0]), bflo(hw[1]), bfhi(hw[1])}, v1 = (f32x4){bflo(hw[2]), bfhi(hw[2]), bflo(hw[3]), bfhi(hw[3])};
                    const f32x4 p0 = (f32x4){bflo(pw[0]), bfhi(pw[0]), bflo(pw[1]), bfhi(pw[1])}, p1 = (f32x4){bflo(pw[2]), bfhi(pw[2]), bflo(pw[3]), bfhi(pw[3])};
#pragma unroll
                    for (int j = 0; j < 4; ++j) { v0[j] += sigmoidf_(acc[ai][bj][m][0][j] * rs) * p0[j]; v1[j] += sigmoidf_(acc[ai][bj][m][1][j] * rs) * p1[j]; }
                    u32x4 w; w.x = pk2(v0[0], v0[1]); w.y = pk2(v0[2], v0[3]); w.z = pk2(v1[0], v1[1]); w.w = pk2(v1[2], v1[3]);
                    *(u32x4*)(HBout + o) = w;
                    s2 += v0[0] * v0[0] + v0[1] * v0[1] + v0[2] * v0[2] + v0[3] * v0[3] + v1[0] * v1[0] + v1[1] * v1[1] + v1[2] * v1[2] + v1[3] * v1[3];
                }
                s2 = fq_sum(s2, fr + 16 * fq);
                if (fq == 0) ssq_add(ssq_out + row, s2);
            }
    }
};

__device__ __forceinline__ int f2ord(float f) { const int b = __builtin_bit_cast(int, f); return b >= 0 ? b : (b ^ 0x7FFFFFFF); }
__device__ __forceinline__ float ord2f(int k) { const int b = k >= 0 ? k : (k ^ 0x7FFFFFFF); return __builtin_bit_cast(float, b); }
__device__ __forceinline__ int row16_max(int v) {
    v = max(v, __builtin_amdgcn_update_dpp(v, v, 0xB1, 0xF, 0xF, false)); v = max(v, __builtin_amdgcn_update_dpp(v, v, 0x4E, 0xF, 0xF, false));
    v = max(v, __builtin_amdgcn_update_dpp(v, v, 0x141, 0xF, 0xF, false)); v = max(v, __builtin_amdgcn_update_dpp(v, v, 0x140, 0xF, 0xF, false));
    return v;
}
__device__ __forceinline__ float row16_sum(float v) {
    v += __builtin_bit_cast(float, __builtin_amdgcn_update_dpp(0, __builtin_bit_cast(int, v), 0xB1, 0xF, 0xF, false)); v += __builtin_bit_cast(float, __builtin_amdgcn_update_dpp(0, __builtin_bit_cast(int, v), 0x4E, 0xF, 0xF, false));
    v += __builtin_bit_cast(float, __builtin_amdgcn_update_dpp(0, __builtin_bit_cast(int, v), 0x141, 0xF, 0xF, false)); v += __builtin_bit_cast(float, __builtin_amdgcn_update_dpp(0, __builtin_bit_cast(int, v), 0x140, 0xF, 0xF, false));
    return v;
}
__device__ __forceinline__ void peer_topk_mfma(LAS unsigned char* lds, int wid, const bf16_t* QB, const bf16_t* SKB, int* PIDX, float* PG, int pm, int pn) {
    constexpr int SQL = 272, L_SK = 0;
    const int lane = lane_id_fresh(), tid = wid * 64 + lane, l15 = lane & 15, g = lane >> 4;
    int tk[2][2][4];
#pragma unroll
    for (int c = 0; c < 2; ++c) {
        const bf16_t* sk = SKB + ((size_t)(pn * 2 + c) * 128) * 128;
#pragma unroll
        for (int i = 0; i < 4; ++i) { const int id = tid + 512 * i, n = id >> 4, dc = id & 15; *(LAS u32x4*)(lds + L_SK + n * SQL + dc * 16) = *(const u32x4*)(sk + n * 128 + dc * 8); }
        bf16x8 af[2][4];
#pragma unroll
        for (int rt = 0; rt < 2; ++rt)
#pragma unroll
            for (int ks = 0; ks < 4; ++ks) af[rt][ks] = *(const bf16x8*)(QB + (size_t)(pm * 256 + 32 * wid + 16 * rt + l15) * D + pn * 256 + c * 128 + 32 * ks + 8 * g);
        __syncthreads();
        int key[2][8][4];
#pragma unroll
        for (int nt = 0; nt < 8; ++nt) {
            f32x4 sc0 = (f32x4){0.f, 0.f, 0.f, 0.f}, sc1 = (f32x4){0.f, 0.f, 0.f, 0.f};
#pragma unroll
            for (int ks = 0; ks < 4; ++ks) {
                const bf16x8 bfr = *(const LAS bf16x8*)(lds + L_SK + (16 * nt + l15) * SQL + (32 * ks + 8 * g) * 2);
                sc0 = __builtin_amdgcn_mfma_f32_16x16x32_bf16(af[0][ks], bfr, sc0, 0, 0, 0);
                sc1 = __builtin_amdgcn_mfma_f32_16x16x32_bf16(af[1][ks], bfr, sc1, 0, 0, 0);
            }
#pragma unroll
            for (int r = 0; r < 4; ++r) { key[0][nt][r] = (f2ord(sc0[r]) & ~127) | (127 - (16 * nt + l15)); key[1][nt][r] = (f2ord(sc1[r]) & ~127) | (127 - (16 * nt + l15)); }
        }
        __syncthreads();
#pragma unroll
        for (int rt = 0; rt < 2; ++rt)
#pragma unroll
            for (int r = 0; r < 4; ++r) {
#define SK_(i) key[rt][i][r]
#define CE_(i, j) do { const int hi_ = max(SK_(i), SK_(j)), lo_ = min(SK_(i), SK_(j)); SK_(i) = hi_; SK_(j) = lo_; } while (0)
                CE_(0, 1); CE_(2, 3); CE_(4, 5); CE_(6, 7); CE_(0, 2); CE_(1, 3); CE_(4, 6); CE_(5, 7); CE_(1, 2); CE_(5, 6);
                CE_(0, 4); CE_(1, 5); CE_(2, 6); CE_(3, 7); CE_(2, 4); CE_(3, 5); CE_(1, 2); CE_(3, 4); CE_(5, 6);
                int mine = 0;
#pragma unroll 1
                for (int k = 0; k < 16; ++k) {
                    const int v = row16_max(SK_(0));
                    if (l15 == k) mine = v;
                    const bool won = (SK_(0) == v);
#pragma unroll
                    for (int nt = 0; nt < 7; ++nt) SK_(nt) = won ? SK_(nt + 1) : SK_(nt);
                    SK_(7) = won ? (int)0x80000000 : SK_(7);
                }
#undef CE_
#undef SK_
                tk[c][rt][r] = mine;
            }
    }
    int ci_[4], cj_[4]; bool cv_[4];
    ci_[0] = 0; cj_[0] = l15; cv_[0] = true;
    ci_[1] = l15 < 8 ? 1 : (l15 < 13 ? 2 : 3); cj_[1] = l15 < 8 ? l15 : (l15 < 13 ? l15 - 8 : l15 - 13); cv_[1] = true;
    ci_[2] = l15 == 0 ? 3 : (l15 < 4 ? 4 : (l15 < 6 ? 5 : (l15 < 8 ? 6 : (l15 < 10 ? 7 : l15 - 2))));
    cj_[2] = l15 == 0 ? 3 : (l15 < 4 ? l15 - 1 : (l15 < 6 ? l15 - 4 : (l15 < 8 ? l15 - 6 : (l15 < 10 ? l15 - 8 : 0)))); cv_[2] = true;
    ci_[3] = 14 + (l15 & 1); cj_[3] = 0; cv_[3] = l15 < 2;
#pragma unroll
    for (int rt = 0; rt < 2; ++rt)
#pragma unroll
        for (int r = 0; r < 4; ++r) {
            int ck[4];
#pragma unroll
            for (int q = 0; q < 4; ++q) {
                const float s0 = ord2f(bperm_i((lane & 48) + ci_[q], tk[0][rt][r]) & ~127), s1 = ord2f(bperm_i((lane & 48) + cj_[q], tk[1][rt][r]) & ~127);
                ck[q] = cv_[q] ? ((f2ord(s0 + s1) & ~255) | (255 - (16 * ci_[q] + cj_[q]))) : (int)0x80000000;
            }
            int mine = 0;
            for (int k = 0; k < 16; ++k) {
                int v = max(max(ck[0], ck[1]), max(ck[2], ck[3]));
                v = row16_max(v);
                if (l15 == k) mine = v;
#pragma unroll
                for (int q = 0; q < 4; ++q) ck[q] = (ck[q] == v) ? (int)0x80000000 : ck[q];
            }
            const int pos = 255 - (mine & 255), ci = pos >> 4, cj = pos & 15;
            const int i0 = 127 - (bperm_i((lane & 48) + ci, tk[0][rt][r]) & 127), i1 = 127 - (bperm_i((lane & 48) + cj, tk[1][rt][r]) & 127);
            const float bv = ord2f(mine & ~255), b0 = ord2f(bperm_i(lane & 48, mine) & ~255);
            const float ex = __expf(bv - b0), sum = row16_sum(ex);
            const size_t o = (size_t)(pm * 256 + 32 * wid + 16 * rt + 4 * g + r) * 128 + pn * 16 + l15;
            PIDX[o] = i0 * 128 + i1; PG[o] = ex * rcpf_(sum);
        }
}

#define XB_TMO      128
#define XB_XCNT(j)  (256  + 64 * (j))
#define XB_XSUB(j)  (1280 + 64 * (j))
#define XB_XGEN(j)  (2304 + 64 * (j))
#define XB_TOP      3328
#define XB_TOPGEN   3392
#define XCD_BAR_WORDS 3456
#define XB_SPIN_CAP (1u << 18)
__device__ __forceinline__ unsigned xb_ld(unsigned* p)              { return __hip_atomic_load(p, __ATOMIC_RELAXED, __HIP_MEMORY_SCOPE_AGENT); }
__device__ __forceinline__ unsigned xb_add(unsigned* p, unsigned v) { return __hip_atomic_fetch_add(p, v, __ATOMIC_RELAXED, __HIP_MEMORY_SCOPE_AGENT); }
__device__ __forceinline__ unsigned xb_xcc_id() { return (unsigned)__builtin_amdgcn_s_getreg((3 << 11) | 20) & 0xFu; }
#define XB_SPIN(cond, bar) do { unsigned _sp = 0; while (cond) { __builtin_amdgcn_s_sleep(1); \
    if ((++_sp & 255u) == 0u) { if (xb_ld(&(bar)[XB_TMO])) break; if (_sp > XB_SPIN_CAP) { atomicAdd(&(bar)[XB_TMO], 1u); break; } } } } while (0)
struct XcdBarrier { unsigned* bar; unsigned x; volatile LAS unsigned* st; };
__device__ __forceinline__ XcdBarrier xcd_barrier_post(unsigned* bar, volatile LAS unsigned* st) {
    XcdBarrier b; b.bar = bar; b.x = xb_xcc_id(); b.st = st;
    if (threadIdx.x == 0) (void)xb_add(&bar[XB_XCNT(b.x)], 1u);
    return b;
}
__device__ __forceinline__ void xcd_barrier_complete(unsigned* bar, unsigned x, unsigned& nloc, unsigned& nx) {
    const unsigned G = gridDim.x * gridDim.y * gridDim.z;
    unsigned sum, cnt, mine, sp = 0u;
    for (;;) {
        sum = 0u; cnt = 0u; mine = 0u;
#pragma unroll
        for (unsigned j = 0; j < 16; ++j) { const unsigned c = xb_ld(&bar[XB_XCNT(j)]); sum += c; cnt += (c > 0u) ? 1u : 0u; mine = (j == x) ? c : mine; }
        if (sum == G) break;
        __builtin_amdgcn_s_sleep(1);
        if ((++sp & 255u) == 0u) { if (xb_ld(&bar[XB_TMO])) break; if (sp > XB_SPIN_CAP) { atomicAdd(&bar[XB_TMO], 1u); break; } }
    }
    nloc = mine > 0u ? mine : 1u; nx = cnt > 0u ? cnt : 1u;
}
__device__ __forceinline__ void xcd_barrier(const XcdBarrier& b, int wave_s) {
    asm volatile("s_waitcnt vmcnt(0)" ::: "memory");
    __syncthreads();
    if (wave_s == 0 && lane_id_fresh() == 0) {
        unsigned* bar = b.bar;
        __builtin_amdgcn_s_waitcnt(0);
        unsigned nloc = b.st[0], nx = b.st[1];
        if (nloc == 0u) { xcd_barrier_complete(bar, b.x, nloc, nx); b.st[0] = nloc; b.st[1] = nx; }
        const unsigned old = xb_add(&bar[XB_XSUB(b.x)], 1u);
        const unsigned gen = old / nloc;
        if (old + 1u == (gen + 1u) * nloc) {
            __builtin_amdgcn_fence(__ATOMIC_RELEASE, "agent");
            asm volatile("s_waitcnt vmcnt(0)" ::: "memory");
            const unsigned og = xb_add(&bar[XB_TOP], 1u);
            const unsigned tg = og / nx;
            if (og + 1u == (tg + 1u) * nx) xb_add(&bar[XB_TOPGEN], 1u);
            else XB_SPIN(xb_ld(&bar[XB_TOPGEN]) == tg, bar);
            __builtin_amdgcn_fence(__ATOMIC_ACQUIRE, "agent");
            xb_add(&bar[XB_XGEN(b.x)], 1u);
            asm volatile("s_waitcnt vmcnt(0)" ::: "memory");
        } else {
            XB_SPIN(xb_ld(&bar[XB_XGEN(b.x)]) == gen, bar);
            __builtin_amdgcn_fence(__ATOMIC_ACQUIRE, "agent");
            asm volatile("s_waitcnt vmcnt(0)" ::: "memory");
        }
    }
    __syncthreads();
}

constexpr int RING_BYTES = 131072, MISC_OFF = RING_BYTES + 320, LDS_BYTES = 147456;
struct Args { const float* in[28]; float* out; unsigned char* ws; int ph_lo, ph_hi; };
enum { I_X = 0, I_P, I_POS, I_LN_MIX, I_W_IN, I_DIFF_LAMBDA, I_DIFF_NORM, I_HGRN_LB, I_HGRN_NORM, I_MLA_QN, I_MLA_KVN, I_MLA_WUQ, I_MLA_WUKV, I_CONV_W, I_CONV_B, I_GATE_B,
       I_MLSTM_NORM, I_GROUP_GAIN, I_W_OUT, I_LN_FFN, I_PEER_WQ, I_PEER_SUBKEYS, I_PEER_U, I_PEER_V, I_LN_PLE, I_PLE_WGATE, I_PLE_WPROJ, I_LN_FINAL };

struct Frame {
    LAS unsigned char* lds; unsigned char* ws; const Args* a;
    int tid, lane, wave, G, gw, ngw, bid;
};

__device__ __forceinline__ int cmap_win(int n) {
    if (n < ZC_MKR) return n;
    if (n < ZC_LQ) { const int j = n - ZC_MKR; return ZC_MKR + (j >> 1) + 32 * (j & 1); }
    if (n < ZC_LO) return n;
    if (n < ZC_LI) return 5320 + (n - ZC_LO);
    if (n < ZC_LF) return 5312 + (n - ZC_LI);
    if (n < IN_COLS) return 5316 + (n - ZC_LF);
    return -1;
}
__device__ __forceinline__ int cmap_uq(int n) { const int hd = n / 192, r = n % 192; if (r < 128) return n; const int j = r - 128; return hd * 192 + 128 + (j >> 1) + 32 * (j & 1); }

template <int MAP>
__device__ __forceinline__ void transpose_item(const float* W, int K, int Nsrc, int Ndst, const float* gain, bf16_t* WT, LAS float* scr_, int item, int lane) {
    LAS unsigned char* scr = (LAS unsigned char*)scr_;
    const int nblk = Ndst / 64, kb = item / nblk, nb = item % nblk, k0 = 64 * kb, n0 = 64 * nb;
    const int nq = (lane & 15) * 4, kr = lane >> 4;
    if (MAP == 0 || (MAP == 1 && (n0 + 64 <= ZC_MKR || (n0 >= ZC_LQ && n0 + 64 <= ZC_LO)))) {
        f32x4 tv[16]; float gk[16];
#pragma unroll
        for (int i = 0; i < 16; ++i) tv[i] = *(const f32x4*)(W + (size_t)(k0 + kr + 4 * i) * Nsrc + n0 + nq);
        if (gain) {
#pragma unroll
            for (int i = 0; i < 16; ++i) gk[i] = gain[k0 + kr + 4 * i];
        } else {
#pragma unroll
            for (int i = 0; i < 16; ++i) gk[i] = 1.f;
        }
#pragma unroll
        for (int i = 0; i < 16; ++i) { const int kk = kr + 4 * i; const f32x4 v = tv[i] * gk[i];
#pragma unroll
            for (int e = 0; e < 4; ++e) *(LAS bf16_t*)(scr + (nq + e) * 144 + kk * 2) = (bf16_t)f2bf(v[e]); }
    } else {
        int src[4];
#pragma unroll
        for (int e = 0; e < 4; ++e) src[e] = (MAP == 1) ? cmap_win(n0 + nq + e) : cmap_uq(n0 + nq + e);
        const int s0 = src[0] > 0 ? src[0] : 0, s1 = src[1] > 0 ? src[1] : 0, s2 = src[2] > 0 ? src[2] : 0, s3 = src[3] > 0 ? src[3] : 0;
        float ts[16][4], gk[16];
#pragma unroll
        for (int i = 0; i < 16; ++i) { const float* wr = W + (size_t)(k0 + kr + 4 * i) * Nsrc; ts[i][0] = wr[s0]; ts[i][1] = wr[s1]; ts[i][2] = wr[s2]; ts[i][3] = wr[s3]; }
        if (gain) {
#pragma unroll
            for (int i = 0; i < 16; ++i) gk[i] = gain[k0 + kr + 4 * i];
        } else {
#pragma unroll
            for (int i = 0; i < 16; ++i) gk[i] = 1.f;
        }
#pragma unroll
        for (int i = 0; i < 16; ++i) { const int kk = kr + 4 * i;
#pragma unroll
            for (int e = 0; e < 4; ++e) { const float v = (src[e] >= 0) ? ts[i][e] * gk[i] : 0.f; *(LAS bf16_t*)(scr + (nq + e) * 144 + kk * 2) = (bf16_t)f2bf(v); } }
    }
    asm volatile("s_waitcnt lgkmcnt(0)" ::: "memory");
#pragma unroll
    for (int j = 0; j < 8; ++j) { const int n = (lane >> 3) + 8 * j, c = lane & 7; *(u32x4*)(WT + (size_t)(n0 + n) * K + k0 + 8 * c) = *(const LAS u32x4*)(scr + n * 144 + c * 16); }
    asm volatile("s_waitcnt lgkmcnt(0)" ::: "memory");
}

constexpr int CV_TAB = 4096, CV_WIN = CV_TAB + 736, CV_WOUT = CV_WIN + 256, CV_WQ = CV_WOUT + 256, CV_WG = CV_WQ + 256, CV_WP = CV_WG + 32, CV_UQ = CV_WP + 18, CV_UKV = CV_UQ + 16,
              CV_P = CV_UKV + 128, NCONV = CV_P + 16;
__device__ __forceinline__ bool conv_early(int item) { return (item >= CV_TAB && item < CV_WIN) || (item >= CV_WP && item < CV_UKV); }
__device__ __forceinline__ void convert_item(Frame& F, int l, int item, int lane) {
    const Args& a = *F.a; unsigned char* ws = F.ws;
    LAS float* scr = (LAS float*)(F.lds + F.wave * 16384);
    if (item < CV_TAB) {
        const int tab = item >> 11, r0 = l * NEXP + (item & 2047) * 8;
        const float* SRC = a.in[tab ? I_PEER_V : I_PEER_U]; unsigned char* DST = ws + (tab ? WS_VB : WS_UB); float* SC = (float*)(ws + (tab ? WS_SV : WS_SU));
        const float* gF = a.in[I_LN_FFN] + l * D;
        f32x4 gv[8];
#pragma unroll
        for (int q = 0; q < 8; ++q) { gv[q] = (f32x4){1.f, 1.f, 1.f, 1.f}; if (tab == 0) gv[q] = *(const f32x4*)(gF + q * 256 + lane * 4); }
        float mysc = 1.f;
        f32x4 nx[2][8];
#pragma unroll
        for (int k = 0; k < 2; ++k)
#pragma unroll
            for (int q = 0; q < 8; ++q) nx[k][q] = *(const f32x4*)(SRC + (size_t)(r0 + k) * D + q * 256 + lane * 4);
#pragma unroll
        for (int rr = 0; rr < 8; ++rr) {
            const int row = r0 + rr; f32x4 v[8]; float am = 0.f;
#pragma unroll
            for (int q = 0; q < 8; ++q) v[q] = nx[rr & 1][q];
            if (rr + 2 < 8) {
#pragma unroll
                for (int q = 0; q < 8; ++q) nx[rr & 1][q] = *(const f32x4*)(SRC + (size_t)(row + 2) * D + q * 256 + lane * 4);
            }
#pragma unroll
            for (int q = 0; q < 8; ++q) {
                v[q] *= gv[q];
                am = fmaxf(am, fmaxf(fmaxf(fabsf(v[q][0]), fabsf(v[q][1])), fmaxf(fabsf(v[q][2]), fabsf(v[q][3]))));
            }
            am = wave_max(am);
            const float sc = am > 0.f ? am * (1.f / 6.f) : 1.f, inv = 1.f / sc;
            u32x4 pk;
#pragma unroll
            for (int q2 = 0; q2 < 4; ++q2) { unsigned w = 0;
                w = __builtin_amdgcn_cvt_scalef32_pk_fp4_f32(w, v[2 * q2][0] * inv, v[2 * q2][1] * inv, 1.0f, 0);
                w = __builtin_amdgcn_cvt_scalef32_pk_fp4_f32(w, v[2 * q2][2] * inv, v[2 * q2][3] * inv, 1.0f, 1);
                w = __builtin_amdgcn_cvt_scalef32_pk_fp4_f32(w, v[2 * q2 + 1][0] * inv, v[2 * q2 + 1][1] * inv, 1.0f, 2);
                w = __builtin_amdgcn_cvt_scalef32_pk_fp4_f32(w, v[2 * q2 + 1][2] * inv, v[2 * q2 + 1][3] * inv, 1.0f, 3);
                pk[q2] = w; }
            *(u32x4*)(DST + (size_t)row * VROW + lane * 16) = pk;
            mysc = (lane == rr) ? sc : mysc;
        }
        if (lane < 8) SC[r0 + lane] = mysc;
        return;
    }
#define CV_TR(MAP, base, WI, GI, K_, NS_, ND_, WSOFF) do { const int i0_ = (item - (base)) * 4; const float* W_ = a.in[WI] + (size_t)l * (K_) * (NS_); const float* g_ = (GI) >= 0 ? a.in[(GI) >= 0 ? (GI) : 0] + l * (K_) : nullptr; \
        bf16_t* WT_ = (bf16_t*)(ws + (WSOFF)) + (size_t)l * (ND_) * (K_); _Pragma("unroll 1") for (int j_ = 0; j_ < 4; ++j_) if (i0_ + j_ < ((K_) / 64) * ((ND_) / 64)) transpose_item<MAP>(W_, K_, NS_, ND_, g_, WT_, scr, i0_ + j_, lane); } while (0)
    if (item < CV_WIN) { CV_TR(1, CV_TAB, I_W_IN, I_LN_MIX, D, IN_COLS, NZ, WS_WIN); return; }
    if (item < CV_WOUT) { CV_TR(0, CV_WIN, I_W_OUT, I_GROUP_GAIN, D, D, D, WS_WOUT); return; }
    if (item < CV_WQ) { CV_TR(0, CV_WOUT, I_PEER_WQ, I_LN_FFN, D, D, D, WS_WQ); return; }
    if (item < CV_WG) { CV_TR(0, CV_WQ, I_PLE_WGATE, I_LN_PLE, D, D, D, WS_WG); return; }
    if (item < CV_WP) { CV_TR(0, CV_WG, I_PLE_WPROJ, -1, PLE, D, D, WS_WP); return; }
    if (item < CV_UQ) { CV_TR(2, CV_WP, I_MLA_WUQ, I_MLA_QN, 384, 768, 768, WS_WUQ); return; }
    if (item < CV_UKV) { CV_TR(0, CV_UQ, I_MLA_WUKV, I_MLA_KVN, 256, 1024, 1024, WS_WUKV); return; }
#undef CV_TR
    if (item < CV_P) {
        const size_t e0 = (size_t)l * T * PLE + (size_t)(item - CV_UKV) * 16384; const float* Pp = a.in[I_P]; bf16_t* PB = (bf16_t*)(ws + WS_PB);
#pragma unroll 4
        for (int i = 0; i < 32; ++i) { const size_t e = e0 + (size_t)i * 512 + lane * 8; const f32x4 v0 = *(const f32x4*)(Pp + e), v1 = *(const f32x4*)(Pp + e + 4);
            u32x4 w; w.x = pk2(v0[0], v0[1]); w.y = pk2(v0[2], v0[3]); w.z = pk2(v1[0], v1[1]); w.w = pk2(v1[2], v1[3]); *(u32x4*)(PB + e) = w; }
        return;
    }
    {
        const size_t e0 = (size_t)l * 8 * 2 * 128 * 128 + (size_t)(item - CV_P) * 16384; const float* sk = a.in[I_PEER_SUBKEYS]; bf16_t* skb = (bf16_t*)(ws + WS_SKB);
#pragma unroll 4
        for (int i = 0; i < 32; ++i) { const size_t e = e0 + (size_t)i * 512 + lane * 8; const f32x4 v0 = *(const f32x4*)(sk + e), v1 = *(const f32x4*)(sk + e + 4);
            u32x4 w; w.x = pk2(v0[0], v0[1]); w.y = pk2(v0[2], v0[3]); w.z = pk2(v1[0], v1[1]); w.w = pk2(v1[2], v1[3]); *(u32x4*)(skb + e) = w; }
    }
}
__device__ __forceinline__ void convert_layers(Frame& F, int l0, int l1, int gw, int NGW, bool early_only) {
    const int lane = lane_id_fresh();
    for (int l = l0; l < l1; ++l)
#pragma unroll 1
        for (int it = gw; it < NCONV; it += NGW) if (!early_only || conv_early(it)) convert_item(F, l, it, lane);
}
__device__ __forceinline__ void convert_layer_queue(Frame& F, int l, unsigned* ctr) {
    const int lane = lane_id_fresh();
#pragma unroll 1
    for (;;) {
        unsigned it = 0;
        if (lane == 0) it = __hip_atomic_fetch_add(ctr, 1u, __ATOMIC_RELAXED, __HIP_MEMORY_SCOPE_AGENT);
        it = __builtin_amdgcn_readfirstlane(it);
        if (it >= (unsigned)NCONV) break;
        const int ll = conv_early((int)it) ? l + 1 : l;
        if (ll < DEPTH) convert_item(F, ll, (int)it, lane);
    }
}

__device__ __forceinline__ void prologue(Frame& F) {
    const Args& a = *F.a; unsigned char* ws = F.ws;
    const int gw = F.gw, NGW = F.ngw, lane = F.lane;
    const size_t gt = (size_t)blockIdx.x * NTHREADS + F.tid, GT = (size_t)F.G * NTHREADS;
    if (F.G == 256) convert_layers(F, 0, 1, gw, NGW, true);
    else convert_layers(F, 0, DEPTH, gw, NGW, false);
    {
        const float* X = a.in[I_X]; bf16_t* HB = (bf16_t*)(ws + WS_HB); u64* ssq = (u64*)(ws + WS_CTL + CTL_SSQA);
        for (int t = gw; t < T; t += NGW) {
            float s2 = 0.f;
#pragma unroll
            for (int c = 0; c < 4; ++c) {
                const size_t o = (size_t)t * D + c * 512 + lane * 8;
                const f32x4 v0 = *(const f32x4*)(X + o), v1 = *(const f32x4*)(X + o + 4);
                u32x4 w; w.x = pk2(v0[0], v0[1]); w.y = pk2(v0[2], v0[3]); w.z = pk2(v1[0], v1[1]); w.w = pk2(v1[2], v1[3]);
                *(u32x4*)(HB + o) = w;
                s2 += v0[0] * v0[0] + v0[1] * v0[1] + v0[2] * v0[2] + v0[3] * v0[3] + v1[0] * v1[0] + v1[1] * v1[1] + v1[2] * v1[2] + v1[3] * v1[3];
            }
            s2 = wave_sum(s2);
            if (lane == 0) ssq[t] = (u64)(s2 * 16777216.f);
        }
    }
    {
        const int* pos = (const int*)a.in[I_POS]; float* cs = (float*)(ws + WS_CS);
        for (size_t i = gt; i < (size_t)T * 32; i += GT) {
            const int t = (int)(i / 32), j = (int)(i % 32);
            const float inv = powf(10000.0f, -(float)j / 32.0f);
            const float ang = (float)pos[t] * inv;
            const double rev = (double)ang * 0.15915494309189535;
            const float fr = (float)(rev - rint(rev));
            cs[i * 2] = __builtin_amdgcn_cosf(fr); cs[i * 2 + 1] = __builtin_amdgcn_sinf(fr);
        }
    }
    {
        float* prm = (float*)(ws + WS_PRM);
#define PRM_COPY(IDX, OFF, N) do { const float* src_ = a.in[IDX]; for (size_t i = gt; i < (size_t)DEPTH * (N); i += GT) { const int l_ = (int)(i / (N)), o_ = (int)(i % (N)); prm[l_ * PRM_L + (OFF) + o_] = src_[i]; } } while (0)
        PRM_COPY(I_CONV_W, PRM_CW, 2048); PRM_COPY(I_CONV_B, PRM_CB, 512); PRM_COPY(I_GATE_B, PRM_GB, 8); PRM_COPY(I_DIFF_LAMBDA, PRM_DL, 256);
        PRM_COPY(I_DIFF_NORM, PRM_DN, 512); PRM_COPY(I_HGRN_NORM, PRM_HN, 512); PRM_COPY(I_MLSTM_NORM, PRM_MN, 512);
#undef PRM_COPY
        for (size_t i = gt; i < (size_t)D; i += GT) prm[PRM_FIN + i] = a.in[I_LN_FINAL][i];
    }
    if (blockIdx.x == 0) {
        const float* lg = a.in[I_HGRN_LB]; float* lbs = (float*)(ws + WS_LBS);
        for (int c = F.tid; c < 512; c += NTHREADS) {
            float v[DEPTH], mx = -1e30f;
#pragma unroll
            for (int l = 0; l < DEPTH; ++l) { v[l] = lg[l * 512 + c]; mx = fmaxf(mx, v[l]); }
            float s = 0.f;
#pragma unroll
            for (int l = 0; l < DEPTH; ++l) { v[l] = expf(v[l] - mx); s += v[l]; }
            float cum = 0.f; float first = 0.f;
#pragma unroll
            for (int l = 0; l < DEPTH; ++l) { cum += v[l] / s; if (l == 0) first = cum; lbs[l * 512 + c] = cum - first; }
        }
    }
}

__device__ __forceinline__ void mix_prep(Frame& F, int l) {
    unsigned char* ws = F.ws;
    const bf16_t* Z = (const bf16_t*)(ws + WS_Z);
    const size_t gt = (size_t)F.bid * NTHREADS + F.tid, GT = (size_t)F.G * NTHREADS;
    bf16_t* KR = (bf16_t*)(ws + WS_KRM); const float* cs = (const float*)(ws + WS_CS);
    for (size_t i = gt; i < (size_t)T * 32; i += GT) {
        const int t = (int)(i / 32), j = (int)(i % 32);
        const float x1 = bf2f(Z[(size_t)t * NZ + ZC_MKR + 2 * j]), x2 = bf2f(Z[(size_t)t * NZ + ZC_MKR + 2 * j + 1]);
        const float c = cs[i * 2], sn = cs[i * 2 + 1];
        *(unsigned*)(KR + (size_t)t * 64 + 2 * j) = pk2(x1 * c - x2 * sn, x2 * c + x1 * sn);
    }
}

typedef float f32x16 __attribute__((ext_vector_type(16)));
typedef short s16x4 __attribute__((ext_vector_type(4)));
__device__ __forceinline__ int crow(int r, int hi) { return (r & 3) + 8 * (r >> 2) + 4 * hi; }
template <int OFF> __device__ __forceinline__ s16x4 tr_read(unsigned addr) { s16x4 r; asm volatile("ds_read_b64_tr_b16 %0, %1 offset:%2" : "=&v"(r) : "v"(addr), "i"(OFF) : "memory"); return r; }
constexpr int ATT_SV = 320;
template <int D0, int BLK, int KS> __device__ __forceinline__ bf16x8 v_frag(unsigned vaddr) {
    const s16x4 lo = tr_read<(32 * BLK + 16 * KS) * ATT_SV + 64 * D0>(vaddr), hi = tr_read<(32 * BLK + 16 * KS + 8) * ATT_SV + 64 * D0>(vaddr);
    return (bf16x8){lo[0], lo[1], lo[2], lo[3], hi[0], hi[1], hi[2], hi[3]};
}
__device__ __forceinline__ bf16x8 pack8(const f32x16& p, int base) {
    u32x4 w; w.x = pk2(p[base + 0], p[base + 1]); w.y = pk2(p[base + 2], p[base + 3]); w.z = pk2(p[base + 4], p[base + 5]); w.w = pk2(p[base + 6], p[base + 7]);
    return __builtin_bit_cast(bf16x8, w);
}
struct VFrags { bf16x8 a00, a01, a10, a11; };
template <int D0> __device__ __forceinline__ VFrags v_frags(unsigned vaddr) { VFrags f; f.a00 = v_frag<D0, 0, 0>(vaddr); f.a01 = v_frag<D0, 0, 1>(vaddr); f.a10 = v_frag<D0, 1, 0>(vaddr); f.a11 = v_frag<D0, 1, 1>(vaddr); return f; }
__device__ __forceinline__ void pv_mma(f32x16& o, const VFrags& f, bf16x8 p00, bf16x8 p01, bf16x8 p10, bf16x8 p11) {
    o = __builtin_amdgcn_mfma_f32_32x32x16_bf16(f.a00, p00, o, 0, 0, 0);
    o = __builtin_amdgcn_mfma_f32_32x32x16_bf16(f.a01, p01, o, 0, 0, 0);
    o = __builtin_amdgcn_mfma_f32_32x32x16_bf16(f.a10, p10, o, 0, 0, 0);
    o = __builtin_amdgcn_mfma_f32_32x32x16_bf16(f.a11, p11, o, 0, 0, 0);
}
__device__ __forceinline__ void pv_all(f32x16 (&o)[4], unsigned vaddr, bf16x8 p00, bf16x8 p01, bf16x8 p10, bf16x8 p11) {
    const VFrags f0 = v_frags<0>(vaddr); const VFrags f1 = v_frags<1>(vaddr);
    asm volatile("s_waitcnt lgkmcnt(8)" ::: "memory"); __builtin_amdgcn_sched_barrier(0);
    pv_mma(o[0], f0, p00, p01, p10, p11);
    __builtin_amdgcn_sched_barrier(0);
    const VFrags f2 = v_frags<2>(vaddr);
    asm volatile("s_waitcnt lgkmcnt(8)" ::: "memory"); __builtin_amdgcn_sched_barrier(0);
    pv_mma(o[1], f1, p00, p01, p10, p11);
    __builtin_amdgcn_sched_barrier(0);
    const VFrags f3 = v_frags<3>(vaddr);
    asm volatile("s_waitcnt lgkmcnt(8)" ::: "memory"); __builtin_amdgcn_sched_barrier(0);
    pv_mma(o[2], f2, p00, p01, p10, p11);
    asm volatile("s_waitcnt lgkmcnt(0)" ::: "memory"); __builtin_amdgcn_sched_barrier(0);
    pv_mma(o[3], f3, p00, p01, p10, p11);
}
template <int MODE>
__device__ __forceinline__ void attn_unit(Frame& F, int l, int b, int h, int qb) {
    constexpr int DK = MODE ? 192 : 64, NS = DK / 16, SK = DK * 2 + 16, KBYTES = 64 * SK, VBYTES = 64 * ATT_SV, BUFB = KBYTES + VBYTES, KCH = DK / 8, NKC = (64 * KCH) / 512;
    constexpr int NMAP = MODE ? 1 : 2;
    constexpr float SCALE = MODE ? 0.07216878364870322f : 0.125f, C = SCALE * 1.4426950408889634f;
    unsigned char* ws = F.ws;
    const bf16_t* Z = (const bf16_t*)(ws + WS_Z); const bf16_t* QM = (const bf16_t*)(ws + WS_QM); const bf16_t* KVM = (const bf16_t*)(ws + WS_KVM); const bf16_t* KRM = (const bf16_t*)(ws + WS_KRM);
    bf16_t* Y = (bf16_t*)(ws + WS_Y);
    const int w = F.wave, lane = lane_id_fresh(), tid = w * 64 + lane, r32 = lane & 31, hi = lane >> 5;
    const int q0 = qb * 256, qw = q0 + 32 * w, ntiles = 4 * (qb + 1);
    const size_t rowb = (size_t)b * SEQ;
    const unsigned lds0 = (unsigned)(uintptr_t)F.lds;
    const unsigned kaddr = lds0 + r32 * SK + 16 * hi;
    const unsigned vaddr = lds0 + KBYTES + (((lane & 15) >> 2) + 4 * hi) * ATT_SV + (16 * ((lane >> 4) & 1) + 4 * (lane & 3)) * 2;
    float* O1 = (float*)(ws + WS_O1) + (rowb + qw + r32) * 512 + h * 128 + 4 * hi;
    for (int mp = 0; mp < NMAP; ++mp) {
        bf16x8 qf[NS];
        {
            const bf16_t* qp = MODE ? QM + (rowb + qw + r32) * 768 + h * 192 + 8 * hi : Z + (rowb + qw + r32) * NZ + ZC_DQ + h * 128 + mp * 64 + 8 * hi;
#pragma unroll
            for (int s = 0; s < NS; ++s) qf[s] = *(const bf16x8*)(qp + 16 * s);
            if (MODE == 1) {
                const float* csq = (const float*)(ws + WS_CS) + (rowb + qw + r32) * 64 + 8 * hi;
#pragma unroll
                for (int s = 8; s < NS; ++s) {
                    const f32x4 ca = *(const f32x4*)(csq + 16 * (s - 8)), cb = *(const f32x4*)(csq + 16 * (s - 8) + 4);
                    const u32x4 w = __builtin_bit_cast(u32x4, qf[s]); u32x4 o;
                    { const float x1 = bflo(w[0]), x2 = bfhi(w[0]); o[0] = pk2(x1 * ca[0] - x2 * ca[1], x2 * ca[0] + x1 * ca[1]); }
                    { const float x1 = bflo(w[1]), x2 = bfhi(w[1]); o[1] = pk2(x1 * ca[2] - x2 * ca[3], x2 * ca[2] + x1 * ca[3]); }
                    { const float x1 = bflo(w[2]), x2 = bfhi(w[2]); o[2] = pk2(x1 * cb[0] - x2 * cb[1], x2 * cb[0] + x1 * cb[1]); }
                    { const float x1 = bflo(w[3]), x2 = bfhi(w[3]); o[3] = pk2(x1 * cb[2] - x2 * cb[3], x2 * cb[2] + x1 * cb[3]); }
                    qf[s] = __builtin_bit_cast(bf16x8, o);
                }
            }
        }
        f32x16 o[4];
#pragma unroll
        for (int d = 0; d < 4; ++d) o[d] = (f32x16){};
        float m_run = -1e30f, l_run = 0.f;
        u32x4 kst[NKC], vst[2];
#define ATT_LOAD(j) do { const int k0_ = 64 * (j); \
            _Pragma("unroll") for (int i_ = 0; i_ < NKC; ++i_) { const int c_ = tid + 512 * i_, row_ = c_ / KCH, cc_ = c_ % KCH; \
                const bf16_t* src_ = MODE ? (cc_ < 16 ? KVM + (rowb + k0_ + row_) * 1024 + h * 256 + cc_ * 8 : KRM + (rowb + k0_ + row_) * 64 + (cc_ - 16) * 8) \
                                          : Z + (rowb + k0_ + row_) * NZ + ZC_DK + h * 128 + mp * 64 + cc_ * 8; \
                kst[i_] = *(const u32x4*)src_; } \
            _Pragma("unroll") for (int i_ = 0; i_ < 2; ++i_) { const int c_ = tid + 512 * i_, row_ = c_ >> 4, cc_ = c_ & 15; \
                const bf16_t* src_ = MODE ? KVM + (rowb + k0_ + row_) * 1024 + h * 256 + 128 + cc_ * 8 : Z + (rowb + k0_ + row_) * NZ + ZC_DV + h * 128 + cc_ * 8; \
                vst[i_] = *(const u32x4*)src_; } } while (0)
#define ATT_WRITE(buf) do { \
            _Pragma("unroll") for (int i_ = 0; i_ < NKC; ++i_) { const int c_ = tid + 512 * i_, row_ = c_ / KCH, cc_ = c_ % KCH; *(LAS u32x4*)(F.lds + (buf) * BUFB + row_ * SK + cc_ * 16) = kst[i_]; } \
            _Pragma("unroll") for (int i_ = 0; i_ < 2; ++i_) { const int c_ = tid + 512 * i_, row_ = c_ >> 4, cc_ = c_ & 15; *(LAS u32x4*)(F.lds + (buf) * BUFB + KBYTES + row_ * ATT_SV + cc_ * 16) = vst[i_]; } } while (0)
        ATT_LOAD(0); ATT_WRITE(0);
        __builtin_amdgcn_s_waitcnt(0x0F70);
        __syncthreads();
        for (int j = 0; j < ntiles; ++j) {
            const int k0 = 64 * j; const unsigned bo = (unsigned)(j & 1) * BUFB;
            if (j + 1 < ntiles) ATT_LOAD(j + 1);
            if (k0 <= qw + 31) {
                f32x16 p0 = (f32x16){}, p1 = (f32x16){};
                {
                    bf16x8 ka[NS], kb[NS];
#pragma unroll
                    for (int s = 0; s < NS; ++s) { ka[s] = *(const LAS bf16x8*)(uintptr_t)(kaddr + bo + 32 * s); kb[s] = *(const LAS bf16x8*)(uintptr_t)(kaddr + bo + 32 * SK + 32 * s); }
#pragma unroll
                    for (int s = 0; s < NS; ++s) { p0 = __builtin_amdgcn_mfma_f32_32x32x16_bf16(ka[s], qf[s], p0, 0, 0, 0); p1 = __builtin_amdgcn_mfma_f32_32x32x16_bf16(kb[s], qf[s], p1, 0, 0, 0); }
                    __builtin_amdgcn_sched_group_barrier(0x100, 6, 0);
#pragma unroll
                    for (int s = 0; s < NS - 3; ++s) { __builtin_amdgcn_sched_group_barrier(0x008, 2, 0); __builtin_amdgcn_sched_group_barrier(0x100, 2, 0); }
                    __builtin_amdgcn_sched_group_barrier(0x008, 6, 0);
                }
                if (k0 + 63 > qw) {
                    const int qi = qw + r32;
#pragma unroll
                    for (int r = 0; r < 16; ++r) { const int key = k0 + crow(r, hi); if (key > qi) p0[r] = -1e30f; if (key + 32 > qi) p1[r] = -1e30f; }
                }
                float pmax = p0[0];
#pragma unroll
                for (int r = 1; r < 16; ++r) pmax = fmaxf(pmax, p0[r]);
#pragma unroll
                for (int r = 0; r < 16; ++r) pmax = fmaxf(pmax, p1[r]);
                pmax = fmaxf(pmax, bperm_f(lane ^ 32, pmax));
                const float mn = fmaxf(m_run, pmax), alpha = __builtin_amdgcn_exp2f((m_run - mn) * C), mnC = -mn * C; m_run = mn;
                float ps = 0.f;
#pragma unroll
                for (int r = 0; r < 16; ++r) { p0[r] = __builtin_amdgcn_exp2f(fmaf(p0[r], C, mnC)); p1[r] = __builtin_amdgcn_exp2f(fmaf(p1[r], C, mnC)); ps += p0[r] + p1[r]; }
                ps += bperm_f(lane ^ 32, ps);
                l_run = l_run * alpha + ps;
                if (!__all(alpha == 1.f)) {
#pragma unroll
                    for (int d = 0; d < 4; ++d) o[d] *= alpha;
                }
                const bf16x8 p00 = pack8(p0, 0), p01 = pack8(p0, 8), p10 = pack8(p1, 0), p11 = pack8(p1, 8);
                asm volatile("s_waitcnt lgkmcnt(0)" ::: "memory");
                pv_all(o, vaddr + bo, p00, p01, p10, p11);
            }
            if (j + 1 < ntiles) ATT_WRITE((j + 1) & 1);
            __syncthreads();
        }
#undef ATT_LOAD
#undef ATT_WRITE
        const float il = rcpf_(l_run);
        if (MODE == 0 && mp == 0) {
#pragma unroll
            for (int d = 0; d < 4; ++d)
#pragma unroll
                for (int r4 = 0; r4 < 4; ++r4) *(f32x4*)(O1 + 32 * d + 8 * r4) = (f32x4){o[d][4 * r4] * il, o[d][4 * r4 + 1] * il, o[d][4 * r4 + 2] * il, o[d][4 * r4 + 3] * il};
        } else {
            const size_t yrow = (rowb + qw + r32) * D + (MODE ? 1024 : 0) + h * 128 + 4 * hi;
            if (MODE == 0) {
                const float* lv = (const float*)(ws + WS_PRM) + l * PRM_L + PRM_DL;
                const float s01 = wave_sum(lv[lane] * lv[64 + lane]), s23 = wave_sum(lv[128 + lane] * lv[192 + lane]);
                const float lam_init = 0.8f - 0.6f * __expf(-0.3f * (float)l);
                const float lam = __expf(s01) - __expf(s23) + lam_init;
                const float il2 = lam * il; float ss = 0.f;
#pragma unroll
                for (int d = 0; d < 4; ++d)
#pragma unroll
                    for (int r4 = 0; r4 < 4; ++r4) { const f32x4 a1 = *(const f32x4*)(O1 + 32 * d + 8 * r4);
#pragma unroll
                        for (int e = 0; e < 4; ++e) { const float x = a1[e] - o[d][4 * r4 + e] * il2; o[d][4 * r4 + e] = x; ss += x * x; } }
                ss += bperm_f(lane ^ 32, ss);
                const float rn = rsqrtf(ss * (1.f / 128.f) + EPS) * (1.f - lam_init);
                const float* g = (const float*)(ws + WS_PRM) + l * PRM_L + PRM_DN + h * 128 + 4 * hi;
#pragma unroll
                for (int d = 0; d < 4; ++d)
#pragma unroll
                    for (int r4 = 0; r4 < 4; ++r4) {
                        const f32x4 gg = *(const f32x4*)(g + 32 * d + 8 * r4);
                        u32x2 wv; wv.x = pk2(o[d][4 * r4] * rn * gg[0], o[d][4 * r4 + 1] * rn * gg[1]); wv.y = pk2(o[d][4 * r4 + 2] * rn * gg[2], o[d][4 * r4 + 3] * rn * gg[3]);
                        *(u32x2*)(Y + yrow + 32 * d + 8 * r4) = wv;
                    }
            } else {
#pragma unroll
                for (int d = 0; d < 4; ++d)
#pragma unroll
                    for (int r4 = 0; r4 < 4; ++r4) {
                        u32x2 wv; wv.x = pk2(o[d][4 * r4] * il, o[d][4 * r4 + 1] * il); wv.y = pk2(o[d][4 * r4 + 2] * il, o[d][4 * r4 + 3] * il);
                        *(u32x2*)(Y + yrow + 32 * d + 8 * r4) = wv;
                    }
            }
        }
    }
}
__device__ __forceinline__ void attn_fast(Frame& F, int l) {
    unsigned* actr = (unsigned*)(F.ws + WS_CTL + CTL_CVQ + 4096) + 64 * l;
    volatile LAS unsigned* slot = (volatile LAS unsigned*)(F.lds + MISC_OFF) + 24;
#pragma unroll 1
    for (;;) {
        __syncthreads();
        if (F.tid == 0) *slot = __hip_atomic_fetch_add(actr, 1u, __ATOMIC_RELAXED, __HIP_MEMORY_SCOPE_AGENT);
        __syncthreads();
        const int u = __builtin_amdgcn_readfirstlane((int)*slot);
        if (u >= 256) break;
        const int qb = 7 - (u >> 5), mode = (u >> 4) & 1, b = (u >> 2) & 3, h = u & 3;
        if (mode == 0) attn_unit<0>(F, l, b, h, qb); else attn_unit<1>(F, l, b, h, qb);
    }
}

typedef float f32x4_t __attribute__((ext_vector_type(4)));
template <int KIND>
__device__ __forceinline__ void scan_unit(Frame& F, int l, int b, int h, int seg) {
    constexpr int DK = KIND ? 64 : 128, NKS = DK / 32, NDT = DK / 16, SQ = DK * 2 + 16, SA = 144;
    constexpr int L_QT = 0, L_KT = 64 * SQ, L_KTT = 128 * SQ, L_VT = L_KTT + DK * SA, L_AT = L_VT + 128 * SA, L_ST = L_AT + 64 * SA, L_TAB = L_ST + 128 * SQ;
    constexpr int T_ER = L_TAB, T_EC = T_ER + 512, T_PS = T_EC + 512, T_QS = T_PS + 2048, T_KS = T_QS + 256, T_MT = T_KS + 256, T_NP = T_MT + 256, T_SC = T_NP + 256, T_DEN = T_SC + 64, T_BS = T_DEN + 8 * 256;
    static_assert(T_BS + 256 <= RING_BYTES, "scan LDS");
    unsigned char* ws = F.ws;
    const bf16_t* Z = (const bf16_t*)(ws + WS_Z);
    float* OUT = (float*)(ws + (KIND ? WS_OL : WS_OG));
    const float* prm = (const float*)(ws + WS_PRM) + l * PRM_L;
    LAS unsigned char* lds = F.lds;
    const int w = F.wave, lane = lane_id_fresh(), tid = w * 64 + lane, l15 = lane & 15, g = lane >> 4;
    const int ch = tid & 127, part = tid >> 7, i0 = 16 * part;
    if (w == 2 || w == 3) { const int rt = (w == 2) ? 0 : 2;
#pragma unroll
        for (int r = 0; r < 4; ++r) *(LAS bf16_t*)(lds + L_AT + (16 * rt + 4 * g + r) * SA + (16 * (rt + 1) + l15) * 2) = 0; }
    f32x4 st[NDT];
#pragma unroll
    for (int d = 0; d < NDT; ++d) st[d] = (f32x4){0.f, 0.f, 0.f, 0.f};
    float m_prev = 0.f, np_reg = 0.f, colsum = 0.f, bseg = 0.f;
    float cumlog = 0.f;
    const int bh = b * 4 + h;
    bf16_t* QTS = (bf16_t*)(ws + (KIND ? WS_QTL : WS_QTG)) + (size_t)bh * SEQ * DK;
    float* SCL = (float*)(ws + WS_SCL) + (size_t)bh * SEQ * 4;
    const float lb = KIND ? 0.f : ((const float*)(ws + WS_LBS))[l * 512 + h * 128 + ch];
    unsigned zA[16], zB[16], vr[16], gA = 0, gB = 0;
#define SCAN_LOAD(cc) do { const size_t r0_ = (size_t)b * SEQ + 64 * (cc); \
        if (KIND == 0) { const bf16_t* zr_ = Z + (r0_ + i0) * NZ + h * 128 + ch; \
            _Pragma("unroll") for (int j = 0; j < 16; ++j) { zA[j] = zr_[j * NZ + ZC_GF]; zB[j] = zr_[j * NZ + ZC_GQ]; } } \
        else { const int cidx_ = (ch < 64) ? h * 64 + ch : 256 + h * 64 + (ch - 64); const bf16_t* zc_ = Z + (r0_ + i0) * NZ + ZC_LQ + cidx_; \
            _Pragma("unroll") for (int j = 0; j < 16; ++j) zA[j] = zc_[j * NZ]; \
            if (!((cc) == 0 && part == 0)) { zB[0] = zc_[-3 * NZ]; zB[1] = zc_[-2 * NZ]; zB[2] = zc_[-1 * NZ]; } \
            if (w == 0) { const bf16_t* zg_ = Z + (r0_ + lane) * NZ + h; gA = zg_[ZC_LI]; gB = zg_[ZC_LF]; } } \
        { const bf16_t* zv_ = Z + (r0_ + i0) * NZ + (KIND ? ZC_LV : ZC_GV) + h * 128 + ch; \
            _Pragma("unroll") for (int j = 0; j < 16; ++j) vr[j] = zv_[j * NZ]; } } while (0)
    SCAN_LOAD(seg * SEGC);
    float cw0 = 0.f, cw1 = 0.f, cw2 = 0.f, cw3 = 0.f, cbias = 0.f, gbi = 0.f, gbf = 0.f;
    if (KIND == 1) { const int cidx = (ch < 64) ? h * 64 + ch : 256 + h * 64 + (ch - 64);
        cw0 = prm[PRM_CW + cidx]; cw1 = prm[PRM_CW + 512 + cidx]; cw2 = prm[PRM_CW + 1024 + cidx]; cw3 = prm[PRM_CW + 1536 + cidx]; cbias = prm[PRM_CB + cidx]; gbi = prm[PRM_GB + h]; gbf = prm[PRM_GB + 4 + h]; }
#pragma unroll 1
    for (int c = seg * SEGC; c < (seg + 1) * SEGC; ++c) {
        const size_t row0 = (size_t)b * SEQ + 64 * c;
        float qv[16], kv[16], lf[16];
        if (KIND == 0) {
            float run = 0.f;
#pragma unroll
            for (int j = 0; j < 16; ++j) {
                const float zf = fmaxf(bf2f((bf16_t)zA[j]), -30.f), zq = bf2f((bf16_t)zB[j]);
                const float ez = __expf(-zf), sg = rcpf_(1.f + ez), sgn = ez * sg;
                run += __logf(lb + (1.f - lb) * sg); lf[j] = run; qv[j] = zq * 0.08838834764831845f; kv[j] = (1.f - lb) * sgn;
            }
            *(LAS float*)(lds + T_PS + (part * 128 + ch) * 4) = run;
        } else {
            const float w0 = cw0, w1 = cw1, w2 = cw2, w3 = cw3, cb = cbias;
            const bool first = (c == 0 && part == 0);
            float x0 = first ? 0.f : bf2f((bf16_t)zB[0]), x1 = first ? 0.f : bf2f((bf16_t)zB[1]), x2 = first ? 0.f : bf2f((bf16_t)zB[2]);
#pragma unroll
            for (int j = 0; j < 16; ++j) {
                const float x3 = bf2f((bf16_t)zA[j]);
                float v = cb + x0 * w0 + x1 * w1 + x2 * w2 + x3 * w3; v = v * rcpf_(1.f + __expf(-v));
                qv[j] = (ch < 64) ? v * 0.125f : v; x0 = x1; x1 = x2; x2 = x3;
            }
            if (w == 0) {
                const float li = bf2f((bf16_t)gA) + gbi, zf = bf2f((bf16_t)gB) + gbf;
                const float lfv = fminf(zf, 0.f) - __logf(1.f + __expf(-fabsf(zf)));
                float bb = lfv;
#pragma unroll
                for (int o = 1; o < 64; o <<= 1) { const float t_ = bperm_f(lane - o, bb); if (lane >= o) bb += t_; }
                const float a_ = li - bb; float cm = a_;
#pragma unroll
                for (int o = 1; o < 64; o <<= 1) { const float t_ = bperm_f(lane - o, cm); if (lane >= o) cm = fmaxf(cm, t_); }
                const float M = fmaxf(m_prev, cm), MC = rdlane_f(M, 63), bC = rdlane_f(bb, 63);
                *(LAS float*)(lds + T_QS + lane * 4) = __expf(MC - M); *(LAS float*)(lds + T_KS + lane * 4) = __expf(a_ - MC); *(LAS float*)(lds + T_MT + lane * 4) = bb + M;
                *(LAS float*)(lds + T_BS + lane * 4) = bseg + bb;
                bseg += bC;
                const float cs = __expf(m_prev - MC);
                np_reg = cs * (np_reg + colsum);
                *(LAS float*)(lds + T_NP + lane * 4) = np_reg;
                if (lane == 0) *(LAS float*)(lds + T_SC) = cs;
                m_prev = bC + MC;
            }
        }
        __syncthreads();
        {
            unsigned ktt[8];
            *(LAS u32x4*)(lds + L_VT + ch * SA + i0 * 2) = (u32x4){vr[0] | (vr[1] << 16), vr[2] | (vr[3] << 16), vr[4] | (vr[5] << 16), vr[6] | (vr[7] << 16)};
            *(LAS u32x4*)(lds + L_VT + ch * SA + i0 * 2 + 16) = (u32x4){vr[8] | (vr[9] << 16), vr[10] | (vr[11] << 16), vr[12] | (vr[13] << 16), vr[14] | (vr[15] << 16)};
            if (KIND == 0) {
                const float p0 = *(LAS float*)(lds + T_PS + ch * 4), p1 = *(LAS float*)(lds + T_PS + (128 + ch) * 4), p2 = *(LAS float*)(lds + T_PS + (256 + ch) * 4), p3 = *(LAS float*)(lds + T_PS + (384 + ch) * 4);
                const float r_ = p0 + p1, off = (part > 0 ? p0 : 0.f) + (part > 1 ? p1 : 0.f) + (part > 2 ? p2 : 0.f);
                if (part == 0) { *(LAS float*)(lds + T_ER + ch * 4) = __expf(r_); *(LAS float*)(lds + T_EC + ch * 4) = __expf(p2 + p3); }
                const float eseg = __expf(r_ + cumlog);
                bf16_t* qg_ = QTS + (size_t)(64 * c + i0) * DK + ch;
                cumlog += (p0 + p1) + (p2 + p3);
#pragma unroll
                for (int j = 0; j < 16; ++j) {
                    const float x = fminf(fmaxf(off + lf[j] - r_, -80.f), 80.f);
                    const float qt = qv[j] * __expf(x), kt = kv[j] * __expf(-x);
                    *(LAS bf16_t*)(lds + L_QT + (i0 + j) * SQ + ch * 2) = (bf16_t)f2bf(qt);
                    qg_[j * DK] = (bf16_t)f2bf(qt * eseg);
                    const unsigned kb_ = f2bf(kt);
                    *(LAS bf16_t*)(lds + L_KT + (i0 + j) * SQ + ch * 2) = (bf16_t)kb_;
                    if (j & 1) ktt[j >> 1] |= kb_ << 16; else ktt[j >> 1] = kb_;
                }
                *(LAS u32x4*)(lds + L_KTT + ch * SA + i0 * 2) = (u32x4){ktt[0], ktt[1], ktt[2], ktt[3]};
                *(LAS u32x4*)(lds + L_KTT + ch * SA + i0 * 2 + 16) = (u32x4){ktt[4], ktt[5], ktt[6], ktt[7]};
            } else {
#pragma unroll
                for (int j = 0; j < 16; ++j) {
                    const float fs = *(LAS float*)(lds + ((ch < 64) ? T_QS : T_KS) + (i0 + j) * 4);
                    const unsigned vb_ = f2bf(qv[j] * fs);
                    if (ch < 64) { *(LAS bf16_t*)(lds + L_QT + (i0 + j) * SQ + ch * 2) = (bf16_t)vb_; QTS[(size_t)(64 * c + i0 + j) * DK + ch] = (bf16_t)f2bf(qv[j]); }
                    else *(LAS bf16_t*)(lds + L_KT + (i0 + j) * SQ + (ch - 64) * 2) = (bf16_t)vb_;
                    if (j & 1) ktt[j >> 1] |= vb_ << 16; else ktt[j >> 1] = vb_;
                }
                if (ch >= 64) {
                    *(LAS u32x4*)(lds + L_KTT + (ch - 64) * SA + i0 * 2) = (u32x4){ktt[0], ktt[1], ktt[2], ktt[3]};
                    *(LAS u32x4*)(lds + L_KTT + (ch - 64) * SA + i0 * 2 + 16) = (u32x4){ktt[4], ktt[5], ktt[6], ktt[7]};
                }
            }
        }
        __syncthreads();
        for (int ti = w; ti < 10; ti += 8) {
            const int rt = (int)((0x3333222110ull >> (4 * ti)) & 15), ct = (int)((0x3210210100ull >> (4 * ti)) & 15);
            f32x4 acc = (f32x4){0.f, 0.f, 0.f, 0.f};
#pragma unroll
            for (int ks = 0; ks < NKS; ++ks) {
                const bf16x8 af = *(const LAS bf16x8*)(lds + L_QT + (16 * rt + l15) * SQ + (32 * ks + 8 * g) * 2), bfr = *(const LAS bf16x8*)(lds + L_KT + (16 * ct + l15) * SQ + (32 * ks + 8 * g) * 2);
                acc = __builtin_amdgcn_mfma_f32_16x16x32_bf16(af, bfr, acc, 0, 0, 0);
            }
#pragma unroll
            for (int r = 0; r < 4; ++r) { const int t_ = 16 * rt + 4 * g + r, s_ = 16 * ct + l15; *(LAS bf16_t*)(lds + L_AT + t_ * SA + s_ * 2) = (bf16_t)f2bf(s_ <= t_ ? acc[r] : 0.f); }
        }
        {
            const float cs = KIND ? *(LAS float*)(lds + T_SC) : 1.f;
#pragma unroll
            for (int d = 0; d < NDT; ++d) {
                if (KIND == 0) st[d] *= *(const LAS f32x4*)(lds + T_ER + (16 * d + 4 * g) * 4); else st[d] *= cs;
                u32x2 pk; pk.x = pk2(st[d][0], st[d][1]); pk.y = pk2(st[d][2], st[d][3]);
                *(LAS u32x2*)(lds + L_ST + (16 * w + l15) * SQ + (16 * d + 4 * g) * 2) = pk;
            }
        }
        __syncthreads();
        { const int cn_ = (c + 1 < SEQ / 64) ? c + 1 : c; SCAN_LOAD(cn_); }
        __builtin_amdgcn_sched_barrier(0);
        bf16x8 sfr[NKS], vfr[2];
#pragma unroll
        for (int ks = 0; ks < NKS; ++ks) sfr[ks] = *(const LAS bf16x8*)(lds + L_ST + (16 * w + l15) * SQ + (32 * ks + 8 * g) * 2);
#pragma unroll
        for (int ks = 0; ks < 2; ++ks) vfr[ks] = *(const LAS bf16x8*)(lds + L_VT + (16 * w + l15) * SA + (32 * ks + 8 * g) * 2);
        if (KIND == 1) {
            float dn = 0.f;
#pragma unroll
            for (int d8 = 0; d8 < 8; ++d8) { const u32x4 qw_ = *(const LAS u32x4*)(lds + L_QT + lane * SQ + d8 * 16); const f32x4 n0 = *(const LAS f32x4*)(lds + T_NP + d8 * 32), n1 = *(const LAS f32x4*)(lds + T_NP + d8 * 32 + 16);
                dn += bflo(qw_[0]) * n0[0] + bfhi(qw_[0]) * n0[1] + bflo(qw_[1]) * n0[2] + bfhi(qw_[1]) * n0[3] + bflo(qw_[2]) * n1[0] + bfhi(qw_[2]) * n1[1] + bflo(qw_[3]) * n1[2] + bfhi(qw_[3]) * n1[3]; }
#pragma unroll
            for (int s8 = 0; s8 < 8; ++s8) { const u32x4 aw_ = *(const LAS u32x4*)(lds + L_AT + lane * SA + s8 * 16);
#pragma unroll
                for (int e = 0; e < 4; ++e) { const int s_ = 8 * s8 + 2 * e; dn += (s_ <= lane ? bflo(aw_[e]) : 0.f) + (s_ + 1 <= lane ? bfhi(aw_[e]) : 0.f); } }
            *(LAS float*)(lds + T_DEN + (w * 64 + lane) * 4) = dn;
            *(f32x4*)(SCL + (size_t)(64 * c + lane) * 4) = (f32x4){dn, *(LAS float*)(lds + T_MT + lane * 4), *(LAS float*)(lds + T_BS + lane * 4), 0.f};
            if (w == 0) {
                float cs_ = 0.f;
                for (int s_ = 0; s_ < 64; ++s_) cs_ += bf2f(*(const LAS bf16_t*)(lds + L_KT + s_ * SQ + lane * 2));
                colsum = cs_;
            }
        }
#pragma unroll
        for (int rt = 0; rt < 4; ++rt) {
            f32x4 o = (f32x4){0.f, 0.f, 0.f, 0.f};
#pragma unroll
            for (int ks = 0; ks < NKS; ++ks) o = __builtin_amdgcn_mfma_f32_16x16x32_bf16(*(const LAS bf16x8*)(lds + L_QT + (16 * rt + l15) * SQ + (32 * ks + 8 * g) * 2), sfr[ks], o, 0, 0, 0);
#pragma unroll
            for (int ks = 0; ks < 2; ++ks) if (2 * ks <= rt) o = __builtin_amdgcn_mfma_f32_16x16x32_bf16(*(const LAS bf16x8*)(lds + L_AT + (16 * rt + l15) * SA + (32 * ks + 8 * g) * 2), vfr[ks], o, 0, 0, 0);
            float* op = OUT + (row0 + 16 * rt + 4 * g) * 512 + h * 128 + 16 * w + l15;
            if (KIND == 1) {
                const f32x4 dn = *(const LAS f32x4*)(lds + T_DEN + (w * 64 + 16 * rt + 4 * g) * 4), mt = *(const LAS f32x4*)(lds + T_MT + (16 * rt + 4 * g) * 4);
#pragma unroll
                for (int r = 0; r < 4; ++r) op[r * 512] = (seg > 0) ? o[r] : o[r] * rcpf_(fmaxf(fabsf(dn[r]), __expf(-mt[r])));
            } else {
#pragma unroll
                for (int r = 0; r < 4; ++r) op[r * 512] = o[r];
            }
        }
#pragma unroll
        for (int d = 0; d < NDT; ++d) {
#pragma unroll
            for (int ks = 0; ks < 2; ++ks) st[d] = __builtin_amdgcn_mfma_f32_16x16x32_bf16(*(const LAS bf16x8*)(lds + L_KTT + (16 * d + l15) * SA + (32 * ks + 8 * g) * 2), vfr[ks], st[d], 0, 0, 0);
            if (KIND == 0) st[d] *= *(const LAS f32x4*)(lds + T_EC + (16 * d + 4 * g) * 4);
        }
        __syncthreads();
    }
#undef SCAN_LOAD
    if (seg < NSEG - 1) {
        float* SIF = (float*)(ws + WS_SIF) + (size_t)((KIND * 16 + bh) * NSEG) * 16384;
        bf16_t* SIB = (bf16_t*)(ws + WS_SIB) + (size_t)((KIND * 16 + bh) * NSEG) * 16384;
        float* SIM = (float*)(ws + WS_SIM) + (size_t)(bh * NSEG) * 128;
        unsigned* flg = (unsigned*)(ws + WS_CTL + CTL_SEGF) + (size_t)(((l * 2 + KIND) * 16 + bh) * NSEG) * 16;
        if (KIND == 0 && part == 0) *(LAS float*)(lds + T_PS + ch * 4) = cumlog;
        if (seg > 0) {
            if (w == 0) { unsigned spins = 0; while (__builtin_amdgcn_readfirstlane(__hip_atomic_load(flg + seg * 16, __ATOMIC_RELAXED, __HIP_MEMORY_SCOPE_AGENT)) == 0u && ++spins < (1u << 22)) __builtin_amdgcn_s_sleep(2); }
            __syncthreads();
            __builtin_amdgcn_fence(__ATOMIC_ACQUIRE, "agent");
        }
        if (KIND == 1 && w == 0) {
            const float n_loc = np_reg + colsum; float m_new = m_prev, al_ = 1.f, be_ = 0.f, n_init = 0.f;
            if (seg > 0) { const float m_init = SIM[seg * 128 + 64]; n_init = SIM[seg * 128 + lane]; m_new = fmaxf(m_prev, bseg + m_init); al_ = __expf(m_prev - m_new); be_ = __expf(bseg + m_init - m_new); }
            __hip_atomic_store(SIM + (seg + 1) * 128 + lane, al_ * n_loc + be_ * n_init, __ATOMIC_RELAXED, __HIP_MEMORY_SCOPE_AGENT);
            if (lane == 0) { __hip_atomic_store(SIM + (seg + 1) * 128 + 64, m_new, __ATOMIC_RELAXED, __HIP_MEMORY_SCOPE_AGENT); if (seg > 0) { *(LAS float*)(lds + T_SC) = al_; *(LAS float*)(lds + T_SC + 4) = be_; } }
        }
        __syncthreads();
        float al_ = 1.f, be_ = 0.f;
        if (KIND == 1 && seg > 0) { al_ = *(LAS float*)(lds + T_SC); be_ = *(LAS float*)(lds + T_SC + 4); }
#pragma unroll
        for (int d = 0; d < NDT; ++d) {
            f32x4 val = st[d];
            if (seg > 0) {
                const f32x4 prev = *(const f32x4*)(SIF + (size_t)seg * 16384 + (16 * w + l15) * 128 + 16 * d + 4 * g);
                if (KIND == 0) { const f32x4 cl_ = *(const LAS f32x4*)(lds + T_PS + (16 * d + 4 * g) * 4);
#pragma unroll
                    for (int r = 0; r < 4; ++r) val[r] += __expf(cl_[r]) * prev[r]; }
                else val = al_ * val + be_ * prev;
            }
            const size_t o_ = (size_t)(seg + 1) * 16384 + (16 * w + l15) * 128 + 16 * d + 4 * g;
            __hip_atomic_store((u64*)(SIF + o_), (u64)__builtin_bit_cast(unsigned, val[0]) | ((u64)__builtin_bit_cast(unsigned, val[1]) << 32), __ATOMIC_RELAXED, __HIP_MEMORY_SCOPE_AGENT);
            __hip_atomic_store((u64*)(SIF + o_ + 2), (u64)__builtin_bit_cast(unsigned, val[2]) | ((u64)__builtin_bit_cast(unsigned, val[3]) << 32), __ATOMIC_RELAXED, __HIP_MEMORY_SCOPE_AGENT);
            __hip_atomic_store((u64*)(SIB + o_), (u64)pk2(val[0], val[1]) | ((u64)pk2(val[2], val[3]) << 32), __ATOMIC_RELAXED, __HIP_MEMORY_SCOPE_AGENT);
        }
        asm volatile("s_waitcnt vmcnt(0)" ::: "memory");
        __syncthreads();
        if (tid == 0) __hip_atomic_store(flg + (seg + 1) * 16, 1u, __ATOMIC_RELAXED, __HIP_MEMORY_SCOPE_AGENT);
    }
}

template <int KIND>
__device__ __forceinline__ void norm_unit(Frame& F, int l, int b, int h, int rb, int seg) {
    constexpr int DK = KIND ? 64 : 128, NKS = DK / 32;
    unsigned char* ws = F.ws;
    const int lane = lane_id_fresh(), l15 = lane & 15, g = lane >> 4, bh = b * 4 + h;
    const size_t trow = (size_t)b * SEQ + 32 * rb;
    const float* prm = (const float*)(ws + WS_PRM) + l * PRM_L + (KIND ? PRM_MN : PRM_HN) + h * 128 + 4 * g;
    const bf16_t* Zg = (const bf16_t*)(ws + WS_Z) + (trow + l15) * NZ + (KIND ? ZC_LO : ZC_GG) + h * 128 + 4 * g;
    const float* OUT = (const float*)(ws + (KIND ? WS_OL : WS_OG)) + (trow + l15) * 512 + h * 128 + 4 * g;
    bf16_t* Y = (bf16_t*)(ws + WS_Y) + (trow + l15) * D + (KIND ? 1536 : 512) + h * 128 + 4 * g;
    f32x4 acc[2][8];
#pragma unroll
    for (int rt = 0; rt < 2; ++rt)
#pragma unroll
        for (int vt = 0; vt < 8; ++vt) acc[rt][vt] = (f32x4){0.f, 0.f, 0.f, 0.f};
    float ea[2] = {1.f, 1.f}, eb[2] = {0.f, 0.f}, inv[2] = {1.f, 1.f};
    f32x4 ov[2][8];
#pragma unroll
    for (int rt = 0; rt < 2; ++rt)
#pragma unroll
        for (int vt = 0; vt < 8; ++vt) ov[rt][vt] = *(const f32x4*)(OUT + (size_t)(16 * rt) * 512 + 16 * vt);
    __builtin_amdgcn_sched_barrier(0);
    if (seg > 0) {
        const bf16_t* SIB = (const bf16_t*)(ws + WS_SIB) + (size_t)((KIND * 16 + bh) * NSEG + seg) * 16384;
        const bf16_t* QTS = (const bf16_t*)(ws + (KIND ? WS_QTL : WS_QTG)) + ((size_t)bh * SEQ + 32 * rb + l15) * DK + 8 * g;
        bf16x8 qf[2][NKS];
#pragma unroll
        for (int rt = 0; rt < 2; ++rt)
#pragma unroll
            for (int ks = 0; ks < NKS; ++ks) qf[rt][ks] = *(const bf16x8*)(QTS + (size_t)(16 * rt) * DK + 32 * ks);
#pragma unroll
        for (int v2 = 0; v2 < 8; v2 += 2) {
            bf16x8 af[2][NKS];
#pragma unroll
            for (int vv = 0; vv < 2; ++vv)
#pragma unroll
                for (int ks = 0; ks < NKS; ++ks) af[vv][ks] = *(const bf16x8*)(SIB + (16 * (v2 + vv) + l15) * 128 + 32 * ks + 8 * g);
            __builtin_amdgcn_sched_barrier(0);
#pragma unroll
            for (int vv = 0; vv < 2; ++vv)
#pragma unroll
                for (int ks = 0; ks < NKS; ++ks)
#pragma unroll
                    for (int rt = 0; rt < 2; ++rt) acc[rt][v2 + vv] = __builtin_amdgcn_mfma_f32_16x16x32_bf16(af[vv][ks], qf[rt][ks], acc[rt][v2 + vv], 0, 0, 0);
        }
        if (KIND == 1) {
            const float* SIM = (const float*)(ws + WS_SIM) + (size_t)(bh * NSEG + seg) * 128;
            const float m_init = SIM[64];
            f32x4 nq[2] = {(f32x4){0.f, 0.f, 0.f, 0.f}, (f32x4){0.f, 0.f, 0.f, 0.f}};
#pragma unroll
            for (int ks = 0; ks < NKS; ++ks) { const f32x4 n0 = *(const f32x4*)(SIM + 32 * ks + 8 * g), n1 = *(const f32x4*)(SIM + 32 * ks + 8 * g + 4);
                const u32x4 nw = (u32x4){pk2(n0[0], n0[1]), pk2(n0[2], n0[3]), pk2(n1[0], n1[1]), pk2(n1[2], n1[3])}; const bf16x8 nfr = __builtin_bit_cast(bf16x8, nw);
#pragma unroll
                for (int rt = 0; rt < 2; ++rt) nq[rt] = __builtin_amdgcn_mfma_f32_16x16x32_bf16(nfr, qf[rt][ks], nq[rt], 0, 0, 0); }
#pragma unroll
            for (int rt = 0; rt < 2; ++rt) {
                const f32x4 sc = *(const f32x4*)((const float*)(ws + WS_SCL) + ((size_t)bh * SEQ + 32 * rb + 16 * rt + l15) * 4);
                const float mi = sc[2] + m_init, mp = fmaxf(sc[1], mi); ea[rt] = __expf(sc[1] - mp); eb[rt] = __expf(mi - mp);
                inv[rt] = rcpf_(fmaxf(fabsf(sc[0] * ea[rt] + nq[rt][0] * eb[rt]), __expf(-mp)));
            }
        }
    }
    u32x2 zv[2][8]; f32x4 gnv[8];
#pragma unroll
    for (int vt = 0; vt < 8; ++vt) { gnv[vt] = *(const f32x4*)(prm + 16 * vt);
#pragma unroll
        for (int rt = 0; rt < 2; ++rt) zv[rt][vt] = *(const u32x2*)(Zg + (size_t)(16 * rt) * NZ + 16 * vt); }
    __builtin_amdgcn_sched_barrier(0);
#pragma unroll
    for (int rt = 0; rt < 2; ++rt) {
        float ss = 0.f;
#pragma unroll
        for (int vt = 0; vt < 8; ++vt) {
            const f32x4 o = ov[rt][vt];
            if (KIND == 0) acc[rt][vt] += o; else acc[rt][vt] = (o * ea[rt] + acc[rt][vt] * eb[rt]) * inv[rt];
            ss += acc[rt][vt][0] * acc[rt][vt][0] + acc[rt][vt][1] * acc[rt][vt][1] + acc[rt][vt][2] * acc[rt][vt][2] + acc[rt][vt][3] * acc[rt][vt][3];
        }
        ss += bperm_f(lane ^ 16, ss); ss += bperm_f(lane ^ 32, ss);
        const float r = rsqrtf(ss * (1.f / 128.f) + EPS);
#pragma unroll
        for (int vt = 0; vt < 8; ++vt) {
            const u32x2 zw = zv[rt][vt]; const f32x4 gn = gnv[vt];
            const float z0 = bflo(zw[0]), z1 = bfhi(zw[0]), z2 = bflo(zw[1]), z3 = bfhi(zw[1]);
            const float s0 = sigmoidf_(z0), s1 = sigmoidf_(z1), s2 = sigmoidf_(z2), s3 = sigmoidf_(z3);
            const f32x4 a = acc[rt][vt];
            u32x2 wv; wv.x = pk2(a[0] * r * gn[0] * (KIND ? s0 : z0 * s0), a[1] * r * gn[1] * (KIND ? s1 : z1 * s1)); wv.y = pk2(a[2] * r * gn[2] * (KIND ? s2 : z2 * s2), a[3] * r * gn[3] * (KIND ? s3 : z3 * s3));
            *(u32x2*)(Y + (size_t)(16 * rt) * D + 16 * vt) = wv;
        }
    }
}
__device__ __forceinline__ void scan_norm(Frame& F, int l) {
#pragma unroll 1
    for (int u = F.bid; u < 256; u += F.G) {
        const int b = u >> 6, rb = u & 63, seg = rb / (64 / NSEG), h = F.wave >> 1;
        if (F.wave & 1) norm_unit<1>(F, l, b, h, rb, seg); else norm_unit<0>(F, l, b, h, rb, seg);
    }
}

__device__ __forceinline__ v32f_t ld_row6(const unsigned char* rowp, int lane) {
    const u32x4 a = *(const u32x4*)(rowp + lane * 16); const u32x2 b = *(const u32x2*)(rowp + 1024 + lane * 8);
    const v6u_t p = (v6u_t){a[0], a[1], a[2], a[3], b[0], b[1]};
    return __builtin_amdgcn_cvt_scalef32_pk32_f32_fp6(p, 1.0f);
}
__device__ __forceinline__ float sw32_add(float a, float b) { asm volatile("s_nop 1\n\tv_permlane32_swap_b32 %0, %1\n\ts_nop 1" : "+v"(a), "+v"(b)); return a + b; }
__device__ __forceinline__ float sw16_add(float a, float b) { asm volatile("s_nop 1\n\tv_permlane16_swap_b32 %0, %1\n\ts_nop 1" : "+v"(a), "+v"(b)); return a + b; }
__device__ __forceinline__ float reduce8(const float (&p)[8], int lane) {
    const float q0 = sw16_add(sw32_add(p[0], p[1]), sw32_add(p[2], p[3])), q1 = sw16_add(sw32_add(p[4], p[5]), sw32_add(p[6], p[7]));
    const float t0 = q0 + DPP_F(q0, 0x128), t1 = q1 + DPP_F(q1, 0x128);
    float t = (lane & 8) ? t1 : t0;
    t += DPP_F(t, 0xB1); t += DPP_F(t, 0x4E); t += DPP_F(t, 0x141);
    return t;
}
__device__ __forceinline__ void peer_gather(Frame& F, int l) {
    constexpr int NF = 16;
    unsigned char* ws = F.ws;
    const unsigned char* U4 = ws + WS_UB + (size_t)l * NEXP * VROW; const unsigned char* V4 = ws + WS_VB + (size_t)l * NEXP * VROW;
    const float* SU = (const float*)(ws + WS_SU) + l * NEXP; const float* SV = (const float*)(ws + WS_SV) + l * NEXP;
    const int* PIDX = (const int*)(ws + WS_PIDX); const float* PG = (const float*)(ws + WS_PGATE);
    bf16_t* HB = (bf16_t*)(ws + WS_HB) + (size_t)(l & 1) * T * D;
    const u64* ssqB = (const u64*)(ws + WS_CTL + CTL_SSQB) + l * T; float* ssqC = (float*)(ws + WS_CTL + CTL_SSQC) + l * T;
    const int lane = F.lane;
    LAS float* cl = (LAS float*)(F.lds + F.wave * 512);
    int emap;
    { float lab[8];
#pragma unroll
      for (int k = 0; k < 8; ++k) lab[k] = (float)k * (1.f / 64.f);
      emap = (int)(reduce8(lab, lane) + 0.5f); }
    for (int t = F.gw; t < T; t += F.ngw) {
        float x[32];
#pragma unroll
        for (int q = 0; q < 8; ++q) { const u32x2 w = *(const u32x2*)(HB + (size_t)t * D + q * 256 + lane * 4);
            x[4 * q] = bflo(w[0]); x[4 * q + 1] = bfhi(w[0]); x[4 * q + 2] = bflo(w[1]); x[4 * q + 3] = bfhi(w[1]); }
        const float rs = rsqrtf(ssq_get(ssqB + t) * (1.f / D) + EPS);
        const int myidx0 = PIDX[(size_t)t * 128 + lane], myidx1 = PIDX[(size_t)t * 128 + 64 + lane];
        const float mys0 = SU[myidx0] * rs, mys1 = SU[myidx1] * rs;
        const float myg0 = PG[(size_t)t * 128 + lane] * SV[myidx0], myg1 = PG[(size_t)t * 128 + 64 + lane] * SV[myidx1];
#pragma unroll 1
        for (int e0 = 0; e0 < 128; e0 += NF) {
            u32x4 uw[NF];
#pragma unroll
            for (int k = 0; k < NF; ++k) { const int e = e0 + k; const int idx = __builtin_amdgcn_readlane(e < 64 ? myidx0 : myidx1, e & 63); uw[k] = *(const u32x4*)(U4 + (size_t)idx * VROW + lane * 16); }
#pragma unroll
            for (int b8 = 0; b8 < NF / 8; ++b8) {
                float part[8];
#pragma unroll
                for (int k = 0; k < 8; ++k) {
                    const int kk = b8 * 8 + k; float s_ = 0.f;
#pragma unroll
                    for (int q2 = 0; q2 < 4; ++q2) {
                        const f32x2_t d0 = __builtin_amdgcn_cvt_scalef32_pk_f32_fp4(uw[kk][q2], 1.0f, 0), d1 = __builtin_amdgcn_cvt_scalef32_pk_f32_fp4(uw[kk][q2], 1.0f, 1);
                        const f32x2_t d2 = __builtin_amdgcn_cvt_scalef32_pk_f32_fp4(uw[kk][q2], 1.0f, 2), d3 = __builtin_amdgcn_cvt_scalef32_pk_f32_fp4(uw[kk][q2], 1.0f, 3);
                        s_ += x[8 * q2] * d0[0] + x[8 * q2 + 1] * d0[1] + x[8 * q2 + 2] * d1[0] + x[8 * q2 + 3] * d1[1] + x[8 * q2 + 4] * d2[0] + x[8 * q2 + 5] * d2[1] + x[8 * q2 + 6] * d3[0] + x[8 * q2 + 7] * d3[1];
                    }
                    part[k] = s_;
                    if (kk + 1 < NF) asm volatile("" : "+v"(uw[kk + 1]) : "v"(s_));
                }
                const float dot = reduce8(part, lane);
                const int eb = e0 + b8 * 8 + emap;
                const float pre = dot * bperm_f(eb & 63, e0 < 64 ? mys0 : mys1);
                const float act = 0.5f * pre * (1.f + erff(pre * 0.7071067811865476f));
                const float cf = act * bperm_f(eb & 63, e0 < 64 ? myg0 : myg1);
                if ((lane & 7) == 0) cl[eb] = cf;
            }
        }
        asm volatile("s_waitcnt lgkmcnt(0)" ::: "memory");
        const float c0 = cl[lane], c1 = cl[64 + lane];
        float y[32];
#pragma unroll
        for (int i = 0; i < 32; ++i) y[i] = 0.f;
#pragma unroll 1
        for (int e0 = 0; e0 < 128; e0 += NF) {
            u32x4 vw[NF];
#pragma unroll
            for (int k = 0; k < NF; ++k) { const int e = e0 + k; const int idx = __builtin_amdgcn_readlane(e < 64 ? myidx0 : myidx1, e & 63); vw[k] = *(const u32x4*)(V4 + (size_t)idx * VROW + lane * 16); }
#pragma unroll
            for (int k = 0; k < NF; ++k) {
                const int e = e0 + k; const float ce = rdlane_f(e < 64 ? c0 : c1, e & 63);
#pragma unroll
                for (int q2 = 0; q2 < 4; ++q2) {
                    const f32x2_t d0 = __builtin_amdgcn_cvt_scalef32_pk_f32_fp4(vw[k][q2], 1.0f, 0), d1 = __builtin_amdgcn_cvt_scalef32_pk_f32_fp4(vw[k][q2], 1.0f, 1);
                    const f32x2_t d2 = __builtin_amdgcn_cvt_scalef32_pk_f32_fp4(vw[k][q2], 1.0f, 2), d3 = __builtin_amdgcn_cvt_scalef32_pk_f32_fp4(vw[k][q2], 1.0f, 3);
                    y[8 * q2] += ce * d0[0]; y[8 * q2 + 1] += ce * d0[1]; y[8 * q2 + 2] += ce * d1[0]; y[8 * q2 + 3] += ce * d1[1];
                    y[8 * q2 + 4] += ce * d2[0]; y[8 * q2 + 5] += ce * d2[1]; y[8 * q2 + 6] += ce * d3[0]; y[8 * q2 + 7] += ce * d3[1];
                }
                if (k + 1 < NF) asm volatile("" : "+v"(vw[k + 1]) : "v"(y[0]), "v"(y[31]));
            }
        }
        float s2 = 0.f;
#pragma unroll
        for (int q = 0; q < 8; ++q) {
            const float v0 = x[4 * q] + y[4 * q], v1 = x[4 * q + 1] + y[4 * q + 1], v2 = x[4 * q + 2] + y[4 * q + 2], v3 = x[4 * q + 3] + y[4 * q + 3];
            *(u32x2*)(HB + (size_t)t * D + q * 256 + lane * 4) = (u32x2){pk2(v0, v1), pk2(v2, v3)};
            s2 += v0 * v0 + v1 * v1 + v2 * v2 + v3 * v3;
        }
        s2 = wave_sum(s2);
        if (lane == 0) ssqC[t] = s2;
    }
}

__device__ __forceinline__ void final_norm(Frame& F) {
    const Args& a = *F.a; unsigned char* ws = F.ws;
    const bf16_t* HB = (const bf16_t*)(ws + WS_HB) + (size_t)(DEPTH & 1) * T * D; const u64* ssq = (const u64*)(ws + WS_CTL + CTL_SSQA) + 4 * T; const float* g = (const float*)(ws + WS_PRM) + PRM_FIN;
    const int lane = F.lane;
    for (int t = F.gw; t < T; t += F.ngw) {
        const float rs = rsqrtf(ssq_get(ssq + t) * (1.f / D) + EPS);
#pragma unroll
        for (int c = 0; c < 4; ++c) { const size_t o = (size_t)t * D + c * 512 + lane * 8; const u32x4 hw = *(const u32x4*)(HB + o); const f32x4 g0 = *(const f32x4*)(g + c * 512 + lane * 8), g1 = *(const f32x4*)(g + c * 512 + lane * 8 + 4);
            *(f32x4*)(a.out + o) = (f32x4){bflo(hw[0]), bfhi(hw[0]), bflo(hw[1]), bfhi(hw[1])} * rs * g0; *(f32x4*)(a.out + o + 4) = (f32x4){bflo(hw[2]), bfhi(hw[2]), bflo(hw[3]), bfhi(hw[3])} * rs * g1; }
    }
}

constexpr int PH_PER_LAYER = 10, N_PHASES = 2 + DEPTH * PH_PER_LAYER;
template <int PH>
__device__ __forceinline__ void run_phase(Frame& F0, int l) {
    Frame F = F0; { int bid_ = blockIdx.x, wv_ = F0.wave; asm volatile("" : "+s"(bid_), "+s"(wv_));
      F.bid = bid_; F.wave = wv_; F.lane = lane_id_fresh(); F.tid = wv_ * 64 + F.lane; F.gw = bid_ * NWAVES + wv_;
      size_t z_ = 0; asm volatile("" : "+s"(z_)); F.ws = F0.ws + z_; }
    unsigned char* ws = F.ws;
    bf16_t* const HBc = (bf16_t*)(ws + WS_HB) + (size_t)(l & 1) * T * D; bf16_t* const HBn = (bf16_t*)(ws + WS_HB) + (size_t)((l + 1) & 1) * T * D;
    if constexpr (PH == 100) prologue(F);
    if constexpr (PH == 101) final_norm(F);
    if constexpr (PH == 0) {
        pg8::Gemm g{HBc, (const bf16_t*)(ws + WS_WIN) + (size_t)l * NZ * D, T, NZ, D, D, D}; pg8::StaticOrder S; S.init(T, NZ, F.G, F.bid);
        EpiZ E{(bf16_t*)(ws + WS_Z), (const u64*)(ws + WS_CTL + CTL_SSQA) + l * T, (u64*)(ws + WS_CTL + CTL_MQS) + l * T, (u64*)(ws + WS_CTL + CTL_MKVS) + l * T};
        pg8::gemm_phase<EpiZ, pg8::StaticOrder, true, true>(F.lds, g, S, E, F.wave);
    }
    if constexpr (PH == 1) {
        mix_prep(F, l);
        { pg8::Gemm g{(const bf16_t*)(ws + WS_Z) + ZC_MCQ, (const bf16_t*)(ws + WS_WUQ) + (size_t)l * 768 * 384, T, 768, 384, NZ, 384}; pg8::StaticOrder S; S.init(T, 768, F.G, F.bid);
          EpiBf16s E{(bf16_t*)(ws + WS_QM), 768, (const u64*)(ws + WS_CTL + CTL_MQS) + l * T, 1.f / 384.f};
          pg8::gemm_phase<EpiBf16s, pg8::StaticOrder, true, true>(F.lds, g, S, E, F.wave); }
        __syncthreads();
        { pg8::Gemm g{(const bf16_t*)(ws + WS_Z) + ZC_MCKV, (const bf16_t*)(ws + WS_WUKV) + (size_t)l * 1024 * 256, T, 1024, 256, NZ, 256}; pg8::StaticOrder S; S.init(T, 1024, F.G, (int)((F.bid + 128) % F.G));
          EpiBf16s E{(bf16_t*)(ws + WS_KVM), 1024, (const u64*)(ws + WS_CTL + CTL_MKVS) + l * T, 1.f / 256.f};
          pg8::gemm_phase<EpiBf16s, pg8::StaticOrder, true, true>(F.lds, g, S, E, F.wave); }
    }
    if constexpr (PH == 3) {
        if (F.bid < 32 * NSEG) { const int bhs = F.bid % (16 * NSEG), b = bhs / (4 * NSEG), h = (bhs / NSEG) & 3, seg = bhs % NSEG; if (F.bid < 16 * NSEG) scan_unit<0>(F, l, b, h, seg); else scan_unit<1>(F, l, b, h, seg); }
        {
            const bool conv_first = F.bid >= 256 - NCONVWG;
#pragma unroll 1
            for (int pass = 0; pass < 2; ++pass) {
                if (pass == 1 || conv_first) { __syncthreads(); convert_layer_queue(F, l, (unsigned*)(ws + WS_CTL + CTL_CVQ) + 64 * l); }
                if (pass == 0) attn_fast(F, l);
            }
        }
    }
    if constexpr (PH == 4) scan_norm(F, l);
    if constexpr (PH == 5) {
        pg8::Gemm g{(const bf16_t*)(ws + WS_Y), (const bf16_t*)(ws + WS_WOUT) + (size_t)l * D * D, T, D, D, D, D}; pg8::StaticOrder S; S.init(T, D, F.G, F.bid);
        EpiRes E{HBc, (u64*)(ws + WS_CTL + CTL_SSQB) + l * T};
        pg8::gemm_phase<EpiRes, pg8::StaticOrder, true, true>(F.lds, g, S, E, F.wave);
    }
    if constexpr (PH == 6) {
        { pg8::Gemm g{HBc, (const bf16_t*)(ws + WS_WQ) + (size_t)l * D * D, T, D, D, D, D}; pg8::StaticOrder S; S.init(T, D, F.G, F.bid);
          EpiBf16s E{(bf16_t*)(ws + WS_QB), D, (const u64*)(ws + WS_CTL + CTL_SSQB) + l * T, 1.f / D};
          pg8::gemm_phase<EpiBf16s, pg8::StaticOrder, true, true>(F.lds, g, S, E, F.wave);
          pg8::Unit u;
          if (S.next(0, u)) {
              asm volatile("s_waitcnt vmcnt(0)" ::: "memory"); __syncthreads();
              __builtin_amdgcn_fence(__ATOMIC_ACQUIRE, "agent"); asm volatile("s_waitcnt vmcnt(0)" ::: "memory");
              peer_topk_mfma(F.lds, F.wave, (const bf16_t*)(ws + WS_QB), (const bf16_t*)(ws + WS_SKB) + (size_t)l * 8 * 2 * 128 * 128, (int*)(ws + WS_PIDX), (float*)(ws + WS_PGATE), u.pm, u.pn);
          } }
        __syncthreads();
        { pg8::Gemm g{(const bf16_t*)(ws + WS_PB) + (size_t)l * T * PLE, (const bf16_t*)(ws + WS_WP) + (size_t)l * D * PLE, T, D, PLE, PLE, PLE}; pg8::StaticOrder S; S.init(T, D, F.G, F.bid);
          EpiBf16s E{(bf16_t*)(ws + WS_PR), D, nullptr, 0.f};
          pg8::gemm_phase<EpiBf16s, pg8::StaticOrder, true, true>(F.lds, g, S, E, F.wave); }
    }
    if constexpr (PH == 8) peer_gather(F, l);
    if constexpr (PH == 9) {
        pg8::Gemm g{HBc, (const bf16_t*)(ws + WS_WG) + (size_t)l * D * D, T, D, D, D, D}; pg8::StaticOrder S; S.init(T, D, F.G, F.bid);
        EpiPle E{HBc, HBn, (const bf16_t*)(ws + WS_PR), (const float*)(ws + WS_CTL + CTL_SSQC) + l * T, (u64*)(ws + WS_CTL + CTL_SSQA) + (l + 1) * T};
        pg8::gemm_phase<EpiPle, pg8::StaticOrder, true, true>(F.lds, g, S, E, F.wave);
    }
}
__global__ void __launch_bounds__(NTHREADS, 2) mega(Args args) {
    extern __shared__ __attribute__((aligned(16))) unsigned char lds_raw[];
    Frame F; F.lds = (LAS unsigned char*)lds_raw; F.ws = args.ws; F.a = &args;
    F.tid = threadIdx.x; F.lane = F.tid & 63; F.wave = __builtin_amdgcn_readfirstlane(F.tid >> 6); F.G = gridDim.x;
    F.gw = blockIdx.x * NWAVES + F.wave; F.ngw = F.G * NWAVES; F.bid = blockIdx.x;
    volatile LAS unsigned* misc = (volatile LAS unsigned*)(F.lds + MISC_OFF);
    if (F.tid < 32) misc[F.tid] = 0u;
    __syncthreads();
    (void)xcd_barrier_post((unsigned*)(args.ws + WS_CTL + CTL_BAR), misc + 8);
#define GRID_BAR() do { XcdBarrier b_; b_.bar = (unsigned*)(args.ws + WS_CTL + CTL_BAR); b_.x = xb_xcc_id(); b_.st = (volatile LAS unsigned*)(F.lds + MISC_OFF) + 8; xcd_barrier(b_, F.wave); } while (0)
    run_phase<100>(F, 0); GRID_BAR();
    for (int l = 0; l < DEPTH; ++l) {
        run_phase<0>(F, l); GRID_BAR();
        run_phase<1>(F, l); GRID_BAR();
        run_phase<3>(F, l); GRID_BAR();
        run_phase<4>(F, l); GRID_BAR();
        run_phase<5>(F, l); GRID_BAR();
        run_phase<6>(F, l); GRID_BAR();
        run_phase<8>(F, l); GRID_BAR();
        run_phase<9>(F, l); GRID_BAR();
    }
    run_phase<101>(F, 0);
#undef GRID_BAR
}

extern "C" void kernel_launch(void* const* d_in, const int* in_sizes, int n_in, void* d_out, int out_size, void* d_ws, size_t ws_size, hipStream_t stream) {
    static int grid = 0;
    if (grid == 0) {
        if (n_in != 28 || out_size != T * D || ws_size < WS_END) { fprintf(stderr, "kernel_launch: unexpected shapes (n_in %d out %d ws %zu need %zu)\n", n_in, out_size, ws_size, (size_t)WS_END); grid = -1; return; }
        if (hipFuncSetAttribute((const void*)mega, hipFuncAttributeMaxDynamicSharedMemorySize, LDS_BYTES) != hipSuccess) { fprintf(stderr, "kernel_launch: hipFuncSetAttribute failed\n"); grid = -1; return; }
        int dev = 0, cus = 0, per_cu = 0; (void)hipGetDevice(&dev); (void)hipDeviceGetAttribute(&cus, hipDeviceAttributeMultiprocessorCount, dev);
        if (hipOccupancyMaxActiveBlocksPerMultiprocessor(&per_cu, (const void*)mega, NTHREADS, LDS_BYTES) != hipSuccess || per_cu < 1) { fprintf(stderr, "kernel_launch: occupancy query says %d blocks per CU\n", per_cu); (void)hipGetLastError(); }
        grid = cus > 0 ? cus : 256;
    }
    if (grid < 0) return;
    (void)hipMemsetAsync((char*)d_ws + WS_CTL, 0, CTL_BYTES, stream);
    Args a{};
    for (int i = 0; i < 28; ++i) a.in[i] = (const float*)d_in[i];
    a.out = (float*)d_out; a.ws = (unsigned char*)d_ws;
    hipLaunchKernelGGL(mega, dim3(grid), dim3(NTHREADS), LDS_BYTES, stream, a);
}
```

```cpp
#include <hip/hip_runtime.h>
#include <cstdio>
#include <cstdint>

#define GAS __attribute__((address_space(1)))
#define LAS __attribute__((address_space(3)))
typedef unsigned short bf16_t;
typedef short bf16x8 __attribute__((ext_vector_type(8)));
typedef float f32x4 __attribute__((ext_vector_type(4)));
typedef unsigned u32x4 __attribute__((ext_vector_type(4)));
typedef unsigned u32x2 __attribute__((ext_vector_type(2)));
typedef float f32x2_t __attribute__((ext_vector_type(2)));
typedef float v16f_t __attribute__((ext_vector_type(16)));
typedef float v32f_t __attribute__((ext_vector_type(32)));
typedef unsigned v6u_t __attribute__((ext_vector_type(6)));
constexpr int EROW = 1536;
constexpr int VROW = 1024;

constexpr int D = 2048, BATCH = 4, SEQ = 2048, T = BATCH * SEQ, DEPTH = 4, PLE = 256;
constexpr int IN_COLS = 5832, NZ = 5888;
constexpr int ZC_DQ = 0, ZC_DK = 512, ZC_DV = 1024, ZC_GQ = 1536, ZC_GF = 2048, ZC_GV = 2560, ZC_GG = 3072, ZC_MCQ = 3584, ZC_MCKV = 3968, ZC_MKR = 4224,
              ZC_LQ = 4288, ZC_LK = 4544, ZC_LV = 4800, ZC_LO = 5312, ZC_LI = 5824, ZC_LF = 5828;
constexpr int NEXP = 16384;
constexpr float EPS = 1e-6f;
constexpr int NWAVES = 8, NTHREADS = 512;

constexpr size_t MiB = 1u << 20;
constexpr size_t al(size_t x) { return (x + 255) & ~(size_t)255; }
constexpr size_t WS_CTL = 0, CTL_BYTES = 2 * MiB;
constexpr size_t CTL_BAR = 0;
constexpr size_t CTL_CVQ = 32 * 1024;
constexpr size_t CTL_SSQA = 64 * 1024;
constexpr size_t CTL_SSQB = CTL_SSQA + 5 * T * 8;
constexpr size_t CTL_MQS = CTL_SSQB + 4 * T * 8;
constexpr size_t CTL_MKVS = CTL_MQS + 4 * T * 8;
constexpr size_t CTL_SSQC = CTL_MKVS + 4 * T * 8;
static_assert(CTL_SSQC + 4 * T * 4 <= 1536 * 1024, "ctl");
constexpr size_t WS_WIN = CTL_BYTES;
constexpr size_t WS_WOUT = WS_WIN + al((size_t)DEPTH * NZ * D * 2);
constexpr size_t WS_WQ = WS_WOUT + al((size_t)DEPTH * D * D * 2);
constexpr size_t WS_WG = WS_WQ + al((size_t)DEPTH * D * D * 2);
constexpr size_t WS_WP = WS_WG + al((size_t)DEPTH * D * D * 2);
constexpr size_t WS_WUQ = WS_WP + al((size_t)DEPTH * D * PLE * 2);
constexpr size_t WS_WUKV = WS_WUQ + al((size_t)DEPTH * 768 * 384 * 2);
constexpr size_t WS_UB = WS_WUKV + al((size_t)DEPTH * 1024 * 256 * 2);
constexpr size_t WS_VB = WS_UB + al((size_t)DEPTH * NEXP * D * 2);
constexpr size_t WS_PB = WS_VB + al((size_t)DEPTH * NEXP * D * 2);
constexpr size_t WS_CS = WS_PB + al((size_t)DEPTH * T * PLE * 2);
constexpr size_t WS_LBS = WS_CS + al((size_t)T * 32 * 2 * 4);
constexpr size_t WS_H = WS_LBS + al((size_t)DEPTH * 512 * 4);
constexpr size_t WS_HB = WS_H + al((size_t)T * D * 4);
constexpr size_t WS_Z = WS_HB + 2 * al((size_t)T * D * 2);
constexpr size_t WS_QM = WS_Z + al((size_t)T * NZ * 2);
constexpr size_t WS_KVM = WS_QM + al((size_t)T * 768 * 2);
constexpr size_t WS_KRM = WS_KVM + al((size_t)T * 1024 * 2);
constexpr size_t WS_Y = WS_KRM + al((size_t)T * 64 * 2);
constexpr size_t WS_QP = WS_Y + al((size_t)T * D * 2);
constexpr size_t WS_QB = WS_QP;
constexpr size_t WS_PR = WS_QP + al((size_t)T * D * 4);
constexpr size_t WS_PIDX = WS_PR + al((size_t)T * D * 4);
constexpr size_t WS_PGATE = WS_PIDX + al((size_t)T * 128 * 4);
constexpr size_t WS_GQ = WS_PGATE + al((size_t)T * 128 * 4);
constexpr size_t WS_GK = WS_GQ + al((size_t)T * 512 * 4);
constexpr size_t WS_GF = WS_GK + al((size_t)T * 512 * 4);
constexpr size_t WS_OG = WS_GF + al((size_t)T * 512 * 4);
constexpr size_t WS_LQK = WS_OG + al((size_t)T * 512 * 4);
constexpr size_t WS_LIF = WS_LQK + al((size_t)T * 512 * 4);
constexpr size_t WS_OL = WS_LIF + al((size_t)T * 8 * 4);
constexpr size_t WS_O1 = WS_OL + al((size_t)T * 512 * 4);
constexpr size_t WS_PRM = WS_O1 + al((size_t)T * 512 * 4);
constexpr int PRM_L = 4608, PRM_CW = 0, PRM_CB = 2048, PRM_GB = 2560, PRM_DL = 2576, PRM_DN = 2832, PRM_HN = 3344, PRM_MN = 3856, PRM_FIN = DEPTH * PRM_L;
constexpr size_t WS_SKB = WS_PRM + al((size_t)(PRM_FIN + D) * 4);
constexpr size_t WS_SU = WS_SKB + al((size_t)DEPTH * 8 * 2 * 128 * 128 * 2);
constexpr size_t WS_SV = WS_SU + al((size_t)DEPTH * NEXP * 4);
constexpr int NSEG = 2, SEGC = SEQ / 64 / NSEG, NCONVWG = 64;
constexpr size_t WS_QTG = WS_SV + al((size_t)DEPTH * NEXP * 4);
constexpr size_t WS_QTL = WS_QTG + al((size_t)16 * SEQ * 128 * 2);
constexpr size_t WS_SCL = WS_QTL + al((size_t)16 * SEQ * 64 * 2);
constexpr size_t WS_SIB = WS_SCL + al((size_t)16 * SEQ * 4 * 4);
constexpr size_t WS_SIF = WS_SIB + al((size_t)2 * 16 * NSEG * 128 * 128 * 2);
constexpr size_t WS_SIM = WS_SIF + al((size_t)2 * 16 * NSEG * 128 * 128 * 4);
constexpr size_t WS_END = WS_SIM + al((size_t)16 * NSEG * 128 * 4);
constexpr size_t CTL_SEGF = 1536 * 1024;
static_assert(CTL_SEGF + DEPTH * 2 * 16 * NSEG * 64 <= CTL_BYTES, "ctl segf");

typedef float f32x2v_t __attribute__((ext_vector_type(2)));
typedef __bf16 bf16x2v_t __attribute__((ext_vector_type(2)));
__device__ __forceinline__ unsigned pk2(float lo, float hi) { const bf16x2v_t r = __builtin_convertvector((f32x2v_t){lo, hi}, bf16x2v_t); return __builtin_bit_cast(unsigned, r); }
__device__ __forceinline__ unsigned f2bf(float f) { return pk2(f, 0.f) & 0xffffu; }
__device__ __forceinline__ float bf2f(unsigned short b) { return __builtin_bit_cast(float, ((unsigned)b) << 16); }
__device__ __forceinline__ float bflo(unsigned w) { return __builtin_bit_cast(float, w << 16); }
__device__ __forceinline__ float bfhi(unsigned w) { return __builtin_bit_cast(float, w & 0xffff0000u); }
#define DPP_F(v, ctrl) __builtin_bit_cast(float, __builtin_amdgcn_update_dpp(0, __builtin_bit_cast(int, (v)), (ctrl), 0xF, 0xF, false))
__device__ __forceinline__ float rdlane_f(float v, int l) { return __builtin_bit_cast(float, __builtin_amdgcn_readlane(__builtin_bit_cast(int, v), l)); }
__device__ __forceinline__ float wave_sum(float v) {
    v += DPP_F(v, 0xB1); v += DPP_F(v, 0x4E); v += DPP_F(v, 0x141); v += DPP_F(v, 0x140);
    return (rdlane_f(v, 0) + rdlane_f(v, 16)) + (rdlane_f(v, 32) + rdlane_f(v, 48));
}
__device__ __forceinline__ float wave_max(float v) {
    v = fmaxf(v, DPP_F(v, 0xB1)); v = fmaxf(v, DPP_F(v, 0x4E)); v = fmaxf(v, DPP_F(v, 0x141)); v = fmaxf(v, DPP_F(v, 0x140));
    return fmaxf(fmaxf(rdlane_f(v, 0), rdlane_f(v, 16)), fmaxf(rdlane_f(v, 32), rdlane_f(v, 48)));
}
__device__ __forceinline__ int bperm_i(int src, int v) { return __builtin_amdgcn_ds_bpermute(src << 2, v); }
__device__ __forceinline__ float bperm_f(int src, float v) { return __builtin_bit_cast(float, __builtin_amdgcn_ds_bpermute(src << 2, __builtin_bit_cast(int, v))); }
typedef unsigned long long u64;
__device__ __forceinline__ int lane_id_fresh() { int l; asm volatile("v_mbcnt_lo_u32_b32 %0, -1, 0\n\tv_mbcnt_hi_u32_b32 %0, -1, %0" : "=v"(l)); return l; }
__device__ __forceinline__ void ssq_add(u64* p, float s) { atomicAdd(p, (u64)(s * 16777216.f)); }
__device__ __forceinline__ float ssq_get(const u64* p) { return (float)(*p) * (1.f / 16777216.f); }
__device__ __forceinline__ float rcpf_(float x) { return __builtin_amdgcn_rcpf(x); }
__device__ __forceinline__ float sigmoidf_(float x) { return rcpf_(1.f + __expf(-x)); }

namespace pg8 {
constexpr int BM = 256, BK = 64, HALF = 128, HTB = HALF * BK * 2, STAGE_BYTES = 8 * HTB, NXCD = 8, WGM = 8;
__host__ __device__ __forceinline__ int lds_byte(int r, int c) { const int st = (r >> 4) * 2 + (c >> 5), rr = r & 15, cc = c & 31, ob = rr * 64 + cc * 2; return st * 1024 + (ob ^ (((ob >> 9) & 1) << 5)); }
__host__ __device__ __forceinline__ void stage_rc(int b, int& R, int& C) { const int st = b / 1024, sb = b % 1024, swz = sb ^ (((sb >> 9) & 1) << 5); R = (st >> 1) * 16 + swz / 64; C = (st & 1) * 32 + (swz % 64) / 2; }
__host__ __device__ __forceinline__ int perm32(int rho) { const int n = rho >> 4, i = rho & 15; return 8 * (i >> 2) + 4 * n + (i & 3); }
struct Unit { int pm, pn; };
struct Gemm { const bf16_t* A; const bf16_t* Bt; int M, N, K, lda, ldb; };
struct StaticOrder {
    int nM, nN, nwg, G, c;
    __host__ __device__ void init(int M, int N, int G_, int c_) { nM = M / BM; nN = N / BM; nwg = nM * nN; G = G_; c = c_; }
    __host__ __device__ bool next(int i, Unit& u) const {
        const long L = (long)i * G + c; if (L >= nwg) return false;
        int wgid = (int)L; { const int q = nwg / NXCD, r = nwg % NXCD, xcd = wgid % NXCD, off = wgid / NXCD; wgid = (xcd < r ? xcd * (q + 1) : r * (q + 1) + (xcd - r) * q) + off; }
        const int nig = WGM * nN, gid = wgid / nig, fm = gid * WGM, gsz = (nM - fm) < WGM ? (nM - fm) : WGM;
        u.pm = fm + ((wgid % nig) % gsz); u.pn = (wgid % nig) / gsz; return true;
    }
    __device__ __forceinline__ void a_ready(const Unit&) const {}
    __device__ __forceinline__ void done(const Unit&) const {}
};
template <class Epi, class Sched, bool ALIGN_EPI = false, bool SP2 = false>
__device__ __forceinline__ void gemm_phase(LAS unsigned char* lds, const Gemm g, const Sched& S, const Epi& E, int wave_s) {
    const int tid = wave_s * 64 + lane_id_fresh(), wid = wave_s, lane = tid & 63, wr = wid >> 2, wc = wid & 3, fr = lane & 15, fq = lane >> 4;
    const int K = g.K, nt = K / BK;
    unsigned voffA[2], voffB[2];
#pragma unroll
    for (int i = 0; i < 2; ++i) { int R, C; stage_rc(tid * 16 + i * 8192, R, C); const int Rb = Epi::PERM ? ((R & ~31) + perm32(R & 31)) : R;
        voffA[i] = (unsigned)(R * g.lda + C) * 2u; voffB[i] = (unsigned)(Rb * g.ldb + C) * 2u; }
    const size_t kstep = (size_t)(BK * 2);
    const size_t hstepA = (size_t)HALF * g.lda * 2, hstepB = (size_t)HALF * g.ldb * 2;
    const size_t tstepA = 2 * hstepA, tstepB = 2 * hstepB;
    const unsigned ldsw = (unsigned)wid * 1024u;
    const int aoff = lds_byte(wr * 64 + fr, fq * 8), boff = lds_byte(wc * 32 + fr, fq * 8);
#define PG8_SA(b, h) (((b) * 2 + (h)) * HTB)
#define PG8_SB(b, h) ((4 + (b) * 2 + (h)) * HTB)
#define PG8_STAGE(bufoff, gbase, voff) do { _Pragma("unroll") for (int _i = 0; _i < 2; ++_i) \
        __builtin_amdgcn_global_load_lds((const unsigned*)((const char*)(gbase) + (voff)[_i]), (LAS unsigned*)(lds + (bufoff) + ldsw + _i * 8192), 16, 0, 0); } while (0)
#define PG8_LDA(dst, b, h) do { _Pragma("unroll") for (int m = 0; m < 4; ++m) _Pragma("unroll") for (int k = 0; k < 2; ++k) dst[m][k] = *(const LAS bf16x8*)(lds + PG8_SA(b, h) + aoff + m * 2048 + k * 1024); } while (0)
#define PG8_LDB(dst, b, h) do { _Pragma("unroll") for (int n = 0; n < 2; ++n) _Pragma("unroll") for (int k = 0; k < 2; ++k) dst[n][k] = *(const LAS bf16x8*)(lds + PG8_SB(b, h) + boff + n * 2048 + k * 1024); } while (0)
#define PG8_MMA(ai, bj, At, Bt) do { __builtin_amdgcn_s_setprio(1); _Pragma("unroll") for (int m = 0; m < 4; ++m) _Pragma("unroll") for (int n = 0; n < 2; ++n) _Pragma("unroll") for (int k = 0; k < 2; ++k) \
        acc[ai][bj][m][n] = __builtin_amdgcn_mfma_f32_16x16x32_bf16(Bt[n][k], At[m][k], acc[ai][bj][m][n], 0, 0, 0); __builtin_amdgcn_s_setprio(0); } while (0)
#define PG8_WAIT_V(n) asm volatile("s_waitcnt vmcnt(" #n ")" ::: "memory")
#define PG8_WAIT_L(n) asm volatile("s_waitcnt lgkmcnt(" #n ")" ::: "memory")
#define PG8_BAR __builtin_amdgcn_s_barrier()
#define PG8_SCHED __builtin_amdgcn_sched_barrier(0)
    Unit cur, nxt; int ui = 0;
    if (!S.next(0, cur)) return;
    f32x4 acc[2][2][4][2];
#pragma unroll
    for (int a = 0; a < 2; ++a)
#pragma unroll
        for (int b = 0; b < 2; ++b)
#pragma unroll
            for (int m = 0; m < 4; ++m)
#pragma unroll
                for (int n = 0; n < 2; ++n) acc[a][b][m][n] = (f32x4){0.f, 0.f, 0.f, 0.f};
    bf16x8 At[4][2], B0[2][2], B1[2][2];
    const char* cA = (const char*)g.A + (size_t)cur.pm * tstepA; const char* cB = (const char*)g.Bt + (size_t)cur.pn * tstepB;
    S.a_ready(cur);
    if constexpr (SP2) {
        PG8_STAGE(PG8_SB(0, 0), cB, voffB); PG8_STAGE(PG8_SB(0, 1), cB + hstepB, voffB); PG8_STAGE(PG8_SA(0, 0), cA, voffA); PG8_STAGE(PG8_SA(0, 1), cA + hstepA, voffA);
        if (wr == 1) PG8_BAR;
        PG8_WAIT_V(2); PG8_BAR;
        PG8_STAGE(PG8_SB(1, 0), cB + kstep, voffB); PG8_STAGE(PG8_SA(1, 0), cA + kstep, voffA); PG8_STAGE(PG8_SB(1, 1), cB + hstepB + kstep, voffB);
        PG8_WAIT_V(6); PG8_BAR;
    } else {
        PG8_STAGE(PG8_SB(0, 0), cB, voffB); PG8_STAGE(PG8_SA(0, 0), cA, voffA); PG8_STAGE(PG8_SB(0, 1), cB + hstepB, voffB); PG8_STAGE(PG8_SA(0, 1), cA + hstepA, voffA);
        if (wr == 1) PG8_BAR;
        PG8_WAIT_V(4); PG8_BAR;
        PG8_STAGE(PG8_SB(1, 0), cB + kstep, voffB); PG8_STAGE(PG8_SA(1, 0), cA + kstep, voffA); PG8_STAGE(PG8_SB(1, 1), cB + hstepB + kstep, voffB);
        PG8_WAIT_V(6); PG8_BAR;
    }
    for (;;) {
        const bool has_next = S.next(ui + 1, nxt);
        const char* nA = has_next ? (const char*)g.A + (size_t)nxt.pm * tstepA : cA; const char* nB = has_next ? (const char*)g.Bt + (size_t)nxt.pn * tstepB : cB;
        for (int t = 0; t < nt; t += 2) {
            const bool last = (t == nt - 2);
            const char* a1 = cA + (size_t)(t + 1) * kstep;
            const char* a2 = last ? nA : cA + (size_t)(t + 2) * kstep; const char* b2 = last ? nB : cB + (size_t)(t + 2) * kstep;
            const char* a3 = a2 + kstep; const char* b3 = b2 + kstep;
            if (last && has_next) S.a_ready(nxt);
            if constexpr (SP2) {
            PG8_LDB(B0, 0, 0); PG8_LDB(B1, 0, 1); PG8_SCHED; PG8_LDA(At, 0, 0); PG8_STAGE(PG8_SA(1, 1), a1 + hstepA, voffA);
            PG8_WAIT_V(8); PG8_WAIT_L(0); PG8_BAR; PG8_MMA(0, 0, At, B0); PG8_MMA(0, 1, At, B1); PG8_BAR; PG8_SCHED;
            PG8_LDA(At, 0, 1); PG8_STAGE(PG8_SB(0, 0), b2, voffB); PG8_STAGE(PG8_SB(0, 1), b2 + hstepB, voffB); PG8_STAGE(PG8_SA(0, 0), a2, voffA);
            PG8_WAIT_V(8); PG8_WAIT_L(0); PG8_BAR; PG8_MMA(1, 0, At, B0); PG8_MMA(1, 1, At, B1); PG8_BAR; PG8_SCHED;
            PG8_LDB(B0, 1, 0); PG8_LDB(B1, 1, 1); PG8_SCHED; PG8_LDA(At, 1, 0); PG8_STAGE(PG8_SA(0, 1), a2 + hstepA, voffA);
            PG8_WAIT_V(8); PG8_WAIT_L(0); PG8_BAR; PG8_MMA(0, 0, At, B0); PG8_MMA(0, 1, At, B1); PG8_BAR; PG8_SCHED;
            PG8_LDA(At, 1, 1); PG8_STAGE(PG8_SB(1, 0), b3, voffB); PG8_STAGE(PG8_SB(1, 1), b3 + hstepB, voffB); PG8_STAGE(PG8_SA(1, 0), a3, voffA);
            PG8_WAIT_V(8); PG8_WAIT_L(0); PG8_BAR; PG8_MMA(1, 0, At, B0); PG8_MMA(1, 1, At, B1); PG8_BAR; PG8_SCHED;
            } else {
            PG8_LDB(B0, 0, 0); PG8_SCHED; PG8_LDA(At, 0, 0); PG8_STAGE(PG8_SA(1, 1), a1 + hstepA, voffA);
            PG8_WAIT_L(8); PG8_BAR; PG8_WAIT_L(0); PG8_MMA(0, 0, At, B0); PG8_BAR; PG8_SCHED;
            PG8_LDB(B1, 0, 1); PG8_STAGE(PG8_SB(0, 0), b2, voffB);
            PG8_BAR; PG8_WAIT_L(0); PG8_MMA(0, 1, At, B1); PG8_BAR;
            PG8_LDA(At, 0, 1); PG8_STAGE(PG8_SA(0, 0), a2, voffA);
            PG8_BAR; PG8_WAIT_L(0); PG8_MMA(1, 0, At, B0); PG8_BAR; PG8_SCHED;
            PG8_STAGE(PG8_SB(0, 1), b2 + hstepB, voffB);
            PG8_WAIT_V(6); PG8_BAR; PG8_MMA(1, 1, At, B1); PG8_BAR;
            PG8_LDB(B0, 1, 0); PG8_SCHED; PG8_LDA(At, 1, 0); PG8_STAGE(PG8_SA(0, 1), a2 + hstepA, voffA);
            PG8_WAIT_L(8); PG8_BAR; PG8_WAIT_L(0); PG8_MMA(0, 0, At, B0); PG8_BAR; PG8_SCHED;
            PG8_LDB(B1, 1, 1); PG8_STAGE(PG8_SB(1, 0), b3, voffB);
            PG8_BAR; PG8_WAIT_L(0); PG8_MMA(0, 1, At, B1); PG8_BAR;
            PG8_LDA(At, 1, 1); PG8_STAGE(PG8_SA(1, 0), a3, voffA);
            PG8_BAR; PG8_WAIT_L(0); PG8_MMA(1, 0, At, B0); PG8_BAR; PG8_SCHED;
            PG8_STAGE(PG8_SB(1, 1), b3 + hstepB, voffB);
            PG8_WAIT_V(6); PG8_BAR; PG8_MMA(1, 1, At, B1); PG8_BAR;
            }
        }
        if constexpr (ALIGN_EPI) { if (wr == 0) PG8_BAR; }
        if constexpr (!Epi::AFTER_DRAIN) { E(acc, cur, wr, wc, fr, fq); S.done(cur); }
        if (!has_next) break;
#pragma unroll
        for (int a = 0; a < 2; ++a)
#pragma unroll
            for (int b = 0; b < 2; ++b)
#pragma unroll
                for (int m = 0; m < 4; ++m)
#pragma unroll
                    for (int n = 0; n < 2; ++n) acc[a][b][m][n] = (f32x4){0.f, 0.f, 0.f, 0.f};
        cur = nxt; cA = nA; cB = nB; ++ui;
        if constexpr (ALIGN_EPI) { if (wr == 1) PG8_BAR; }
    }
    PG8_WAIT_V(0);
    if constexpr (!ALIGN_EPI) { if (wr == 0) PG8_BAR; }
    PG8_BAR;
    if constexpr (Epi::AFTER_DRAIN) { E.fused(acc, cur, wr, wc, fr, fq, lds, wid, lane); S.done(cur); }
#undef PG8_SA
#undef PG8_SB
#undef PG8_STAGE
#undef PG8_LDA
#undef PG8_LDB
#undef PG8_MMA
#undef PG8_WAIT_V
#undef PG8_WAIT_L
#undef PG8_BAR
#undef PG8_SCHED
}
}

#define EPI_ROWS(ai, m) (u.pm * 256 + (ai) * 128 + wr * 64 + (m) * 16 + fr)
#define EPI_COL0 (u.pn * 256 + wc * 32 + 8 * fq)
typedef const f32x4 (&AccT)[2][2][4][2];

__device__ __forceinline__ float fq_sum(float v, int lane) { v += bperm_f(lane ^ 16, v); v += bperm_f(lane ^ 32, v); return v; }

struct EpiZ {
    static constexpr bool PERM = true, AFTER_DRAIN = false;
    bf16_t* Z; const u64* ssq; u64* mqs; u64* mkvs;
    __device__ __forceinline__ void operator()(AccT acc, const pg8::Unit& u, int wr, int wc, int fr, int fq) const {
        const int col0 = EPI_COL0;
#pragma unroll
        for (int ai = 0; ai < 2; ++ai)
#pragma unroll
            for (int m = 0; m < 4; ++m) {
                const int row = EPI_ROWS(ai, m); const float rs = rsqrtf(ssq_get(ssq + row) * (1.f / D) + EPS);
                float sq = 0.f, skv = 0.f;
#pragma unroll
                for (int bj = 0; bj < 2; ++bj) {
                    const f32x4 v0 = acc[ai][bj][m][0] * rs, v1 = acc[ai][bj][m][1] * rs;
                    u32x4 w; w.x = pk2(v0[0], v0[1]); w.y = pk2(v0[2], v0[3]); w.z = pk2(v1[0], v1[1]); w.w = pk2(v1[2], v1[3]);
                    *(u32x4*)(Z + (size_t)row * NZ + col0 + bj * 128) = w;
                    const float s2 = v0[0] * v0[0] + v0[1] * v0[1] + v0[2] * v0[2] + v0[3] * v0[3] + v1[0] * v1[0] + v1[1] * v1[1] + v1[2] * v1[2] + v1[3] * v1[3];
                    const int cb = u.pn * 256 + bj * 128;
                    if (cb >= ZC_MCQ && cb < ZC_MCKV) sq += s2;
                    if (cb >= ZC_MCKV && cb < ZC_MKR) skv += s2;
                }
                if (u.pn >= 14 && u.pn <= 16) {
                    sq = fq_sum(sq, fr + 16 * fq); skv = fq_sum(skv, fr + 16 * fq);
                    if (fq == 0) { if (u.pn <= 15) ssq_add(mqs + row, sq); if (u.pn >= 15) ssq_add(mkvs + row, skv); }
                }
            }
    }
};
struct EpiBf16s {
    static constexpr bool PERM = true, AFTER_DRAIN = false;
    bf16_t* O; int ldo; const u64* ssq; float inv_n;
    __device__ __forceinline__ void operator()(AccT acc, const pg8::Unit& u, int wr, int wc, int fr, int fq) const {
        const int col0 = EPI_COL0;
#pragma unroll
        for (int ai = 0; ai < 2; ++ai)
#pragma unroll
            for (int m = 0; m < 4; ++m) {
                const int row = EPI_ROWS(ai, m); const float rs = ssq ? rsqrtf(ssq_get(ssq + row) * inv_n + EPS) : 1.f;
#pragma unroll
                for (int bj = 0; bj < 2; ++bj) {
                    const f32x4 v0 = acc[ai][bj][m][0] * rs, v1 = acc[ai][bj][m][1] * rs;
                    u32x4 w; w.x = pk2(v0[0], v0[1]); w.y = pk2(v0[2], v0[3]); w.z = pk2(v1[0], v1[1]); w.w = pk2(v1[2], v1[3]);
                    *(u32x4*)(O + (size_t)row * ldo + col0 + bj * 128) = w;
                }
            }
    }
};
struct EpiRes {
    static constexpr bool PERM = true, AFTER_DRAIN = false;
    bf16_t* HB; u64* ssq;
    __device__ __forceinline__ void operator()(AccT acc, const pg8::Unit& u, int wr, int wc, int fr, int fq) const {
        const int col0 = EPI_COL0;
#pragma unroll
        for (int ai = 0; ai < 2; ++ai)
#pragma unroll
            for (int m = 0; m < 4; ++m) {
                const int row = EPI_ROWS(ai, m); float s2 = 0.f;
#pragma unroll
                for (int bj = 0; bj < 2; ++bj) {
                    bf16_t* hp = HB + (size_t)row * D + col0 + bj * 128;
                    const u32x4 hw = *(const u32x4*)hp;
                    const f32x4 v0 = (f32x4){bflo(hw[0]), bfhi(hw[0]), bflo(hw[1]), bfhi(hw[1])} + acc[ai][bj][m][0], v1 = (f32x4){bflo(hw[2]), bfhi(hw[2]), bflo(hw[3]), bfhi(hw[3])} + acc[ai][bj][m][1];
                    u32x4 w; w.x = pk2(v0[0], v0[1]); w.y = pk2(v0[2], v0[3]); w.z = pk2(v1[0], v1[1]); w.w = pk2(v1[2], v1[3]);
                    *(u32x4*)hp = w;
                    s2 += v0[0] * v0[0] + v0[1] * v0[1] + v0[2] * v0[2] + v0[3] * v0[3] + v1[0] * v1[0] + v1[1] * v1[1] + v1[2] * v1[2] + v1[3] * v1[3];
                }
                s2 = fq_sum(s2, fr + 16 * fq);
                if (fq == 0) ssq_add(ssq + row, s2);
            }
    }
};
struct EpiF32s {
    static constexpr bool PERM = true, AFTER_DRAIN = false;
    float* C; const u64* ssq;
    __device__ __forceinline__ void operator()(AccT acc, const pg8::Unit& u, int wr, int wc, int fr, int fq) const {
        const int col0 = EPI_COL0;
#pragma unroll
        for (int ai = 0; ai < 2; ++ai)
#pragma unroll
            for (int m = 0; m < 4; ++m) {
                const int row = EPI_ROWS(ai, m); const float rs = ssq ? rsqrtf(ssq_get(ssq + row) * (1.f / D) + EPS) : 1.f;
#pragma unroll
                for (int bj = 0; bj < 2; ++bj) {
                    float* cp = C + (size_t)row * D + col0 + bj * 128;
                    *(f32x4*)cp = acc[ai][bj][m][0] * rs; *(f32x4*)(cp + 4) = acc[ai][bj][m][1] * rs;
                }
            }
    }
};
struct EpiPle {
    static constexpr bool PERM = true, AFTER_DRAIN = false;
    const bf16_t* HBin; bf16_t* HBout; const bf16_t* PR; const float* ssq_in; u64* ssq_out;
    __device__ __forceinline__ void operator()(AccT acc, const pg8::Unit& u, int wr, int wc, int fr, int fq) const {
        const int col0 = EPI_COL0;
#pragma unroll
        for (int ai = 0; ai < 2; ++ai)
#pragma unroll
            for (int m = 0; m < 4; ++m) {
                const int row = EPI_ROWS(ai, m); const float rs = rsqrtf(ssq_in[row] * (1.f / D) + EPS); float s2 = 0.f;
#pragma unroll
                for (int bj = 0; bj < 2; ++bj) {
                    const size_t o = (size_t)row * D + col0 + bj * 128;
                    const u32x4 hw = *(const u32x4*)(HBin + o), pw = *(const u32x4*)(PR + o);
                    f32x4 v0 = (f32x4){bflo(hw[0]), bfhi(hw[0]), bflo(hw[1]), bfhi(hw[1])}, v1 = (f32x4){bflo(hw[2]), bfhi(hw[2]), bflo(hw[3]), bfhi(hw[3])};
                    const f32x4 p0 = (f32x4){bflo(pw[0]), bfhi(pw[0]), bflo(pw[1]), bfhi(pw[1])}, p1 = (f32x4){bflo(pw[2]), bfhi(pw[2]), bflo(pw[3]), bfhi(pw[3])};
#pragma unroll
                    for (int j = 0; j < 4; ++j) { v0[j] += sigmoidf_(acc[ai][bj][m][0][j] * rs) * p0[j]; v1[j] += sigmoidf_(acc[ai][bj][m][1][j] * rs) * p1[j]; }
                    u32x4 w; w.x = pk2(v0[0], v0[1]); w.y = pk2(v0[2], v0[3]); w.z = pk2(v1[0], v1[1]); w.w = pk2(v1[2], v1[3]);
                    *(u32x4*)(HBout + o) = w;
                    s2 += v0[0] * v0[0] + v0[1] * v0[1] + v0[2] * v0[2] + v0[3] * v0[3] + v1[0] * v1[0] + v1[1] * v1[1] + v1[2] * v1[2] + v1[3] * v1[3];
                }
                s2 = fq_sum(s2, fr + 16 * fq);
                if (fq == 0) ssq_add(ssq_out + row, s2);
            }
    }
};

__device__ __forceinline__ int f2ord(float f) { const int b = __builtin_bit_cast(int, f); return b >= 0 ? b : (b ^ 0x7FFFFFFF); }
__device__ __forceinline__ float ord2f(int k) { const int b = k >= 0 ? k : (k ^ 0x7FFFFFFF); return __builtin_bit_cast(float, b); }
__device__ __forceinline__ int row16_max(int v) {
    v = max(v, __builtin_amdgcn_update_dpp(v, v, 0xB1, 0xF, 0xF, false)); v = max(v, __builtin_amdgcn_update_dpp(v, v, 0x4E, 0xF, 0xF, false));
    v = max(v, __builtin_amdgcn_update_dpp(v, v, 0x141, 0xF, 0xF, false)); v = max(v, __builtin_amdgcn_update_dpp(v, v, 0x140, 0xF, 0xF, false));
    return v;
}
__device__ __forceinline__ float row16_sum(float v) {
    v += __builtin_bit_cast(float, __builtin_amdgcn_update_dpp(0, __builtin_bit_cast(int, v), 0xB1, 0xF, 0xF, false)); v += __builtin_bit_cast(float, __builtin_amdgcn_update_dpp(0, __builtin_bit_cast(int, v), 0x4E, 0xF, 0xF, false));
    v += __builtin_bit_cast(float, __builtin_amdgcn_update_dpp(0, __builtin_bit_cast(int, v), 0x141, 0xF, 0xF, false)); v += __builtin_bit_cast(float, __builtin_amdgcn_update_dpp(0, __builtin_bit_cast(int, v), 0x140, 0xF, 0xF, false));
    return v;
}
__device__ __forceinline__ void peer_topk_mfma(LAS unsigned char* lds, int wid, const bf16_t* QB, const bf16_t* SKB, int* PIDX, float* PG, int pm, int pn) {
    constexpr int SQL = 272, L_SK = 0;
    const int lane = lane_id_fresh(), tid = wid * 64 + lane, l15 = lane & 15, g = lane >> 4;
    int tk[2][2][4];
#pragma unroll
    for (int c = 0; c < 2; ++c) {
        const bf16_t* sk = SKB + ((size_t)(pn * 2 + c) * 128) * 128;
#pragma unroll
        for (int i = 0; i < 4; ++i) { const int id = tid + 512 * i, n = id >> 4, dc = id & 15; *(LAS u32x4*)(lds + L_SK + n * SQL + dc * 16) = *(const u32x4*)(sk + n * 128 + dc * 8); }
        bf16x8 af[2][4];
#pragma unroll
        for (int rt = 0; rt < 2; ++rt)
#pragma unroll
            for (int ks = 0; ks < 4; ++ks) af[rt][ks] = *(const bf16x8*)(QB + (size_t)(pm * 256 + 32 * wid + 16 * rt + l15) * D + pn * 256 + c * 128 + 32 * ks + 8 * g);
        __syncthreads();
        int key[2][8][4];
#pragma unroll
        for (int nt = 0; nt < 8; ++nt) {
            f32x4 sc0 = (f32x4){0.f, 0.f, 0.f, 0.f}, sc1 = (f32x4){0.f, 0.f, 0.f, 0.f};
#pragma unroll
            for (int ks = 0; ks < 4; ++ks) {
                const bf16x8 bfr = *(const LAS bf16x8*)(lds + L_SK + (16 * nt + l15) * SQL + (32 * ks + 8 * g) * 2);
                sc0 = __builtin_amdgcn_mfma_f32_16x16x32_bf16(af[0][ks], bfr, sc0, 0, 0, 0);
                sc1 = __builtin_amdgcn_mfma_f32_16x16x32_bf16(af[1][ks], bfr, sc1, 0, 0, 0);
            }
#pragma unroll
            for (int r = 0; r < 4; ++r) { key[0][nt][r] = (f2ord(sc0[r]) & ~127) | (127 - (16 * nt + l15)); key[1][nt][r] = (f2ord(sc1[r]) & ~127) | (127 - (16 * nt + l15)); }
        }
        __syncthreads();
#pragma unroll
        for (int rt = 0; rt < 2; ++rt)
#pragma unroll
            for (int r = 0; r < 4; ++r) {
#define SK_(i) key[rt][i][r]
#define CE_(i, j) do { const int hi_ = max(SK_(i), SK_(j)), lo_ = min(SK_(i), SK_(j)); SK_(i) = hi_; SK_(j) = lo_; } while (0)
                CE_(0, 1); CE_(2, 3); CE_(4, 5); CE_(6, 7); CE_(0, 2); CE_(1, 3); CE_(4, 6); CE_(5, 7); CE_(1, 2); CE_(5, 6);
                CE_(0, 4); CE_(1, 5); CE_(2, 6); CE_(3, 7); CE_(2, 4); CE_(3, 5); CE_(1, 2); CE_(3, 4); CE_(5, 6);
                int mine = 0;
#pragma unroll 1
                for (int k = 0; k < 16; ++k) {
                    const int v = row16_max(SK_(0));
                    if (l15 == k) mine = v;
                    const bool won = (SK_(0) == v);
#pragma unroll
                    for (int nt = 0; nt < 7; ++nt) SK_(nt) = won ? SK_(nt + 1) : SK_(nt);
                    SK_(7) = won ? (int)0x80000000 : SK_(7);
                }
#undef CE_
#undef SK_
                tk[c][rt][r] = mine;
            }
    }
    int ci_[4], cj_[4]; bool cv_[4];
    ci_[0] = 0; cj_[0] = l15; cv_[0] = true;
    ci_[1] = l15 < 8 ? 1 : (l15 < 13 ? 2 : 3); cj_[1] = l15 < 8 ? l15 : (l15 < 13 ? l15 - 8 : l15 - 13); cv_[1] = true;
    ci_[2] = l15 == 0 ? 3 : (l15 < 4 ? 4 : (l15 < 6 ? 5 : (l15 < 8 ? 6 : (l15 < 10 ? 7 : l15 - 2))));
    cj_[2] = l15 == 0 ? 3 : (l15 < 4 ? l15 - 1 : (l15 < 6 ? l15 - 4 : (l15 < 8 ? l15 - 6 : (l15 < 10 ? l15 - 8 : 0)))); cv_[2] = true;
    ci_[3] = 14 + (l15 & 1); cj_[3] = 0; cv_[3] = l15 < 2;
#pragma unroll
    for (int rt = 0; rt < 2; ++rt)
#pragma unroll
        for (int r = 0; r < 4; ++r) {
            int ck[4];
#pragma unroll
            for (int q = 0; q < 4; ++q) {
                const float s0 = ord2f(bperm_i((lane & 48) + ci_[q], tk[0][rt][r]) & ~127), s1 = ord2f(bperm_i((lane & 48) + cj_[q], tk[1][rt][r]) & ~127);
                ck[q] = cv_[q] ? ((f2ord(s0 + s1) & ~255) | (255 - (16 * ci_[q] + cj_[q]))) : (int)0x80000000;
            }
            int mine = 0;
            for (int k = 0; k < 16; ++k) {
                int v = max(max(ck[0], ck[1]), max(ck[2], ck[3]));
                v = row16_max(v);
                if (l15 == k) mine = v;
#pragma unroll
                for (int q = 0; q < 4; ++q) ck[q] = (ck[q] == v) ? (int)0x80000000 : ck[q];
            }
            const int pos = 255 - (mine & 255), ci = pos >> 4, cj = pos & 15;
            const int i0 = 127 - (bperm_i((lane & 48) + ci, tk[0][rt][r]) & 127), i1 = 127 - (bperm_i((lane & 48) + cj, tk[1][rt][r]) & 127);
            const float bv = ord2f(mine & ~255), b0 = ord2f(bperm_i(lane & 48, mine) & ~255);
            const float ex = __expf(bv - b0), sum = row16_sum(ex);
            const size_t o = (size_t)(pm * 256 + 32 * wid + 16 * rt + 4 * g + r) * 128 + pn * 16 + l15;
            PIDX[o] = i0 * 128 + i1; PG[o] = ex * rcpf_(sum);
        }
}

#define XB_TMO      128
#define XB_XCNT(j)  (256  + 64 * (j))
#define XB_XSUB(j)  (1280 + 64 * (j))
#define XB_XGEN(j)  (2304 + 64 * (j))
#define XB_TOP      3328
#define XB_TOPGEN   3392
#define XCD_BAR_WORDS 3456
#define XB_SPIN_CAP (1u << 18)
__device__ __forceinline__ unsigned xb_ld(unsigned* p)              { return __hip_atomic_load(p, __ATOMIC_RELAXED, __HIP_MEMORY_SCOPE_AGENT); }
__device__ __forceinline__ unsigned xb_add(unsigned* p, unsigned v) { return __hip_atomic_fetch_add(p, v, __ATOMIC_RELAXED, __HIP_MEMORY_SCOPE_AGENT); }
__device__ __forceinline__ unsigned xb_xcc_id() { return (unsigned)__builtin_amdgcn_s_getreg((3 << 11) | 20) & 0xFu; }
#define XB_SPIN(cond, bar) do { unsigned _sp = 0; while (cond) { __builtin_amdgcn_s_sleep(1); \
    if ((++_sp & 255u) == 0u) { if (xb_ld(&(bar)[XB_TMO])) break; if (_sp > XB_SPIN_CAP) { atomicAdd(&(bar)[XB_TMO], 1u); break; } } } } while (0)
struct XcdBarrier { unsigned* bar; unsigned x; volatile LAS unsigned* st; };
__device__ __forceinline__ XcdBarrier xcd_barrier_post(unsigned* bar, volatile LAS unsigned* st) {
    XcdBarrier b; b.bar = bar; b.x = xb_xcc_id(); b.st = st;
    if (threadIdx.x == 0) (void)xb_add(&bar[XB_XCNT(b.x)], 1u);
    return b;
}
__device__ __forceinline__ void xcd_barrier_complete(unsigned* bar, unsigned x, unsigned& nloc, unsigned& nx) {
    const unsigned G = gridDim.x * gridDim.y * gridDim.z;
    unsigned sum, cnt, mine, sp = 0u;
    for (;;) {
        sum = 0u; cnt = 0u; mine = 0u;
#pragma unroll
        for (unsigned j = 0; j < 16; ++j) { const unsigned c = xb_ld(&bar[XB_XCNT(j)]); sum += c; cnt += (c > 0u) ? 1u : 0u; mine = (j == x) ? c : mine; }
        if (sum == G) break;
        __builtin_amdgcn_s_sleep(1);
        if ((++sp & 255u) == 0u) { if (xb_ld(&bar[XB_TMO])) break; if (sp > XB_SPIN_CAP) { atomicAdd(&bar[XB_TMO], 1u); break; } }
    }
    nloc = mine > 0u ? mine : 1u; nx = cnt > 0u ? cnt : 1u;
}
__device__ __forceinline__ void xcd_barrier(const XcdBarrier& b, int wave_s) {
    asm volatile("s_waitcnt vmcnt(0)" ::: "memory");
    __syncthreads();
    if (wave_s == 0 && lane_id_fresh() == 0) {
        unsigned* bar = b.bar;
        __builtin_amdgcn_s_waitcnt(0);
        unsigned nloc = b.st[0], nx = b.st[1];
        if (nloc == 0u) { xcd_barrier_complete(bar, b.x, nloc, nx); b.st[0] = nloc; b.st[1] = nx; }
        const unsigned old = xb_add(&bar[XB_XSUB(b.x)], 1u);
        const unsigned gen = old / nloc;
        if (old + 1u == (gen + 1u) * nloc) {
            __builtin_amdgcn_fence(__ATOMIC_RELEASE, "agent");
            asm volatile("s_waitcnt vmcnt(0)" ::: "memory");
            const unsigned og = xb_add(&bar[XB_TOP], 1u);
            const unsigned tg = og / nx;
            if (og + 1u == (tg + 1u) * nx) xb_add(&bar[XB_TOPGEN], 1u);
            else XB_SPIN(xb_ld(&bar[XB_TOPGEN]) == tg, bar);
            __builtin_amdgcn_fence(__ATOMIC_ACQUIRE, "agent");
            xb_add(&bar[XB_XGEN(b.x)], 1u);
            asm volatile("s_waitcnt vmcnt(0)" ::: "memory");
        } else {
            XB_SPIN(xb_ld(&bar[XB_XGEN(b.x)]) == gen, bar);
            __builtin_amdgcn_fence(__ATOMIC_ACQUIRE, "agent");
            asm volatile("s_waitcnt vmcnt(0)" ::: "memory");
        }
    }
    __syncthreads();
}

constexpr int RING_BYTES = 131072, MISC_OFF = RING_BYTES + 320, LDS_BYTES = 147456;
struct Args { const float* in[28]; float* out; unsigned char* ws; int ph_lo, ph_hi; };
enum { I_X = 0, I_P, I_POS, I_LN_MIX, I_W_IN, I_DIFF_LAMBDA, I_DIFF_NORM, I_HGRN_LB, I_HGRN_NORM, I_MLA_QN, I_MLA_KVN, I_MLA_WUQ, I_MLA_WUKV, I_CONV_W, I_CONV_B, I_GATE_B,
       I_MLSTM_NORM, I_GROUP_GAIN, I_W_OUT, I_LN_FFN, I_PEER_WQ, I_PEER_SUBKEYS, I_PEER_U, I_PEER_V, I_LN_PLE, I_PLE_WGATE, I_PLE_WPROJ, I_LN_FINAL };

struct Frame {
    LAS unsigned char* lds; unsigned char* ws; const Args* a;
    int tid, lane, wave, G, gw, ngw, bid;
};

__device__ __forceinline__ int cmap_win(int n) {
    if (n < ZC_MKR) return n;
    if (n < ZC_LQ) { const int j = n - ZC_MKR; return ZC_MKR + (j >> 1) + 32 * (j & 1); }
    if (n < ZC_LO) return n;
    if (n < ZC_LI) return 5320 + (n - ZC_LO);
    if (n < ZC_LF) return 5312 + (n - ZC_LI);
    if (n < IN_COLS) return 5316 + (n - ZC_LF);
    return -1;
}
__device__ __forceinline__ int cmap_uq(int n) { const int hd = n / 192, r = n % 192; if (r < 128) return n; const int j = r - 128; return hd * 192 + 128 + (j >> 1) + 32 * (j & 1); }

template <int MAP>
__device__ __forceinline__ void transpose_item(const float* W, int K, int Nsrc, int Ndst, const float* gain, bf16_t* WT, LAS float* scr_, int item, int lane) {
    LAS unsigned char* scr = (LAS unsigned char*)scr_;
    const int nblk = Ndst / 64, kb = item / nblk, nb = item % nblk, k0 = 64 * kb, n0 = 64 * nb;
    const int nq = (lane & 15) * 4, kr = lane >> 4;
    if (MAP == 0 || (MAP == 1 && (n0 + 64 <= ZC_MKR || (n0 >= ZC_LQ && n0 + 64 <= ZC_LO)))) {
        f32x4 tv[16]; float gk[16];
#pragma unroll
        for (int i = 0; i < 16; ++i) tv[i] = *(const f32x4*)(W + (size_t)(k0 + kr + 4 * i) * Nsrc + n0 + nq);
        if (gain) {
#pragma unroll
            for (int i = 0; i < 16; ++i) gk[i] = gain[k0 + kr + 4 * i];
        } else {
#pragma unroll
            for (int i = 0; i < 16; ++i) gk[i] = 1.f;
        }
#pragma unroll
        for (int i = 0; i < 16; ++i) { const int kk = kr + 4 * i; const f32x4 v = tv[i] * gk[i];
#pragma unroll
            for (int e = 0; e < 4; ++e) *(LAS bf16_t*)(scr + (nq + e) * 144 + kk * 2) = (bf16_t)f2bf(v[e]); }
    } else {
        int src[4];
#pragma unroll
        for (int e = 0; e < 4; ++e) src[e] = (MAP == 1) ? cmap_win(n0 + nq + e) : cmap_uq(n0 + nq + e);
        const int s0 = src[0] > 0 ? src[0] : 0, s1 = src[1] > 0 ? src[1] : 0, s2 = src[2] > 0 ? src[2] : 0, s3 = src[3] > 0 ? src[3] : 0;
        float ts[16][4], gk[16];
#pragma unroll
        for (int i = 0; i < 16; ++i) { const float* wr = W + (size_t)(k0 + kr + 4 * i) * Nsrc; ts[i][0] = wr[s0]; ts[i][1] = wr[s1]; ts[i][2] = wr[s2]; ts[i][3] = wr[s3]; }
        if (gain) {
#pragma unroll
            for (int i = 0; i < 16; ++i) gk[i] = gain[k0 + kr + 4 * i];
        } else {
#pragma unroll
            for (int i = 0; i < 16; ++i) gk[i] = 1.f;
        }
#pragma unroll
        for (int i = 0; i < 16; ++i) { const int kk = kr + 4 * i;
#pragma unroll
            for (int e = 0; e < 4; ++e) { const float v = (src[e] >= 0) ? ts[i][e] * gk[i] : 0.f; *(LAS bf16_t*)(scr + (nq + e) * 144 + kk * 2) = (bf16_t)f2bf(v); } }
    }
    asm volatile("s_waitcnt lgkmcnt(0)" ::: "memory");
#pragma unroll
    for (int j = 0; j < 8; ++j) { const int n = (lane >> 3) + 8 * j, c = lane & 7; *(u32x4*)(WT + (size_t)(n0 + n) * K + k0 + 8 * c) = *(const LAS u32x4*)(scr + n * 144 + c * 16); }
    asm volatile("s_waitcnt lgkmcnt(0)" ::: "memory");
}

constexpr int CV_TAB = 4096, CV_WIN = CV_TAB + 736, CV_WOUT = CV_WIN + 256, CV_WQ = CV_WOUT + 256, CV_WG = CV_WQ + 256, CV_WP = CV_WG + 32, CV_UQ = CV_WP + 18, CV_UKV = CV_UQ + 16,
              CV_P = CV_UKV + 128, NCONV = CV_P + 16;
__device__ __forceinline__ bool conv_early(int item) { return (item >= CV_TAB && item < CV_WIN) || (item >= CV_WP && item < CV_UKV); }
__device__ __forceinline__ void convert_item(Frame& F, int l, int item, int lane) {
    const Args& a = *F.a; unsigned char* ws = F.ws;
    LAS float* scr = (LAS float*)(F.lds + F.wave * 16384);
    if (item < CV_TAB) {
        const int tab = item >> 11, r0 = l * NEXP + (item & 2047) * 8;
        const float* SRC = a.in[tab ? I_PEER_V : I_PEER_U]; unsigned char* DST = ws + (tab ? WS_VB : WS_UB); float* SC = (float*)(ws + (tab ? WS_SV : WS_SU));
        const float* gF = a.in[I_LN_FFN] + l * D;
        f32x4 gv[8];
#pragma unroll
        for (int q = 0; q < 8; ++q) { gv[q] = (f32x4){1.f, 1.f, 1.f, 1.f}; if (tab == 0) gv[q] = *(const f32x4*)(gF + q * 256 + lane * 4); }
        float mysc = 1.f;
        f32x4 nx[2][8];
#pragma unroll
        for (int k = 0; k < 2; ++k)
#pragma unroll
            for (int q = 0; q < 8; ++q) nx[k][q] = *(const f32x4*)(SRC + (size_t)(r0 + k) * D + q * 256 + lane * 4);
#pragma unroll
        for (int rr = 0; rr < 8; ++rr) {
            const int row = r0 + rr; f32x4 v[8]; float am = 0.f;
#pragma unroll
            for (int q = 0; q < 8; ++q) v[q] = nx[rr & 1][q];
            if (rr + 2 < 8) {
#pragma unroll
                for (int q = 0; q < 8; ++q) nx[rr & 1][q] = *(const f32x4*)(SRC + (size_t)(row + 2) * D + q * 256 + lane * 4);
            }
#pragma unroll
            for (int q = 0; q < 8; ++q) {
                v[q] *= gv[q];
                am = fmaxf(am, fmaxf(fmaxf(fabsf(v[q][0]), fabsf(v[q][1])), fmaxf(fabsf(v[q][2]), fabsf(v[q][3]))));
            }
            am = wave_max(am);
            const float sc = am > 0.f ? am * (1.f / 6.f) : 1.f, inv = 1.f / sc;
            u32x4 pk;
#pragma unroll
            for (int q2 = 0; q2 < 4; ++q2) { unsigned w = 0;
                w = __builtin_amdgcn_cvt_scalef32_pk_fp4_f32(w, v[2 * q2][0] * inv, v[2 * q2][1] * inv, 1.0f, 0);
                w = __builtin_amdgcn_cvt_scalef32_pk_fp4_f32(w, v[2 * q2][2] * inv, v[2 * q2][3] * inv, 1.0f, 1);
                w = __builtin_amdgcn_cvt_scalef32_pk_fp4_f32(w, v[2 * q2 + 1][0] * inv, v[2 * q2 + 1][1] * inv, 1.0f, 2);
                w = __builtin_amdgcn_cvt_scalef32_pk_fp4_f32(w, v[2 * q2 + 1][2] * inv, v[2 * q2 + 1][3] * inv, 1.0f, 3);
                pk[q2] = w; }
            *(u32x4*)(DST + (size_t)row * VROW + lane * 16) = pk;
            mysc = (lane == rr) ? sc : mysc;
        }
        if (lane < 8) SC[r0 + lane] = mysc;
        return;
    }
#define CV_TR(MAP, base, WI, GI, K_, NS_, ND_, WSOFF) do { const int i0_ = (item - (base)) * 4; const float* W_ = a.in[WI] + (size_t)l * (K_) * (NS_); const float* g_ = (GI) >= 0 ? a.in[(GI) >= 0 ? (GI) : 0] + l * (K_) : nullptr; \
        bf16_t* WT_ = (bf16_t*)(ws + (WSOFF)) + (size_t)l * (ND_) * (K_); _Pragma("unroll 1") for (int j_ = 0; j_ < 4; ++j_) if (i0_ + j_ < ((K_) / 64) * ((ND_) / 64)) transpose_item<MAP>(W_, K_, NS_, ND_, g_, WT_, scr, i0_ + j_, lane); } while (0)
    if (item < CV_WIN) { CV_TR(1, CV_TAB, I_W_IN, I_LN_MIX, D, IN_COLS, NZ, WS_WIN); return; }
    if (item < CV_WOUT) { CV_TR(0, CV_WIN, I_W_OUT, I_GROUP_GAIN, D, D, D, WS_WOUT); return; }
    if (item < CV_WQ) { CV_TR(0, CV_WOUT, I_PEER_WQ, I_LN_FFN, D, D, D, WS_WQ); return; }
    if (item < CV_WG) { CV_TR(0, CV_WQ, I_PLE_WGATE, I_LN_PLE, D, D, D, WS_WG); return; }
    if (item < CV_WP) { CV_TR(0, CV_WG, I_PLE_WPROJ, -1, PLE, D, D, WS_WP); return; }
    if (item < CV_UQ) { CV_TR(2, CV_WP, I_MLA_WUQ, I_MLA_QN, 384, 768, 768, WS_WUQ); return; }
    if (item < CV_UKV) { CV_TR(0, CV_UQ, I_MLA_WUKV, I_MLA_KVN, 256, 1024, 1024, WS_WUKV); return; }
#undef CV_TR
    if (item < CV_P) {
        const size_t e0 = (size_t)l * T * PLE + (size_t)(item - CV_UKV) * 16384; const float* Pp = a.in[I_P]; bf16_t* PB = (bf16_t*)(ws + WS_PB);
#pragma unroll 4
        for (int i = 0; i < 32; ++i) { const size_t e = e0 + (size_t)i * 512 + lane * 8; const f32x4 v0 = *(const f32x4*)(Pp + e), v1 = *(const f32x4*)(Pp + e + 4);
            u32x4 w; w.x = pk2(v0[0], v0[1]); w.y = pk2(v0[2], v0[3]); w.z = pk2(v1[0], v1[1]); w.w = pk2(v1[2], v1[3]); *(u32x4*)(PB + e) = w; }
        return;
    }
    {
        const size_t e0 = (size_t)l * 8 * 2 * 128 * 128 + (size_t)(item - CV_P) * 16384; const float* sk = a.in[I_PEER_SUBKEYS]; bf16_t* skb = (bf16_t*)(ws + WS_SKB);
#pragma unroll 4
        for (int i = 0; i < 32; ++i) { const size_t e = e0 + (size_t)i * 512 + lane * 8; const f32x4 v0 = *(const f32x4*)(sk + e), v1 = *(const f32x4*)(sk + e + 4);
            u32x4 w; w.x = pk2(v0[0], v0[1]); w.y = pk2(v0[2], v0[3]); w.z = pk2(v1[0], v1[1]); w.w = pk2(v1[2], v1[3]); *(u32x4*)(skb + e) = w; }
    }
}
__device__ __forceinline__ void convert_layers(Frame& F, int l0, int l1, int gw, int NGW, bool early_only) {
    const int lane = lane_id_fresh();
    for (int l = l0; l < l1; ++l)
#pragma unroll 1
        for (int it = gw; it < NCONV; it += NGW) if (!early_only || conv_early(it)) convert_item(F, l, it, lane);
}
__device__ __forceinline__ void convert_layer_queue(Frame& F, int l, unsigned* ctr) {
    const int lane = lane_id_fresh();
#pragma unroll 1
    for (;;) {
        unsigned it = 0;
        if (lane == 0) it = __hip_atomic_fetch_add(ctr, 1u, __ATOMIC_RELAXED, __HIP_MEMORY_SCOPE_AGENT);
        it = __builtin_amdgcn_readfirstlane(it);
        if (it >= (unsigned)NCONV) break;
        const int ll = conv_early((int)it) ? l + 1 : l;
        if (ll < DEPTH) convert_item(F, ll, (int)it, lane);
    }
}

__device__ __forceinline__ void prologue(Frame& F) {
    const Args& a = *F.a; unsigned char* ws = F.ws;
    const int gw = F.gw, NGW = F.ngw, lane = F.lane;
    const size_t gt = (size_t)blockIdx.x * NTHREADS + F.tid, GT = (size_t)F.G * NTHREADS;
    if (F.G == 256) convert_layers(F, 0, 1, gw, NGW, true);
    else convert_layers(F, 0, DEPTH, gw, NGW, false);
    {
        const float* X = a.in[I_X]; bf16_t* HB = (bf16_t*)(ws + WS_HB); u64* ssq = (u64*)(ws + WS_CTL + CTL_SSQA);
        for (int t = gw; t < T; t += NGW) {
            float s2 = 0.f;
#pragma unroll
            for (int c = 0; c < 4; ++c) {
                const size_t o = (size_t)t * D + c * 512 + lane * 8;
                const f32x4 v0 = *(const f32x4*)(X + o), v1 = *(const f32x4*)(X + o + 4);
                u32x4 w; w.x = pk2(v0[0], v0[1]); w.y = pk2(v0[2], v0[3]); w.z = pk2(v1[0], v1[1]); w.w = pk2(v1[2], v1[3]);
                *(u32x4*)(HB + o) = w;
                s2 += v0[0] * v0[0] + v0[1] * v0[1] + v0[2] * v0[2] + v0[3] * v0[3] + v1[0] * v1[0] + v1[1] * v1[1] + v1[2] * v1[2] + v1[3] * v1[3];
            }
            s2 = wave_sum(s2);
            if (lane == 0) ssq[t] = (u64)(s2 * 16777216.f);
        }
    }
    {
        const int* pos = (const int*)a.in[I_POS]; float* cs = (float*)(ws + WS_CS);
        for (size_t i = gt; i < (size_t)T * 32; i += GT) {
            const int t = (int)(i / 32), j = (int)(i % 32);
            const float inv = powf(10000.0f, -(float)j / 32.0f);
            const float ang = (float)pos[t] * inv;
            const double rev = (double)ang * 0.15915494309189535;
            const float fr = (float)(rev - rint(rev));
            cs[i * 2] = __builtin_amdgcn_cosf(fr); cs[i * 2 + 1] = __builtin_amdgcn_sinf(fr);
        }
    }
    {
        float* prm = (float*)(ws + WS_PRM);
#define PRM_COPY(IDX, OFF, N) do { const float* src_ = a.in[IDX]; for (size_t i = gt; i < (size_t)DEPTH * (N); i += GT) { const int l_ = (int)(i / (N)), o_ = (int)(i % (N)); prm[l_ * PRM_L + (OFF) + o_] = src_[i]; } } while (0)
        PRM_COPY(I_CONV_W, PRM_CW, 2048); PRM_COPY(I_CONV_B, PRM_CB, 512); PRM_COPY(I_GATE_B, PRM_GB, 8); PRM_COPY(I_DIFF_LAMBDA, PRM_DL, 256);
        PRM_COPY(I_DIFF_NORM, PRM_DN, 512); PRM_COPY(I_HGRN_NORM, PRM_HN, 512); PRM_COPY(I_MLSTM_NORM, PRM_MN, 512);
#undef PRM_COPY
        for (size_t i = gt; i < (size_t)D; i += GT) prm[PRM_FIN + i] = a.in[I_LN_FINAL][i];
    }
    if (blockIdx.x == 0) {
        const float* lg = a.in[I_HGRN_LB]; float* lbs = (float*)(ws + WS_LBS);
        for (int c = F.tid; c < 512; c += NTHREADS) {
            float v[DEPTH], mx = -1e30f;
#pragma unroll
            for (int l = 0; l < DEPTH; ++l) { v[l] = lg[l * 512 + c]; mx = fmaxf(mx, v[l]); }
            float s = 0.f;
#pragma unroll
            for (int l = 0; l < DEPTH; ++l) { v[l] = expf(v[l] - mx); s += v[l]; }
            float cum = 0.f; float first = 0.f;
#pragma unroll
            for (int l = 0; l < DEPTH; ++l) { cum += v[l] / s; if (l == 0) first = cum; lbs[l * 512 + c] = cum - first; }
        }
    }
}

__device__ __forceinline__ void mix_prep(Frame& F, int l) {
    unsigned char* ws = F.ws;
    const bf16_t* Z = (const bf16_t*)(ws + WS_Z);
    const size_t gt = (size_t)F.bid * NTHREADS + F.tid, GT = (size_t)F.G * NTHREADS;
    bf16_t* KR = (bf16_t*)(ws + WS_KRM); const float* cs = (const float*)(ws + WS_CS);
    for (size_t i = gt; i < (size_t)T * 32; i += GT) {
        const int t = (int)(i / 32), j = (int)(i % 32);
        const float x1 = bf2f(Z[(size_t)t * NZ + ZC_MKR + 2 * j]), x2 = bf2f(Z[(size_t)t * NZ + ZC_MKR + 2 * j + 1]);
        const float c = cs[i * 2], sn = cs[i * 2 + 1];
        *(unsigned*)(KR + (size_t)t * 64 + 2 * j) = pk2(x1 * c - x2 * sn, x2 * c + x1 * sn);
    }
}

typedef float f32x16 __attribute__((ext_vector_type(16)));
typedef short s16x4 __attribute__((ext_vector_type(4)));
__device__ __forceinline__ int crow(int r, int hi) { return (r & 3) + 8 * (r >> 2) + 4 * hi; }
template <int OFF> __device__ __forceinline__ s16x4 tr_read(unsigned addr) { s16x4 r; asm volatile("ds_read_b64_tr_b16 %0, %1 offset:%2" : "=&v"(r) : "v"(addr), "i"(OFF) : "memory"); return r; }
constexpr int ATT_SV = 320;
template <int D0, int BLK, int KS> __device__ __forceinline__ bf16x8 v_frag(unsigned vaddr) {
    const s16x4 lo = tr_read<(32 * BLK + 16 * KS) * ATT_SV + 64 * D0>(vaddr), hi = tr_read<(32 * BLK + 16 * KS + 8) * ATT_SV + 64 * D0>(vaddr);
    return (bf16x8){lo[0], lo[1], lo[2], lo[3], hi[0], hi[1], hi[2], hi[3]};
}
__device__ __forceinline__ bf16x8 pack8(const f32x16& p, int base) {
    u32x4 w; w.x = pk2(p[base + 0], p[base + 1]); w.y = pk2(p[base + 2], p[base + 3]); w.z = pk2(p[base + 4], p[base + 5]); w.w = pk2(p[base + 6], p[base + 7]);
    return __builtin_bit_cast(bf16x8, w);
}
struct VFrags { bf16x8 a00, a01, a10, a11; };
template <int D0> __device__ __forceinline__ VFrags v_frags(unsigned vaddr) { VFrags f; f.a00 = v_frag<D0, 0, 0>(vaddr); f.a01 = v_frag<D0, 0, 1>(vaddr); f.a10 = v_frag<D0, 1, 0>(vaddr); f.a11 = v_frag<D0, 1, 1>(vaddr); return f; }
__device__ __forceinline__ void pv_mma(f32x16& o, const VFrags& f, bf16x8 p00, bf16x8 p01, bf16x8 p10, bf16x8 p11) {
    o = __builtin_amdgcn_mfma_f32_32x32x16_bf16(f.a00, p00, o, 0, 0, 0);
    o = __builtin_amdgcn_mfma_f32_32x32x16_bf16(f.a01, p01, o, 0, 0, 0);
    o = __builtin_amdgcn_mfma_f32_32x32x16_bf16(f.a10, p10, o, 0, 0, 0);
    o = __builtin_amdgcn_mfma_f32_32x32x16_bf16(f.a11, p11, o, 0, 0, 0);
}
__device__ __forceinline__ void pv_all(f32x16 (&o)[4], unsigned vaddr, bf16x8 p00, bf16x8 p01, bf16x8 p10, bf16x8 p11) {
    const VFrags f0 = v_frags<0>(vaddr); const VFrags f1 = v_frags<1>(vaddr);
    asm volatile("s_waitcnt lgkmcnt(8)" ::: "memory"); __builtin_amdgcn_sched_barrier(0);
    pv_mma(o[0], f0, p00, p01, p10, p11);
    __builtin_amdgcn_sched_barrier(0);
    const VFrags f2 = v_frags<2>(vaddr);
    asm volatile("s_waitcnt lgkmcnt(8)" ::: "memory"); __builtin_amdgcn_sched_barrier(0);
    pv_mma(o[1], f1, p00, p01, p10, p11);
    __builtin_amdgcn_sched_barrier(0);
    const VFrags f3 = v_frags<3>(vaddr);
    asm volatile("s_waitcnt lgkmcnt(8)" ::: "memory"); __builtin_amdgcn_sched_barrier(0);
    pv_mma(o[2], f2, p00, p01, p10, p11);
    asm volatile("s_waitcnt lgkmcnt(0)" ::: "memory"); __builtin_amdgcn_sched_barrier(0);
    pv_mma(o[3], f3, p00, p01, p10, p11);
}
template <int MODE>
__device__ __forceinline__ void attn_unit(Frame& F, int l, int b, int h, int qb) {
    constexpr int DK = MODE ? 192 : 64, NS = DK / 16, SK = DK * 2 + 16, KBYTES = 64 * SK, VBYTES = 64 * ATT_SV, BUFB = KBYTES + VBYTES, KCH = DK / 8, NKC = (64 * KCH) / 512;
    constexpr int NMAP = MODE ? 1 : 2;
    constexpr float SCALE = MODE ? 0.07216878364870322f : 0.125f, C = SCALE * 1.4426950408889634f;
    unsigned char* ws = F.ws;
    const bf16_t* Z = (const bf16_t*)(ws + WS_Z); const bf16_t* QM = (const bf16_t*)(ws + WS_QM); const bf16_t* KVM = (const bf16_t*)(ws + WS_KVM); const bf16_t* KRM = (const bf16_t*)(ws + WS_KRM);
    bf16_t* Y = (bf16_t*)(ws + WS_Y);
    const int w = F.wave, lane = lane_id_fresh(), tid = w * 64 + lane, r32 = lane & 31, hi = lane >> 5;
    const int q0 = qb * 256, qw = q0 + 32 * w, ntiles = 4 * (qb + 1);
    const size_t rowb = (size_t)b * SEQ;
    const unsigned lds0 = (unsigned)(uintptr_t)F.lds;
    const unsigned kaddr = lds0 + r32 * SK + 16 * hi;
    const unsigned vaddr = lds0 + KBYTES + (((lane & 15) >> 2) + 4 * hi) * ATT_SV + (16 * ((lane >> 4) & 1) + 4 * (lane & 3)) * 2;
    float* O1 = (float*)(ws + WS_O1) + (rowb + qw + r32) * 512 + h * 128 + 4 * hi;
    for (int mp = 0; mp < NMAP; ++mp) {
        bf16x8 qf[NS];
        {
            const bf16_t* qp = MODE ? QM + (rowb + qw + r32) * 768 + h * 192 + 8 * hi : Z + (rowb + qw + r32) * NZ + ZC_DQ + h * 128 + mp * 64 + 8 * hi;
#pragma unroll
            for (int s = 0; s < NS; ++s) qf[s] = *(const bf16x8*)(qp + 16 * s);
            if (MODE == 1) {
                const float* csq = (const float*)(ws + WS_CS) + (rowb + qw + r32) * 64 + 8 * hi;
#pragma unroll
                for (int s = 8; s < NS; ++s) {
                    const f32x4 ca = *(const f32x4*)(csq + 16 * (s - 8)), cb = *(const f32x4*)(csq + 16 * (s - 8) + 4);
                    const u32x4 w = __builtin_bit_cast(u32x4, qf[s]); u32x4 o;
                    { const float x1 = bflo(w[0]), x2 = bfhi(w[0]); o[0] = pk2(x1 * ca[0] - x2 * ca[1], x2 * ca[0] + x1 * ca[1]); }
                    { const float x1 = bflo(w[1]), x2 = bfhi(w[1]); o[1] = pk2(x1 * ca[2] - x2 * ca[3], x2 * ca[2] + x1 * ca[3]); }
                    { const float x1 = bflo(w[2]), x2 = bfhi(w[2]); o[2] = pk2(x1 * cb[0] - x2 * cb[1], x2 * cb[0] + x1 * cb[1]); }
                    { const float x1 = bflo(w[3]), x2 = bfhi(w[3]); o[3] = pk2(x1 * cb[2] - x2 * cb[3], x2 * cb[2] + x1 * cb[3]); }
                    qf[s] = __builtin_bit_cast(bf16x8, o);
                }
            }
        }
        f32x16 o[4];
#pragma unroll
        for (int d = 0; d < 4; ++d) o[d] = (f32x16){};
        float m_run = -1e30f, l_run = 0.f;
        u32x4 kst[NKC], vst[2];
#define ATT_LOAD(j) do { const int k0_ = 64 * (j); \
            _Pragma("unroll") for (int i_ = 0; i_ < NKC; ++i_) { const int c_ = tid + 512 * i_, row_ = c_ / KCH, cc_ = c_ % KCH; \
                const bf16_t* src_ = MODE ? (cc_ < 16 ? KVM + (rowb + k0_ + row_) * 1024 + h * 256 + cc_ * 8 : KRM + (rowb + k0_ + row_) * 64 + (cc_ - 16) * 8) \
                                          : Z + (rowb + k0_ + row_) * NZ + ZC_DK + h * 128 + mp * 64 + cc_ * 8; \
                kst[i_] = *(const u32x4*)src_; } \
            _Pragma("unroll") for (int i_ = 0; i_ < 2; ++i_) { const int c_ = tid + 512 * i_, row_ = c_ >> 4, cc_ = c_ & 15; \
                const bf16_t* src_ = MODE ? KVM + (rowb + k0_ + row_) * 1024 + h * 256 + 128 + cc_ * 8 : Z + (rowb + k0_ + row_) * NZ + ZC_DV + h * 128 + cc_ * 8; \
                vst[i_] = *(const u32x4*)src_; } } while (0)
#define ATT_WRITE(buf) do { \
            _Pragma("unroll") for (int i_ = 0; i_ < NKC; ++i_) { const int c_ = tid + 512 * i_, row_ = c_ / KCH, cc_ = c_ % KCH; *(LAS u32x4*)(F.lds + (buf) * BUFB + row_ * SK + cc_ * 16) = kst[i_]; } \
            _Pragma("unroll") for (int i_ = 0; i_ < 2; ++i_) { const int c_ = tid + 512 * i_, row_ = c_ >> 4, cc_ = c_ & 15; *(LAS u32x4*)(F.lds + (buf) * BUFB + KBYTES + row_ * ATT_SV + cc_ * 16) = vst[i_]; } } while (0)
        ATT_LOAD(0); ATT_WRITE(0);
        __builtin_amdgcn_s_waitcnt(0x0F70);
        __syncthreads();
        for (int j = 0; j < ntiles; ++j) {
            const int k0 = 64 * j; const unsigned bo = (unsigned)(j & 1) * BUFB;
            if (j + 1 < ntiles) ATT_LOAD(j + 1);
            if (k0 <= qw + 31) {
                f32x16 p0 = (f32x16){}, p1 = (f32x16){};
                {
                    bf16x8 ka[NS], kb[NS];
#pragma unroll
                    for (int s = 0; s < NS; ++s) { ka[s] = *(const LAS bf16x8*)(uintptr_t)(kaddr + bo + 32 * s); kb[s] = *(const LAS bf16x8*)(uintptr_t)(kaddr + bo + 32 * SK + 32 * s); }
#pragma unroll
                    for (int s = 0; s < NS; ++s) { p0 = __builtin_amdgcn_mfma_f32_32x32x16_bf16(ka[s], qf[s], p0, 0, 0, 0); p1 = __builtin_amdgcn_mfma_f32_32x32x16_bf16(kb[s], qf[s], p1, 0, 0, 0); }
                    __builtin_amdgcn_sched_group_barrier(0x100, 6, 0);
#pragma unroll
                    for (int s = 0; s < NS - 3; ++s) { __builtin_amdgcn_sched_group_barrier(0x008, 2, 0); __builtin_amdgcn_sched_group_barrier(0x100, 2, 0); }
                    __builtin_amdgcn_sched_group_barrier(0x008, 6, 0);
                }
                if (k0 + 63 > qw) {
                    const int qi = qw + r32;
#pragma unroll
                    for (int r = 0; r < 16; ++r) { const int key = k0 + crow(r, hi); if (key > qi) p0[r] = -1e30f; if (key + 32 > qi) p1[r] = -1e30f; }
                }
                float pmax = p0[0];
#pragma unroll
                for (int r = 1; r < 16; ++r) pmax = fmaxf(pmax, p0[r]);
#pragma unroll
                for (int r = 0; r < 16; ++r) pmax = fmaxf(pmax, p1[r]);
                pmax = fmaxf(pmax, bperm_f(lane ^ 32, pmax));
                const float mn = fmaxf(m_run, pmax), alpha = __builtin_amdgcn_exp2f((m_run - mn) * C), mnC = -mn * C; m_run = mn;
                float ps = 0.f;
#pragma unroll
                for (int r = 0; r < 16; ++r) { p0[r] = __builtin_amdgcn_exp2f(fmaf(p0[r], C, mnC)); p1[r] = __builtin_amdgcn_exp2f(fmaf(p1[r], C, mnC)); ps += p0[r] + p1[r]; }
                ps += bperm_f(lane ^ 32, ps);
                l_run = l_run * alpha + ps;
                if (!__all(alpha == 1.f)) {
#pragma unroll
                    for (int d = 0; d < 4; ++d) o[d] *= alpha;
                }
                const bf16x8 p00 = pack8(p0, 0), p01 = pack8(p0, 8), p10 = pack8(p1, 0), p11 = pack8(p1, 8);
                asm volatile("s_waitcnt lgkmcnt(0)" ::: "memory");
                pv_all(o, vaddr + bo, p00, p01, p10, p11);
            }
            if (j + 1 < ntiles) ATT_WRITE((j + 1) & 1);
            __syncthreads();
        }
#undef ATT_LOAD
#undef ATT_WRITE
        const float il = rcpf_(l_run);
        if (MODE == 0 && mp == 0) {
#pragma unroll
            for (int d = 0; d < 4; ++d)
#pragma unroll
                for (int r4 = 0; r4 < 4; ++r4) *(f32x4*)(O1 + 32 * d + 8 * r4) = (f32x4){o[d][4 * r4] * il, o[d][4 * r4 + 1] * il, o[d][4 * r4 + 2] * il, o[d][4 * r4 + 3] * il};
        } else {
            const size_t yrow = (rowb + qw + r32) * D + (MODE ? 1024 : 0) + h * 128 + 4 * hi;
            if (MODE == 0) {
                const float* lv = (const float*)(ws + WS_PRM) + l * PRM_L + PRM_DL;
                const float s01 = wave_sum(lv[lane] * lv[64 + lane]), s23 = wave_sum(lv[128 + lane] * lv[192 + lane]);
                const float lam_init = 0.8f - 0.6f * __expf(-0.3f * (float)l);
                const float lam = __expf(s01) - __expf(s23) + lam_init;
                const float il2 = lam * il; float ss = 0.f;
#pragma unroll
                for (int d = 0; d < 4; ++d)
#pragma unroll
                    for (int r4 = 0; r4 < 4; ++r4) { const f32x4 a1 = *(const f32x4*)(O1 + 32 * d + 8 * r4);
#pragma unroll
                        for (int e = 0; e < 4; ++e) { const float x = a1[e] - o[d][4 * r4 + e] * il2; o[d][4 * r4 + e] = x; ss += x * x; } }
                ss += bperm_f(lane ^ 32, ss);
                const float rn = rsqrtf(ss * (1.f / 128.f) + EPS) * (1.f - lam_init);
                const float* g = (const float*)(ws + WS_PRM) + l * PRM_L + PRM_DN + h * 128 + 4 * hi;
#pragma unroll
                for (int d = 0; d < 4; ++d)
#pragma unroll
                    for (int r4 = 0; r4 < 4; ++r4) {
                        const f32x4 gg = *(const f32x4*)(g + 32 * d + 8 * r4);
                        u32x2 wv; wv.x = pk2(o[d][4 * r4] * rn * gg[0], o[d][4 * r4 + 1] * rn * gg[1]); wv.y = pk2(o[d][4 * r4 + 2] * rn * gg[2], o[d][4 * r4 + 3] * rn * gg[3]);
                        *(u32x2*)(Y + yrow + 32 * d + 8 * r4) = wv;
                    }
            } else {
#pragma unroll
                for (int d = 0; d < 4; ++d)
#pragma unroll
                    for (int r4 = 0; r4 < 4; ++r4) {
                        u32x2 wv; wv.x = pk2(o[d][4 * r4] * il, o[d][4 * r4 + 1] * il); wv.y = pk2(o[d][4 * r4 + 2] * il, o[d][4 * r4 + 3] * il);
                        *(u32x2*)(Y + yrow + 32 * d + 8 * r4) = wv;
                    }
            }
        }
    }
}
__device__ __forceinline__ void attn_fast(Frame& F, int l) {
    unsigned* actr = (unsigned*)(F.ws + WS_CTL + CTL_CVQ + 4096) + 64 * l;
    volatile LAS unsigned* slot = (volatile LAS unsigned*)(F.lds + MISC_OFF) + 24;
#pragma unroll 1
    for (;;) {
        __syncthreads();
        if (F.tid == 0) *slot = __hip_atomic_fetch_add(actr, 1u, __ATOMIC_RELAXED, __HIP_MEMORY_SCOPE_AGENT);
        __syncthreads();
        const int u = __builtin_amdgcn_readfirstlane((int)*slot);
        if (u >= 256) break;
        const int qb = 7 - (u >> 5), mode = (u >> 4) & 1, b = (u >> 2) & 3, h = u & 3;
        if (mode == 0) attn_unit<0>(F, l, b, h, qb); else attn_unit<1>(F, l, b, h, qb);
    }
}

typedef float f32x4_t __attribute__((ext_vector_type(4)));
template <int KIND>
__device__ __forceinline__ void scan_unit(Frame& F, int l, int b, int h, int seg) {
    constexpr int DK = KIND ? 64 : 128, NKS = DK / 32, NDT = DK / 16, SQ = DK * 2 + 16, SA = 144;
    constexpr int L_QT = 0, L_KT = 64 * SQ, L_KTT = 128 * SQ, L_VT = L_KTT + DK * SA, L_AT = L_VT + 128 * SA, L_ST = L_AT + 64 * SA, L_TAB = L_ST + 128 * SQ;
    constexpr int T_ER = L_TAB, T_EC = T_ER + 512, T_PS = T_EC + 512, T_QS = T_PS + 2048, T_KS = T_QS + 256, T_MT = T_KS + 256, T_NP = T_MT + 256, T_SC = T_NP + 256, T_DEN = T_SC + 64, T_BS = T_DEN + 8 * 256;
    static_assert(T_BS + 256 <= RING_BYTES, "scan LDS");
    unsigned char* ws = F.ws;
    const bf16_t* Z = (const bf16_t*)(ws + WS_Z);
    float* OUT = (float*)(ws + (KIND ? WS_OL : WS_OG));
    const float* prm = (const float*)(ws + WS_PRM) + l * PRM_L;
    LAS unsigned char* lds = F.lds;
    const int w = F.wave, lane = lane_id_fresh(), tid = w * 64 + lane, l15 = lane & 15, g = lane >> 4;
    const int ch = tid & 127, part = tid >> 7, i0 = 16 * part;
    if (w == 2 || w == 3) { const int rt = (w == 2) ? 0 : 2;
#pragma unroll
        for (int r = 0; r < 4; ++r) *(LAS bf16_t*)(lds + L_AT + (16 * rt + 4 * g + r) * SA + (16 * (rt + 1) + l15) * 2) = 0; }
    f32x4 st[NDT];
#pragma unroll
    for (int d = 0; d < NDT; ++d) st[d] = (f32x4){0.f, 0.f, 0.f, 0.f};
    float m_prev = 0.f, np_reg = 0.f, colsum = 0.f, bseg = 0.f;
    float cumlog = 0.f;
    const int bh = b * 4 + h;
    bf16_t* QTS = (bf16_t*)(ws + (KIND ? WS_QTL : WS_QTG)) + (size_t)bh * SEQ * DK;
    float* SCL = (float*)(ws + WS_SCL) + (size_t)bh * SEQ * 4;
    const float lb = KIND ? 0.f : ((const float*)(ws + WS_LBS))[l * 512 + h * 128 + ch];
    unsigned zA[16], zB[16], vr[16], gA = 0, gB = 0;
#define SCAN_LOAD(cc) do { const size_t r0_ = (size_t)b * SEQ + 64 * (cc); \
        if (KIND == 0) { const bf16_t* zr_ = Z + (r0_ + i0) * NZ + h * 128 + ch; \
            _Pragma("unroll") for (int j = 0; j < 16; ++j) { zA[j] = zr_[j * NZ + ZC_GF]; zB[j] = zr_[j * NZ + ZC_GQ]; } } \
        else { const int cidx_ = (ch < 64) ? h * 64 + ch : 256 + h * 64 + (ch - 64); const bf16_t* zc_ = Z + (r0_ + i0) * NZ + ZC_LQ + cidx_; \
            _Pragma("unroll") for (int j = 0; j < 16; ++j) zA[j] = zc_[j * NZ]; \
            if (!((cc) == 0 && part == 0)) { zB[0] = zc_[-3 * NZ]; zB[1] = zc_[-2 * NZ]; zB[2] = zc_[-1 * NZ]; } \
            if (w == 0) { const bf16_t* zg_ = Z + (r0_ + lane) * NZ + h; gA = zg_[ZC_LI]; gB = zg_[ZC_LF]; } } \
        { const bf16_t* zv_ = Z + (r0_ + i0) * NZ + (KIND ? ZC_LV : ZC_GV) + h * 128 + ch; \
            _Pragma("unroll") for (int j = 0; j < 16; ++j) vr[j] = zv_[j * NZ]; } } while (0)
    SCAN_LOAD(seg * SEGC);
    float cw0 = 0.f, cw1 = 0.f, cw2 = 0.f, cw3 = 0.f, cbias = 0.f, gbi = 0.f, gbf = 0.f;
    if (KIND == 1) { const int cidx = (ch < 64) ? h * 64 + ch : 256 + h * 64 + (ch - 64);
        cw0 = prm[PRM_CW + cidx]; cw1 = prm[PRM_CW + 512 + cidx]; cw2 = prm[PRM_CW + 1024 + cidx]; cw3 = prm[PRM_CW + 1536 + cidx]; cbias = prm[PRM_CB + cidx]; gbi = prm[PRM_GB + h]; gbf = prm[PRM_GB + 4 + h]; }
#pragma unroll 1
    for (int c = seg * SEGC; c < (seg + 1) * SEGC; ++c) {
        const size_t row0 = (size_t)b * SEQ + 64 * c;
        float qv[16], kv[16], lf[16];
        if (KIND == 0) {
            float run = 0.f;
#pragma unroll
            for (int j = 0; j < 16; ++j) {
                const float zf = fmaxf(bf2f((bf16_t)zA[j]), -30.f), zq = bf2f((bf16_t)zB[j]);
                const float ez = __expf(-zf), sg = rcpf_(1.f + ez), sgn = ez * sg;
                run += __logf(lb + (1.f - lb) * sg); lf[j] = run; qv[j] = zq * 0.08838834764831845f; kv[j] = (1.f - lb) * sgn;
            }
            *(LAS float*)(lds + T_PS + (part * 128 + ch) * 4) = run;
        } else {
            const float w0 = cw0, w1 = cw1, w2 = cw2, w3 = cw3, cb = cbias;
            const bool first = (c == 0 && part == 0);
            float x0 = first ? 0.f : bf2f((bf16_t)zB[0]), x1 = first ? 0.f : bf2f((bf16_t)zB[1]), x2 = first ? 0.f : bf2f((bf16_t)zB[2]);
#pragma unroll
            for (int j = 0; j < 16; ++j) {
                const float x3 = bf2f((bf16_t)zA[j]);
                float v = cb + x0 * w0 + x1 * w1 + x2 * w2 + x3 * w3; v = v * rcpf_(1.f + __expf(-v));
                qv[j] = (ch < 64) ? v * 0.125f : v; x0 = x1; x1 = x2; x2 = x3;
            }
            if (w == 0) {
                const float li = bf2f((bf16_t)gA) + gbi, zf = bf2f((bf16_t)gB) + gbf;
                const float lfv = fminf(zf, 0.f) - __logf(1.f + __expf(-fabsf(zf)));
                float bb = lfv;
#pragma unroll
                for (int o = 1; o < 64; o <<= 1) { const float t_ = bperm_f(lane - o, bb); if (lane >= o) bb += t_; }
                const float a_ = li - bb; float cm = a_;
#pragma unroll
                for (int o = 1; o < 64; o <<= 1) { const float t_ = bperm_f(lane - o, cm); if (lane >= o) cm = fmaxf(cm, t_); }
                const float M = fmaxf(m_prev, cm), MC = rdlane_f(M, 63), bC = rdlane_f(bb, 63);
                *(LAS float*)(lds + T_QS + lane * 4) = __expf(MC - M); *(LAS float*)(lds + T_KS + lane * 4) = __expf(a_ - MC); *(LAS float*)(lds + T_MT + lane * 4) = bb + M;
                *(LAS float*)(lds + T_BS + lane * 4) = bseg + bb;
                bseg += bC;
                const float cs = __expf(m_prev - MC);
                np_reg = cs * (np_reg + colsum);
                *(LAS float*)(lds + T_NP + lane * 4) = np_reg;
                if (lane == 0) *(LAS float*)(lds + T_SC) = cs;
                m_prev = bC + MC;
            }
        }
        __syncthreads();
        {
            unsigned ktt[8];
            *(LAS u32x4*)(lds + L_VT + ch * SA + i0 * 2) = (u32x4){vr[0] | (vr[1] << 16), vr[2] | (vr[3] << 16), vr[4] | (vr[5] << 16), vr[6] | (vr[7] << 16)};
            *(LAS u32x4*)(lds + L_VT + ch * SA + i0 * 2 + 16) = (u32x4){vr[8] | (vr[9] << 16), vr[10] | (vr[11] << 16), vr[12] | (vr[13] << 16), vr[14] | (vr[15] << 16)};
            if (KIND == 0) {
                const float p0 = *(LAS float*)(lds + T_PS + ch * 4), p1 = *(LAS float*)(lds + T_PS + (128 + ch) * 4), p2 = *(LAS float*)(lds + T_PS + (256 + ch) * 4), p3 = *(LAS float*)(lds + T_PS + (384 + ch) * 4);
                const float r_ = p0 + p1, off = (part > 0 ? p0 : 0.f) + (part > 1 ? p1 : 0.f) + (part > 2 ? p2 : 0.f);
                if (part == 0) { *(LAS float*)(lds + T_ER + ch * 4) = __expf(r_); *(LAS float*)(lds + T_EC + ch * 4) = __expf(p2 + p3); }
                const float eseg = __expf(r_ + cumlog);
                bf16_t* qg_ = QTS + (size_t)(64 * c + i0) * DK + ch;
                cumlog += (p0 + p1) + (p2 + p3);
#pragma unroll
                for (int j = 0; j < 16; ++j) {
                    const float x = fminf(fmaxf(off + lf[j] - r_, -80.f), 80.f);
                    const float qt = qv[j] * __expf(x), kt = kv[j] * __expf(-x);
                    *(LAS bf16_t*)(lds + L_QT + (i0 + j) * SQ + ch * 2) = (bf16_t)f2bf(qt);
                    qg_[j * DK] = (bf16_t)f2bf(qt * eseg);
                    const unsigned kb_ = f2bf(kt);
                    *(LAS bf16_t*)(lds + L_KT + (i0 + j) * SQ + ch * 2) = (bf16_t)kb_;
                    if (j & 1) ktt[j >> 1] |= kb_ << 16; else ktt[j >> 1] = kb_;
                }
                *(LAS u32x4*)(lds + L_KTT + ch * SA + i0 * 2) = (u32x4){ktt[0], ktt[1], ktt[2], ktt[3]};
                *(LAS u32x4*)(lds + L_KTT + ch * SA + i0 * 2 + 16) = (u32x4){ktt[4], ktt[5], ktt[6], ktt[7]};
            } else {
#pragma unroll
                for (int j = 0; j < 16; ++j) {
                    const float fs = *(LAS float*)(lds + ((ch < 64) ? T_QS : T_KS) + (i0 + j) * 4);
                    const unsigned vb_ = f2bf(qv[j] * fs);
                    if (ch < 64) { *(LAS bf16_t*)(lds + L_QT + (i0 + j) * SQ + ch * 2) = (bf16_t)vb_; QTS[(size_t)(64 * c + i0 + j) * DK + ch] = (bf16_t)f2bf(qv[j]); }
                    else *(LAS bf16_t*)(lds + L_KT + (i0 + j) * SQ + (ch - 64) * 2) = (bf16_t)vb_;
                    if (j & 1) ktt[j >> 1] |= vb_ << 16; else ktt[j >> 1] = vb_;
                }
                if (ch >= 64) {
                    *(LAS u32x4*)(lds + L_KTT + (ch - 64) * SA + i0 * 2) = (u32x4){ktt[0], ktt[1], ktt[2], ktt[3]};
                    *(LAS u32x4*)(lds + L_KTT + (ch - 64) * SA + i0 * 2 + 16) = (u32x4){ktt[4], ktt[5], ktt[6], ktt[7]};
                }
            }
        }
        __syncthreads();
        for (int ti = w; ti < 10; ti += 8) {
            const int rt = (int)((0x3333222110ull >> (4 * ti)) & 15), ct = (int)((0x3210210100ull >> (4 * ti)) & 15);
            f32x4 acc = (f32x4){0.f, 0.f, 0.f, 0.f};
#pragma unroll
            for (int ks = 0; ks < NKS; ++ks) {
                const bf16x8 af = *(const LAS bf16x8*)(lds + L_QT + (16 * rt + l15) * SQ + (32 * ks + 8 * g) * 2), bfr = *(const LAS bf16x8*)(lds + L_KT + (16 * ct + l15) * SQ + (32 * ks + 8 * g) * 2);
                acc = __builtin_amdgcn_mfma_f32_16x16x32_bf16(af, bfr, acc, 0, 0, 0);
            }
#pragma unroll
            for (int r = 0; r < 4; ++r) { const int t_ = 16 * rt + 4 * g + r, s_ = 16 * ct + l15; *(LAS bf16_t*)(lds + L_AT + t_ * SA + s_ * 2) = (bf16_t)f2bf(s_ <= t_ ? acc[r] : 0.f); }
        }
        {
            const float cs = KIND ? *(LAS float*)(lds + T_SC) : 1.f;
#pragma unroll
            for (int d = 0; d < NDT; ++d) {
                if (KIND == 0) st[d] *= *(const LAS f32x4*)(lds + T_ER + (16 * d + 4 * g) * 4); else st[d] *= cs;
                u32x2 pk; pk.x = pk2(st[d][0], st[d][1]); pk.y = pk2(st[d][2], st[d][3]);
                *(LAS u32x2*)(lds + L_ST + (16 * w + l15) * SQ + (16 * d + 4 * g) * 2) = pk;
            }
        }
        __syncthreads();
        { const int cn_ = (c + 1 < SEQ / 64) ? c + 1 : c; SCAN_LOAD(cn_); }
        __builtin_amdgcn_sched_barrier(0);
        bf16x8 sfr[NKS], vfr[2];
#pragma unroll
        for (int ks = 0; ks < NKS; ++ks) sfr[ks] = *(const LAS bf16x8*)(lds + L_ST + (16 * w + l15) * SQ + (32 * ks + 8 * g) * 2);
#pragma unroll
        for (int ks = 0; ks < 2; ++ks) vfr[ks] = *(const LAS bf16x8*)(lds + L_VT + (16 * w + l15) * SA + (32 * ks + 8 * g) * 2);
        if (KIND == 1) {
            float dn = 0.f;
#pragma unroll
            for (int d8 = 0; d8 < 8; ++d8) { const u32x4 qw_ = *(const LAS u32x4*)(lds + L_QT + lane * SQ + d8 * 16); const f32x4 n0 = *(const LAS f32x4*)(lds + T_NP + d8 * 32), n1 = *(const LAS f32x4*)(lds + T_NP + d8 * 32 + 16);
                dn += bflo(qw_[0]) * n0[0] + bfhi(qw_[0]) * n0[1] + bflo(qw_[1]) * n0[2] + bfhi(qw_[1]) * n0[3] + bflo(qw_[2]) * n1[0] + bfhi(qw_[2]) * n1[1] + bflo(qw_[3]) * n1[2] + bfhi(qw_[3]) * n1[3]; }
#pragma unroll
            for (int s8 = 0; s8 < 8; ++s8) { const u32x4 aw_ = *(const LAS u32x4*)(lds + L_AT + lane * SA + s8 * 16);
#pragma unroll
                for (int e = 0; e < 4; ++e) { const int s_ = 8 * s8 + 2 * e; dn += (s_ <= lane ? bflo(aw_[e]) : 0.f) + (s_ + 1 <= lane ? bfhi(aw_[e]) : 0.f); } }
            *(LAS float*)(lds + T_DEN + (w * 64 + lane) * 4) = dn;
            *(f32x4*)(SCL + (size_t)(64 * c + lane) * 4) = (f32x4){dn, *(LAS float*)(lds + T_MT + lane * 4), *(LAS float*)(lds + T_BS + lane * 4), 0.f};
            if (w == 0) {
                float cs_ = 0.f;
                for (int s_ = 0; s_ < 64; ++s_) cs_ += bf2f(*(const LAS bf16_t*)(lds + L_KT + s_ * SQ + lane * 2));
                colsum = cs_;
            }
        }
#pragma unroll
        for (int rt = 0; rt < 4; ++rt) {
            f32x4 o = (f32x4){0.f, 0.f, 0.f, 0.f};
#pragma unroll
            for (int ks = 0; ks < NKS; ++ks) o = __builtin_amdgcn_mfma_f32_16x16x32_bf16(*(const LAS bf16x8*)(lds + L_QT + (16 * rt + l15) * SQ + (32 * ks + 8 * g) * 2), sfr[ks], o, 0, 0, 0);
#pragma unroll
            for (int ks = 0; ks < 2; ++ks) if (2 * ks <= rt) o = __builtin_amdgcn_mfma_f32_16x16x32_bf16(*(const LAS bf16x8*)(lds + L_AT + (16 * rt + l15) * SA + (32 * ks + 8 * g) * 2), vfr[ks], o, 0, 0, 0);
            float* op = OUT + (row0 + 16 * rt + 4 * g) * 512 + h * 128 + 16 * w + l15;
            if (KIND == 1) {
                const f32x4 dn = *(const LAS f32x4*)(lds + T_DEN + (w * 64 + 16 * rt + 4 * g) * 4), mt = *(const LAS f32x4*)(lds + T_MT + (16 * rt + 4 * g) * 4);
#pragma unroll
                for (int r = 0; r < 4; ++r) op[r * 512] = (seg > 0) ? o[r] : o[r] * rcpf_(fmaxf(fabsf(dn[r]), __expf(-mt[r])));
            } else {
#pragma unroll
                for (int r = 0; r < 4; ++r) op[r * 512] = o[r];
            }
        }
#pragma unroll
        for (int d = 0; d < NDT; ++d) {
#pragma unroll
            for (int ks = 0; ks < 2; ++ks) st[d] = __builtin_amdgcn_mfma_f32_16x16x32_bf16(*(const LAS bf16x8*)(lds + L_KTT + (16 * d + l15) * SA + (32 * ks + 8 * g) * 2), vfr[ks], st[d], 0, 0, 0);
            if (KIND == 0) st[d] *= *(const LAS f32x4*)(lds + T_EC + (16 * d + 4 * g) * 4);
        }
        __syncthreads();
    }
#undef SCAN_LOAD
    if (seg < NSEG - 1) {
        float* SIF = (float*)(ws + WS_SIF) + (size_t)((KIND * 16 + bh) * NSEG) * 16384;
        bf16_t* SIB = (bf16_t*)(ws + WS_SIB) + (size_t)((KIND * 16 + bh) * NSEG) * 16384;
        float* SIM = (float*)(ws + WS_SIM) + (size_t)(bh * NSEG) * 128;
        unsigned* flg = (unsigned*)(ws + WS_CTL + CTL_SEGF) + (size_t)(((l * 2 + KIND) * 16 + bh) * NSEG) * 16;
        if (KIND == 0 && part == 0) *(LAS float*)(lds + T_PS + ch * 4) = cumlog;
        if (seg > 0) {
            if (w == 0) { unsigned spins = 0; while (__builtin_amdgcn_readfirstlane(__hip_atomic_load(flg + seg * 16, __ATOMIC_RELAXED, __HIP_MEMORY_SCOPE_AGENT)) == 0u && ++spins < (1u << 22)) __builtin_amdgcn_s_sleep(2); }
            __syncthreads();
            __builtin_amdgcn_fence(__ATOMIC_ACQUIRE, "agent");
        }
        if (KIND == 1 && w == 0) {
            const float n_loc = np_reg + colsum; float m_new = m_prev, al_ = 1.f, be_ = 0.f, n_init = 0.f;
            if (seg > 0) { const float m_init = SIM[seg * 128 + 64]; n_init = SIM[seg * 128 + lane]; m_new = fmaxf(m_prev, bseg + m_init); al_ = __expf(m_prev - m_new); be_ = __expf(bseg + m_init - m_new); }
            __hip_atomic_store(SIM + (seg + 1) * 128 + lane, al_ * n_loc + be_ * n_init, __ATOMIC_RELAXED, __HIP_MEMORY_SCOPE_AGENT);
            if (lane == 0) { __hip_atomic_store(SIM + (seg + 1) * 128 + 64, m_new, __ATOMIC_RELAXED, __HIP_MEMORY_SCOPE_AGENT); if (seg > 0) { *(LAS float*)(lds + T_SC) = al_; *(LAS float*)(lds + T_SC + 4) = be_; } }
        }
        __syncthreads();
        float al_ = 1.f, be_ = 0.f;
        if (KIND == 1 && seg > 0) { al_ = *(LAS float*)(lds + T_SC); be_ = *(LAS float*)(lds + T_SC + 4); }
#pragma unroll
        for (int d = 0; d < NDT; ++d) {
            f32x4 val = st[d];
            if (seg > 0) {
                const f32x4 prev = *(const f32x4*)(SIF + (size_t)seg * 16384 + (16 * w + l15) * 128 + 16 * d + 4 * g);
                if (KIND == 0) { const f32x4 cl_ = *(const LAS f32x4*)(lds + T_PS + (16 * d + 4 * g) * 4);
#pragma unroll
                    for (int r = 0; r < 4; ++r) val[r] += __expf(cl_[r]) * prev[r]; }
                else val = al_ * val + be_ * prev;
            }
            const size_t o_ = (size_t)(seg + 1) * 16384 + (16 * w + l15) * 128 + 16 * d + 4 * g;
            __hip_atomic_store((u64*)(SIF + o_), (u64)__builtin_bit_cast(unsigned, val[0]) | ((u64)__builtin_bit_cast(unsigned, val[1]) << 32), __ATOMIC_RELAXED, __HIP_MEMORY_SCOPE_AGENT);
            __hip_atomic_store((u64*)(SIF + o_ + 2), (u64)__builtin_bit_cast(unsigned, val[2]) | ((u64)__builtin_bit_cast(unsigned, val[3]) << 32), __ATOMIC_RELAXED, __HIP_MEMORY_SCOPE_AGENT);
            __hip_atomic_store((u64*)(SIB + o_), (u64)pk2(val[0], val[1]) | ((u64)pk2(val[2], val[3]) << 32), __ATOMIC_RELAXED, __HIP_MEMORY_SCOPE_AGENT);
        }
        asm volatile("s_waitcnt vmcnt(0)" ::: "memory");
        __syncthreads();
        if (tid == 0) __hip_atomic_store(flg + (seg + 1) * 16, 1u, __ATOMIC_RELAXED, __HIP_MEMORY_SCOPE_AGENT);
    }
}

template <int KIND>
__device__ __forceinline__ void norm_unit(Frame& F, int l, int b, int h, int rb, int seg) {
    constexpr int DK = KIND ? 64 : 128, NKS = DK / 32;
    unsigned char* ws = F.ws;
    const int lane = lane_id_fresh(), l15 = lane & 15, g = lane >> 4, bh = b * 4 + h;
    const size_t trow = (size_t)b * SEQ + 32 * rb;
    const float* prm = (const float*)(ws + WS_PRM) + l * PRM_L + (KIND ? PRM_MN : PRM_HN) + h * 128 + 4 * g;
    const bf16_t* Zg = (const bf16_t*)(ws + WS_Z) + (trow + l15) * NZ + (KIND ? ZC_LO : ZC_GG) + h * 128 + 4 * g;
    const float* OUT = (const float*)(ws + (KIND ? WS_OL : WS_OG)) + (trow + l15) * 512 + h * 128 + 4 * g;
    bf16_t* Y = (bf16_t*)(ws + WS_Y) + (trow + l15) * D + (KIND ? 1536 : 512) + h * 128 + 4 * g;
    f32x4 acc[2][8];
#pragma unroll
    for (int rt = 0; rt < 2; ++rt)
#pragma unroll
        for (int vt = 0; vt < 8; ++vt) acc[rt][vt] = (f32x4){0.f, 0.f, 0.f, 0.f};
    float ea[2] = {1.f, 1.f}, eb[2] = {0.f, 0.f}, inv[2] = {1.f, 1.f};
    f32x4 ov[2][8];
#pragma unroll
    for (int rt = 0; rt < 2; ++rt)
#pragma unroll
        for (int vt = 0; vt < 8; ++vt) ov[rt][vt] = *(const f32x4*)(OUT + (size_t)(16 * rt) * 512 + 16 * vt);
    __builtin_amdgcn_sched_barrier(0);
    if (seg > 0) {
        const bf16_t* SIB = (const bf16_t*)(ws + WS_SIB) + (size_t)((KIND * 16 + bh) * NSEG + seg) * 16384;
        const bf16_t* QTS = (const bf16_t*)(ws + (KIND ? WS_QTL : WS_QTG)) + ((size_t)bh * SEQ + 32 * rb + l15) * DK + 8 * g;
        bf16x8 qf[2][NKS];
#pragma unroll
        for (int rt = 0; rt < 2; ++rt)
#pragma unroll
            for (int ks = 0; ks < NKS; ++ks) qf[rt][ks] = *(const bf16x8*)(QTS + (size_t)(16 * rt) * DK + 32 * ks);
#pragma unroll
        for (int v2 = 0; v2 < 8; v2 += 2) {
            bf16x8 af[2][NKS];
#pragma unroll
            for (int vv = 0; vv < 2; ++vv)
#pragma unroll
                for (int ks = 0; ks < NKS; ++ks) af[vv][ks] = *(const bf16x8*)(SIB + (16 * (v2 + vv) + l15) * 128 + 32 * ks + 8 * g);
            __builtin_amdgcn_sched_barrier(0);
#pragma unroll
            for (int vv = 0; vv < 2; ++vv)
#pragma unroll
                for (int ks = 0; ks < NKS; ++ks)
#pragma unroll
                    for (int rt = 0; rt < 2; ++rt) acc[rt][v2 + vv] = __builtin_amdgcn_mfma_f32_16x16x32_bf16(af[vv][ks], qf[rt][ks], acc[rt][v2 + vv], 0, 0, 0);
        }
        if (KIND == 1) {
            const float* SIM = (const float*)(ws + WS_SIM) + (size_t)(bh * NSEG + seg) * 128;
            const float m_init = SIM[64];
            f32x4 nq[2] = {(f32x4){0.f, 0.f, 0.f, 0.f}, (f32x4){0.f, 0.f, 0.f, 0.f}};
#pragma unroll
            for (int ks = 0; ks < NKS; ++ks) { const f32x4 n0 = *(const f32x4*)(SIM + 32 * ks + 8 * g), n1 = *(const f32x4*)(SIM + 32 * ks + 8 * g + 4);
                const u32x4 nw = (u32x4){pk2(n0[0], n0[1]), pk2(n0[2], n0[3]), pk2(n1[0], n1[1]), pk2(n1[2], n1[3])}; const bf16x8 nfr = __builtin_bit_cast(bf16x8, nw);
#pragma unroll
                for (int rt = 0; rt < 2; ++rt) nq[rt] = __builtin_amdgcn_mfma_f32_16x16x32_bf16(nfr, qf[rt][ks], nq[rt], 0, 0, 0); }
#pragma unroll
            for (int rt = 0; rt < 2; ++rt) {
                const f32x4 sc = *(const f32x4*)((const float*)(ws + WS_SCL) + ((size_t)bh * SEQ + 32 * rb + 16 * rt + l15) * 4);
                const float mi = sc[2] + m_init, mp = fmaxf(sc[1], mi); ea[rt] = __expf(sc[1] - mp); eb[rt] = __expf(mi - mp);
                inv[rt] = rcpf_(fmaxf(fabsf(sc[0] * ea[rt] + nq[rt][0] * eb[rt]), __expf(-mp)));
            }
        }
    }
    u32x2 zv[2][8]; f32x4 gnv[8];
#pragma unroll
    for (int vt = 0; vt < 8; ++vt) { gnv[vt] = *(const f32x4*)(prm + 16 * vt);
#pragma unroll
        for (int rt = 0; rt < 2; ++rt) zv[rt][vt] = *(const u32x2*)(Zg + (size_t)(16 * rt) * NZ + 16 * vt); }
    __builtin_amdgcn_sched_barrier(0);
#pragma unroll
    for (int rt = 0; rt < 2; ++rt) {
        float ss = 0.f;
#pragma unroll
        for (int vt = 0; vt < 8; ++vt) {
            const f32x4 o = ov[rt][vt];
            if (KIND == 0) acc[rt][vt] += o; else acc[rt][vt] = (o * ea[rt] + acc[rt][vt] * eb[rt]) * inv[rt];
            ss += acc[rt][vt][0] * acc[rt][vt][0] + acc[rt][vt][1] * acc[rt][vt][1] + acc[rt][vt][2] * acc[rt][vt][2] + acc[rt][vt][3] * acc[rt][vt][3];
        }
        ss += bperm_f(lane ^ 16, ss); ss += bperm_f(lane ^ 32, ss);
        const float r = rsqrtf(ss * (1.f / 128.f) + EPS);
#pragma unroll
        for (int vt = 0; vt < 8; ++vt) {
            const u32x2 zw = zv[rt][vt]; const f32x4 gn = gnv[vt];
            const float z0 = bflo(zw[0]), z1 = bfhi(zw[0]), z2 = bflo(zw[1]), z3 = bfhi(zw[1]);
            const float s0 = sigmoidf_(z0), s1 = sigmoidf_(z1), s2 = sigmoidf_(z2), s3 = sigmoidf_(z3);
            const f32x4 a = acc[rt][vt];
            u32x2 wv; wv.x = pk2(a[0] * r * gn[0] * (KIND ? s0 : z0 * s0), a[1] * r * gn[1] * (KIND ? s1 : z1 * s1)); wv.y = pk2(a[2] * r * gn[2] * (KIND ? s2 : z2 * s2), a[3] * r * gn[3] * (KIND ? s3 : z3 * s3));
            *(u32x2*)(Y + (size_t)(16 * rt) * D + 16 * vt) = wv;
        }
    }
}
__device__ __forceinline__ void scan_norm(Frame& F, int l) {
#pragma unroll 1
    for (int u = F.bid; u < 256; u += F.G) {
        const int b = u >> 6, rb = u & 63, seg = rb / (64 / NSEG), h = F.wave >> 1;
        if (F.wave & 1) norm_unit<1>(F, l, b, h, rb, seg); else norm_unit<0>(F, l, b, h, rb, seg);
    }
}

__device__ __forceinline__ v32f_t ld_row6(const unsigned char* rowp, int lane) {
    const u32x4 a = *(const u32x4*)(rowp + lane * 16); const u32x2 b = *(const u32x2*)(rowp + 1024 + lane * 8);
    const v6u_t p = (v6u_t){a[0], a[1], a[2], a[3], b[0], b[1]};
    return __builtin_amdgcn_cvt_scalef32_pk32_f32_fp6(p, 1.0f);
}
__device__ __forceinline__ float sw32_add(float a, float b) { asm volatile("s_nop 1\n\tv_permlane32_swap_b32 %0, %1\n\ts_nop 1" : "+v"(a), "+v"(b)); return a + b; }
__device__ __forceinline__ float sw16_add(float a, float b) { asm volatile("s_nop 1\n\tv_permlane16_swap_b32 %0, %1\n\ts_nop 1" : "+v"(a), "+v"(b)); return a + b; }
__device__ __forceinline__ float reduce8(const float (&p)[8], int lane) {
    const float q0 = sw16_add(sw32_add(p[0], p[1]), sw32_add(p[2], p[3])), q1 = sw16_add(sw32_add(p[4], p[5]), sw32_add(p[6], p[7]));
    const float t0 = q0 + DPP_F(q0, 0x128), t1 = q1 + DPP_F(q1, 0x128);
    float t = (lane & 8) ? t1 : t0;
    t += DPP_F(t, 0xB1); t += DPP_F(t, 0x4E); t += DPP_F(t, 0x141);
    return t;
}
__device__ __forceinline__ void peer_gather(Frame& F, int l) {
    constexpr int NF = 16;
    unsigned char* ws = F.ws;
    const unsigned char* U4 = ws + WS_UB + (size_t)l * NEXP * VROW; const unsigned char* V4 = ws + WS_VB + (size_t)l * NEXP * VROW;
    const float* SU = (const float*)(ws + WS_SU) + l * NEXP; const float* SV = (const float*)(ws + WS_SV) + l * NEXP;
    const int* PIDX = (const int*)(ws + WS_PIDX); const float* PG = (const float*)(ws + WS_PGATE);
    bf16_t* HB = (bf16_t*)(ws + WS_HB) + (size_t)(l & 1) * T * D;
    const u64* ssqB = (const u64*)(ws + WS_CTL + CTL_SSQB) + l * T; float* ssqC = (float*)(ws + WS_CTL + CTL_SSQC) + l * T;
    const int lane = F.lane;
    LAS float* cl = (LAS float*)(F.lds + F.wave * 512);
    int emap;
    { float lab[8];
#pragma unroll
      for (int k = 0; k < 8; ++k) lab[k] = (float)k * (1.f / 64.f);
      emap = (int)(reduce8(lab, lane) + 0.5f); }
    for (int t = F.gw; t < T; t += F.ngw) {
        float x[32];
#pragma unroll
        for (int q = 0; q < 8; ++q) { const u32x2 w = *(const u32x2*)(HB + (size_t)t * D + q * 256 + lane * 4);
            x[4 * q] = bflo(w[0]); x[4 * q + 1] = bfhi(w[0]); x[4 * q + 2] = bflo(w[1]); x[4 * q + 3] = bfhi(w[1]); }
        const float rs = rsqrtf(ssq_get(ssqB + t) * (1.f / D) + EPS);
        const int myidx0 = PIDX[(size_t)t * 128 + lane], myidx1 = PIDX[(size_t)t * 128 + 64 + lane];
        const float mys0 = SU[myidx0] * rs, mys1 = SU[myidx1] * rs;
        const float myg0 = PG[(size_t)t * 128 + lane] * SV[myidx0], myg1 = PG[(size_t)t * 128 + 64 + lane] * SV[myidx1];
#pragma unroll 1
        for (int e0 = 0; e0 < 128; e0 += NF) {
            u32x4 uw[NF];
#pragma unroll
            for (int k = 0; k < NF; ++k) { const int e = e0 + k; const int idx = __builtin_amdgcn_readlane(e < 64 ? myidx0 : myidx1, e & 63); uw[k] = *(const u32x4*)(U4 + (size_t)idx * VROW + lane * 16); }
#pragma unroll
            for (int b8 = 0; b8 < NF / 8; ++b8) {
                float part[8];
#pragma unroll
                for (int k = 0; k < 8; ++k) {
                    const int kk = b8 * 8 + k; f32x2_t sa = (f32x2_t){0.f, 0.f}, sb = (f32x2_t){0.f, 0.f};
#pragma unroll
                    for (int q2 = 0; q2 < 4; ++q2) {
                        const f32x2_t d0 = __builtin_amdgcn_cvt_scalef32_pk_f32_fp4(uw[kk][q2], 1.0f, 0), d1 = __builtin_amdgcn_cvt_scalef32_pk_f32_fp4(uw[kk][q2], 1.0f, 1);
                        const f32x2_t d2 = __builtin_amdgcn_cvt_scalef32_pk_f32_fp4(uw[kk][q2], 1.0f, 2), d3 = __builtin_amdgcn_cvt_scalef32_pk_f32_fp4(uw[kk][q2], 1.0f, 3);
                        sa = __builtin_elementwise_fma((f32x2_t){x[8 * q2], x[8 * q2 + 1]}, d0, sa); sb = __builtin_elementwise_fma((f32x2_t){x[8 * q2 + 2], x[8 * q2 + 3]}, d1, sb);
                        sa = __builtin_elementwise_fma((f32x2_t){x[8 * q2 + 4], x[8 * q2 + 5]}, d2, sa); sb = __builtin_elementwise_fma((f32x2_t){x[8 * q2 + 6], x[8 * q2 + 7]}, d3, sb);
                    }
                    const f32x2_t st_ = sa + sb; const float s_ = st_[0] + st_[1];
                    part[k] = s_;
                    if (kk + 1 < NF) asm volatile("" : "+v"(uw[kk + 1]) : "v"(s_));
                }
                const float dot = reduce8(part, lane);
                const int eb = e0 + b8 * 8 + emap;
                const float pre = dot * bperm_f(eb & 63, e0 < 64 ? mys0 : mys1);
                const float act = 0.5f * pre * (1.f + erff(pre * 0.7071067811865476f));
                const float cf = act * bperm_f(eb & 63, e0 < 64 ? myg0 : myg1);
                if ((lane & 7) == 0) cl[eb] = cf;
            }
        }
        asm volatile("s_waitcnt lgkmcnt(0)" ::: "memory");
        const float c0 = cl[lane], c1 = cl[64 + lane];
        float y[32];
#pragma unroll
        for (int i = 0; i < 32; ++i) y[i] = 0.f;
#pragma unroll 1
        for (int e0 = 0; e0 < 128; e0 += NF) {
            u32x4 vw[NF];
#pragma unroll
            for (int k = 0; k < NF; ++k) { const int e = e0 + k; const int idx = __builtin_amdgcn_readlane(e < 64 ? myidx0 : myidx1, e & 63); vw[k] = *(const u32x4*)(V4 + (size_t)idx * VROW + lane * 16); }
#pragma unroll
            for (int k = 0; k < NF; ++k) {
                const int e = e0 + k; const float ce = rdlane_f(e < 64 ? c0 : c1, e & 63);
#pragma unroll
                for (int q2 = 0; q2 < 4; ++q2) {
                    const f32x2_t d0 = __builtin_amdgcn_cvt_scalef32_pk_f32_fp4(vw[k][q2], 1.0f, 0), d1 = __builtin_amdgcn_cvt_scalef32_pk_f32_fp4(vw[k][q2], 1.0f, 1);
                    const f32x2_t d2 = __builtin_amdgcn_cvt_scalef32_pk_f32_fp4(vw[k][q2], 1.0f, 2), d3 = __builtin_amdgcn_cvt_scalef32_pk_f32_fp4(vw[k][q2], 1.0f, 3);
                    y[8 * q2] += ce * d0[0]; y[8 * q2 + 1] += ce * d0[1]; y[8 * q2 + 2] += ce * d1[0]; y[8 * q2 + 3] += ce * d1[1];
                    y[8 * q2 + 4] += ce * d2[0]; y[8 * q2 + 5] += ce * d2[1]; y[8 * q2 + 6] += ce * d3[0]; y[8 * q2 + 7] += ce * d3[1];
                }
                if (k + 1 < NF) asm volatile("" : "+v"(vw[k + 1]) : "v"(y[0]), "v"(y[31]));
            }
        }
        float s2 = 0.f;
#pragma unroll
        for (int q = 0; q < 8; ++q) {
            const float v0 = x[4 * q] + y[4 * q], v1 = x[4 * q + 1] + y[4 * q + 1], v2 = x[4 * q + 2] + y[4 * q + 2], v3 = x[4 * q + 3] + y[4 * q + 3];
            *(u32x2*)(HB + (size_t)t * D + q * 256 + lane * 4) = (u32x2){pk2(v0, v1), pk2(v2, v3)};
            s2 += v0 * v0 + v1 * v1 + v2 * v2 + v3 * v3;
        }
        s2 = wave_sum(s2);
        if (lane == 0) ssqC[t] = s2;
    }
}

__device__ __forceinline__ void final_norm(Frame& F) {
    const Args& a = *F.a; unsigned char* ws = F.ws;
    const bf16_t* HB = (const bf16_t*)(ws + WS_HB) + (size_t)(DEPTH & 1) * T * D; const u64* ssq = (const u64*)(ws + WS_CTL + CTL_SSQA) + 4 * T; const float* g = (const float*)(ws + WS_PRM) + PRM_FIN;
    const int lane = F.lane;
    for (int t = F.gw; t < T; t += F.ngw) {
        const float rs = rsqrtf(ssq_get(ssq + t) * (1.f / D) + EPS);
#pragma unroll
        for (int c = 0; c < 4; ++c) { const size_t o = (size_t)t * D + c * 512 + lane * 8; const u32x4 hw = *(const u32x4*)(HB + o); const f32x4 g0 = *(const f32x4*)(g + c * 512 + lane * 8), g1 = *(const f32x4*)(g + c * 512 + lane * 8 + 4);
            *(f32x4*)(a.out + o) = (f32x4){bflo(hw[0]), bfhi(hw[0]), bflo(hw[1]), bfhi(hw[1])} * rs * g0; *(f32x4*)(a.out + o + 4) = (f32x4){bflo(hw[2]), bfhi(hw[2]), bflo(hw[3]), bfhi(hw[3])} * rs * g1; }
    }
}

constexpr int PH_PER_LAYER = 10, N_PHASES = 2 + DEPTH * PH_PER_LAYER;
template <int PH>
__device__ __forceinline__ void run_phase(Frame& F0, int l) {
    Frame F = F0; { int bid_ = blockIdx.x, wv_ = F0.wave; asm volatile("" : "+s"(bid_), "+s"(wv_));
      F.bid = bid_; F.wave = wv_; F.lane = lane_id_fresh(); F.tid = wv_ * 64 + F.lane; F.gw = bid_ * NWAVES + wv_;
      size_t z_ = 0; asm volatile("" : "+s"(z_)); F.ws = F0.ws + z_; }
    unsigned char* ws = F.ws;
    bf16_t* const HBc = (bf16_t*)(ws + WS_HB) + (size_t)(l & 1) * T * D; bf16_t* const HBn = (bf16_t*)(ws + WS_HB) + (size_t)((l + 1) & 1) * T * D;
    if constexpr (PH == 100) prologue(F);
    if constexpr (PH == 101) final_norm(F);
    if constexpr (PH == 0) {
        pg8::Gemm g{HBc, (const bf16_t*)(ws + WS_WIN) + (size_t)l * NZ * D, T, NZ, D, D, D}; pg8::StaticOrder S; S.init(T, NZ, F.G, F.bid);
        EpiZ E{(bf16_t*)(ws + WS_Z), (const u64*)(ws + WS_CTL + CTL_SSQA) + l * T, (u64*)(ws + WS_CTL + CTL_MQS) + l * T, (u64*)(ws + WS_CTL + CTL_MKVS) + l * T};
        pg8::gemm_phase<EpiZ, pg8::StaticOrder, true, true>(F.lds, g, S, E, F.wave);
    }
    if constexpr (PH == 1) {
        mix_prep(F, l);
        { pg8::Gemm g{(const bf16_t*)(ws + WS_Z) + ZC_MCQ, (const bf16_t*)(ws + WS_WUQ) + (size_t)l * 768 * 384, T, 768, 384, NZ, 384}; pg8::StaticOrder S; S.init(T, 768, F.G, F.bid);
          EpiBf16s E{(bf16_t*)(ws + WS_QM), 768, (const u64*)(ws + WS_CTL + CTL_MQS) + l * T, 1.f / 384.f};
          pg8::gemm_phase<EpiBf16s, pg8::StaticOrder, true, true>(F.lds, g, S, E, F.wave); }
        __syncthreads();
        { pg8::Gemm g{(const bf16_t*)(ws + WS_Z) + ZC_MCKV, (const bf16_t*)(ws + WS_WUKV) + (size_t)l * 1024 * 256, T, 1024, 256, NZ, 256}; pg8::StaticOrder S; S.init(T, 1024, F.G, (int)((F.bid + 128) % F.G));
          EpiBf16s E{(bf16_t*)(ws + WS_KVM), 1024, (const u64*)(ws + WS_CTL + CTL_MKVS) + l * T, 1.f / 256.f};
          pg8::gemm_phase<EpiBf16s, pg8::StaticOrder, true, true>(F.lds, g, S, E, F.wave); }
    }
    if constexpr (PH == 3) {
        if (F.bid < 32 * NSEG) { const int bhs = F.bid % (16 * NSEG), b = bhs / (4 * NSEG), h = (bhs / NSEG) & 3, seg = bhs % NSEG; if (F.bid < 16 * NSEG) scan_unit<0>(F, l, b, h, seg); else scan_unit<1>(F, l, b, h, seg); }
        {
            const bool conv_first = F.bid >= 256 - NCONVWG;
#pragma unroll 1
            for (int pass = 0; pass < 2; ++pass) {
                if (pass == 1 || conv_first) { __syncthreads(); convert_layer_queue(F, l, (unsigned*)(ws + WS_CTL + CTL_CVQ) + 64 * l); }
                if (pass == 0) attn_fast(F, l);
            }
        }
    }
    if constexpr (PH == 4) scan_norm(F, l);
    if constexpr (PH == 5) {
        pg8::Gemm g{(const bf16_t*)(ws + WS_Y), (const bf16_t*)(ws + WS_WOUT) + (size_t)l * D * D, T, D, D, D, D}; pg8::StaticOrder S; S.init(T, D, F.G, F.bid);
        EpiRes E{HBc, (u64*)(ws + WS_CTL + CTL_SSQB) + l * T};
        pg8::gemm_phase<EpiRes, pg8::StaticOrder, true, true>(F.lds, g, S, E, F.wave);
    }
    if constexpr (PH == 6) {
        { pg8::Gemm g{HBc, (const bf16_t*)(ws + WS_WQ) + (size_t)l * D * D, T, D, D, D, D}; pg8::StaticOrder S; S.init(T, D, F.G, F.bid);
          EpiBf16s E{(bf16_t*)(ws + WS_QB), D, (const u64*)(ws + WS_CTL + CTL_SSQB) + l * T, 1.f / D};
          pg8::gemm_phase<EpiBf16s, pg8::StaticOrder, true, true>(F.lds, g, S, E, F.wave);
          pg8::Unit u;
          if (S.next(0, u)) {
              asm volatile("s_waitcnt vmcnt(0)" ::: "memory"); __syncthreads();
              __builtin_amdgcn_fence(__ATOMIC_ACQUIRE, "agent"); asm volatile("s_waitcnt vmcnt(0)" ::: "memory");
              peer_topk_mfma(F.lds, F.wave, (const bf16_t*)(ws + WS_QB), (const bf16_t*)(ws + WS_SKB) + (size_t)l * 8 * 2 * 128 * 128, (int*)(ws + WS_PIDX), (float*)(ws + WS_PGATE), u.pm, u.pn);
          } }
        __syncthreads();
        { pg8::Gemm g{(const bf16_t*)(ws + WS_PB) + (size_t)l * T * PLE, (const bf16_t*)(ws + WS_WP) + (size_t)l * D * PLE, T, D, PLE, PLE, PLE}; pg8::StaticOrder S; S.init(T, D, F.G, F.bid);
          EpiBf16s E{(bf16_t*)(ws + WS_PR), D, nullptr, 0.f};
          pg8::gemm_phase<EpiBf16s, pg8::StaticOrder, true, true>(F.lds, g, S, E, F.wave); }
    }
    if constexpr (PH == 8) peer_gather(F, l);
    if constexpr (PH == 9) {
        pg8::Gemm g{HBc, (const bf16_t*)(ws + WS_WG) + (size_t)l * D * D, T, D, D, D, D}; pg8::StaticOrder S; S.init(T, D, F.G, F.bid);
        EpiPle E{HBc, HBn, (const bf16_t*)(ws + WS_PR), (const float*)(ws + WS_CTL + CTL_SSQC) + l * T, (u64*)(ws + WS_CTL + CTL_SSQA) + (l + 1) * T};
        pg8::gemm_phase<EpiPle, pg8::StaticOrder, true, true>(F.lds, g, S, E, F.wave);
    }
}
__global__ void __launch_bounds__(NTHREADS, 2) mega(Args args) {
    extern __shared__ __attribute__((aligned(16))) unsigned char lds_raw[];
    Frame F; F.lds = (LAS unsigned char*)lds_raw; F.ws = args.ws; F.a = &args;
    F.tid = threadIdx.x; F.lane = F.tid & 63; F.wave = __builtin_amdgcn_readfirstlane(F.tid >> 6); F.G = gridDim.x;
    F.gw = blockIdx.x * NWAVES + F.wave; F.ngw = F.G * NWAVES; F.bid = blockIdx.x;
    volatile LAS unsigned* misc = (volatile LAS unsigned*)(F.lds + MISC_OFF);
    if (F.tid < 32) misc[F.tid] = 0u;
    __syncthreads();
    (void)xcd_barrier_post((unsigned*)(args.ws + WS_CTL + CTL_BAR), misc + 8);
#define GRID_BAR() do { XcdBarrier b_; b_.bar = (unsigned*)(args.ws + WS_CTL + CTL_BAR); b_.x = xb_xcc_id(); b_.st = (volatile LAS unsigned*)(F.lds + MISC_OFF) + 8; xcd_barrier(b_, F.wave); } while (0)
    run_phase<100>(F, 0); GRID_BAR();
    for (int l = 0; l < DEPTH; ++l) {
        run_phase<0>(F, l); GRID_BAR();
        run_phase<1>(F, l); GRID_BAR();
        run_phase<3>(F, l); GRID_BAR();
        run_phase<4>(F, l); GRID_BAR();
        run_phase<5>(F, l); GRID_BAR();
        run_phase<6>(F, l); GRID_BAR();
        run_phase<8>(F, l); GRID_BAR();
        run_phase<9>(F, l); GRID_BAR();
    }
    run_phase<101>(F, 0);
#undef GRID_BAR
}

extern "C" void kernel_launch(void* const* d_in, const int* in_sizes, int n_in, void* d_out, int out_size, void* d_ws, size_t ws_size, hipStream_t stream) {
    static int grid = 0;
    if (grid == 0) {
        if (n_in != 28 || out_size != T * D || ws_size < WS_END) { fprintf(stderr, "kernel_launch: unexpected shapes (n_in %d out %d ws %zu need %zu)\n", n_in, out_size, ws_size, (size_t)WS_END); grid = -1; return; }
        if (hipFuncSetAttribute((const void*)mega, hipFuncAttributeMaxDynamicSharedMemorySize, LDS_BYTES) != hipSuccess) { fprintf(stderr, "kernel_launch: hipFuncSetAttribute failed\n"); grid = -1; return; }
        int dev = 0, cus = 0, per_cu = 0; (void)hipGetDevice(&dev); (void)hipDeviceGetAttribute(&cus, hipDeviceAttributeMultiprocessorCount, dev);
        if (hipOccupancyMaxActiveBlocksPerMultiprocessor(&per_cu, (const void*)mega, NTHREADS, LDS_BYTES) != hipSuccess || per_cu < 1) { fprintf(stderr, "kernel_launch: occupancy query says %d blocks per CU\n", per_cu); (void)hipGetLastError(); }
        grid = cus > 0 ? cus : 256;
    }
    if (grid < 0) return;
    (void)hipMemsetAsync((char*)d_ws + WS_CTL, 0, CTL_BYTES, stream);
    Args a{};
    for (int i = 0; i < 28; ++i) a.in[i] = (const float*)d_in[i];
    a.out = (float*)d_out; a.ws = (unsigned char*)d_ws;
    hipLaunchKernelGGL(mega, dim3(grid), dim3(NTHREADS), LDS_BYTES, stream, a);
}
```

```cpp
#include <hip/hip_runtime.h>
#include <cstdio>
#include <cstdint>

#define GAS __attribute__((address_space(1)))
#define LAS __attribute__((address_space(3)))
typedef unsigned short bf16_t;
typedef short bf16x8 __attribute__((ext_vector_type(8)));
typedef float f32x4 __attribute__((ext_vector_type(4)));
typedef unsigned u32x4 __attribute__((ext_vector_type(4)));
typedef unsigned u32x2 __attribute__((ext_vector_type(2)));
typedef float f32x2_t __attribute__((ext_vector_type(2)));
typedef float v16f_t __attribute__((ext_vector_type(16)));
typedef float v32f_t __attribute__((ext_vector_type(32)));
typedef unsigned v6u_t __attribute__((ext_vector_type(6)));
constexpr int EROW = 1536;
constexpr int VROW = 1024;

constexpr int D = 2048, BATCH = 4, SEQ = 2048, T = BATCH * SEQ, DEPTH = 4, PLE = 256;
constexpr int IN_COLS = 5832, NZ = 5888;
constexpr int ZC_DQ = 0, ZC_DK = 512, ZC_DV = 1024, ZC_GQ = 1536, ZC_GF = 2048, ZC_GV = 2560, ZC_GG = 3072, ZC_MCQ = 3584, ZC_MCKV = 3968, ZC_MKR = 4224,
              ZC_LQ = 4288, ZC_LK = 4544, ZC_LV = 4800, ZC_LO = 5312, ZC_LI = 5824, ZC_LF = 5828;
constexpr int NEXP = 16384;
constexpr float EPS = 1e-6f;
constexpr int NWAVES = 8, NTHREADS = 512;

constexpr size_t MiB = 1u << 20;
constexpr size_t al(size_t x) { return (x + 255) & ~(size_t)255; }
constexpr size_t WS_CTL = 0, CTL_BYTES = 2 * MiB;
constexpr size_t CTL_BAR = 0;
constexpr size_t CTL_CVQ = 32 * 1024;
constexpr size_t CTL_SSQA = 64 * 1024;
constexpr size_t CTL_SSQB = CTL_SSQA + 5 * T * 8;
constexpr size_t CTL_MQS = CTL_SSQB + 4 * T * 8;
constexpr size_t CTL_MKVS = CTL_MQS + 4 * T * 8;
constexpr size_t CTL_SSQC = CTL_MKVS + 4 * T * 8;
static_assert(CTL_SSQC + 4 * T * 4 <= 1536 * 1024, "ctl");
constexpr size_t WS_WIN = CTL_BYTES;
constexpr size_t WS_WOUT = WS_WIN + al((size_t)DEPTH * NZ * D * 2);
constexpr size_t WS_WQ = WS_WOUT + al((size_t)DEPTH * D * D * 2);
constexpr size_t WS_WG = WS_WQ + al((size_t)DEPTH * D * D * 2);
constexpr size_t WS_WP = WS_WG + al((size_t)DEPTH * D * D * 2);
constexpr size_t WS_WUQ = WS_WP + al((size_t)DEPTH * D * PLE * 2);
constexpr size_t WS_WUKV = WS_WUQ + al((size_t)DEPTH * 768 * 384 * 2);
constexpr size_t WS_UB = WS_WUKV + al((size_t)DEPTH * 1024 * 256 * 2);
constexpr size_t WS_VB = WS_UB + al((size_t)DEPTH * NEXP * D * 2);
constexpr size_t WS_PB = WS_VB + al((size_t)DEPTH * NEXP * D * 2);
constexpr size_t WS_CS = WS_PB + al((size_t)DEPTH * T * PLE * 2);
constexpr size_t WS_LBS = WS_CS + al((size_t)T * 32 * 2 * 4);
constexpr size_t WS_H = WS_LBS + al((size_t)DEPTH * 512 * 4);
constexpr size_t WS_HB = WS_H + al((size_t)T * D * 4);
constexpr size_t WS_Z = WS_HB + 2 * al((size_t)T * D * 2);
constexpr size_t WS_QM = WS_Z + al((size_t)T * NZ * 2);
constexpr size_t WS_KVM = WS_QM + al((size_t)T * 768 * 2);
constexpr size_t WS_KRM = WS_KVM + al((size_t)T * 1024 * 2);
constexpr size_t WS_Y = WS_KRM + al((size_t)T * 64 * 2);
constexpr size_t WS_QP = WS_Y + al((size_t)T * D * 2);
constexpr size_t WS_QB = WS_QP;
constexpr size_t WS_PR = WS_QP + al((size_t)T * D * 4);
constexpr size_t WS_PIDX = WS_PR + al((size_t)T * D * 4);
constexpr size_t WS_PGATE = WS_PIDX + al((size_t)T * 128 * 4);
constexpr size_t WS_GQ = WS_PGATE + al((size_t)T * 128 * 4);
constexpr size_t WS_GK = WS_GQ + al((size_t)T * 512 * 4);
constexpr size_t WS_GF = WS_GK + al((size_t)T * 512 * 4);
constexpr size_t WS_OG = WS_GF + al((size_t)T * 512 * 4);
constexpr size_t WS_LQK = WS_OG + al((size_t)T * 512 * 4);
constexpr size_t WS_LIF = WS_LQK + al((size_t)T * 512 * 4);
constexpr size_t WS_OL = WS_LIF + al((size_t)T * 8 * 4);
constexpr size_t WS_O1 = WS_OL + al((size_t)T * 512 * 4);
constexpr size_t WS_PRM = WS_O1 + al((size_t)T * 512 * 4);
constexpr int PRM_L = 4608, PRM_CW = 0, PRM_CB = 2048, PRM_GB = 2560, PRM_DL = 2576, PRM_DN = 2832, PRM_HN = 3344, PRM_MN = 3856, PRM_FIN = DEPTH * PRM_L;
constexpr size_t WS_SKB = WS_PRM + al((size_t)(PRM_FIN + D) * 4);
constexpr size_t WS_SU = WS_SKB + al((size_t)DEPTH * 8 * 2 * 128 * 128 * 2);
constexpr size_t WS_SV = WS_SU + al((size_t)DEPTH * NEXP * 4);
constexpr int NSEG = 2, SEGC = SEQ / 64 / NSEG, NCONVWG = 64;
constexpr size_t WS_QTG = WS_SV + al((size_t)DEPTH * NEXP * 4);
constexpr size_t WS_QTL = WS_QTG + al((size_t)16 * SEQ * 128 * 2);
constexpr size_t WS_SCL = WS_QTL + al((size_t)16 * SEQ * 64 * 2);
constexpr size_t WS_SIB = WS_SCL + al((size_t)16 * SEQ * 4 * 4);
constexpr size_t WS_SIF = WS_SIB + al((size_t)2 * 16 * NSEG * 128 * 128 * 2);
constexpr size_t WS_SIM = WS_SIF + al((size_t)2 * 16 * NSEG * 128 * 128 * 4);
constexpr size_t WS_END = WS_SIM + al((size_t)16 * NSEG * 128 * 4);
constexpr size_t CTL_SEGF = 1536 * 1024;
static_assert(CTL_SEGF + DEPTH * 2 * 16 * NSEG * 64 <= CTL_BYTES, "ctl segf");

typedef float f32x2v_t __attribute__((ext_vector_type(2)));
typedef __bf16 bf16x2v_t __attribute__((ext_vector_type(2)));
__device__ __forceinline__ unsigned pk2(float lo, float hi) { const bf16x2v_t r = __builtin_convertvector((f32x2v_t){lo, hi}, bf16x2v_t); return __builtin_bit_cast(unsigned, r); }
__device__ __forceinline__ unsigned f2bf(float f) { return pk2(f, 0.f) & 0xffffu; }
__device__ __forceinline__ float bf2f(unsigned short b) { return __builtin_bit_cast(float, ((unsigned)b) << 16); }
__device__ __forceinline__ float bflo(unsigned w) { return __builtin_bit_cast(float, w << 16); }
__device__ __forceinline__ float bfhi(unsigned w) { return __builtin_bit_cast(float, w & 0xffff0000u); }
#define DPP_F(v, ctrl) __builtin_bit_cast(float, __builtin_amdgcn_update_dpp(0, __builtin_bit_cast(int, (v)), (ctrl), 0xF, 0xF, false))
__device__ __forceinline__ float rdlane_f(float v, int l) { return __builtin_bit_cast(float, __builtin_amdgcn_readlane(__builtin_bit_cast(int, v), l)); }
__device__ __forceinline__ float wave_sum(float v) {
    v += DPP_F(v, 0xB1); v += DPP_F(v, 0x4E); v += DPP_F(v, 0x141); v += DPP_F(v, 0x140);
    return (rdlane_f(v, 0) + rdlane_f(v, 16)) + (rdlane_f(v, 32) + rdlane_f(v, 48));
}
__device__ __forceinline__ float wave_max(float v) {
    v = fmaxf(v, DPP_F(v, 0xB1)); v = fmaxf(v, DPP_F(v, 0x4E)); v = fmaxf(v, DPP_F(v, 0x141)); v = fmaxf(v, DPP_F(v, 0x140));
    return fmaxf(fmaxf(rdlane_f(v, 0), rdlane_f(v, 16)), fmaxf(rdlane_f(v, 32), rdlane_f(v, 48)));
}
__device__ __forceinline__ int bperm_i(int src, int v) { return __builtin_amdgcn_ds_bpermute(src << 2, v); }
__device__ __forceinline__ float bperm_f(int src, float v) { return __builtin_bit_cast(float, __builtin_amdgcn_ds_bpermute(src << 2, __builtin_bit_cast(int, v))); }
typedef unsigned long long u64;
__device__ __forceinline__ int lane_id_fresh() { int l; asm volatile("v_mbcnt_lo_u32_b32 %0, -1, 0\n\tv_mbcnt_hi_u32_b32 %0, -1, %0" : "=v"(l)); return l; }
__device__ __forceinline__ void ssq_add(u64* p, float s) { atomicAdd(p, (u64)(s * 16777216.f)); }
__device__ __forceinline__ float ssq_get(const u64* p) { return (float)(*p) * (1.f / 16777216.f); }
__device__ __forceinline__ float rcpf_(float x) { return __builtin_amdgcn_rcpf(x); }
__device__ __forceinline__ float sigmoidf_(float x) { return rcpf_(1.f + __expf(-x)); }

namespace pg8 {
constexpr int BM = 256, BK = 64, HALF = 128, HTB = HALF * BK * 2, STAGE_BYTES = 8 * HTB, NXCD = 8, WGM = 8;
__host__ __device__ __forceinline__ int lds_byte(int r, int c) { const int st = (r >> 4) * 2 + (c >> 5), rr = r & 15, cc = c & 31, ob = rr * 64 + cc * 2; return st * 1024 + (ob ^ (((ob >> 9) & 1) << 5)); }
__host__ __device__ __forceinline__ void stage_rc(int b, int& R, int& C) { const int st = b / 1024, sb = b % 1024, swz = sb ^ (((sb >> 9) & 1) << 5); R = (st >> 1) * 16 + swz / 64; C = (st & 1) * 32 + (swz % 64) / 2; }
__host__ __device__ __forceinline__ int perm32(int rho) { const int n = rho >> 4, i = rho & 15; return 8 * (i >> 2) + 4 * n + (i & 3); }
struct Unit { int pm, pn; };
struct Gemm { const bf16_t* A; const bf16_t* Bt; int M, N, K, lda, ldb; };
struct StaticOrder {
    int nM, nN, nwg, G, c;
    __host__ __device__ void init(int M, int N, int G_, int c_) { nM = M / BM; nN = N / BM; nwg = nM * nN; G = G_; c = c_; }
    __host__ __device__ bool next(int i, Unit& u) const {
        const long L = (long)i * G + c; if (L >= nwg) return false;
        int wgid = (int)L; { const int q = nwg / NXCD, r = nwg % NXCD, xcd = wgid % NXCD, off = wgid / NXCD; wgid = (xcd < r ? xcd * (q + 1) : r * (q + 1) + (xcd - r) * q) + off; }
        const int nig = WGM * nN, gid = wgid / nig, fm = gid * WGM, gsz = (nM - fm) < WGM ? (nM - fm) : WGM;
        u.pm = fm + ((wgid % nig) % gsz); u.pn = (wgid % nig) / gsz; return true;
    }
    __device__ __forceinline__ void a_ready(const Unit&) const {}
    __device__ __forceinline__ void done(const Unit&) const {}
};
template <class Epi, class Sched, bool ALIGN_EPI = false, bool SP2 = false>
__device__ __forceinline__ void gemm_phase(LAS unsigned char* lds, const Gemm g, const Sched& S, const Epi& E, int wave_s) {
    const int tid = wave_s * 64 + lane_id_fresh(), wid = wave_s, lane = tid & 63, wr = wid >> 2, wc = wid & 3, fr = lane & 15, fq = lane >> 4;
    const int K = g.K, nt = K / BK;
    unsigned voffA[2], voffB[2];
#pragma unroll
    for (int i = 0; i < 2; ++i) { int R, C; stage_rc(tid * 16 + i * 8192, R, C); const int Rb = Epi::PERM ? ((R & ~31) + perm32(R & 31)) : R;
        voffA[i] = (unsigned)(R * g.lda + C) * 2u; voffB[i] = (unsigned)(Rb * g.ldb + C) * 2u; }
    const size_t kstep = (size_t)(BK * 2);
    const size_t hstepA = (size_t)HALF * g.lda * 2, hstepB = (size_t)HALF * g.ldb * 2;
    const size_t tstepA = 2 * hstepA, tstepB = 2 * hstepB;
    const unsigned ldsw = (unsigned)wid * 1024u;
    const int aoff = lds_byte(wr * 64 + fr, fq * 8), boff = lds_byte(wc * 32 + fr, fq * 8);
#define PG8_SA(b, h) (((b) * 2 + (h)) * HTB)
#define PG8_SB(b, h) ((4 + (b) * 2 + (h)) * HTB)
#define PG8_STAGE(bufoff, gbase, voff) do { _Pragma("unroll") for (int _i = 0; _i < 2; ++_i) \
        __builtin_amdgcn_global_load_lds((const unsigned*)((const char*)(gbase) + (voff)[_i]), (LAS unsigned*)(lds + (bufoff) + ldsw + _i * 8192), 16, 0, 0); } while (0)
#define PG8_LDA(dst, b, h) do { _Pragma("unroll") for (int m = 0; m < 4; ++m) _Pragma("unroll") for (int k = 0; k < 2; ++k) dst[m][k] = *(const LAS bf16x8*)(lds + PG8_SA(b, h) + aoff + m * 2048 + k * 1024); } while (0)
#define PG8_LDB(dst, b, h) do { _Pragma("unroll") for (int n = 0; n < 2; ++n) _Pragma("unroll") for (int k = 0; k < 2; ++k) dst[n][k] = *(const LAS bf16x8*)(lds + PG8_SB(b, h) + boff + n * 2048 + k * 1024); } while (0)
#define PG8_MMA(ai, bj, At, Bt) do { __builtin_amdgcn_s_setprio(1); _Pragma("unroll") for (int m = 0; m < 4; ++m) _Pragma("unroll") for (int n = 0; n < 2; ++n) _Pragma("unroll") for (int k = 0; k < 2; ++k) \
        acc[ai][bj][m][n] = __builtin_amdgcn_mfma_f32_16x16x32_bf16(Bt[n][k], At[m][k], acc[ai][bj][m][n], 0, 0, 0); __builtin_amdgcn_s_setprio(0); } while (0)
#define PG8_WAIT_V(n) asm volatile("s_waitcnt vmcnt(" #n ")" ::: "memory")
#define PG8_WAIT_L(n) asm volatile("s_waitcnt lgkmcnt(" #n ")" ::: "memory")
#define PG8_BAR __builtin_amdgcn_s_barrier()
#define PG8_SCHED __builtin_amdgcn_sched_barrier(0)
    Unit cur, nxt; int ui = 0;
    if (!S.next(0, cur)) return;
    f32x4 acc[2][2][4][2];
#pragma unroll
    for (int a = 0; a < 2; ++a)
#pragma unroll
        for (int b = 0; b < 2; ++b)
#pragma unroll
            for (int m = 0; m < 4; ++m)
#pragma unroll
                for (int n = 0; n < 2; ++n) acc[a][b][m][n] = (f32x4){0.f, 0.f, 0.f, 0.f};
    bf16x8 At[4][2], B0[2][2], B1[2][2];
    const char* cA = (const char*)g.A + (size_t)cur.pm * tstepA; const char* cB = (const char*)g.Bt + (size_t)cur.pn * tstepB;
    S.a_ready(cur);
    if constexpr (SP2) {
        PG8_STAGE(PG8_SB(0, 0), cB, voffB); PG8_STAGE(PG8_SB(0, 1), cB + hstepB, voffB); PG8_STAGE(PG8_SA(0, 0), cA, voffA); PG8_STAGE(PG8_SA(0, 1), cA + hstepA, voffA);
        if (wr == 1) PG8_BAR;
        PG8_WAIT_V(2); PG8_BAR;
        PG8_STAGE(PG8_SB(1, 0), cB + kstep, voffB); PG8_STAGE(PG8_SA(1, 0), cA + kstep, voffA); PG8_STAGE(PG8_SB(1, 1), cB + hstepB + kstep, voffB);
        PG8_WAIT_V(6); PG8_BAR;
    } else {
        PG8_STAGE(PG8_SB(0, 0), cB, voffB); PG8_STAGE(PG8_SA(0, 0), cA, voffA); PG8_STAGE(PG8_SB(0, 1), cB + hstepB, voffB); PG8_STAGE(PG8_SA(0, 1), cA + hstepA, voffA);
        if (wr == 1) PG8_BAR;
        PG8_WAIT_V(4); PG8_BAR;
        PG8_STAGE(PG8_SB(1, 0), cB + kstep, voffB); PG8_STAGE(PG8_SA(1, 0), cA + kstep, voffA); PG8_STAGE(PG8_SB(1, 1), cB + hstepB + kstep, voffB);
        PG8_WAIT_V(6); PG8_BAR;
    }
    for (;;) {
        const bool has_next = S.next(ui + 1, nxt);
        const char* nA = has_next ? (const char*)g.A + (size_t)nxt.pm * tstepA : cA; const char* nB = has_next ? (const char*)g.Bt + (size_t)nxt.pn * tstepB : cB;
        for (int t = 0; t < nt; t += 2) {
            const bool last = (t == nt - 2);
            const char* a1 = cA + (size_t)(t + 1) * kstep;
            const char* a2 = last ? nA : cA + (size_t)(t + 2) * kstep; const char* b2 = last ? nB : cB + (size_t)(t + 2) * kstep;
            const char* a3 = a2 + kstep; const char* b3 = b2 + kstep;
            if (last && has_next) S.a_ready(nxt);
            if constexpr (SP2) {
            PG8_LDB(B0, 0, 0); PG8_LDB(B1, 0, 1); PG8_SCHED; PG8_LDA(At, 0, 0); PG8_STAGE(PG8_SA(1, 1), a1 + hstepA, voffA);
            PG8_WAIT_V(8); PG8_WAIT_L(0); PG8_BAR; PG8_MMA(0, 0, At, B0); PG8_MMA(0, 1, At, B1); PG8_BAR; PG8_SCHED;
            PG8_LDA(At, 0, 1); PG8_STAGE(PG8_SB(0, 0), b2, voffB); PG8_STAGE(PG8_SB(0, 1), b2 + hstepB, voffB); PG8_STAGE(PG8_SA(0, 0), a2, voffA);
            PG8_WAIT_V(8); PG8_WAIT_L(0); PG8_BAR; PG8_MMA(1, 0, At, B0); PG8_MMA(1, 1, At, B1); PG8_BAR; PG8_SCHED;
            PG8_LDB(B0, 1, 0); PG8_LDB(B1, 1, 1); PG8_SCHED; PG8_LDA(At, 1, 0); PG8_STAGE(PG8_SA(0, 1), a2 + hstepA, voffA);
            PG8_WAIT_V(8); PG8_WAIT_L(0); PG8_BAR; PG8_MMA(0, 0, At, B0); PG8_MMA(0, 1, At, B1); PG8_BAR; PG8_SCHED;
            PG8_LDA(At, 1, 1); PG8_STAGE(PG8_SB(1, 0), b3, voffB); PG8_STAGE(PG8_SB(1, 1), b3 + hstepB, voffB); PG8_STAGE(PG8_SA(1, 0), a3, voffA);
            PG8_WAIT_V(8); PG8_WAIT_L(0); PG8_BAR; PG8_MMA(1, 0, At, B0); PG8_MMA(1, 1, At, B1); PG8_BAR; PG8_SCHED;
            } else {
            PG8_LDB(B0, 0, 0); PG8_SCHED; PG8_LDA(At, 0, 0); PG8_STAGE(PG8_SA(1, 1), a1 + hstepA, voffA);
            PG8_WAIT_L(8); PG8_BAR; PG8_WAIT_L(0); PG8_MMA(0, 0, At, B0); PG8_BAR; PG8_SCHED;
            PG8_LDB(B1, 0, 1); PG8_STAGE(PG8_SB(0, 0), b2, voffB);
            PG8_BAR; PG8_WAIT_L(0); PG8_MMA(0, 1, At, B1); PG8_BAR;
            PG8_LDA(At, 0, 1); PG8_STAGE(PG8_SA(0, 0), a2, voffA);
            PG8_BAR; PG8_WAIT_L(0); PG8_MMA(1, 0, At, B0); PG8_BAR; PG8_SCHED;
            PG8_STAGE(PG8_SB(0, 1), b2 + hstepB, voffB);
            PG8_WAIT_V(6); PG8_BAR; PG8_MMA(1, 1, At, B1); PG8_BAR;
            PG8_LDB(B0, 1, 0); PG8_SCHED; PG8_LDA(At, 1, 0); PG8_STAGE(PG8_SA(0, 1), a2 + hstepA, voffA);
            PG8_WAIT_L(8); PG8_BAR; PG8_WAIT_L(0); PG8_MMA(0, 0, At, B0); PG8_BAR; PG8_SCHED;
            PG8_LDB(B1, 1, 1); PG8_STAGE(PG8_SB(1, 0), b3, voffB);
            PG8_BAR; PG8_WAIT_L(0); PG8_MMA(0, 1, At, B1); PG8_BAR;
            PG8_LDA(At, 1, 1); PG8_STAGE(PG8_SA(1, 0), a3, voffA);
            PG8_BAR; PG8_WAIT_L(0); PG8_MMA(1, 0, At, B0); PG8_BAR; PG8_SCHED;
            PG8_STAGE(PG8_SB(1, 1), b3 + hstepB, voffB);
            PG8_WAIT_V(6); PG8_BAR; PG8_MMA(1, 1, At, B1); PG8_BAR;
            }
        }
        if constexpr (ALIGN_EPI) { if (wr == 0) PG8_BAR; }
        if constexpr (!Epi::AFTER_DRAIN) { E(acc, cur, wr, wc, fr, fq); S.done(cur); }
        if (!has_next) break;
#pragma unroll
        for (int a = 0; a < 2; ++a)
#pragma unroll
            for (int b = 0; b < 2; ++b)
#pragma unroll
                for (int m = 0; m < 4; ++m)
#pragma unroll
                    for (int n = 0; n < 2; ++n) acc[a][b][m][n] = (f32x4){0.f, 0.f, 0.f, 0.f};
        cur = nxt; cA = nA; cB = nB; ++ui;
        if constexpr (ALIGN_EPI) { if (wr == 1) PG8_BAR; }
    }
    PG8_WAIT_V(0);
    if constexpr (!ALIGN_EPI) { if (wr == 0) PG8_BAR; }
    PG8_BAR;
    if constexpr (Epi::AFTER_DRAIN) { E.fused(acc, cur, wr, wc, fr, fq, lds, wid, lane); S.done(cur); }
#undef PG8_SA
#undef PG8_SB
#undef PG8_STAGE
#undef PG8_LDA
#undef PG8_LDB
#undef PG8_MMA
#undef PG8_WAIT_V
#undef PG8_WAIT_L
#undef PG8_BAR
#undef PG8_SCHED
}
}

#define EPI_ROWS(ai, m) (u.pm * 256 + (ai) * 128 + wr * 64 + (m) * 16 + fr)
#define EPI_COL0 (u.pn * 256 + wc * 32 + 8 * fq)
typedef const f32x4 (&AccT)[2][2][4][2];

__device__ __forceinline__ float fq_sum(float v, int lane) { v += bperm_f(lane ^ 16, v); v += bperm_f(lane ^ 32, v); return v; }

struct EpiZ {
    static constexpr bool PERM = true, AFTER_DRAIN = false;
    bf16_t* Z; const u64* ssq; u64* mqs; u64* mkvs;
    __device__ __forceinline__ void operator()(AccT acc, const pg8::Unit& u, int wr, int wc, int fr, int fq) const {
        const int col0 = EPI_COL0;
#pragma unroll
        for (int ai = 0; ai < 2; ++ai)
#pragma unroll
            for (int m = 0; m < 4; ++m) {
                const int row = EPI_ROWS(ai, m); const float rs = rsqrtf(ssq_get(ssq + row) * (1.f / D) + EPS);
                float sq = 0.f, skv = 0.f;
#pragma unroll
                for (int bj = 0; bj < 2; ++bj) {
                    const f32x4 v0 = acc[ai][bj][m][0] * rs, v1 = acc[ai][bj][m][1] * rs;
                    u32x4 w; w.x = pk2(v0[0], v0[1]); w.y = pk2(v0[2], v0[3]); w.z = pk2(v1[0], v1[1]); w.w = pk2(v1[2], v1[3]);
                    *(u32x4*)(Z + (size_t)row * NZ + col0 + bj * 128) = w;
                    const float s2 = v0[0] * v0[0] + v0[1] * v0[1] + v0[2] * v0[2] + v0[3] * v0[3] + v1[0] * v1[0] + v1[1] * v1[1] + v1[2] * v1[2] + v1[3] * v1[3];
                    const int cb = u.pn * 256 + bj * 128;
                    if (cb >= ZC_MCQ && cb < ZC_MCKV) sq += s2;
                    if (cb >= ZC_MCKV && cb < ZC_MKR) skv += s2;
                }
                if (u.pn >= 14 && u.pn <= 16) {
                    sq = fq_sum(sq, fr + 16 * fq); skv = fq_sum(skv, fr + 16 * fq);
                    if (fq == 0) { if (u.pn <= 15) ssq_add(mqs + row, sq); if (u.pn >= 15) ssq_add(mkvs + row, skv); }
                }
            }
    }
};
struct EpiBf16s {
    static constexpr bool PERM = true, AFTER_DRAIN = false;
    bf16_t* O; int ldo; const u64* ssq; float inv_n;
    __device__ __forceinline__ void operator()(AccT acc, const pg8::Unit& u, int wr, int wc, int fr, int fq) const {
        const int col0 = EPI_COL0;
#pragma unroll
        for (int ai = 0; ai < 2; ++ai)
#pragma unroll
            for (int m = 0; m < 4; ++m) {
                const int row = EPI_ROWS(ai, m); const float rs = ssq ? rsqrtf(ssq_get(ssq + row) * inv_n + EPS) : 1.f;
#pragma unroll
                for (int bj = 0; bj < 2; ++bj) {
                    const f32x4 v0 = acc[ai][bj][m][0] * rs, v1 = acc[ai][bj][m][1] * rs;
                    u32x4 w; w.x = pk2(v0[0], v0[1]); w.y = pk2(v0[2], v0[3]); w.z = pk2(v1[0], v1[1]); w.w = pk2(v1[2], v1[3]);
                    *(u32x4*)(O + (size_t)row * ldo + col0 + bj * 128) = w;
                }
            }
    }
};
struct EpiRes {
    static constexpr bool PERM = true, AFTER_DRAIN = false;
    bf16_t* HB; u64* ssq;
    __device__ __forceinline__ void operator()(AccT acc, const pg8::Unit& u, int wr, int wc, int fr, int fq) const {
        const int col0 = EPI_COL0;
#pragma unroll
        for (int ai = 0; ai < 2; ++ai)
#pragma unroll
            for (int m = 0; m < 4; ++m) {
                const int row = EPI_ROWS(ai, m); float s2 = 0.f;
#pragma unroll
                for (int bj = 0; bj < 2; ++bj) {
                    bf16_t* hp = HB + (size_t)row * D + col0 + bj * 128;
                    const u32x4 hw = *(const u32x4*)hp;
                    const f32x4 v0 = (f32x4){bflo(hw[0]), bfhi(hw[0]), bflo(hw[1]), bfhi(hw[1])} + acc[ai][bj][m][0], v1 = (f32x4){bflo(hw[2]), bfhi(hw[2]), bflo(hw[3]), bfhi(hw[3])} + acc[ai][bj][m][1];
                    u32x4 w; w.x = pk2(v0[0], v0[1]); w.y = pk2(v0[2], v0[3]); w.z = pk2(v1[0], v1[1]); w.w = pk2(v1[2], v1[3]);
                    *(u32x4*)hp = w;
                    s2 += v0[0] * v0[0] + v0[1] * v0[1] + v0[2] * v0[2] + v0[3] * v0[3] + v1[0] * v1[0] + v1[1] * v1[1] + v1[2] * v1[2] + v1[3] * v1[3];
                }
                s2 = fq_sum(s2, fr + 16 * fq);
                if (fq == 0) ssq_add(ssq + row, s2);
            }
    }
};
struct EpiF32s {
    static constexpr bool PERM = true, AFTER_DRAIN = false;
    float* C; const u64* ssq;
    __device__ __forceinline__ void operator()(AccT acc, const pg8::Unit& u, int wr, int wc, int fr, int fq) const {
        const int col0 = EPI_COL0;
#pragma unroll
        for (int ai = 0; ai < 2; ++ai)
#pragma unroll
            for (int m = 0; m < 4; ++m) {
                const int row = EPI_ROWS(ai, m); const float rs = ssq ? rsqrtf(ssq_get(ssq + row) * (1.f / D) + EPS) : 1.f;
#pragma unroll
                for (int bj = 0; bj < 2; ++bj) {
                    float* cp = C + (size_t)row * D + col0 + bj * 128;
                    *(f32x4*)cp = acc[ai][bj][m][0] * rs; *(f32x4*)(cp + 4) = acc[ai][bj][m][1] * rs;
                }
            }
    }
};
struct EpiPle {
    static constexpr bool PERM = true, AFTER_DRAIN = false;
    const bf16_t* HBin; bf16_t* HBout; const bf16_t* PR; const float* ssq_in; u64* ssq_out;
    __device__ __forceinline__ void operator()(AccT acc, const pg8::Unit& u, int wr, int wc, int fr, int fq) const {
        const int col0 = EPI_COL0;
#pragma unroll
        for (int ai = 0; ai < 2; ++ai)
#pragma unroll
            for (int m = 0; m < 4; ++m) {
                const int row = EPI_ROWS(ai, m); const float rs = rsqrtf(ssq_in[row] * (1.f / D) + EPS); float s2 = 0.f;
#pragma unroll
                for (int bj = 0; bj < 2; ++bj) {
                    const size_t o = (size_t)row * D + col0 + bj * 128;
                    const u32x4 hw = *(const u32x4*)(HBin + o), pw = *(const u32x4*)(PR + o);
                    f32x4 v0 = (f32x4){bflo(hw[0]), bfhi(hw[0]), bflo(hw[1]), bfhi(hw[1])}, v1 = (f32x4){bflo(hw[2]), bfhi(hw[2]), bflo(hw[3]), bfhi(hw[3])};
                    const f32x4 p0 = (f32x4){bflo(pw[0]), bfhi(pw[0]), bflo(pw[1]), bfhi(pw[1])}, p1 = (f32x4){bflo(pw[2]), bfhi(pw[2]), bflo(pw[3]), bfhi(pw[3])};
#pragma unroll
                    for (int j = 0; j < 4; ++j) { v0[j] += sigmoidf_(acc[ai][bj][m][0][j] * rs) * p0[j]; v1[j] += sigmoidf_(acc[ai][bj][m][1][j] * rs) * p1[j]; }
                    u32x4 w; w.x = pk2(v0[0], v0[1]); w.y = pk2(v0[2], v0[3]); w.z = pk2(v1[0], v1[1]); w.w = pk2(v1[2], v1[3]);
                    *(u32x4*)(HBout + o) = w;
                    s2 += v0[0] * v0[0] + v0[1] * v0[1] + v0[2] * v0[2] + v0[3] * v0[3] + v1[0] * v1[0] + v1[1] * v1[1] + v1[2] * v1[2] + v1[3] * v1[3];
                }
                s2 = fq_sum(s2, fr + 16 * fq);
                if (fq == 0) ssq_add(ssq_out + row, s2);
            }
    }
};

__device__ __forceinline__ int f2ord(float f) { const int b = __builtin_bit_cast(int, f); return b >= 0 ? b : (b ^ 0x7FFFFFFF); }
__device__ __forceinline__ float ord2f(int k) { const int b = k >= 0 ? k : (k ^ 0x7FFFFFFF); return __builtin_bit_cast(float, b); }
__device__ __forceinline__ int row16_max(int v) {
    asm("s_nop 1\n\tv_max_i32_dpp %0, %0, %0 quad_perm:[1,0,3,2] row_mask:0xf bank_mask:0xf\n\ts_nop 1\n\tv_max_i32_dpp %0, %0, %0 quad_perm:[2,3,0,1] row_mask:0xf bank_mask:0xf\n\t"
        "s_nop 1\n\tv_max_i32_dpp %0, %0, %0 row_half_mirror row_mask:0xf bank_mask:0xf\n\ts_nop 1\n\tv_max_i32_dpp %0, %0, %0 row_mirror row_mask:0xf bank_mask:0xf" : "+v"(v));
    return v;
}
__device__ __forceinline__ float row16_sum(float v) {
    v += __builtin_bit_cast(float, __builtin_amdgcn_update_dpp(0, __builtin_bit_cast(int, v), 0xB1, 0xF, 0xF, false)); v += __builtin_bit_cast(float, __builtin_amdgcn_update_dpp(0, __builtin_bit_cast(int, v), 0x4E, 0xF, 0xF, false));
    v += __builtin_bit_cast(float, __builtin_amdgcn_update_dpp(0, __builtin_bit_cast(int, v), 0x141, 0xF, 0xF, false)); v += __builtin_bit_cast(float, __builtin_amdgcn_update_dpp(0, __builtin_bit_cast(int, v), 0x140, 0xF, 0xF, false));
    return v;
}
__device__ __forceinline__ void peer_topk_mfma(LAS unsigned char* lds, int wid, const bf16_t* QB, const bf16_t* SKB, int* PIDX, float* PG, int pm, int pn) {
    constexpr int SQL = 272, L_SK = 0;
    const int lane = lane_id_fresh(), tid = wid * 64 + lane, l15 = lane & 15, g = lane >> 4;
    int tk[2][2][4];
#pragma unroll
    for (int c = 0; c < 2; ++c) {
        const bf16_t* sk = SKB + ((size_t)(pn * 2 + c) * 128) * 128;
#pragma unroll
        for (int i = 0; i < 4; ++i) { const int id = tid + 512 * i, n = id >> 4, dc = id & 15; *(LAS u32x4*)(lds + L_SK + n * SQL + dc * 16) = *(const u32x4*)(sk + n * 128 + dc * 8); }
        bf16x8 af[2][4];
#pragma unroll
        for (int rt = 0; rt < 2; ++rt)
#pragma unroll
            for (int ks = 0; ks < 4; ++ks) af[rt][ks] = *(const bf16x8*)(QB + (size_t)(pm * 256 + 32 * wid + 16 * rt + l15) * D + pn * 256 + c * 128 + 32 * ks + 8 * g);
        __syncthreads();
        int key[2][8][4];
#pragma unroll
        for (int nt = 0; nt < 8; ++nt) {
            f32x4 sc0 = (f32x4){0.f, 0.f, 0.f, 0.f}, sc1 = (f32x4){0.f, 0.f, 0.f, 0.f};
#pragma unroll
            for (int ks = 0; ks < 4; ++ks) {
                const bf16x8 bfr = *(const LAS bf16x8*)(lds + L_SK + (16 * nt + l15) * SQL + (32 * ks + 8 * g) * 2);
                sc0 = __builtin_amdgcn_mfma_f32_16x16x32_bf16(af[0][ks], bfr, sc0, 0, 0, 0);
                sc1 = __builtin_amdgcn_mfma_f32_16x16x32_bf16(af[1][ks], bfr, sc1, 0, 0, 0);
            }
#pragma unroll
            for (int r = 0; r < 4; ++r) { key[0][nt][r] = (f2ord(sc0[r]) & ~127) | (127 - (16 * nt + l15)); key[1][nt][r] = (f2ord(sc1[r]) & ~127) | (127 - (16 * nt + l15)); }
        }
        __syncthreads();
#pragma unroll
        for (int rt = 0; rt < 2; ++rt)
#pragma unroll
            for (int r = 0; r < 4; ++r) {
#define SK_(i) key[rt][i][r]
#define CE_(i, j) do { const int hi_ = max(SK_(i), SK_(j)), lo_ = min(SK_(i), SK_(j)); SK_(i) = hi_; SK_(j) = lo_; } while (0)
                CE_(0, 1); CE_(2, 3); CE_(4, 5); CE_(6, 7); CE_(0, 2); CE_(1, 3); CE_(4, 6); CE_(5, 7); CE_(1, 2); CE_(5, 6);
                CE_(0, 4); CE_(1, 5); CE_(2, 6); CE_(3, 7); CE_(2, 4); CE_(3, 5); CE_(1, 2); CE_(3, 4); CE_(5, 6);
                int mine = 0;
#pragma unroll 1
                for (int k = 0; k < 16; ++k) {
                    const int v = row16_max(SK_(0));
                    if (l15 == k) mine = v;
                    const bool won = (SK_(0) == v);
#pragma unroll
                    for (int nt = 0; nt < 7; ++nt) SK_(nt) = won ? SK_(nt + 1) : SK_(nt);
                    SK_(7) = won ? (int)0x80000000 : SK_(7);
                }
#undef CE_
#undef SK_
                tk[c][rt][r] = mine;
            }
    }
    int ci_[4], cj_[4]; bool cv_[4];
    ci_[0] = 0; cj_[0] = l15; cv_[0] = true;
    ci_[1] = l15 < 8 ? 1 : (l15 < 13 ? 2 : 3); cj_[1] = l15 < 8 ? l15 : (l15 < 13 ? l15 - 8 : l15 - 13); cv_[1] = true;
    ci_[2] = l15 == 0 ? 3 : (l15 < 4 ? 4 : (l15 < 6 ? 5 : (l15 < 8 ? 6 : (l15 < 10 ? 7 : l15 - 2))));
    cj_[2] = l15 == 0 ? 3 : (l15 < 4 ? l15 - 1 : (l15 < 6 ? l15 - 4 : (l15 < 8 ? l15 - 6 : (l15 < 10 ? l15 - 8 : 0)))); cv_[2] = true;
    ci_[3] = 14 + (l15 & 1); cj_[3] = 0; cv_[3] = l15 < 2;
#pragma unroll
    for (int rt = 0; rt < 2; ++rt)
#pragma unroll
        for (int r = 0; r < 4; ++r) {
            int ck[4];
#pragma unroll
            for (int q = 0; q < 4; ++q) {
                const float s0 = ord2f(bperm_i((lane & 48) + ci_[q], tk[0][rt][r]) & ~127), s1 = ord2f(bperm_i((lane & 48) + cj_[q], tk[1][rt][r]) & ~127);
                ck[q] = cv_[q] ? ((f2ord(s0 + s1) & ~255) | (255 - (16 * ci_[q] + cj_[q]))) : (int)0x80000000;
            }
            int mine = 0;
            for (int k = 0; k < 16; ++k) {
                int v = max(max(ck[0], ck[1]), max(ck[2], ck[3]));
                v = row16_max(v);
                if (l15 == k) mine = v;
#pragma unroll
                for (int q = 0; q < 4; ++q) ck[q] = (ck[q] == v) ? (int)0x80000000 : ck[q];
            }
            const int pos = 255 - (mine & 255), ci = pos >> 4, cj = pos & 15;
            const int i0 = 127 - (bperm_i((lane & 48) + ci, tk[0][rt][r]) & 127), i1 = 127 - (bperm_i((lane & 48) + cj, tk[1][rt][r]) & 127);
            const float bv = ord2f(mine & ~255), b0 = ord2f(bperm_i(lane & 48, mine) & ~255);
            const float ex = __expf(bv - b0), sum = row16_sum(ex);
            const size_t o = (size_t)(pm * 256 + 32 * wid + 16 * rt + 4 * g + r) * 128 + pn * 16 + l15;
            PIDX[o] = i0 * 128 + i1; PG[o] = ex * rcpf_(sum);
        }
}

#define XB_TMO      128
#define XB_XCNT(j)  (256  + 64 * (j))
#define XB_XSUB(j)  (1280 + 64 * (j))
#define XB_XGEN(j)  (2304 + 64 * (j))
#define XB_TOP      3328
#define XB_TOPGEN   3392
#define XCD_BAR_WORDS 3456
#define XB_SPIN_CAP (1u << 18)
__device__ __forceinline__ unsigned xb_ld(unsigned* p)              { return __hip_atomic_load(p, __ATOMIC_RELAXED, __HIP_MEMORY_SCOPE_AGENT); }
__device__ __forceinline__ unsigned xb_add(unsigned* p, unsigned v) { return __hip_atomic_fetch_add(p, v, __ATOMIC_RELAXED, __HIP_MEMORY_SCOPE_AGENT); }
__device__ __forceinline__ unsigned xb_xcc_id() { return (unsigned)__builtin_amdgcn_s_getreg((3 << 11) | 20) & 0xFu; }
#define XB_SPIN(cond, bar) do { unsigned _sp = 0; while (cond) { __builtin_amdgcn_s_sleep(1); \
    if ((++_sp & 255u) == 0u) { if (xb_ld(&(bar)[XB_TMO])) break; if (_sp > XB_SPIN_CAP) { atomicAdd(&(bar)[XB_TMO], 1u); break; } } } } while (0)
struct XcdBarrier { unsigned* bar; unsigned x; volatile LAS unsigned* st; };
__device__ __forceinline__ XcdBarrier xcd_barrier_post(unsigned* bar, volatile LAS unsigned* st) {
    XcdBarrier b; b.bar = bar; b.x = xb_xcc_id(); b.st = st;
    if (threadIdx.x == 0) (void)xb_add(&bar[XB_XCNT(b.x)], 1u);
    return b;
}
__device__ __forceinline__ void xcd_barrier_complete(unsigned* bar, unsigned x, unsigned& nloc, unsigned& nx) {
    const unsigned G = gridDim.x * gridDim.y * gridDim.z;
    unsigned sum, cnt, mine, sp = 0u;
    for (;;) {
        sum = 0u; cnt = 0u; mine = 0u;
#pragma unroll
        for (unsigned j = 0; j < 16; ++j) { const unsigned c = xb_ld(&bar[XB_XCNT(j)]); sum += c; cnt += (c > 0u) ? 1u : 0u; mine = (j == x) ? c : mine; }
        if (sum == G) break;
        __builtin_amdgcn_s_sleep(1);
        if ((++sp & 255u) == 0u) { if (xb_ld(&bar[XB_TMO])) break; if (sp > XB_SPIN_CAP) { atomicAdd(&bar[XB_TMO], 1u); break; } }
    }
    nloc = mine > 0u ? mine : 1u; nx = cnt > 0u ? cnt : 1u;
}
__device__ __forceinline__ void xcd_barrier(const XcdBarrier& b, int wave_s) {
    asm volatile("s_waitcnt vmcnt(0)" ::: "memory");
    __syncthreads();
    if (wave_s == 0 && lane_id_fresh() == 0) {
        unsigned* bar = b.bar;
        __builtin_amdgcn_s_waitcnt(0);
        unsigned nloc = b.st[0], nx = b.st[1];
        if (nloc == 0u) { xcd_barrier_complete(bar, b.x, nloc, nx); b.st[0] = nloc; b.st[1] = nx; }
        const unsigned old = xb_add(&bar[XB_XSUB(b.x)], 1u);
        const unsigned gen = old / nloc;
        if (old + 1u == (gen + 1u) * nloc) {
            __builtin_amdgcn_fence(__ATOMIC_RELEASE, "agent");
            asm volatile("s_waitcnt vmcnt(0)" ::: "memory");
            const unsigned og = xb_add(&bar[XB_TOP], 1u);
            const unsigned tg = og / nx;
            if (og + 1u == (tg + 1u) * nx) xb_add(&bar[XB_TOPGEN], 1u);
            else XB_SPIN(xb_ld(&bar[XB_TOPGEN]) == tg, bar);
            __builtin_amdgcn_fence(__ATOMIC_ACQUIRE, "agent");
            xb_add(&bar[XB_XGEN(b.x)], 1u);
            asm volatile("s_waitcnt vmcnt(0)" ::: "memory");
        } else {
            XB_SPIN(xb_ld(&bar[XB_XGEN(b.x)]) == gen, bar);
            __builtin_amdgcn_fence(__ATOMIC_ACQUIRE, "agent");
            asm volatile("s_waitcnt vmcnt(0)" ::: "memory");
        }
    }
    __syncthreads();
}

constexpr int RING_BYTES = 131072, MISC_OFF = RING_BYTES + 320, LDS_BYTES = 147456;
struct Args { const float* in[28]; float* out; unsigned char* ws; int ph_lo, ph_hi; };
enum { I_X = 0, I_P, I_POS, I_LN_MIX, I_W_IN, I_DIFF_LAMBDA, I_DIFF_NORM, I_HGRN_LB, I_HGRN_NORM, I_MLA_QN, I_MLA_KVN, I_MLA_WUQ, I_MLA_WUKV, I_CONV_W, I_CONV_B, I_GATE_B,
       I_MLSTM_NORM, I_GROUP_GAIN, I_W_OUT, I_LN_FFN, I_PEER_WQ, I_PEER_SUBKEYS, I_PEER_U, I_PEER_V, I_LN_PLE, I_PLE_WGATE, I_PLE_WPROJ, I_LN_FINAL };

struct Frame {
    LAS unsigned char* lds; unsigned char* ws; const Args* a;
    int tid, lane, wave, G, gw, ngw, bid;
};

__device__ __forceinline__ int cmap_win(int n) {
    if (n < ZC_MKR) return n;
    if (n < ZC_LQ) { const int j = n - ZC_MKR; return ZC_MKR + (j >> 1) + 32 * (j & 1); }
    if (n < ZC_LO) return n;
    if (n < ZC_LI) return 5320 + (n - ZC_LO);
    if (n < ZC_LF) return 5312 + (n - ZC_LI);
    if (n < IN_COLS) return 5316 + (n - ZC_LF);
    return -1;
}
__device__ __forceinline__ int cmap_uq(int n) { const int hd = n / 192, r = n % 192; if (r < 128) return n; const int j = r - 128; return hd * 192 + 128 + (j >> 1) + 32 * (j & 1); }

template <int MAP>
__device__ __forceinline__ void transpose_item(const float* W, int K, int Nsrc, int Ndst, const float* gain, bf16_t* WT, LAS float* scr_, int item, int lane) {
    LAS unsigned char* scr = (LAS unsigned char*)scr_;
    const int nblk = Ndst / 64, kb = item / nblk, nb = item % nblk, k0 = 64 * kb, n0 = 64 * nb;
    const int nq = (lane & 15) * 4, kr = lane >> 4;
    if (MAP == 0 || (MAP == 1 && (n0 + 64 <= ZC_MKR || (n0 >= ZC_LQ && n0 + 64 <= ZC_LO)))) {
        f32x4 tv[16]; float gk[16];
#pragma unroll
        for (int i = 0; i < 16; ++i) tv[i] = *(const f32x4*)(W + (size_t)(k0 + kr + 4 * i) * Nsrc + n0 + nq);
        if (gain) {
#pragma unroll
            for (int i = 0; i < 16; ++i) gk[i] = gain[k0 + kr + 4 * i];
        } else {
#pragma unroll
            for (int i = 0; i < 16; ++i) gk[i] = 1.f;
        }
#pragma unroll
        for (int i = 0; i < 16; ++i) { const int kk = kr + 4 * i; const f32x4 v = tv[i] * gk[i];
#pragma unroll
            for (int e = 0; e < 4; ++e) *(LAS bf16_t*)(scr + (nq + e) * 144 + kk * 2) = (bf16_t)f2bf(v[e]); }
    } else {
        int src[4];
#pragma unroll
        for (int e = 0; e < 4; ++e) src[e] = (MAP == 1) ? cmap_win(n0 + nq + e) : cmap_uq(n0 + nq + e);
        const int s0 = src[0] > 0 ? src[0] : 0, s1 = src[1] > 0 ? src[1] : 0, s2 = src[2] > 0 ? src[2] : 0, s3 = src[3] > 0 ? src[3] : 0;
        float ts[16][4], gk[16];
#pragma unroll
        for (int i = 0; i < 16; ++i) { const float* wr = W + (size_t)(k0 + kr + 4 * i) * Nsrc; ts[i][0] = wr[s0]; ts[i][1] = wr[s1]; ts[i][2] = wr[s2]; ts[i][3] = wr[s3]; }
        if (gain) {
#pragma unroll
            for (int i = 0; i < 16; ++i) gk[i] = gain[k0 + kr + 4 * i];
        } else {
#pragma unroll
            for (int i = 0; i < 16; ++i) gk[i] = 1.f;
        }
#pragma unroll
        for (int i = 0; i < 16; ++i) { const int kk = kr + 4 * i;
#pragma unroll
            for (int e = 0; e < 4; ++e) { const float v = (src[e] >= 0) ? ts[i][e] * gk[i] : 0.f; *(LAS bf16_t*)(scr + (nq + e) * 144 + kk * 2) = (bf16_t)f2bf(v); } }
    }
    asm volatile("s_waitcnt lgkmcnt(0)" ::: "memory");
#pragma unroll
    for (int j = 0; j < 8; ++j) { const int n = (lane >> 3) + 8 * j, c = lane & 7; *(u32x4*)(WT + (size_t)(n0 + n) * K + k0 + 8 * c) = *(const LAS u32x4*)(scr + n * 144 + c * 16); }
    asm volatile("s_waitcnt lgkmcnt(0)" ::: "memory");
}

constexpr int CV_TAB = 4096, CV_WIN = CV_TAB + 736, CV_WOUT = CV_WIN + 256, CV_WQ = CV_WOUT + 256, CV_WG = CV_WQ + 256, CV_WP = CV_WG + 32, CV_UQ = CV_WP + 18, CV_UKV = CV_UQ + 16,
              CV_P = CV_UKV + 128, NCONV = CV_P + 16;
__device__ __forceinline__ bool conv_early(int item) { return (item >= CV_TAB && item < CV_WIN) || (item >= CV_WP && item < CV_UKV); }
__device__ __forceinline__ void convert_item(Frame& F, int l, int item, int lane) {
    const Args& a = *F.a; unsigned char* ws = F.ws;
    LAS float* scr = (LAS float*)(F.lds + F.wave * 16384);
    if (item < CV_TAB) {
        const int tab = item >> 11, r0 = l * NEXP + (item & 2047) * 8;
        const float* SRC = a.in[tab ? I_PEER_V : I_PEER_U]; unsigned char* DST = ws + (tab ? WS_VB : WS_UB); float* SC = (float*)(ws + (tab ? WS_SV : WS_SU));
        const float* gF = a.in[I_LN_FFN] + l * D;
        f32x4 gv[8];
#pragma unroll
        for (int q = 0; q < 8; ++q) { gv[q] = (f32x4){1.f, 1.f, 1.f, 1.f}; if (tab == 0) gv[q] = *(const f32x4*)(gF + q * 256 + lane * 4); }
        float mysc = 1.f;
        f32x4 nx[2][8];
#pragma unroll
        for (int k = 0; k < 2; ++k)
#pragma unroll
            for (int q = 0; q < 8; ++q) nx[k][q] = *(const f32x4*)(SRC + (size_t)(r0 + k) * D + q * 256 + lane * 4);
#pragma unroll
        for (int rr = 0; rr < 8; ++rr) {
            const int row = r0 + rr; f32x4 v[8]; float am = 0.f;
#pragma unroll
            for (int q = 0; q < 8; ++q) v[q] = nx[rr & 1][q];
            if (rr + 2 < 8) {
#pragma unroll
                for (int q = 0; q < 8; ++q) nx[rr & 1][q] = *(const f32x4*)(SRC + (size_t)(row + 2) * D + q * 256 + lane * 4);
            }
#pragma unroll
            for (int q = 0; q < 8; ++q) {
                v[q] *= gv[q];
                am = fmaxf(am, fmaxf(fmaxf(fabsf(v[q][0]), fabsf(v[q][1])), fmaxf(fabsf(v[q][2]), fabsf(v[q][3]))));
            }
            am = wave_max(am);
            const float sc = am > 0.f ? am * (1.f / 6.f) : 1.f, inv = 1.f / sc;
            u32x4 pk;
#pragma unroll
            for (int q2 = 0; q2 < 4; ++q2) { unsigned w = 0;
                w = __builtin_amdgcn_cvt_scalef32_pk_fp4_f32(w, v[2 * q2][0] * inv, v[2 * q2][1] * inv, 1.0f, 0);
                w = __builtin_amdgcn_cvt_scalef32_pk_fp4_f32(w, v[2 * q2][2] * inv, v[2 * q2][3] * inv, 1.0f, 1);
                w = __builtin_amdgcn_cvt_scalef32_pk_fp4_f32(w, v[2 * q2 + 1][0] * inv, v[2 * q2 + 1][1] * inv, 1.0f, 2);
                w = __builtin_amdgcn_cvt_scalef32_pk_fp4_f32(w, v[2 * q2 + 1][2] * inv, v[2 * q2 + 1][3] * inv, 1.0f, 3);
                pk[q2] = w; }
            *(u32x4*)(DST + (size_t)row * VROW + lane * 16) = pk;
            mysc = (lane == rr) ? sc : mysc;
        }
        if (lane < 8) SC[r0 + lane] = mysc;
        return;
    }
#define CV_TR(MAP, base, WI, GI, K_, NS_, ND_, WSOFF) do { const int i0_ = (item - (base)) * 4; const float* W_ = a.in[WI] + (size_t)l * (K_) * (NS_); const float* g_ = (GI) >= 0 ? a.in[(GI) >= 0 ? (GI) : 0] + l * (K_) : nullptr; \
        bf16_t* WT_ = (bf16_t*)(ws + (WSOFF)) + (size_t)l * (ND_) * (K_); _Pragma("unroll 1") for (int j_ = 0; j_ < 4; ++j_) if (i0_ + j_ < ((K_) / 64) * ((ND_) / 64)) transpose_item<MAP>(W_, K_, NS_, ND_, g_, WT_, scr, i0_ + j_, lane); } while (0)
    if (item < CV_WIN) { CV_TR(1, CV_TAB, I_W_IN, I_LN_MIX, D, IN_COLS, NZ, WS_WIN); return; }
    if (item < CV_WOUT) { CV_TR(0, CV_WIN, I_W_OUT, I_GROUP_GAIN, D, D, D, WS_WOUT); return; }
    if (item < CV_WQ) { CV_TR(0, CV_WOUT, I_PEER_WQ, I_LN_FFN, D, D, D, WS_WQ); return; }
    if (item < CV_WG) { CV_TR(0, CV_WQ, I_PLE_WGATE, I_LN_PLE, D, D, D, WS_WG); return; }
    if (item < CV_WP) { CV_TR(0, CV_WG, I_PLE_WPROJ, -1, PLE, D, D, WS_WP); return; }
    if (item < CV_UQ) { CV_TR(2, CV_WP, I_MLA_WUQ, I_MLA_QN, 384, 768, 768, WS_WUQ); return; }
    if (item < CV_UKV) { CV_TR(0, CV_UQ, I_MLA_WUKV, I_MLA_KVN, 256, 1024, 1024, WS_WUKV); return; }
#undef CV_TR
    if (item < CV_P) {
        const size_t e0 = (size_t)l * T * PLE + (size_t)(item - CV_UKV) * 16384; const float* Pp = a.in[I_P]; bf16_t* PB = (bf16_t*)(ws + WS_PB);
#pragma unroll 4
        for (int i = 0; i < 32; ++i) { const size_t e = e0 + (size_t)i * 512 + lane * 8; const f32x4 v0 = *(const f32x4*)(Pp + e), v1 = *(const f32x4*)(Pp + e + 4);
            u32x4 w; w.x = pk2(v0[0], v0[1]); w.y = pk2(v0[2], v0[3]); w.z = pk2(v1[0], v1[1]); w.w = pk2(v1[2], v1[3]); *(u32x4*)(PB + e) = w; }
        return;
    }
    {
        const size_t e0 = (size_t)l * 8 * 2 * 128 * 128 + (size_t)(item - CV_P) * 16384; const float* sk = a.in[I_PEER_SUBKEYS]; bf16_t* skb = (bf16_t*)(ws + WS_SKB);
#pragma unroll 4
        for (int i = 0; i < 32; ++i) { const size_t e = e0 + (size_t)i * 512 + lane * 8; const f32x4 v0 = *(const f32x4*)(sk + e), v1 = *(const f32x4*)(sk + e + 4);
            u32x4 w; w.x = pk2(v0[0], v0[1]); w.y = pk2(v0[2], v0[3]); w.z = pk2(v1[0], v1[1]); w.w = pk2(v1[2], v1[3]); *(u32x4*)(skb + e) = w; }
    }
}
__device__ __forceinline__ void convert_layers(Frame& F, int l0, int l1, int gw, int NGW, bool early_only) {
    const int lane = lane_id_fresh();
    for (int l = l0; l < l1; ++l)
#pragma unroll 1
        for (int it = gw; it < NCONV; it += NGW) if (!early_only || conv_early(it)) convert_item(F, l, it, lane);
}
__device__ __forceinline__ void convert_layer_queue(Frame& F, int l, unsigned* ctr) {
    const int lane = lane_id_fresh();
#pragma unroll 1
    for (;;) {
        unsigned it = 0;
        if (lane == 0) it = __hip_atomic_fetch_add(ctr, 1u, __ATOMIC_RELAXED, __HIP_MEMORY_SCOPE_AGENT);
        it = __builtin_amdgcn_readfirstlane(it);
        if (it >= (unsigned)NCONV) break;
        const int ll = conv_early((int)it) ? l + 1 : l;
        if (ll < DEPTH) convert_item(F, ll, (int)it, lane);
    }
}

__device__ __forceinline__ void prologue(Frame& F) {
    const Args& a = *F.a; unsigned char* ws = F.ws;
    const int gw = F.gw, NGW = F.ngw, lane = F.lane;
    const size_t gt = (size_t)blockIdx.x * NTHREADS + F.tid, GT = (size_t)F.G * NTHREADS;
    if (F.G == 256) convert_layers(F, 0, 1, gw, NGW, true);
    else convert_layers(F, 0, DEPTH, gw, NGW, false);
    {
        const float* X = a.in[I_X]; bf16_t* HB = (bf16_t*)(ws + WS_HB); u64* ssq = (u64*)(ws + WS_CTL + CTL_SSQA);
        for (int t = gw; t < T; t += NGW) {
            float s2 = 0.f;
#pragma unroll
            for (int c = 0; c < 4; ++c) {
                const size_t o = (size_t)t * D + c * 512 + lane * 8;
                const f32x4 v0 = *(const f32x4*)(X + o), v1 = *(const f32x4*)(X + o + 4);
                u32x4 w; w.x = pk2(v0[0], v0[1]); w.y = pk2(v0[2], v0[3]); w.z = pk2(v1[0], v1[1]); w.w = pk2(v1[2], v1[3]);
                *(u32x4*)(HB + o) = w;
                s2 += v0[0] * v0[0] + v0[1] * v0[1] + v0[2] * v0[2] + v0[3] * v0[3] + v1[0] * v1[0] + v1[1] * v1[1] + v1[2] * v1[2] + v1[3] * v1[3];
            }
            s2 = wave_sum(s2);
            if (lane == 0) ssq[t] = (u64)(s2 * 16777216.f);
        }
    }
    {
        const int* pos = (const int*)a.in[I_POS]; float* cs = (float*)(ws + WS_CS);
        for (size_t i = gt; i < (size_t)T * 32; i += GT) {
            const int t = (int)(i / 32), j = (int)(i % 32);
            const float inv = powf(10000.0f, -(float)j / 32.0f);
            const float ang = (float)pos[t] * inv;
            const double rev = (double)ang * 0.15915494309189535;
            const float fr = (float)(rev - rint(rev));
            cs[i * 2] = __builtin_amdgcn_cosf(fr); cs[i * 2 + 1] = __builtin_amdgcn_sinf(fr);
        }
    }
    {
        float* prm = (float*)(ws + WS_PRM);
#define PRM_COPY(IDX, OFF, N) do { const float* src_ = a.in[IDX]; for (size_t i = gt; i < (size_t)DEPTH * (N); i += GT) { const int l_ = (int)(i / (N)), o_ = (int)(i % (N)); prm[l_ * PRM_L + (OFF) + o_] = src_[i]; } } while (0)
        PRM_COPY(I_CONV_W, PRM_CW, 2048); PRM_COPY(I_CONV_B, PRM_CB, 512); PRM_COPY(I_GATE_B, PRM_GB, 8); PRM_COPY(I_DIFF_LAMBDA, PRM_DL, 256);
        PRM_COPY(I_DIFF_NORM, PRM_DN, 512); PRM_COPY(I_HGRN_NORM, PRM_HN, 512); PRM_COPY(I_MLSTM_NORM, PRM_MN, 512);
#undef PRM_COPY
        for (size_t i = gt; i < (size_t)D; i += GT) prm[PRM_FIN + i] = a.in[I_LN_FINAL][i];
    }
    if (blockIdx.x == 0) {
        const float* lg = a.in[I_HGRN_LB]; float* lbs = (float*)(ws + WS_LBS);
        for (int c = F.tid; c < 512; c += NTHREADS) {
            float v[DEPTH], mx = -1e30f;
#pragma unroll
            for (int l = 0; l < DEPTH; ++l) { v[l] = lg[l * 512 + c]; mx = fmaxf(mx, v[l]); }
            float s = 0.f;
#pragma unroll
            for (int l = 0; l < DEPTH; ++l) { v[l] = expf(v[l] - mx); s += v[l]; }
            float cum = 0.f; float first = 0.f;
#pragma unroll
            for (int l = 0; l < DEPTH; ++l) { cum += v[l] / s; if (l == 0) first = cum; lbs[l * 512 + c] = cum - first; }
        }
    }
}

__device__ __forceinline__ void mix_prep(Frame& F, int l) {
    unsigned char* ws = F.ws;
    const bf16_t* Z = (const bf16_t*)(ws + WS_Z);
    const size_t gt = (size_t)F.bid * NTHREADS + F.tid, GT = (size_t)F.G * NTHREADS;
    bf16_t* KR = (bf16_t*)(ws + WS_KRM); const float* cs = (const float*)(ws + WS_CS);
    for (size_t i = gt; i < (size_t)T * 32; i += GT) {
        const int t = (int)(i / 32), j = (int)(i % 32);
        const float x1 = bf2f(Z[(size_t)t * NZ + ZC_MKR + 2 * j]), x2 = bf2f(Z[(size_t)t * NZ + ZC_MKR + 2 * j + 1]);
        const float c = cs[i * 2], sn = cs[i * 2 + 1];
        *(unsigned*)(KR + (size_t)t * 64 + 2 * j) = pk2(x1 * c - x2 * sn, x2 * c + x1 * sn);
    }
}

typedef float f32x16 __attribute__((ext_vector_type(16)));
typedef short s16x4 __attribute__((ext_vector_type(4)));
__device__ __forceinline__ int crow(int r, int hi) { return (r & 3) + 8 * (r >> 2) + 4 * hi; }
template <int OFF> __device__ __forceinline__ s16x4 tr_read(unsigned addr) { s16x4 r; asm volatile("ds_read_b64_tr_b16 %0, %1 offset:%2" : "=&v"(r) : "v"(addr), "i"(OFF) : "memory"); return r; }
constexpr int ATT_SV = 320;
template <int D0, int BLK, int KS> __device__ __forceinline__ bf16x8 v_frag(unsigned vaddr) {
    const s16x4 lo = tr_read<(32 * BLK + 16 * KS) * ATT_SV + 64 * D0>(vaddr), hi = tr_read<(32 * BLK + 16 * KS + 8) * ATT_SV + 64 * D0>(vaddr);
    return (bf16x8){lo[0], lo[1], lo[2], lo[3], hi[0], hi[1], hi[2], hi[3]};
}
__device__ __forceinline__ bf16x8 pack8(const f32x16& p, int base) {
    u32x4 w; w.x = pk2(p[base + 0], p[base + 1]); w.y = pk2(p[base + 2], p[base + 3]); w.z = pk2(p[base + 4], p[base + 5]); w.w = pk2(p[base + 6], p[base + 7]);
    return __builtin_bit_cast(bf16x8, w);
}
struct VFrags { bf16x8 a00, a01, a10, a11; };
template <int D0> __device__ __forceinline__ VFrags v_frags(unsigned vaddr) { VFrags f; f.a00 = v_frag<D0, 0, 0>(vaddr); f.a01 = v_frag<D0, 0, 1>(vaddr); f.a10 = v_frag<D0, 1, 0>(vaddr); f.a11 = v_frag<D0, 1, 1>(vaddr); return f; }
__device__ __forceinline__ void pv_mma(f32x16& o, const VFrags& f, bf16x8 p00, bf16x8 p01, bf16x8 p10, bf16x8 p11) {
    o = __builtin_amdgcn_mfma_f32_32x32x16_bf16(f.a00, p00, o, 0, 0, 0);
    o = __builtin_amdgcn_mfma_f32_32x32x16_bf16(f.a01, p01, o, 0, 0, 0);
    o = __builtin_amdgcn_mfma_f32_32x32x16_bf16(f.a10, p10, o, 0, 0, 0);
    o = __builtin_amdgcn_mfma_f32_32x32x16_bf16(f.a11, p11, o, 0, 0, 0);
}
__device__ __forceinline__ void pv_all(f32x16 (&o)[4], unsigned vaddr, bf16x8 p00, bf16x8 p01, bf16x8 p10, bf16x8 p11) {
    const VFrags f0 = v_frags<0>(vaddr); const VFrags f1 = v_frags<1>(vaddr);
    asm volatile("s_waitcnt lgkmcnt(8)" ::: "memory"); __builtin_amdgcn_sched_barrier(0);
    pv_mma(o[0], f0, p00, p01, p10, p11);
    __builtin_amdgcn_sched_barrier(0);
    const VFrags f2 = v_frags<2>(vaddr);
    asm volatile("s_waitcnt lgkmcnt(8)" ::: "memory"); __builtin_amdgcn_sched_barrier(0);
    pv_mma(o[1], f1, p00, p01, p10, p11);
    __builtin_amdgcn_sched_barrier(0);
    const VFrags f3 = v_frags<3>(vaddr);
    asm volatile("s_waitcnt lgkmcnt(8)" ::: "memory"); __builtin_amdgcn_sched_barrier(0);
    pv_mma(o[2], f2, p00, p01, p10, p11);
    asm volatile("s_waitcnt lgkmcnt(0)" ::: "memory"); __builtin_amdgcn_sched_barrier(0);
    pv_mma(o[3], f3, p00, p01, p10, p11);
}
template <int MODE>
__device__ __forceinline__ void attn_unit(Frame& F, int l, int b, int h, int qb) {
    constexpr int DK = MODE ? 192 : 64, NS = DK / 16, SK = DK * 2 + 16, KBYTES = 64 * SK, VBYTES = 64 * ATT_SV, BUFB = KBYTES + VBYTES, KCH = DK / 8, NKC = (64 * KCH) / 512;
    constexpr int NMAP = MODE ? 1 : 2;
    constexpr float SCALE = MODE ? 0.07216878364870322f : 0.125f, C = SCALE * 1.4426950408889634f;
    unsigned char* ws = F.ws;
    const bf16_t* Z = (const bf16_t*)(ws + WS_Z); const bf16_t* QM = (const bf16_t*)(ws + WS_QM); const bf16_t* KVM = (const bf16_t*)(ws + WS_KVM); const bf16_t* KRM = (const bf16_t*)(ws + WS_KRM);
    bf16_t* Y = (bf16_t*)(ws + WS_Y);
    const int w = F.wave, lane = lane_id_fresh(), tid = w * 64 + lane, r32 = lane & 31, hi = lane >> 5;
    const int q0 = qb * 256, qw = q0 + 32 * w, ntiles = 4 * (qb + 1);
    const size_t rowb = (size_t)b * SEQ;
    const unsigned lds0 = (unsigned)(uintptr_t)F.lds;
    const unsigned kaddr = lds0 + r32 * SK + 16 * hi;
    const unsigned vaddr = lds0 + KBYTES + (((lane & 15) >> 2) + 4 * hi) * ATT_SV + (16 * ((lane >> 4) & 1) + 4 * (lane & 3)) * 2;
    float* O1 = (float*)(ws + WS_O1) + (rowb + qw + r32) * 512 + h * 128 + 4 * hi;
    for (int mp = 0; mp < NMAP; ++mp) {
        bf16x8 qf[NS];
        {
            const bf16_t* qp = MODE ? QM + (rowb + qw + r32) * 768 + h * 192 + 8 * hi : Z + (rowb + qw + r32) * NZ + ZC_DQ + h * 128 + mp * 64 + 8 * hi;
#pragma unroll
            for (int s = 0; s < NS; ++s) qf[s] = *(const bf16x8*)(qp + 16 * s);
            if (MODE == 1) {
                const float* csq = (const float*)(ws + WS_CS) + (rowb + qw + r32) * 64 + 8 * hi;
#pragma unroll
                for (int s = 8; s < NS; ++s) {
                    const f32x4 ca = *(const f32x4*)(csq + 16 * (s - 8)), cb = *(const f32x4*)(csq + 16 * (s - 8) + 4);
                    const u32x4 w = __builtin_bit_cast(u32x4, qf[s]); u32x4 o;
                    { const float x1 = bflo(w[0]), x2 = bfhi(w[0]); o[0] = pk2(x1 * ca[0] - x2 * ca[1], x2 * ca[0] + x1 * ca[1]); }
                    { const float x1 = bflo(w[1]), x2 = bfhi(w[1]); o[1] = pk2(x1 * ca[2] - x2 * ca[3], x2 * ca[2] + x1 * ca[3]); }
                    { const float x1 = bflo(w[2]), x2 = bfhi(w[2]); o[2] = pk2(x1 * cb[0] - x2 * cb[1], x2 * cb[0] + x1 * cb[1]); }
                    { const float x1 = bflo(w[3]), x2 = bfhi(w[3]); o[3] = pk2(x1 * cb[2] - x2 * cb[3], x2 * cb[2] + x1 * cb[3]); }
                    qf[s] = __builtin_bit_cast(bf16x8, o);
                }
            }
        }
        f32x16 o[4];
#pragma unroll
        for (int d = 0; d < 4; ++d) o[d] = (f32x16){};
        float m_run = -1e30f, l_run = 0.f;
        u32x4 kst[NKC], vst[2];
#define ATT_LOAD(j) do { const int k0_ = 64 * (j); \
            _Pragma("unroll") for (int i_ = 0; i_ < NKC; ++i_) { const int c_ = tid + 512 * i_, row_ = c_ / KCH, cc_ = c_ % KCH; \
                const bf16_t* src_ = MODE ? (cc_ < 16 ? KVM + (rowb + k0_ + row_) * 1024 + h * 256 + cc_ * 8 : KRM + (rowb + k0_ + row_) * 64 + (cc_ - 16) * 8) \
                                          : Z + (rowb + k0_ + row_) * NZ + ZC_DK + h * 128 + mp * 64 + cc_ * 8; \
                kst[i_] = *(const u32x4*)src_; } \
            _Pragma("unroll") for (int i_ = 0; i_ < 2; ++i_) { const int c_ = tid + 512 * i_, row_ = c_ >> 4, cc_ = c_ & 15; \
                const bf16_t* src_ = MODE ? KVM + (rowb + k0_ + row_) * 1024 + h * 256 + 128 + cc_ * 8 : Z + (rowb + k0_ + row_) * NZ + ZC_DV + h * 128 + cc_ * 8; \
                vst[i_] = *(const u32x4*)src_; } } while (0)
#define ATT_WRITE(buf) do { \
            _Pragma("unroll") for (int i_ = 0; i_ < NKC; ++i_) { const int c_ = tid + 512 * i_, row_ = c_ / KCH, cc_ = c_ % KCH; *(LAS u32x4*)(F.lds + (buf) * BUFB + row_ * SK + cc_ * 16) = kst[i_]; } \
            _Pragma("unroll") for (int i_ = 0; i_ < 2; ++i_) { const int c_ = tid + 512 * i_, row_ = c_ >> 4, cc_ = c_ & 15; *(LAS u32x4*)(F.lds + (buf) * BUFB + KBYTES + row_ * ATT_SV + cc_ * 16) = vst[i_]; } } while (0)
        ATT_LOAD(0); ATT_WRITE(0);
        __builtin_amdgcn_s_waitcnt(0x0F70);
        __syncthreads();
        for (int j = 0; j < ntiles; ++j) {
            const int k0 = 64 * j; const unsigned bo = (unsigned)(j & 1) * BUFB;
            if (j + 1 < ntiles) ATT_LOAD(j + 1);
            if (k0 <= qw + 31) {
                f32x16 p0 = (f32x16){}, p1 = (f32x16){};
                {
                    bf16x8 ka[NS], kb[NS];
#pragma unroll
                    for (int s = 0; s < NS; ++s) { ka[s] = *(const LAS bf16x8*)(uintptr_t)(kaddr + bo + 32 * s); kb[s] = *(const LAS bf16x8*)(uintptr_t)(kaddr + bo + 32 * SK + 32 * s); }
#pragma unroll
                    for (int s = 0; s < NS; ++s) { p0 = __builtin_amdgcn_mfma_f32_32x32x16_bf16(ka[s], qf[s], p0, 0, 0, 0); p1 = __builtin_amdgcn_mfma_f32_32x32x16_bf16(kb[s], qf[s], p1, 0, 0, 0); }
                    __builtin_amdgcn_sched_group_barrier(0x100, 6, 0);
#pragma unroll
                    for (int s = 0; s < NS - 3; ++s) { __builtin_amdgcn_sched_group_barrier(0x008, 2, 0); __builtin_amdgcn_sched_group_barrier(0x100, 2, 0); }
                    __builtin_amdgcn_sched_group_barrier(0x008, 6, 0);
                }
                if (k0 + 63 > qw) {
                    const int qi = qw + r32;
#pragma unroll
                    for (int r = 0; r < 16; ++r) { const int key = k0 + crow(r, hi); if (key > qi) p0[r] = -1e30f; if (key + 32 > qi) p1[r] = -1e30f; }
                }
                float pmax = p0[0];
#pragma unroll
                for (int r = 1; r < 16; ++r) pmax = fmaxf(pmax, p0[r]);
#pragma unroll
                for (int r = 0; r < 16; ++r) pmax = fmaxf(pmax, p1[r]);
                pmax = fmaxf(pmax, bperm_f(lane ^ 32, pmax));
                const float mn = fmaxf(m_run, pmax), alpha = __builtin_amdgcn_exp2f((m_run - mn) * C), mnC = -mn * C; m_run = mn;
                float ps = 0.f;
#pragma unroll
                for (int r = 0; r < 16; ++r) { p0[r] = __builtin_amdgcn_exp2f(fmaf(p0[r], C, mnC)); p1[r] = __builtin_amdgcn_exp2f(fmaf(p1[r], C, mnC)); ps += p0[r] + p1[r]; }
                ps += bperm_f(lane ^ 32, ps);
                l_run = l_run * alpha + ps;
                if (!__all(alpha == 1.f)) {
#pragma unroll
                    for (int d = 0; d < 4; ++d) o[d] *= alpha;
                }
                const bf16x8 p00 = pack8(p0, 0), p01 = pack8(p0, 8), p10 = pack8(p1, 0), p11 = pack8(p1, 8);
                asm volatile("s_waitcnt lgkmcnt(0)" ::: "memory");
                pv_all(o, vaddr + bo, p00, p01, p10, p11);
            }
            if (j + 1 < ntiles) ATT_WRITE((j + 1) & 1);
            __syncthreads();
        }
#undef ATT_LOAD
#undef ATT_WRITE
        const float il = rcpf_(l_run);
        if (MODE == 0 && mp == 0) {
#pragma unroll
            for (int d = 0; d < 4; ++d)
#pragma unroll
                for (int r4 = 0; r4 < 4; ++r4) *(f32x4*)(O1 + 32 * d + 8 * r4) = (f32x4){o[d][4 * r4] * il, o[d][4 * r4 + 1] * il, o[d][4 * r4 + 2] * il, o[d][4 * r4 + 3] * il};
        } else {
            const size_t yrow = (rowb + qw + r32) * D + (MODE ? 1024 : 0) + h * 128 + 4 * hi;
            if (MODE == 0) {
                const float* lv = (const float*)(ws + WS_PRM) + l * PRM_L + PRM_DL;
                const float s01 = wave_sum(lv[lane] * lv[64 + lane]), s23 = wave_sum(lv[128 + lane] * lv[192 + lane]);
                const float lam_init = 0.8f - 0.6f * __expf(-0.3f * (float)l);
                const float lam = __expf(s01) - __expf(s23) + lam_init;
                const float il2 = lam * il; float ss = 0.f;
#pragma unroll
                for (int d = 0; d < 4; ++d)
#pragma unroll
                    for (int r4 = 0; r4 < 4; ++r4) { const f32x4 a1 = *(const f32x4*)(O1 + 32 * d + 8 * r4);
#pragma unroll
                        for (int e = 0; e < 4; ++e) { const float x = a1[e] - o[d][4 * r4 + e] * il2; o[d][4 * r4 + e] = x; ss += x * x; } }
                ss += bperm_f(lane ^ 32, ss);
                const float rn = rsqrtf(ss * (1.f / 128.f) + EPS) * (1.f - lam_init);
                const float* g = (const float*)(ws + WS_PRM) + l * PRM_L + PRM_DN + h * 128 + 4 * hi;
#pragma unroll
                for (int d = 0; d < 4; ++d)
#pragma unroll
                    for (int r4 = 0; r4 < 4; ++r4) {
                        const f32x4 gg = *(const f32x4*)(g + 32 * d + 8 * r4);
                        u32x2 wv; wv.x = pk2(o[d][4 * r4] * rn * gg[0], o[d][4 * r4 + 1] * rn * gg[1]); wv.y = pk2(o[d][4 * r4 + 2] * rn * gg[2], o[d][4 * r4 + 3] * rn * gg[3]);
                        *(u32x2*)(Y + yrow + 32 * d + 8 * r4) = wv;
                    }
            } else {
#pragma unroll
                for (int d = 0; d < 4; ++d)
#pragma unroll
                    for (int r4 = 0; r4 < 4; ++r4) {
                        u32x2 wv; wv.x = pk2(o[d][4 * r4] * il, o[d][4 * r4 + 1] * il); wv.y = pk2(o[d][4 * r4 + 2] * il, o[d][4 * r4 + 3] * il);
                        *(u32x2*)(Y + yrow + 32 * d + 8 * r4) = wv;
                    }
            }
        }
    }
}
__device__ __forceinline__ void attn_fast(Frame& F, int l) {
    unsigned* actr = (unsigned*)(F.ws + WS_CTL + CTL_CVQ + 4096) + 64 * l;
    volatile LAS unsigned* slot = (volatile LAS unsigned*)(F.lds + MISC_OFF) + 24;
#pragma unroll 1
    for (;;) {
        __syncthreads();
        if (F.tid == 0) *slot = __hip_atomic_fetch_add(actr, 1u, __ATOMIC_RELAXED, __HIP_MEMORY_SCOPE_AGENT);
        __syncthreads();
        const int u = __builtin_amdgcn_readfirstlane((int)*slot);
        if (u >= 256) break;
        const int qb = 7 - (u >> 5), mode = (u >> 4) & 1, b = (u >> 2) & 3, h = u & 3;
        if (mode == 0) attn_unit<0>(F, l, b, h, qb); else attn_unit<1>(F, l, b, h, qb);
    }
}

typedef float f32x4_t __attribute__((ext_vector_type(4)));
template <int KIND>
__device__ __forceinline__ void scan_unit(Frame& F, int l, int b, int h, int seg) {
    constexpr int DK = KIND ? 64 : 128, NKS = DK / 32, NDT = DK / 16, SQ = DK * 2 + 16, SA = 144;
    constexpr int L_QT = 0, L_KT = 64 * SQ, L_KTT = 128 * SQ, L_VT = L_KTT + DK * SA, L_AT = L_VT + 128 * SA, L_ST = L_AT + 64 * SA, L_TAB = L_ST + 128 * SQ;
    constexpr int T_ER = L_TAB, T_EC = T_ER + 512, T_PS = T_EC + 512, T_QS = T_PS + 2048, T_KS = T_QS + 256, T_MT = T_KS + 256, T_NP = T_MT + 256, T_SC = T_NP + 256, T_DEN = T_SC + 64, T_BS = T_DEN + 8 * 256;
    static_assert(T_BS + 256 <= RING_BYTES, "scan LDS");
    unsigned char* ws = F.ws;
    const bf16_t* Z = (const bf16_t*)(ws + WS_Z);
    float* OUT = (float*)(ws + (KIND ? WS_OL : WS_OG));
    const float* prm = (const float*)(ws + WS_PRM) + l * PRM_L;
    LAS unsigned char* lds = F.lds;
    const int w = F.wave, lane = lane_id_fresh(), tid = w * 64 + lane, l15 = lane & 15, g = lane >> 4;
    const int ch = tid & 127, part = tid >> 7, i0 = 16 * part;
    if (w == 2 || w == 3) { const int rt = (w == 2) ? 0 : 2;
#pragma unroll
        for (int r = 0; r < 4; ++r) *(LAS bf16_t*)(lds + L_AT + (16 * rt + 4 * g + r) * SA + (16 * (rt + 1) + l15) * 2) = 0; }
    f32x4 st[NDT];
#pragma unroll
    for (int d = 0; d < NDT; ++d) st[d] = (f32x4){0.f, 0.f, 0.f, 0.f};
    float m_prev = 0.f, np_reg = 0.f, colsum = 0.f, bseg = 0.f;
    float cumlog = 0.f;
    const int bh = b * 4 + h;
    bf16_t* QTS = (bf16_t*)(ws + (KIND ? WS_QTL : WS_QTG)) + (size_t)bh * SEQ * DK;
    float* SCL = (float*)(ws + WS_SCL) + (size_t)bh * SEQ * 4;
    const float lb = KIND ? 0.f : ((const float*)(ws + WS_LBS))[l * 512 + h * 128 + ch];
    unsigned zA[16], zB[16], vr[16], gA = 0, gB = 0;
#define SCAN_LOAD(cc) do { const size_t r0_ = (size_t)b * SEQ + 64 * (cc); \
        if (KIND == 0) { const bf16_t* zr_ = Z + (r0_ + i0) * NZ + h * 128 + ch; \
            _Pragma("unroll") for (int j = 0; j < 16; ++j) { zA[j] = zr_[j * NZ + ZC_GF]; zB[j] = zr_[j * NZ + ZC_GQ]; } } \
        else { const int cidx_ = (ch < 64) ? h * 64 + ch : 256 + h * 64 + (ch - 64); const bf16_t* zc_ = Z + (r0_ + i0) * NZ + ZC_LQ + cidx_; \
            _Pragma("unroll") for (int j = 0; j < 16; ++j) zA[j] = zc_[j * NZ]; \
            if (!((cc) == 0 && part == 0)) { zB[0] = zc_[-3 * NZ]; zB[1] = zc_[-2 * NZ]; zB[2] = zc_[-1 * NZ]; } \
            if (w == 0) { const bf16_t* zg_ = Z + (r0_ + lane) * NZ + h; gA = zg_[ZC_LI]; gB = zg_[ZC_LF]; } } \
        { const bf16_t* zv_ = Z + (r0_ + i0) * NZ + (KIND ? ZC_LV : ZC_GV) + h * 128 + ch; \
            _Pragma("unroll") for (int j = 0; j < 16; ++j) vr[j] = zv_[j * NZ]; } } while (0)
    SCAN_LOAD(seg * SEGC);
    float cw0 = 0.f, cw1 = 0.f, cw2 = 0.f, cw3 = 0.f, cbias = 0.f, gbi = 0.f, gbf = 0.f;
    if (KIND == 1) { const int cidx = (ch < 64) ? h * 64 + ch : 256 + h * 64 + (ch - 64);
        cw0 = prm[PRM_CW + cidx]; cw1 = prm[PRM_CW + 512 + cidx]; cw2 = prm[PRM_CW + 1024 + cidx]; cw3 = prm[PRM_CW + 1536 + cidx]; cbias = prm[PRM_CB + cidx]; gbi = prm[PRM_GB + h]; gbf = prm[PRM_GB + 4 + h]; }
#pragma unroll 1
    for (int c = seg * SEGC; c < (seg + 1) * SEGC; ++c) {
        const size_t row0 = (size_t)b * SEQ + 64 * c;
        float qv[16], kv[16], lf[16];
        if (KIND == 0) {
            float run = 0.f;
#pragma unroll
            for (int j = 0; j < 16; ++j) {
                const float zf = fmaxf(bf2f((bf16_t)zA[j]), -30.f), zq = bf2f((bf16_t)zB[j]);
                const float ez = __expf(-zf), sg = rcpf_(1.f + ez), sgn = ez * sg;
                run += __logf(lb + (1.f - lb) * sg); lf[j] = run; qv[j] = zq * 0.08838834764831845f; kv[j] = (1.f - lb) * sgn;
            }
            *(LAS float*)(lds + T_PS + (part * 128 + ch) * 4) = run;
        } else {
            const float w0 = cw0, w1 = cw1, w2 = cw2, w3 = cw3, cb = cbias;
            const bool first = (c == 0 && part == 0);
            float x0 = first ? 0.f : bf2f((bf16_t)zB[0]), x1 = first ? 0.f : bf2f((bf16_t)zB[1]), x2 = first ? 0.f : bf2f((bf16_t)zB[2]);
#pragma unroll
            for (int j = 0; j < 16; ++j) {
                const float x3 = bf2f((bf16_t)zA[j]);
                float v = cb + x0 * w0 + x1 * w1 + x2 * w2 + x3 * w3; v = v * rcpf_(1.f + __expf(-v));
                qv[j] = (ch < 64) ? v * 0.125f : v; x0 = x1; x1 = x2; x2 = x3;
            }
            if (w == 0) {
                const float li = bf2f((bf16_t)gA) + gbi, zf = bf2f((bf16_t)gB) + gbf;
                const float lfv = fminf(zf, 0.f) - __logf(1.f + __expf(-fabsf(zf)));
                float bb = lfv;
#pragma unroll
                for (int o = 1; o < 64; o <<= 1) { const float t_ = bperm_f(lane - o, bb); if (lane >= o) bb += t_; }
                const float a_ = li - bb; float cm = a_;
#pragma unroll
                for (int o = 1; o < 64; o <<= 1) { const float t_ = bperm_f(lane - o, cm); if (lane >= o) cm = fmaxf(cm, t_); }
                const float M = fmaxf(m_prev, cm), MC = rdlane_f(M, 63), bC = rdlane_f(bb, 63);
                *(LAS float*)(lds + T_QS + lane * 4) = __expf(MC - M); *(LAS float*)(lds + T_KS + lane * 4) = __expf(a_ - MC); *(LAS float*)(lds + T_MT + lane * 4) = bb + M;
                *(LAS float*)(lds + T_BS + lane * 4) = bseg + bb;
                bseg += bC;
                const float cs = __expf(m_prev - MC);
                np_reg = cs * (np_reg + colsum);
                *(LAS float*)(lds + T_NP + lane * 4) = np_reg;
                if (lane == 0) *(LAS float*)(lds + T_SC) = cs;
                m_prev = bC + MC;
            }
        }
        __syncthreads();
        {
            unsigned ktt[8];
            *(LAS u32x4*)(lds + L_VT + ch * SA + i0 * 2) = (u32x4){vr[0] | (vr[1] << 16), vr[2] | (vr[3] << 16), vr[4] | (vr[5] << 16), vr[6] | (vr[7] << 16)};
            *(LAS u32x4*)(lds + L_VT + ch * SA + i0 * 2 + 16) = (u32x4){vr[8] | (vr[9] << 16), vr[10] | (vr[11] << 16), vr[12] | (vr[13] << 16), vr[14] | (vr[15] << 16)};
            if (KIND == 0) {
                const float p0 = *(LAS float*)(lds + T_PS + ch * 4), p1 = *(LAS float*)(lds + T_PS + (128 + ch) * 4), p2 = *(LAS float*)(lds + T_PS + (256 + ch) * 4), p3 = *(LAS float*)(lds + T_PS + (384 + ch) * 4);
                const float r_ = p0 + p1, off = (part > 0 ? p0 : 0.f) + (part > 1 ? p1 : 0.f) + (part > 2 ? p2 : 0.f);
                if (part == 0) { *(LAS float*)(lds + T_ER + ch * 4) = __expf(r_); *(LAS float*)(lds + T_EC + ch * 4) = __expf(p2 + p3); }
                const float eseg = __expf(r_ + cumlog);
                bf16_t* qg_ = QTS + (size_t)(64 * c + i0) * DK + ch;
                cumlog += (p0 + p1) + (p2 + p3);
#pragma unroll
                for (int j = 0; j < 16; ++j) {
                    const float x = fminf(fmaxf(off + lf[j] - r_, -80.f), 80.f);
                    const float qt = qv[j] * __expf(x), kt = kv[j] * __expf(-x);
                    *(LAS bf16_t*)(lds + L_QT + (i0 + j) * SQ + ch * 2) = (bf16_t)f2bf(qt);
                    qg_[j * DK] = (bf16_t)f2bf(qt * eseg);
                    const unsigned kb_ = f2bf(kt);
                    *(LAS bf16_t*)(lds + L_KT + (i0 + j) * SQ + ch * 2) = (bf16_t)kb_;
                    if (j & 1) ktt[j >> 1] |= kb_ << 16; else ktt[j >> 1] = kb_;
                }
                *(LAS u32x4*)(lds + L_KTT + ch * SA + i0 * 2) = (u32x4){ktt[0], ktt[1], ktt[2], ktt[3]};
                *(LAS u32x4*)(lds + L_KTT + ch * SA + i0 * 2 + 16) = (u32x4){ktt[4], ktt[5], ktt[6], ktt[7]};
            } else {
#pragma unroll
                for (int j = 0; j < 16; ++j) {
                    const float fs = *(LAS float*)(lds + ((ch < 64) ? T_QS : T_KS) + (i0 + j) * 4);
                    const unsigned vb_ = f2bf(qv[j] * fs);
                    if (ch < 64) { *(LAS bf16_t*)(lds + L_QT + (i0 + j) * SQ + ch * 2) = (bf16_t)vb_; QTS[(size_t)(64 * c + i0 + j) * DK + ch] = (bf16_t)f2bf(qv[j]); }
                    else *(LAS bf16_t*)(lds + L_KT + (i0 + j) * SQ + (ch - 64) * 2) = (bf16_t)vb_;
                    if (j & 1) ktt[j >> 1] |= vb_ << 16; else ktt[j >> 1] = vb_;
                }
                if (ch >= 64) {
                    *(LAS u32x4*)(lds + L_KTT + (ch - 64) * SA + i0 * 2) = (u32x4){ktt[0], ktt[1], ktt[2], ktt[3]};
                    *(LAS u32x4*)(lds + L_KTT + (ch - 64) * SA + i0 * 2 + 16) = (u32x4){ktt[4], ktt[5], ktt[6], ktt[7]};
                }
            }
        }
        __syncthreads();
        for (int ti = w; ti < 10; ti += 8) {
            const int rt = (int)((0x3333222110ull >> (4 * ti)) & 15), ct = (int)((0x3210210100ull >> (4 * ti)) & 15);
            f32x4 acc = (f32x4){0.f, 0.f, 0.f, 0.f};
#pragma unroll
            for (int ks = 0; ks < NKS; ++ks) {
                const bf16x8 af = *(const LAS bf16x8*)(lds + L_QT + (16 * rt + l15) * SQ + (32 * ks + 8 * g) * 2), bfr = *(const LAS bf16x8*)(lds + L_KT + (16 * ct + l15) * SQ + (32 * ks + 8 * g) * 2);
                acc = __builtin_amdgcn_mfma_f32_16x16x32_bf16(af, bfr, acc, 0, 0, 0);
            }
#pragma unroll
            for (int r = 0; r < 4; ++r) { const int t_ = 16 * rt + 4 * g + r, s_ = 16 * ct + l15; *(LAS bf16_t*)(lds + L_AT + t_ * SA + s_ * 2) = (bf16_t)f2bf(s_ <= t_ ? acc[r] : 0.f); }
        }
        {
            const float cs = KIND ? *(LAS float*)(lds + T_SC) : 1.f;
#pragma unroll
            for (int d = 0; d < NDT; ++d) {
                if (KIND == 0) st[d] *= *(const LAS f32x4*)(lds + T_ER + (16 * d + 4 * g) * 4); else st[d] *= cs;
                u32x2 pk; pk.x = pk2(st[d][0], st[d][1]); pk.y = pk2(st[d][2], st[d][3]);
                *(LAS u32x2*)(lds + L_ST + (16 * w + l15) * SQ + (16 * d + 4 * g) * 2) = pk;
            }
        }
        __syncthreads();
        { const int cn_ = (c + 1 < SEQ / 64) ? c + 1 : c; SCAN_LOAD(cn_); }
        __builtin_amdgcn_sched_barrier(0);
        bf16x8 sfr[NKS], vfr[2];
#pragma unroll
        for (int ks = 0; ks < NKS; ++ks) sfr[ks] = *(const LAS bf16x8*)(lds + L_ST + (16 * w + l15) * SQ + (32 * ks + 8 * g) * 2);
#pragma unroll
        for (int ks = 0; ks < 2; ++ks) vfr[ks] = *(const LAS bf16x8*)(lds + L_VT + (16 * w + l15) * SA + (32 * ks + 8 * g) * 2);
        if (KIND == 1) {
            float dn = 0.f;
#pragma unroll
            for (int d8 = 0; d8 < 8; ++d8) { const u32x4 qw_ = *(const LAS u32x4*)(lds + L_QT + lane * SQ + d8 * 16); const f32x4 n0 = *(const LAS f32x4*)(lds + T_NP + d8 * 32), n1 = *(const LAS f32x4*)(lds + T_NP + d8 * 32 + 16);
                dn += bflo(qw_[0]) * n0[0] + bfhi(qw_[0]) * n0[1] + bflo(qw_[1]) * n0[2] + bfhi(qw_[1]) * n0[3] + bflo(qw_[2]) * n1[0] + bfhi(qw_[2]) * n1[1] + bflo(qw_[3]) * n1[2] + bfhi(qw_[3]) * n1[3]; }
#pragma unroll
            for (int s8 = 0; s8 < 8; ++s8) { const u32x4 aw_ = *(const LAS u32x4*)(lds + L_AT + lane * SA + s8 * 16);
#pragma unroll
                for (int e = 0; e < 4; ++e) { const int s_ = 8 * s8 + 2 * e; dn += (s_ <= lane ? bflo(aw_[e]) : 0.f) + (s_ + 1 <= lane ? bfhi(aw_[e]) : 0.f); } }
            *(LAS float*)(lds + T_DEN + (w * 64 + lane) * 4) = dn;
            *(f32x4*)(SCL + (size_t)(64 * c + lane) * 4) = (f32x4){dn, *(LAS float*)(lds + T_MT + lane * 4), *(LAS float*)(lds + T_BS + lane * 4), 0.f};
            if (w == 0) {
                float cs_ = 0.f;
                for (int s_ = 0; s_ < 64; ++s_) cs_ += bf2f(*(const LAS bf16_t*)(lds + L_KT + s_ * SQ + lane * 2));
                colsum = cs_;
            }
        }
#pragma unroll
        for (int rt = 0; rt < 4; ++rt) {
            f32x4 o = (f32x4){0.f, 0.f, 0.f, 0.f};
#pragma unroll
            for (int ks = 0; ks < NKS; ++ks) o = __builtin_amdgcn_mfma_f32_16x16x32_bf16(*(const LAS bf16x8*)(lds + L_QT + (16 * rt + l15) * SQ + (32 * ks + 8 * g) * 2), sfr[ks], o, 0, 0, 0);
#pragma unroll
            for (int ks = 0; ks < 2; ++ks) if (2 * ks <= rt) o = __builtin_amdgcn_mfma_f32_16x16x32_bf16(*(const LAS bf16x8*)(lds + L_AT + (16 * rt + l15) * SA + (32 * ks + 8 * g) * 2), vfr[ks], o, 0, 0, 0);
            float* op = OUT + (row0 + 16 * rt + 4 * g) * 512 + h * 128 + 16 * w + l15;
            if (KIND == 1) {
                const f32x4 dn = *(const LAS f32x4*)(lds + T_DEN + (w * 64 + 16 * rt + 4 * g) * 4), mt = *(const LAS f32x4*)(lds + T_MT + (16 * rt + 4 * g) * 4);
#pragma unroll
                for (int r = 0; r < 4; ++r) op[r * 512] = (seg > 0) ? o[r] : o[r] * rcpf_(fmaxf(fabsf(dn[r]), __expf(-mt[r])));
            } else {
#pragma unroll
                for (int r = 0; r < 4; ++r) op[r * 512] = o[r];
            }
        }
#pragma unroll
        for (int d = 0; d < NDT; ++d) {
#pragma unroll
            for (int ks = 0; ks < 2; ++ks) st[d] = __builtin_amdgcn_mfma_f32_16x16x32_bf16(*(const LAS bf16x8*)(lds + L_KTT + (16 * d + l15) * SA + (32 * ks + 8 * g) * 2), vfr[ks], st[d], 0, 0, 0);
            if (KIND == 0) st[d] *= *(const LAS f32x4*)(lds + T_EC + (16 * d + 4 * g) * 4);
        }
        __syncthreads();
    }
#undef SCAN_LOAD
    if (seg < NSEG - 1) {
        float* SIF = (float*)(ws + WS_SIF) + (size_t)((KIND * 16 + bh) * NSEG) * 16384;
        bf16_t* SIB = (bf16_t*)(ws + WS_SIB) + (size_t)((KIND * 16 + bh) * NSEG) * 16384;
        float* SIM = (float*)(ws + WS_SIM) + (size_t)(bh * NSEG) * 128;
        unsigned* flg = (unsigned*)(ws + WS_CTL + CTL_SEGF) + (size_t)(((l * 2 + KIND) * 16 + bh) * NSEG) * 16;
        if (KIND == 0 && part == 0) *(LAS float*)(lds + T_PS + ch * 4) = cumlog;
        if (seg > 0) {
            if (w == 0) { unsigned spins = 0; while (__builtin_amdgcn_readfirstlane(__hip_atomic_load(flg + seg * 16, __ATOMIC_RELAXED, __HIP_MEMORY_SCOPE_AGENT)) == 0u && ++spins < (1u << 22)) __builtin_amdgcn_s_sleep(2); }
            __syncthreads();
            __builtin_amdgcn_fence(__ATOMIC_ACQUIRE, "agent");
        }
        if (KIND == 1 && w == 0) {
            const float n_loc = np_reg + colsum; float m_new = m_prev, al_ = 1.f, be_ = 0.f, n_init = 0.f;
            if (seg > 0) { const float m_init = SIM[seg * 128 + 64]; n_init = SIM[seg * 128 + lane]; m_new = fmaxf(m_prev, bseg + m_init); al_ = __expf(m_prev - m_new); be_ = __expf(bseg + m_init - m_new); }
            __hip_atomic_store(SIM + (seg + 1) * 128 + lane, al_ * n_loc + be_ * n_init, __ATOMIC_RELAXED, __HIP_MEMORY_SCOPE_AGENT);
            if (lane == 0) { __hip_atomic_store(SIM + (seg + 1) * 128 + 64, m_new, __ATOMIC_RELAXED, __HIP_MEMORY_SCOPE_AGENT); if (seg > 0) { *(LAS float*)(lds + T_SC) = al_; *(LAS float*)(lds + T_SC + 4) = be_; } }
        }
        __syncthreads();
        float al_ = 1.f, be_ = 0.f;
        if (KIND == 1 && seg > 0) { al_ = *(LAS float*)(lds + T_SC); be_ = *(LAS float*)(lds + T_SC + 4); }
#pragma unroll
        for (int d = 0; d < NDT; ++d) {
            f32x4 val = st[d];
            if (seg > 0) {
                const f32x4 prev = *(const f32x4*)(SIF + (size_t)seg * 16384 + (16 * w + l15) * 128 + 16 * d + 4 * g);
                if (KIND == 0) { const f32x4 cl_ = *(const LAS f32x4*)(lds + T_PS + (16 * d + 4 * g) * 4);
#pragma unroll
                    for (int r = 0; r < 4; ++r) val[r] += __expf(cl_[r]) * prev[r]; }
                else val = al_ * val + be_ * prev;
            }
            const size_t o_ = (size_t)(seg + 1) * 16384 + (16 * w + l15) * 128 + 16 * d + 4 * g;
            __hip_atomic_store((u64*)(SIF + o_), (u64)__builtin_bit_cast(unsigned, val[0]) | ((u64)__builtin_bit_cast(unsigned, val[1]) << 32), __ATOMIC_RELAXED, __HIP_MEMORY_SCOPE_AGENT);
            __hip_atomic_store((u64*)(SIF + o_ + 2), (u64)__builtin_bit_cast(unsigned, val[2]) | ((u64)__builtin_bit_cast(unsigned, val[3]) << 32), __ATOMIC_RELAXED, __HIP_MEMORY_SCOPE_AGENT);
            __hip_atomic_store((u64*)(SIB + o_), (u64)pk2(val[0], val[1]) | ((u64)pk2(val[2], val[3]) << 32), __ATOMIC_RELAXED, __HIP_MEMORY_SCOPE_AGENT);
        }
        asm volatile("s_waitcnt vmcnt(0)" ::: "memory");
        __syncthreads();
        if (tid == 0) __hip_atomic_store(flg + (seg + 1) * 16, 1u, __ATOMIC_RELAXED, __HIP_MEMORY_SCOPE_AGENT);
    }
}

template <int KIND>
__device__ __forceinline__ void norm_unit(Frame& F, int l, int b, int h, int rb, int seg) {
    constexpr int DK = KIND ? 64 : 128, NKS = DK / 32;
    unsigned char* ws = F.ws;
    const int lane = lane_id_fresh(), l15 = lane & 15, g = lane >> 4, bh = b * 4 + h;
    const size_t trow = (size_t)b * SEQ + 32 * rb;
    const float* prm = (const float*)(ws + WS_PRM) + l * PRM_L + (KIND ? PRM_MN : PRM_HN) + h * 128 + 4 * g;
    const bf16_t* Zg = (const bf16_t*)(ws + WS_Z) + (trow + l15) * NZ + (KIND ? ZC_LO : ZC_GG) + h * 128 + 4 * g;
    const float* OUT = (const float*)(ws + (KIND ? WS_OL : WS_OG)) + (trow + l15) * 512 + h * 128 + 4 * g;
    bf16_t* Y = (bf16_t*)(ws + WS_Y) + (trow + l15) * D + (KIND ? 1536 : 512) + h * 128 + 4 * g;
    f32x4 acc[2][8];
#pragma unroll
    for (int rt = 0; rt < 2; ++rt)
#pragma unroll
        for (int vt = 0; vt < 8; ++vt) acc[rt][vt] = (f32x4){0.f, 0.f, 0.f, 0.f};
    float ea[2] = {1.f, 1.f}, eb[2] = {0.f, 0.f}, inv[2] = {1.f, 1.f};
    f32x4 ov[2][8];
#pragma unroll
    for (int rt = 0; rt < 2; ++rt)
#pragma unroll
        for (int vt = 0; vt < 8; ++vt) ov[rt][vt] = *(const f32x4*)(OUT + (size_t)(16 * rt) * 512 + 16 * vt);
    __builtin_amdgcn_sched_barrier(0);
    if (seg > 0) {
        const bf16_t* SIB = (const bf16_t*)(ws + WS_SIB) + (size_t)((KIND * 16 + bh) * NSEG + seg) * 16384;
        const bf16_t* QTS = (const bf16_t*)(ws + (KIND ? WS_QTL : WS_QTG)) + ((size_t)bh * SEQ + 32 * rb + l15) * DK + 8 * g;
        bf16x8 qf[2][NKS];
#pragma unroll
        for (int rt = 0; rt < 2; ++rt)
#pragma unroll
            for (int ks = 0; ks < NKS; ++ks) qf[rt][ks] = *(const bf16x8*)(QTS + (size_t)(16 * rt) * DK + 32 * ks);
#pragma unroll
        for (int v2 = 0; v2 < 8; v2 += 2) {
            bf16x8 af[2][NKS];
#pragma unroll
            for (int vv = 0; vv < 2; ++vv)
#pragma unroll
                for (int ks = 0; ks < NKS; ++ks) af[vv][ks] = *(const bf16x8*)(SIB + (16 * (v2 + vv) + l15) * 128 + 32 * ks + 8 * g);
            __builtin_amdgcn_sched_barrier(0);
#pragma unroll
            for (int vv = 0; vv < 2; ++vv)
#pragma unroll
                for (int ks = 0; ks < NKS; ++ks)
#pragma unroll
                    for (int rt = 0; rt < 2; ++rt) acc[rt][v2 + vv] = __builtin_amdgcn_mfma_f32_16x16x32_bf16(af[vv][ks], qf[rt][ks], acc[rt][v2 + vv], 0, 0, 0);
        }
        if (KIND == 1) {
            const float* SIM = (const float*)(ws + WS_SIM) + (size_t)(bh * NSEG + seg) * 128;
            const float m_init = SIM[64];
            f32x4 nq[2] = {(f32x4){0.f, 0.f, 0.f, 0.f}, (f32x4){0.f, 0.f, 0.f, 0.f}};
#pragma unroll
            for (int ks = 0; ks < NKS; ++ks) { const f32x4 n0 = *(const f32x4*)(SIM + 32 * ks + 8 * g), n1 = *(const f32x4*)(SIM + 32 * ks + 8 * g + 4);
                const u32x4 nw = (u32x4){pk2(n0[0], n0[1]), pk2(n0[2], n0[3]), pk2(n1[0], n1[1]), pk2(n1[2], n1[3])}; const bf16x8 nfr = __builtin_bit_cast(bf16x8, nw);
#pragma unroll
                for (int rt = 0; rt < 2; ++rt) nq[rt] = __builtin_amdgcn_mfma_f32_16x16x32_bf16(nfr, qf[rt][ks], nq[rt], 0, 0, 0); }
#pragma unroll
            for (int rt = 0; rt < 2; ++rt) {
                const f32x4 sc = *(const f32x4*)((const float*)(ws + WS_SCL) + ((size_t)bh * SEQ + 32 * rb + 16 * rt + l15) * 4);
                const float mi = sc[2] + m_init, mp = fmaxf(sc[1], mi); ea[rt] = __expf(sc[1] - mp); eb[rt] = __expf(mi - mp);
                inv[rt] = rcpf_(fmaxf(fabsf(sc[0] * ea[rt] + nq[rt][0] * eb[rt]), __expf(-mp)));
            }
        }
    }
    u32x2 zv[2][8]; f32x4 gnv[8];
#pragma unroll
    for (int vt = 0; vt < 8; ++vt) { gnv[vt] = *(const f32x4*)(prm + 16 * vt);
#pragma unroll
        for (int rt = 0; rt < 2; ++rt) zv[rt][vt] = *(const u32x2*)(Zg + (size_t)(16 * rt) * NZ + 16 * vt); }
    __builtin_amdgcn_sched_barrier(0);
#pragma unroll
    for (int rt = 0; rt < 2; ++rt) {
        float ss = 0.f;
#pragma unroll
        for (int vt = 0; vt < 8; ++vt) {
            const f32x4 o = ov[rt][vt];
            if (KIND == 0) acc[rt][vt] += o; else acc[rt][vt] = (o * ea[rt] + acc[rt][vt] * eb[rt]) * inv[rt];
            ss += acc[rt][vt][0] * acc[rt][vt][0] + acc[rt][vt][1] * acc[rt][vt][1] + acc[rt][vt][2] * acc[rt][vt][2] + acc[rt][vt][3] * acc[rt][vt][3];
        }
        ss += bperm_f(lane ^ 16, ss); ss += bperm_f(lane ^ 32, ss);
        const float r = rsqrtf(ss * (1.f / 128.f) + EPS);
#pragma unroll
        for (int vt = 0; vt < 8; ++vt) {
            const u32x2 zw = zv[rt][vt]; const f32x4 gn = gnv[vt];
            const float z0 = bflo(zw[0]), z1 = bfhi(zw[0]), z2 = bflo(zw[1]), z3 = bfhi(zw[1]);
            const float s0 = sigmoidf_(z0), s1 = sigmoidf_(z1), s2 = sigmoidf_(z2), s3 = sigmoidf_(z3);
            const f32x4 a = acc[rt][vt];
            u32x2 wv; wv.x = pk2(a[0] * r * gn[0] * (KIND ? s0 : z0 * s0), a[1] * r * gn[1] * (KIND ? s1 : z1 * s1)); wv.y = pk2(a[2] * r * gn[2] * (KIND ? s2 : z2 * s2), a[3] * r * gn[3] * (KIND ? s3 : z3 * s3));
            *(u32x2*)(Y + (size_t)(16 * rt) * D + 16 * vt) = wv;
        }
    }
}
__device__ __forceinline__ void scan_norm(Frame& F, int l) {
#pragma unroll 1
    for (int u = F.bid; u < 256; u += F.G) {
        const int b = u >> 6, rb = u & 63, seg = rb / (64 / NSEG), h = F.wave >> 1;
        if (F.wave & 1) norm_unit<1>(F, l, b, h, rb, seg); else norm_unit<0>(F, l, b, h, rb, seg);
    }
}

__device__ __forceinline__ v32f_t ld_row6(const unsigned char* rowp, int lane) {
    const u32x4 a = *(const u32x4*)(rowp + lane * 16); const u32x2 b = *(const u32x2*)(rowp + 1024 + lane * 8);
    const v6u_t p = (v6u_t){a[0], a[1], a[2], a[3], b[0], b[1]};
    return __builtin_amdgcn_cvt_scalef32_pk32_f32_fp6(p, 1.0f);
}
__device__ __forceinline__ float sw32_add(float a, float b) { asm volatile("s_nop 1\n\tv_permlane32_swap_b32 %0, %1\n\ts_nop 1" : "+v"(a), "+v"(b)); return a + b; }
__device__ __forceinline__ float sw16_add(float a, float b) { asm volatile("s_nop 1\n\tv_permlane16_swap_b32 %0, %1\n\ts_nop 1" : "+v"(a), "+v"(b)); return a + b; }
__device__ __forceinline__ float reduce8(const float (&p)[8], int lane) {
    const float q0 = sw16_add(sw32_add(p[0], p[1]), sw32_add(p[2], p[3])), q1 = sw16_add(sw32_add(p[4], p[5]), sw32_add(p[6], p[7]));
    const float t0 = q0 + DPP_F(q0, 0x128), t1 = q1 + DPP_F(q1, 0x128);
    float t = (lane & 8) ? t1 : t0;
    t += DPP_F(t, 0xB1); t += DPP_F(t, 0x4E); t += DPP_F(t, 0x141);
    return t;
}
__device__ __forceinline__ void peer_gather(Frame& F, int l) {
    constexpr int NF = 16;
    unsigned char* ws = F.ws;
    const unsigned char* U4 = ws + WS_UB + (size_t)l * NEXP * VROW; const unsigned char* V4 = ws + WS_VB + (size_t)l * NEXP * VROW;
    const float* SU = (const float*)(ws + WS_SU) + l * NEXP; const float* SV = (const float*)(ws + WS_SV) + l * NEXP;
    const int* PIDX = (const int*)(ws + WS_PIDX); const float* PG = (const float*)(ws + WS_PGATE);
    bf16_t* HB = (bf16_t*)(ws + WS_HB) + (size_t)(l & 1) * T * D;
    const u64* ssqB = (const u64*)(ws + WS_CTL + CTL_SSQB) + l * T; float* ssqC = (float*)(ws + WS_CTL + CTL_SSQC) + l * T;
    const int lane = F.lane;
    LAS float* cl = (LAS float*)(F.lds + F.wave * 512);
    int emap;
    { float lab[8];
#pragma unroll
      for (int k = 0; k < 8; ++k) lab[k] = (float)k * (1.f / 64.f);
      emap = (int)(reduce8(lab, lane) + 0.5f); }
    for (int t = F.gw; t < T; t += F.ngw) {
        float x[32];
#pragma unroll
        for (int q = 0; q < 8; ++q) { const u32x2 w = *(const u32x2*)(HB + (size_t)t * D + q * 256 + lane * 4);
            x[4 * q] = bflo(w[0]); x[4 * q + 1] = bfhi(w[0]); x[4 * q + 2] = bflo(w[1]); x[4 * q + 3] = bfhi(w[1]); }
        const float rs = rsqrtf(ssq_get(ssqB + t) * (1.f / D) + EPS);
        const int myidx0 = PIDX[(size_t)t * 128 + lane], myidx1 = PIDX[(size_t)t * 128 + 64 + lane];
        const float mys0 = SU[myidx0] * rs, mys1 = SU[myidx1] * rs;
        const float myg0 = PG[(size_t)t * 128 + lane] * SV[myidx0], myg1 = PG[(size_t)t * 128 + 64 + lane] * SV[myidx1];
#pragma unroll 1
        for (int e0 = 0; e0 < 128; e0 += NF) {
            u32x4 uw[NF];
#pragma unroll
            for (int k = 0; k < NF; ++k) { const int e = e0 + k; const int idx = __builtin_amdgcn_readlane(e < 64 ? myidx0 : myidx1, e & 63); uw[k] = *(const u32x4*)(U4 + (size_t)idx * VROW + lane * 16); }
#pragma unroll
            for (int b8 = 0; b8 < NF / 8; ++b8) {
                float part[8];
#pragma unroll
                for (int k = 0; k < 8; ++k) {
                    const int kk = b8 * 8 + k; f32x2_t sa = (f32x2_t){0.f, 0.f}, sb = (f32x2_t){0.f, 0.f};
#pragma unroll
                    for (int q2 = 0; q2 < 4; ++q2) {
                        const f32x2_t d0 = __builtin_amdgcn_cvt_scalef32_pk_f32_fp4(uw[kk][q2], 1.0f, 0), d1 = __builtin_amdgcn_cvt_scalef32_pk_f32_fp4(uw[kk][q2], 1.0f, 1);
                        const f32x2_t d2 = __builtin_amdgcn_cvt_scalef32_pk_f32_fp4(uw[kk][q2], 1.0f, 2), d3 = __builtin_amdgcn_cvt_scalef32_pk_f32_fp4(uw[kk][q2], 1.0f, 3);
                        sa = __builtin_elementwise_fma((f32x2_t){x[8 * q2], x[8 * q2 + 1]}, d0, sa); sb = __builtin_elementwise_fma((f32x2_t){x[8 * q2 + 2], x[8 * q2 + 3]}, d1, sb);
                        sa = __builtin_elementwise_fma((f32x2_t){x[8 * q2 + 4], x[8 * q2 + 5]}, d2, sa); sb = __builtin_elementwise_fma((f32x2_t){x[8 * q2 + 6], x[8 * q2 + 7]}, d3, sb);
                    }
                    const f32x2_t st_ = sa + sb; const float s_ = st_[0] + st_[1];
                    part[k] = s_;
                    if (kk + 1 < NF) asm volatile("" : "+v"(uw[kk + 1]) : "v"(s_));
                }
                const float dot = reduce8(part, lane);
                const int eb = e0 + b8 * 8 + emap;
                const float pre = dot * bperm_f(eb & 63, e0 < 64 ? mys0 : mys1);
                const float act = 0.5f * pre * (1.f + erff(pre * 0.7071067811865476f));
                const float cf = act * bperm_f(eb & 63, e0 < 64 ? myg0 : myg1);
                if ((lane & 7) == 0) cl[eb] = cf;
            }
        }
        asm volatile("s_waitcnt lgkmcnt(0)" ::: "memory");
        const float c0 = cl[lane], c1 = cl[64 + lane];
        float y[32];
#pragma unroll
        for (int i = 0; i < 32; ++i) y[i] = 0.f;
#pragma unroll 1
        for (int e0 = 0; e0 < 128; e0 += NF) {
            u32x4 vw[NF];
#pragma unroll
            for (int k = 0; k < NF; ++k) { const int e = e0 + k; const int idx = __builtin_amdgcn_readlane(e < 64 ? myidx0 : myidx1, e & 63); vw[k] = *(const u32x4*)(V4 + (size_t)idx * VROW + lane * 16); }
#pragma unroll
            for (int k = 0; k < NF; ++k) {
                const int e = e0 + k; const float ce = rdlane_f(e < 64 ? c0 : c1, e & 63);
#pragma unroll
                for (int q2 = 0; q2 < 4; ++q2) {
                    const f32x2_t d0 = __builtin_amdgcn_cvt_scalef32_pk_f32_fp4(vw[k][q2], 1.0f, 0), d1 = __builtin_amdgcn_cvt_scalef32_pk_f32_fp4(vw[k][q2], 1.0f, 1);
                    const f32x2_t d2 = __builtin_amdgcn_cvt_scalef32_pk_f32_fp4(vw[k][q2], 1.0f, 2), d3 = __builtin_amdgcn_cvt_scalef32_pk_f32_fp4(vw[k][q2], 1.0f, 3);
                    y[8 * q2] += ce * d0[0]; y[8 * q2 + 1] += ce * d0[1]; y[8 * q2 + 2] += ce * d1[0]; y[8 * q2 + 3] += ce * d1[1];
                    y[8 * q2 + 4] += ce * d2[0]; y[8 * q2 + 5] += ce * d2[1]; y[8 * q2 + 6] += ce * d3[0]; y[8 * q2 + 7] += ce * d3[1];
                }
                if (k + 1 < NF) asm volatile("" : "+v"(vw[k + 1]) : "v"(y[0]), "v"(y[31]));
            }
        }
        float s2 = 0.f;
#pragma unroll
        for (int q = 0; q < 8; ++q) {
            const float v0 = x[4 * q] + y[4 * q], v1 = x[4 * q + 1] + y[4 * q + 1], v2 = x[4 * q + 2] + y[4 * q + 2], v3 = x[4 * q + 3] + y[4 * q + 3];
            *(u32x2*)(HB + (size_t)t * D + q * 256 + lane * 4) = (u32x2){pk2(v0, v1), pk2(v2, v3)};
            s2 += v0 * v0 + v1 * v1 + v2 * v2 + v3 * v3;
        }
        s2 = wave_sum(s2);
        if (lane == 0) ssqC[t] = s2;
    }
}

__device__ __forceinline__ void final_norm(Frame& F) {
    const Args& a = *F.a; unsigned char* ws = F.ws;
    const bf16_t* HB = (const bf16_t*)(ws + WS_HB) + (size_t)(DEPTH & 1) * T * D; const u64* ssq = (const u64*)(ws + WS_CTL + CTL_SSQA) + 4 * T; const float* g = (const float*)(ws + WS_PRM) + PRM_FIN;
    const int lane = F.lane;
    for (int t = F.gw; t < T; t += F.ngw) {
        const float rs = rsqrtf(ssq_get(ssq + t) * (1.f / D) + EPS);
#pragma unroll
        for (int c = 0; c < 4; ++c) { const size_t o = (size_t)t * D + c * 512 + lane * 8; const u32x4 hw = *(const u32x4*)(HB + o); const f32x4 g0 = *(const f32x4*)(g + c * 512 + lane * 8), g1 = *(const f32x4*)(g + c * 512 + lane * 8 + 4);
            *(f32x4*)(a.out + o) = (f32x4){bflo(hw[0]), bfhi(hw[0]), bflo(hw[1]), bfhi(hw[1])} * rs * g0; *(f32x4*)(a.out + o + 4) = (f32x4){bflo(hw[2]), bfhi(hw[2]), bflo(hw[3]), bfhi(hw[3])} * rs * g1; }
    }
}

constexpr int PH_PER_LAYER = 10, N_PHASES = 2 + DEPTH * PH_PER_LAYER;
template <int PH>
__device__ __forceinline__ void run_phase(Frame& F0, int l) {
    Frame F = F0; { int bid_ = blockIdx.x, wv_ = F0.wave; asm volatile("" : "+s"(bid_), "+s"(wv_));
      F.bid = bid_; F.wave = wv_; F.lane = lane_id_fresh(); F.tid = wv_ * 64 + F.lane; F.gw = bid_ * NWAVES + wv_;
      size_t z_ = 0; asm volatile("" : "+s"(z_)); F.ws = F0.ws + z_; }
    unsigned char* ws = F.ws;
    bf16_t* const HBc = (bf16_t*)(ws + WS_HB) + (size_t)(l & 1) * T * D; bf16_t* const HBn = (bf16_t*)(ws + WS_HB) + (size_t)((l + 1) & 1) * T * D;
    if constexpr (PH == 100) prologue(F);
    if constexpr (PH == 101) final_norm(F);
    if constexpr (PH == 0) {
        pg8::Gemm g{HBc, (const bf16_t*)(ws + WS_WIN) + (size_t)l * NZ * D, T, NZ, D, D, D}; pg8::StaticOrder S; S.init(T, NZ, F.G, F.bid);
        EpiZ E{(bf16_t*)(ws + WS_Z), (const u64*)(ws + WS_CTL + CTL_SSQA) + l * T, (u64*)(ws + WS_CTL + CTL_MQS) + l * T, (u64*)(ws + WS_CTL + CTL_MKVS) + l * T};
        pg8::gemm_phase<EpiZ, pg8::StaticOrder, true, true>(F.lds, g, S, E, F.wave);
    }
    if constexpr (PH == 1) {
        mix_prep(F, l);
        { pg8::Gemm g{(const bf16_t*)(ws + WS_Z) + ZC_MCQ, (const bf16_t*)(ws + WS_WUQ) + (size_t)l * 768 * 384, T, 768, 384, NZ, 384}; pg8::StaticOrder S; S.init(T, 768, F.G, F.bid);
          EpiBf16s E{(bf16_t*)(ws + WS_QM), 768, (const u64*)(ws + WS_CTL + CTL_MQS) + l * T, 1.f / 384.f};
          pg8::gemm_phase<EpiBf16s, pg8::StaticOrder, true, true>(F.lds, g, S, E, F.wave); }
        __syncthreads();
        { pg8::Gemm g{(const bf16_t*)(ws + WS_Z) + ZC_MCKV, (const bf16_t*)(ws + WS_WUKV) + (size_t)l * 1024 * 256, T, 1024, 256, NZ, 256}; pg8::StaticOrder S; S.init(T, 1024, F.G, (int)((F.bid + 128) % F.G));
          EpiBf16s E{(bf16_t*)(ws + WS_KVM), 1024, (const u64*)(ws + WS_CTL + CTL_MKVS) + l * T, 1.f / 256.f};
          pg8::gemm_phase<EpiBf16s, pg8::StaticOrder, true, true>(F.lds, g, S, E, F.wave); }
    }
    if constexpr (PH == 3) {
        if (F.bid < 32 * NSEG) { const int bhs = F.bid % (16 * NSEG), b = bhs / (4 * NSEG), h = (bhs / NSEG) & 3, seg = bhs % NSEG; if (F.bid < 16 * NSEG) scan_unit<0>(F, l, b, h, seg); else scan_unit<1>(F, l, b, h, seg); }
        {
            const bool conv_first = F.bid >= 256 - NCONVWG;
#pragma unroll 1
            for (int pass = 0; pass < 2; ++pass) {
                if (pass == 1 || conv_first) { __syncthreads(); convert_layer_queue(F, l, (unsigned*)(ws + WS_CTL + CTL_CVQ) + 64 * l); }
                if (pass == 0) attn_fast(F, l);
            }
        }
    }
    if constexpr (PH == 4) scan_norm(F, l);
    if constexpr (PH == 5) {
        pg8::Gemm g{(const bf16_t*)(ws + WS_Y), (const bf16_t*)(ws + WS_WOUT) + (size_t)l * D * D, T, D, D, D, D}; pg8::StaticOrder S; S.init(T, D, F.G, F.bid);
        EpiRes E{HBc, (u64*)(ws + WS_CTL + CTL_SSQB) + l * T};
        pg8::gemm_phase<EpiRes, pg8::StaticOrder, true, true>(F.lds, g, S, E, F.wave);
    }
    if constexpr (PH == 6) {
        { pg8::Gemm g{HBc, (const bf16_t*)(ws + WS_WQ) + (size_t)l * D * D, T, D, D, D, D}; pg8::StaticOrder S; S.init(T, D, F.G, F.bid);
          EpiBf16s E{(bf16_t*)(ws + WS_QB), D, (const u64*)(ws + WS_CTL + CTL_SSQB) + l * T, 1.f / D};
          pg8::gemm_phase<EpiBf16s, pg8::StaticOrder, true, true>(F.lds, g, S, E, F.wave);
          pg8::Unit u;
          if (S.next(0, u)) {
              asm volatile("s_waitcnt vmcnt(0)" ::: "memory"); __syncthreads();
              __builtin_amdgcn_fence(__ATOMIC_ACQUIRE, "agent"); asm volatile("s_waitcnt vmcnt(0)" ::: "memory");
              peer_topk_mfma(F.lds, F.wave, (const bf16_t*)(ws + WS_QB), (const bf16_t*)(ws + WS_SKB) + (size_t)l * 8 * 2 * 128 * 128, (int*)(ws + WS_PIDX), (float*)(ws + WS_PGATE), u.pm, u.pn);
          } }
        __syncthreads();
        { pg8::Gemm g{(const bf16_t*)(ws + WS_PB) + (size_t)l * T * PLE, (const bf16_t*)(ws + WS_WP) + (size_t)l * D * PLE, T, D, PLE, PLE, PLE}; pg8::StaticOrder S; S.init(T, D, F.G, F.bid);
          EpiBf16s E{(bf16_t*)(ws + WS_PR), D, nullptr, 0.f};
          pg8::gemm_phase<EpiBf16s, pg8::StaticOrder, true, true>(F.lds, g, S, E, F.wave); }
    }
    if constexpr (PH == 8) peer_gather(F, l);
    if constexpr (PH == 9) {
        pg8::Gemm g{HBc, (const bf16_t*)(ws + WS_WG) + (size_t)l * D * D, T, D, D, D, D}; pg8::StaticOrder S; S.init(T, D, F.G, F.bid);
        EpiPle E{HBc, HBn, (const bf16_t*)(ws + WS_PR), (const float*)(ws + WS_CTL + CTL_SSQC) + l * T, (u64*)(ws + WS_CTL + CTL_SSQA) + (l + 1) * T};
        pg8::gemm_phase<EpiPle, pg8::StaticOrder, true, true>(F.lds, g, S, E, F.wave);
    }
}
__global__ void __launch_bounds__(NTHREADS, 2) mega(Args args) {
    extern __shared__ __attribute__((aligned(16))) unsigned char lds_raw[];
    Frame F; F.lds = (LAS unsigned char*)lds_raw; F.ws = args.ws; F.a = &args;
    F.tid = threadIdx.x; F.lane = F.tid & 63; F.wave = __builtin_amdgcn_readfirstlane(F.tid >> 6); F.G = gridDim.x;
    F.gw = blockIdx.x * NWAVES + F.wave; F.ngw = F.G * NWAVES; F.bid = blockIdx.x;
    volatile LAS unsigned* misc = (volatile LAS unsigned*)(F.lds + MISC_OFF);
    if (F.tid < 32) misc[F.tid] = 0u;
    __syncthreads();
    (void)xcd_barrier_post((unsigned*)(args.ws + WS_CTL + CTL_BAR), misc + 8);
#define GRID_BAR() do { XcdBarrier b_; b_.bar = (unsigned*)(args.ws + WS_CTL + CTL_BAR); b_.x = xb_xcc_id(); b_.st = (volatile LAS unsigned*)(F.lds + MISC_OFF) + 8; xcd_barrier(b_, F.wave); } while (0)
    run_phase<100>(F, 0); GRID_BAR();
    for (int l = 0; l < DEPTH; ++l) {
        run_phase<0>(F, l); GRID_BAR();
        run_phase<1>(F, l); GRID_BAR();
        run_phase<3>(F, l); GRID_BAR();
        run_phase<4>(F, l); GRID_BAR();
        run_phase<5>(F, l); GRID_BAR();
        run_phase<6>(F, l); GRID_BAR();
        run_phase<8>(F, l); GRID_BAR();
        run_phase<9>(F, l); GRID_BAR();
    }
    run_phase<101>(F, 0);
#undef GRID_BAR
}

extern "C" void kernel_launch(void* const* d_in, const int* in_sizes, int n_in, void* d_out, int out_size, void* d_ws, size_t ws_size, hipStream_t stream) {
    static int grid = 0;
    if (grid == 0) {
        if (n_in != 28 || out_size != T * D || ws_size < WS_END) { fprintf(stderr, "kernel_launch: unexpected shapes (n_in %d out %d ws %zu need %zu)\n", n_in, out_size, ws_size, (size_t)WS_END); grid = -1; return; }
        if (hipFuncSetAttribute((const void*)mega, hipFuncAttributeMaxDynamicSharedMemorySize, LDS_BYTES) != hipSuccess) { fprintf(stderr, "kernel_launch: hipFuncSetAttribute failed\n"); grid = -1; return; }
        int dev = 0, cus = 0, per_cu = 0; (void)hipGetDevice(&dev); (void)hipDeviceGetAttribute(&cus, hipDeviceAttributeMultiprocessorCount, dev);
        if (hipOccupancyMaxActiveBlocksPerMultiprocessor(&per_cu, (const void*)mega, NTHREADS, LDS_BYTES) != hipSuccess || per_cu < 1) { fprintf(stderr, "kernel_launch: occupancy query says %d blocks per CU\n", per_cu); (void)hipGetLastError(); }
        grid = cus > 0 ? cus : 256;
    }
    if (grid < 0) return;
    (void)hipMemsetAsync((char*)d_ws + WS_CTL, 0, CTL_BYTES, stream);
    Args a{};
    for (int i = 0; i < 28; ++i) a.in[i] = (const float*)d_in[i];
    a.out = (float*)d_out; a.ws = (unsigned char*)d_ws;
    hipLaunchKernelGGL(mega, dim3(grid), dim3(NTHREADS), LDS_BYTES, stream, a);
}
```

```cpp
#include <hip/hip_runtime.h>
#include <cstdio>
#include <cstdint>

#define GAS __attribute__((address_space(1)))
#define LAS __attribute__((address_space(3)))
typedef unsigned short bf16_t;
typedef short bf16x8 __attribute__((ext_vector_type(8)));
typedef float f32x4 __attribute__((ext_vector_type(4)));
typedef unsigned u32x4 __attribute__((ext_vector_type(4)));
typedef unsigned u32x2 __attribute__((ext_vector_type(2)));
typedef float f32x2_t __attribute__((ext_vector_type(2)));
typedef float v16f_t __attribute__((ext_vector_type(16)));
typedef float v32f_t __attribute__((ext_vector_type(32)));
typedef unsigned v6u_t __attribute__((ext_vector_type(6)));
constexpr int EROW = 1536;
constexpr int VROW = 1024;

constexpr int D = 2048, BATCH = 4, SEQ = 2048, T = BATCH * SEQ, DEPTH = 4, PLE = 256;
constexpr int IN_COLS = 5832, NZ = 5888;
constexpr int ZC_DQ = 0, ZC_DK = 512, ZC_DV = 1024, ZC_GQ = 1536, ZC_GF = 2048, ZC_GV = 2560, ZC_GG = 3072, ZC_MCQ = 3584, ZC_MCKV = 3968, ZC_MKR = 4224,
              ZC_LQ = 4288, ZC_LK = 4544, ZC_LV = 4800, ZC_LO = 5312, ZC_LI = 5824, ZC_LF = 5828;
constexpr int NEXP = 16384;
constexpr float EPS = 1e-6f;
constexpr int NWAVES = 8, NTHREADS = 512;

constexpr size_t MiB = 1u << 20;
constexpr size_t al(size_t x) { return (x + 255) & ~(size_t)255; }
constexpr size_t WS_CTL = 0, CTL_BYTES = 2 * MiB;
constexpr size_t CTL_BAR = 0;
constexpr size_t CTL_CVQ = 32 * 1024;
constexpr size_t CTL_SSQA = 64 * 1024;
constexpr size_t CTL_SSQB = CTL_SSQA + 5 * T * 8;
constexpr size_t CTL_MQS = CTL_SSQB + 4 * T * 8;
constexpr size_t CTL_MKVS = CTL_MQS + 4 * T * 8;
constexpr size_t CTL_SSQC = CTL_MKVS + 4 * T * 8;
static_assert(CTL_SSQC + 4 * T * 4 <= 1536 * 1024, "ctl");
constexpr size_t WS_WIN = CTL_BYTES;
constexpr size_t WS_WOUT = WS_WIN + al((size_t)DEPTH * NZ * D * 2);
constexpr size_t WS_WQ = WS_WOUT + al((size_t)DEPTH * D * D * 2);
constexpr size_t WS_WG = WS_WQ + al((size_t)DEPTH * D * D * 2);
constexpr size_t WS_WP = WS_WG + al((size_t)DEPTH * D * D * 2);
constexpr size_t WS_WUQ = WS_WP + al((size_t)DEPTH * D * PLE * 2);
constexpr size_t WS_WUKV = WS_WUQ + al((size_t)DEPTH * 768 * 384 * 2);
constexpr size_t WS_UB = WS_WUKV + al((size_t)DEPTH * 1024 * 256 * 2);
constexpr size_t WS_VB = WS_UB + al((size_t)DEPTH * NEXP * D * 2);
constexpr size_t WS_PB = WS_VB + al((size_t)DEPTH * NEXP * D * 2);
constexpr size_t WS_CS = WS_PB + al((size_t)DEPTH * T * PLE * 2);
constexpr size_t WS_LBS = WS_CS + al((size_t)T * 32 * 2 * 4);
constexpr size_t WS_H = WS_LBS + al((size_t)DEPTH * 512 * 4);
constexpr size_t WS_HB = WS_H + al((size_t)T * D * 4);
constexpr size_t WS_Z = WS_HB + 2 * al((size_t)T * D * 2);
constexpr size_t WS_QM = WS_Z + al((size_t)T * NZ * 2);
constexpr size_t WS_KVM = WS_QM + al((size_t)T * 768 * 2);
constexpr size_t WS_KRM = WS_KVM + al((size_t)T * 1024 * 2);
constexpr size_t WS_Y = WS_KRM + al((size_t)T * 64 * 2);
constexpr size_t WS_QP = WS_Y + al((size_t)T * D * 2);
constexpr size_t WS_QB = WS_QP;
constexpr size_t WS_PR = WS_QP + al((size_t)T * D * 4);
constexpr size_t WS_PIDX = WS_PR + al((size_t)T * D * 4);
constexpr size_t WS_PGATE = WS_PIDX + al((size_t)T * 128 * 4);
constexpr size_t WS_GQ = WS_PGATE + al((size_t)T * 128 * 4);
constexpr size_t WS_GK = WS_GQ + al((size_t)T * 512 * 4);
constexpr size_t WS_GF = WS_GK + al((size_t)T * 512 * 4);
constexpr size_t WS_OG = WS_GF + al((size_t)T * 512 * 4);
constexpr size_t WS_LQK = WS_OG + al((size_t)T * 512 * 4);
constexpr size_t WS_LIF = WS_LQK + al((size_t)T * 512 * 4);
constexpr size_t WS_OL = WS_LIF + al((size_t)T * 8 * 4);
constexpr size_t WS_O1 = WS_OL + al((size_t)T * 512 * 4);
constexpr size_t WS_PRM = WS_O1 + al((size_t)T * 512 * 4);
constexpr int PRM_L = 4608, PRM_CW = 0, PRM_CB = 2048, PRM_GB = 2560, PRM_DL = 2576, PRM_DN = 2832, PRM_HN = 3344, PRM_MN = 3856, PRM_FIN = DEPTH * PRM_L;
constexpr size_t WS_SKB = WS_PRM + al((size_t)(PRM_FIN + D) * 4);
constexpr size_t WS_SU = WS_SKB + al((size_t)DEPTH * 8 * 2 * 128 * 128 * 2);
constexpr size_t WS_SV = WS_SU + al((size_t)DEPTH * NEXP * 4);
constexpr int NSEG = 2, SEGC = SEQ / 64 / NSEG, NCONVWG = 64;
constexpr size_t WS_QTG = WS_SV + al((size_t)DEPTH * NEXP * 4);
constexpr size_t WS_QTL = WS_QTG + al((size_t)16 * SEQ * 128 * 2);
constexpr size_t WS_SCL = WS_QTL + al((size_t)16 * SEQ * 64 * 2);
constexpr size_t WS_SIB = WS_SCL + al((size_t)16 * SEQ * 4 * 4);
constexpr size_t WS_SIF = WS_SIB + al((size_t)2 * 16 * NSEG * 128 * 128 * 2);
constexpr size_t WS_SIM = WS_SIF + al((size_t)2 * 16 * NSEG * 128 * 128 * 4);
constexpr size_t WS_END = WS_SIM + al((size_t)16 * NSEG * 128 * 4);
constexpr size_t CTL_SEGF = 1536 * 1024;
static_assert(CTL_SEGF + DEPTH * 2 * 16 * NSEG * 64 <= CTL_BYTES, "ctl segf");

typedef float f32x2v_t __attribute__((ext_vector_type(2)));
typedef __bf16 bf16x2v_t __attribute__((ext_vector_type(2)));
__device__ __forceinline__ unsigned pk2(float lo, float hi) { const bf16x2v_t r = __builtin_convertvector((f32x2v_t){lo, hi}, bf16x2v_t); return __builtin_bit_cast(unsigned, r); }
__device__ __forceinline__ unsigned f2bf(float f) { return pk2(f, 0.f) & 0xffffu; }
__device__ __forceinline__ float bf2f(unsigned short b) { return __builtin_bit_cast(float, ((unsigned)b) << 16); }
__device__ __forceinline__ float bflo(unsigned w) { return __builtin_bit_cast(float, w << 16); }
__device__ __forceinline__ float bfhi(unsigned w) { return __builtin_bit_cast(float, w & 0xffff0000u); }
#define DPP_F(v, ctrl) __builtin_bit_cast(float, __builtin_amdgcn_update_dpp(0, __builtin_bit_cast(int, (v)), (ctrl), 0xF, 0xF, false))
__device__ __forceinline__ float rdlane_f(float v, int l) { return __builtin_bit_cast(float, __builtin_amdgcn_readlane(__builtin_bit_cast(int, v), l)); }
__device__ __forceinline__ float wave_sum(float v) {
    v += DPP_F(v, 0xB1); v += DPP_F(v, 0x4E); v += DPP_F(v, 0x141); v += DPP_F(v, 0x140);
    return (rdlane_f(v, 0) + rdlane_f(v, 16)) + (rdlane_f(v, 32) + rdlane_f(v, 48));
}
__device__ __forceinline__ float wave_max(float v) {
    v = fmaxf(v, DPP_F(v, 0xB1)); v = fmaxf(v, DPP_F(v, 0x4E)); v = fmaxf(v, DPP_F(v, 0x141)); v = fmaxf(v, DPP_F(v, 0x140));
    return fmaxf(fmaxf(rdlane_f(v, 0), rdlane_f(v, 16)), fmaxf(rdlane_f(v, 32), rdlane_f(v, 48)));
}
__device__ __forceinline__ int bperm_i(int src, int v) { return __builtin_amdgcn_ds_bpermute(src << 2, v); }
__device__ __forceinline__ float bperm_f(int src, float v) { return __builtin_bit_cast(float, __builtin_amdgcn_ds_bpermute(src << 2, __builtin_bit_cast(int, v))); }
typedef unsigned long long u64;
__device__ __forceinline__ int lane_id_fresh() { int l; asm volatile("v_mbcnt_lo_u32_b32 %0, -1, 0\n\tv_mbcnt_hi_u32_b32 %0, -1, %0" : "=v"(l)); return l; }
__device__ __forceinline__ void ssq_add(u64* p, float s) { atomicAdd(p, (u64)(s * 16777216.f)); }
__device__ __forceinline__ float ssq_get(const u64* p) { return (float)(*p) * (1.f / 16777216.f); }
__device__ __forceinline__ float rcpf_(float x) { return __builtin_amdgcn_rcpf(x); }
__device__ __forceinline__ float sigmoidf_(float x) { return rcpf_(1.f + __expf(-x)); }

namespace pg8 {
constexpr int BM = 256, BK = 64, HALF = 128, HTB = HALF * BK * 2, STAGE_BYTES = 8 * HTB, NXCD = 8, WGM = 8;
__host__ __device__ __forceinline__ int lds_byte(int r, int c) { const int st = (r >> 4) * 2 + (c >> 5), rr = r & 15, cc = c & 31, ob = rr * 64 + cc * 2; return st * 1024 + (ob ^ (((ob >> 9) & 1) << 5)); }
__host__ __device__ __forceinline__ void stage_rc(int b, int& R, int& C) { const int st = b / 1024, sb = b % 1024, swz = sb ^ (((sb >> 9) & 1) << 5); R = (st >> 1) * 16 + swz / 64; C = (st & 1) * 32 + (swz % 64) / 2; }
__host__ __device__ __forceinline__ int perm32(int rho) { const int n = rho >> 4, i = rho & 15; return 8 * (i >> 2) + 4 * n + (i & 3); }
struct Unit { int pm, pn; };
struct Gemm { const bf16_t* A; const bf16_t* Bt; int M, N, K, lda, ldb; };
struct StaticOrder {
    int nM, nN, nwg, G, c;
    __host__ __device__ void init(int M, int N, int G_, int c_) { nM = M / BM; nN = N / BM; nwg = nM * nN; G = G_; c = c_; }
    __host__ __device__ bool next(int i, Unit& u) const {
        const long L = (long)i * G + c; if (L >= nwg) return false;
        int wgid = (int)L; { const int q = nwg / NXCD, r = nwg % NXCD, xcd = wgid % NXCD, off = wgid / NXCD; wgid = (xcd < r ? xcd * (q + 1) : r * (q + 1) + (xcd - r) * q) + off; }
        const int nig = WGM * nN, gid = wgid / nig, fm = gid * WGM, gsz = (nM - fm) < WGM ? (nM - fm) : WGM;
        u.pm = fm + ((wgid % nig) % gsz); u.pn = (wgid % nig) / gsz; return true;
    }
    __device__ __forceinline__ void a_ready(const Unit&) const {}
    __device__ __forceinline__ void done(const Unit&) const {}
};
template <class Epi, class Sched, bool ALIGN_EPI = false, bool SP2 = false>
__device__ __forceinline__ void gemm_phase(LAS unsigned char* lds, const Gemm g, const Sched& S, const Epi& E, int wave_s) {
    const int tid = wave_s * 64 + lane_id_fresh(), wid = wave_s, lane = tid & 63, wr = wid >> 2, wc = wid & 3, fr = lane & 15, fq = lane >> 4;
    const int K = g.K, nt = K / BK;
    unsigned voffA[2], voffB[2];
#pragma unroll
    for (int i = 0; i < 2; ++i) { int R, C; stage_rc(tid * 16 + i * 8192, R, C); const int Rb = Epi::PERM ? ((R & ~31) + perm32(R & 31)) : R;
        voffA[i] = (unsigned)(R * g.lda + C) * 2u; voffB[i] = (unsigned)(Rb * g.ldb + C) * 2u; }
    const size_t kstep = (size_t)(BK * 2);
    const size_t hstepA = (size_t)HALF * g.lda * 2, hstepB = (size_t)HALF * g.ldb * 2;
    const size_t tstepA = 2 * hstepA, tstepB = 2 * hstepB;
    const unsigned ldsw = (unsigned)wid * 1024u;
    const int aoff = lds_byte(wr * 64 + fr, fq * 8), boff = lds_byte(wc * 32 + fr, fq * 8);
#define PG8_SA(b, h) (((b) * 2 + (h)) * HTB)
#define PG8_SB(b, h) ((4 + (b) * 2 + (h)) * HTB)
#define PG8_STAGE(bufoff, gbase, voff) do { _Pragma("unroll") for (int _i = 0; _i < 2; ++_i) \
        __builtin_amdgcn_global_load_lds((const unsigned*)((const char*)(gbase) + (voff)[_i]), (LAS unsigned*)(lds + (bufoff) + ldsw + _i * 8192), 16, 0, 0); } while (0)
#define PG8_LDA(dst, b, h) do { _Pragma("unroll") for (int m = 0; m < 4; ++m) _Pragma("unroll") for (int k = 0; k < 2; ++k) dst[m][k] = *(const LAS bf16x8*)(lds + PG8_SA(b, h) + aoff + m * 2048 + k * 1024); } while (0)
#define PG8_LDB(dst, b, h) do { _Pragma("unroll") for (int n = 0; n < 2; ++n) _Pragma("unroll") for (int k = 0; k < 2; ++k) dst[n][k] = *(const LAS bf16x8*)(lds + PG8_SB(b, h) + boff + n * 2048 + k * 1024); } while (0)
#define PG8_MMA(ai, bj, At, Bt) do { __builtin_amdgcn_s_setprio(1); _Pragma("unroll") for (int m = 0; m < 4; ++m) _Pragma("unroll") for (int n = 0; n < 2; ++n) _Pragma("unroll") for (int k = 0; k < 2; ++k) \
        acc[ai][bj][m][n] = __builtin_amdgcn_mfma_f32_16x16x32_bf16(Bt[n][k], At[m][k], acc[ai][bj][m][n], 0, 0, 0); __builtin_amdgcn_s_setprio(0); } while (0)
#define PG8_WAIT_V(n) asm volatile("s_waitcnt vmcnt(" #n ")" ::: "memory")
#define PG8_WAIT_L(n) asm volatile("s_waitcnt lgkmcnt(" #n ")" ::: "memory")
#define PG8_BAR __builtin_amdgcn_s_barrier()
#define PG8_SCHED __builtin_amdgcn_sched_barrier(0)
    Unit cur, nxt; int ui = 0;
    if (!S.next(0, cur)) return;
    f32x4 acc[2][2][4][2];
#pragma unroll
    for (int a = 0; a < 2; ++a)
#pragma unroll
        for (int b = 0; b < 2; ++b)
#pragma unroll
            for (int m = 0; m < 4; ++m)
#pragma unroll
                for (int n = 0; n < 2; ++n) acc[a][b][m][n] = (f32x4){0.f, 0.f, 0.f, 0.f};
    bf16x8 At[4][2], B0[2][2], B1[2][2];
    const char* cA = (const char*)g.A + (size_t)cur.pm * tstepA; const char* cB = (const char*)g.Bt + (size_t)cur.pn * tstepB;
    S.a_ready(cur);
    if constexpr (SP2) {
        PG8_STAGE(PG8_SB(0, 0), cB, voffB); PG8_STAGE(PG8_SB(0, 1), cB + hstepB, voffB); PG8_STAGE(PG8_SA(0, 0), cA, voffA); PG8_STAGE(PG8_SA(0, 1), cA + hstepA, voffA);
        if (wr == 1) PG8_BAR;
        PG8_WAIT_V(2); PG8_BAR;
        PG8_STAGE(PG8_SB(1, 0), cB + kstep, voffB); PG8_STAGE(PG8_SA(1, 0), cA + kstep, voffA); PG8_STAGE(PG8_SB(1, 1), cB + hstepB + kstep, voffB);
        PG8_WAIT_V(6); PG8_BAR;
    } else {
        PG8_STAGE(PG8_SB(0, 0), cB, voffB); PG8_STAGE(PG8_SA(0, 0), cA, voffA); PG8_STAGE(PG8_SB(0, 1), cB + hstepB, voffB); PG8_STAGE(PG8_SA(0, 1), cA + hstepA, voffA);
        if (wr == 1) PG8_BAR;
        PG8_WAIT_V(4); PG8_BAR;
        PG8_STAGE(PG8_SB(1, 0), cB + kstep, voffB); PG8_STAGE(PG8_SA(1, 0), cA + kstep, voffA); PG8_STAGE(PG8_SB(1, 1), cB + hstepB + kstep, voffB);
        PG8_WAIT_V(6); PG8_BAR;
    }
    for (;;) {
        const bool has_next = S.next(ui + 1, nxt);
        const char* nA = has_next ? (const char*)g.A + (size_t)nxt.pm * tstepA : cA; const char* nB = has_next ? (const char*)g.Bt + (size_t)nxt.pn * tstepB : cB;
        for (int t = 0; t < nt; t += 2) {
            const bool last = (t == nt - 2);
            const char* a1 = cA + (size_t)(t + 1) * kstep;
            const char* a2 = last ? nA : cA + (size_t)(t + 2) * kstep; const char* b2 = last ? nB : cB + (size_t)(t + 2) * kstep;
            const char* a3 = a2 + kstep; const char* b3 = b2 + kstep;
            if (last && has_next) S.a_ready(nxt);
            if constexpr (SP2) {
            PG8_LDB(B0, 0, 0); PG8_LDB(B1, 0, 1); PG8_SCHED; PG8_LDA(At, 0, 0); PG8_STAGE(PG8_SA(1, 1), a1 + hstepA, voffA);
            PG8_WAIT_V(8); PG8_WAIT_L(0); PG8_BAR; PG8_MMA(0, 0, At, B0); PG8_MMA(0, 1, At, B1); PG8_BAR; PG8_SCHED;
            PG8_LDA(At, 0, 1); PG8_STAGE(PG8_SB(0, 0), b2, voffB); PG8_STAGE(PG8_SB(0, 1), b2 + hstepB, voffB); PG8_STAGE(PG8_SA(0, 0), a2, voffA);
            PG8_WAIT_V(8); PG8_WAIT_L(0); PG8_BAR; PG8_MMA(1, 0, At, B0); PG8_MMA(1, 1, At, B1); PG8_BAR; PG8_SCHED;
            PG8_LDB(B0, 1, 0); PG8_LDB(B1, 1, 1); PG8_SCHED; PG8_LDA(At, 1, 0); PG8_STAGE(PG8_SA(0, 1), a2 + hstepA, voffA);
            PG8_WAIT_V(8); PG8_WAIT_L(0); PG8_BAR; PG8_MMA(0, 0, At, B0); PG8_MMA(0, 1, At, B1); PG8_BAR; PG8_SCHED;
            PG8_LDA(At, 1, 1); PG8_STAGE(PG8_SB(1, 0), b3, voffB); PG8_STAGE(PG8_SB(1, 1), b3 + hstepB, voffB); PG8_STAGE(PG8_SA(1, 0), a3, voffA);
            PG8_WAIT_V(8); PG8_WAIT_L(0); PG8_BAR; PG8_MMA(1, 0, At, B0); PG8_MMA(1, 1, At, B1); PG8_BAR; PG8_SCHED;
            } else {
            PG8_LDB(B0, 0, 0); PG8_SCHED; PG8_LDA(At, 0, 0); PG8_STAGE(PG8_SA(1, 1), a1 + hstepA, voffA);
            PG8_WAIT_L(8); PG8_BAR; PG8_WAIT_L(0); PG8_MMA(0, 0, At, B0); PG8_BAR; PG8_SCHED;
            PG8_LDB(B1, 0, 1); PG8_STAGE(PG8_SB(0, 0), b2, voffB);
            PG8_BAR; PG8_WAIT_L(0); PG8_MMA(0, 1, At, B1); PG8_BAR;
            PG8_LDA(At, 0, 1); PG8_STAGE(PG8_SA(0, 0), a2, voffA);
            PG8_BAR; PG8_WAIT_L(0); PG8_MMA(1, 0, At, B0); PG8_BAR; PG8_SCHED;
            PG8_STAGE(PG8_SB(0, 1), b2 + hstepB, voffB);
            PG8_WAIT_V(6); PG8_BAR; PG8_MMA(1, 1, At, B1); PG8_BAR;
            PG8_LDB(B0, 1, 0); PG8_SCHED; PG8_LDA(At, 1, 0); PG8_STAGE(PG8_SA(0, 1), a2 + hstepA, voffA);
            PG8_WAIT_L(8); PG8_BAR; PG8_WAIT_L(0); PG8_MMA(0, 0, At, B0); PG8_BAR; PG8_SCHED;
            PG8_LDB(B1, 1, 1); PG8_STAGE(PG8_SB(1, 0), b3, voffB);
            PG8_BAR; PG8_WAIT_L(0); PG8_MMA(0, 1, At, B1); PG8_BAR;
            PG8_LDA(At, 1, 1); PG8_STAGE(PG8_SA(1, 0), a3, voffA);
            PG8_BAR; PG8_WAIT_L(0); PG8_MMA(1, 0, At, B0); PG8_BAR; PG8_SCHED;
            PG8_STAGE(PG8_SB(1, 1), b3 + hstepB, voffB);
            PG8_WAIT_V(6); PG8_BAR; PG8_MMA(1, 1, At, B1); PG8_BAR;
            }
        }
        if constexpr (ALIGN_EPI) { if (wr == 0) PG8_BAR; }
        if constexpr (!Epi::AFTER_DRAIN) { E(acc, cur, wr, wc, fr, fq); S.done(cur); }
        if (!has_next) break;
#pragma unroll
        for (int a = 0; a < 2; ++a)
#pragma unroll
            for (int b = 0; b < 2; ++b)
#pragma unroll
                for (int m = 0; m < 4; ++m)
#pragma unroll
                    for (int n = 0; n < 2; ++n) acc[a][b][m][n] = (f32x4){0.f, 0.f, 0.f, 0.f};
        cur = nxt; cA = nA; cB = nB; ++ui;
        if constexpr (ALIGN_EPI) { if (wr == 1) PG8_BAR; }
    }
    PG8_WAIT_V(0);
    if constexpr (!ALIGN_EPI) { if (wr == 0) PG8_BAR; }
    PG8_BAR;
    if constexpr (Epi::AFTER_DRAIN) { E.fused(acc, cur, wr, wc, fr, fq, lds, wid, lane); S.done(cur); }
#undef PG8_SA
#undef PG8_SB
#undef PG8_STAGE
#undef PG8_LDA
#undef PG8_LDB
#undef PG8_MMA
#undef PG8_WAIT_V
#undef PG8_WAIT_L
#undef PG8_BAR
#undef PG8_SCHED
}
}

#define EPI_ROWS(ai, m) (u.pm * 256 + (ai) * 128 + wr * 64 + (m) * 16 + fr)
#define EPI_COL0 (u.pn * 256 + wc * 32 + 8 * fq)
typedef const f32x4 (&AccT)[2][2][4][2];

__device__ __forceinline__ float fq_sum(float v, int lane) { v += bperm_f(lane ^ 16, v); v += bperm_f(lane ^ 32, v); return v; }

struct EpiZ {
    static constexpr bool PERM = true, AFTER_DRAIN = false;
    bf16_t* Z; const u64* ssq; u64* mqs; u64* mkvs;
    __device__ __forceinline__ void operator()(AccT acc, const pg8::Unit& u, int wr, int wc, int fr, int fq) const {
        const int col0 = EPI_COL0;
#pragma unroll
        for (int ai = 0; ai < 2; ++ai)
#pragma unroll
            for (int m = 0; m < 4; ++m) {
                const int row = EPI_ROWS(ai, m); const float rs = rsqrtf(ssq_get(ssq + row) * (1.f / D) + EPS);
                float sq = 0.f, skv = 0.f;
#pragma unroll
                for (int bj = 0; bj < 2; ++bj) {
                    const f32x4 v0 = acc[ai][bj][m][0] * rs, v1 = acc[ai][bj][m][1] * rs;
                    u32x4 w; w.x = pk2(v0[0], v0[1]); w.y = pk2(v0[2], v0[3]); w.z = pk2(v1[0], v1[1]); w.w = pk2(v1[2], v1[3]);
                    *(u32x4*)(Z + (size_t)row * NZ + col0 + bj * 128) = w;
                    const float s2 = v0[0] * v0[0] + v0[1] * v0[1] + v0[2] * v0[2] + v0[3] * v0[3] + v1[0] * v1[0] + v1[1] * v1[1] + v1[2] * v1[2] + v1[3] * v1[3];
                    const int cb = u.pn * 256 + bj * 128;
                    if (cb >= ZC_MCQ && cb < ZC_MCKV) sq += s2;
                    if (cb >= ZC_MCKV && cb < ZC_MKR) skv += s2;
                }
                if (u.pn >= 14 && u.pn <= 16) {
                    sq = fq_sum(sq, fr + 16 * fq); skv = fq_sum(skv, fr + 16 * fq);
                    if (fq == 0) { if (u.pn <= 15) ssq_add(mqs + row, sq); if (u.pn >= 15) ssq_add(mkvs + row, skv); }
                }
            }
    }
};
struct EpiBf16s {
    static constexpr bool PERM = true, AFTER_DRAIN = false;
    bf16_t* O; int ldo; const u64* ssq; float inv_n;
    __device__ __forceinline__ void operator()(AccT acc, const pg8::Unit& u, int wr, int wc, int fr, int fq) const {
        const int col0 = EPI_COL0;
#pragma unroll
        for (int ai = 0; ai < 2; ++ai)
#pragma unroll
            for (int m = 0; m < 4; ++m) {
                const int row = EPI_ROWS(ai, m); const float rs = ssq ? rsqrtf(ssq_get(ssq + row) * inv_n + EPS) : 1.f;
#pragma unroll
                for (int bj = 0; bj < 2; ++bj) {
                    const f32x4 v0 = acc[ai][bj][m][0] * rs, v1 = acc[ai][bj][m][1] * rs;
                    u32x4 w; w.x = pk2(v0[0], v0[1]); w.y = pk2(v0[2], v0[3]); w.z = pk2(v1[0], v1[1]); w.w = pk2(v1[2], v1[3]);
                    *(u32x4*)(O + (size_t)row * ldo + col0 + bj * 128) = w;
                }
            }
    }
};
struct EpiRes {
    static constexpr bool PERM = true, AFTER_DRAIN = false;
    bf16_t* HB; u64* ssq;
    __device__ __forceinline__ void operator()(AccT acc, const pg8::Unit& u, int wr, int wc, int fr, int fq) const {
        const int col0 = EPI_COL0;
#pragma unroll
        for (int ai = 0; ai < 2; ++ai)
#pragma unroll
            for (int m = 0; m < 4; ++m) {
                const int row = EPI_ROWS(ai, m); float s2 = 0.f;
#pragma unroll
                for (int bj = 0; bj < 2; ++bj) {
                    bf16_t* hp = HB + (size_t)row * D + col0 + bj * 128;
                    const u32x4 hw = *(const u32x4*)hp;
                    const f32x4 v0 = (f32x4){bflo(hw[0]), bfhi(hw[0]), bflo(hw[1]), bfhi(hw[1])} + acc[ai][bj][m][0], v1 = (f32x4){bflo(hw[2]), bfhi(hw[2]), bflo(hw[3]), bfhi(hw[3])} + acc[ai][bj][m][1];
                    u32x4 w; w.x = pk2(v0[0], v0[1]); w.y = pk2(v0[2], v0[3]); w.z = pk2(v1[0], v1[1]); w.w = pk2(v1[2], v1[3]);
                    *(u32x4*)hp = w;
                    s2 += v0[0] * v0[0] + v0[1] * v0[1] + v0[2] * v0[2] + v0[3] * v0[3] + v1[0] * v1[0] + v1[1] * v1[1] + v1[2] * v1[2] + v1[3] * v1[3];
                }
                s2 = fq_sum(s2, fr + 16 * fq);
                if (fq == 0) ssq_add(ssq + row, s2);
            }
    }
};
struct EpiF32s {
    static constexpr bool PERM = true, AFTER_DRAIN = false;
    float* C; const u64* ssq;
    __device__ __forceinline__ void operator()(AccT acc, const pg8::Unit& u, int wr, int wc, int fr, int fq) const {
        const int col0 = EPI_COL0;
#pragma unroll
        for (int ai = 0; ai < 2; ++ai)
#pragma unroll
            for (int m = 0; m < 4; ++m) {
                const int row = EPI_ROWS(ai, m); const float rs = ssq ? rsqrtf(ssq_get(ssq + row) * (1.f / D) + EPS) : 1.f;
#pragma unroll
                for (int bj = 0; bj < 2; ++bj) {
                    float* cp = C + (size_t)row * D + col0 + bj * 128;
                    *(f32x4*)cp = acc[ai][bj][m][0] * rs; *(f32x4*)(cp + 4) = acc[ai][bj][m][1] * rs;
                }
            }
    }
};
struct EpiPle {
    static constexpr bool PERM = true, AFTER_DRAIN = false;
    const bf16_t* HBin; bf16_t* HBout; const bf16_t* PR; const float* ssq_in; u64* ssq_out;
    __device__ __forceinline__ void operator()(AccT acc, const pg8::Unit& u, int wr, int wc, int fr, int fq) const {
        const int col0 = EPI_COL0;
#pragma unroll
        for (int ai = 0; ai < 2; ++ai)
#pragma unroll
            for (int m = 0; m < 4; ++m) {
                const int row = EPI_ROWS(ai, m); const float rs = rsqrtf(ssq_in[row] * (1.f / D) + EPS); float s2 = 0.f;
#pragma unroll
                for (int bj = 0; bj < 2; ++bj) {
                    const size_t o = (size_t)row * D + col0 + bj * 128;
                    const u32x4 hw = *(const u32x4*)(HBin + o), pw = *(const u32x4*)(PR + o);
                    f32x4 v0 = (f32x4){bflo(hw[0]), bfhi(hw[0]), bflo(hw[1]), bfhi(hw[1])}, v1 = (f32x4){bflo(hw[2]), bfhi(hw[2]), bflo(hw[3]), bfhi(hw[3])};
                    const f32x4 p0 = (f32x4){bflo(pw[0]), bfhi(pw[0]), bflo(pw[1]), bfhi(pw[1])}, p1 = (f32x4){bflo(pw[2]), bfhi(pw[2]), bflo(pw[3]), bfhi(pw[3])};
#pragma unroll
                    for (int j = 0; j < 4; ++j) { v0[j] += sigmoidf_(acc[ai][bj][m][0][j] * rs) * p0[j]; v1[j] += sigmoidf_(acc[ai][bj][m][1][j] * rs) * p1[j]; }
                    u32x4 w; w.x = pk2(v0[0], v0[1]); w.y = pk2(v0[2], v0[3]); w.z = pk2(v1[0], v1[1]); w.w = pk2(v1[2], v1[3]);
                    *(u32x4*)(HBout + o) = w;
                    s2 += v0[0] * v0[0] + v0[1] * v0[1] + v0[2] * v0[2] + v0[3] * v0[3] + v1[0] * v1[0] + v1[1] * v1[1] + v1[2] * v1[2] + v1[3] * v1[3];
                }
                s2 = fq_sum(s2, fr + 16 * fq);
                if (fq == 0) ssq_add(ssq_out + row, s2);
            }
    }
};

__device__ __forceinline__ int f2ord(float f) { const int b = __builtin_bit_cast(int, f); return b >= 0 ? b : (b ^ 0x7FFFFFFF); }
__device__ __forceinline__ float ord2f(int k) { const int b = k >= 0 ? k : (k ^ 0x7FFFFFFF); return __builtin_bit_cast(float, b); }
__device__ __forceinline__ int row16_max(int v) {
    asm("s_nop 1\n\tv_max_i32_dpp %0, %0, %0 quad_perm:[1,0,3,2] row_mask:0xf bank_mask:0xf\n\ts_nop 1\n\tv_max_i32_dpp %0, %0, %0 quad_perm:[2,3,0,1] row_mask:0xf bank_mask:0xf\n\t"
        "s_nop 1\n\tv_max_i32_dpp %0, %0, %0 row_half_mirror row_mask:0xf bank_mask:0xf\n\ts_nop 1\n\tv_max_i32_dpp %0, %0, %0 row_mirror row_mask:0xf bank_mask:0xf" : "+v"(v));
    return v;
}
__device__ __forceinline__ float row16_sum(float v) {
    v += __builtin_bit_cast(float, __builtin_amdgcn_update_dpp(0, __builtin_bit_cast(int, v), 0xB1, 0xF, 0xF, false)); v += __builtin_bit_cast(float, __builtin_amdgcn_update_dpp(0, __builtin_bit_cast(int, v), 0x4E, 0xF, 0xF, false));
    v += __builtin_bit_cast(float, __builtin_amdgcn_update_dpp(0, __builtin_bit_cast(int, v), 0x141, 0xF, 0xF, false)); v += __builtin_bit_cast(float, __builtin_amdgcn_update_dpp(0, __builtin_bit_cast(int, v), 0x140, 0xF, 0xF, false));
    return v;
}
__device__ __forceinline__ void peer_topk_mfma(LAS unsigned char* lds, int wid, const bf16_t* QB, const bf16_t* SKB, int* PIDX, float* PG, int pm, int pn) {
    constexpr int SQL = 272, L_SK = 0;
    const int lane = lane_id_fresh(), tid = wid * 64 + lane, l15 = lane & 15, g = lane >> 4;
    int tk[2][2][4];
#pragma unroll
    for (int c = 0; c < 2; ++c) {
        const bf16_t* sk = SKB + ((size_t)(pn * 2 + c) * 128) * 128;
#pragma unroll
        for (int i = 0; i < 4; ++i) { const int id = tid + 512 * i, n = id >> 4, dc = id & 15; *(LAS u32x4*)(lds + L_SK + n * SQL + dc * 16) = *(const u32x4*)(sk + n * 128 + dc * 8); }
        bf16x8 af[2][4];
#pragma unroll
        for (int rt = 0; rt < 2; ++rt)
#pragma unroll
            for (int ks = 0; ks < 4; ++ks) af[rt][ks] = *(const bf16x8*)(QB + (size_t)(pm * 256 + 32 * wid + 16 * rt + l15) * D + pn * 256 + c * 128 + 32 * ks + 8 * g);
        __syncthreads();
        int key[2][8][4];
#pragma unroll
        for (int nt = 0; nt < 8; ++nt) {
            f32x4 sc0 = (f32x4){0.f, 0.f, 0.f, 0.f}, sc1 = (f32x4){0.f, 0.f, 0.f, 0.f};
#pragma unroll
            for (int ks = 0; ks < 4; ++ks) {
                const bf16x8 bfr = *(const LAS bf16x8*)(lds + L_SK + (16 * nt + l15) * SQL + (32 * ks + 8 * g) * 2);
                sc0 = __builtin_amdgcn_mfma_f32_16x16x32_bf16(af[0][ks], bfr, sc0, 0, 0, 0);
                sc1 = __builtin_amdgcn_mfma_f32_16x16x32_bf16(af[1][ks], bfr, sc1, 0, 0, 0);
            }
#pragma unroll
            for (int r = 0; r < 4; ++r) { key[0][nt][r] = (f2ord(sc0[r]) & ~127) | (127 - (16 * nt + l15)); key[1][nt][r] = (f2ord(sc1[r]) & ~127) | (127 - (16 * nt + l15)); }
        }
        __syncthreads();
#pragma unroll
        for (int rt = 0; rt < 2; ++rt)
#pragma unroll
            for (int r = 0; r < 4; ++r) {
#define SK_(i) key[rt][i][r]
#define CE_(i, j) do { const int hi_ = max(SK_(i), SK_(j)), lo_ = min(SK_(i), SK_(j)); SK_(i) = hi_; SK_(j) = lo_; } while (0)
                CE_(0, 1); CE_(2, 3); CE_(4, 5); CE_(6, 7); CE_(0, 2); CE_(1, 3); CE_(4, 6); CE_(5, 7); CE_(1, 2); CE_(5, 6);
                CE_(0, 4); CE_(1, 5); CE_(2, 6); CE_(3, 7); CE_(2, 4); CE_(3, 5); CE_(1, 2); CE_(3, 4); CE_(5, 6);
                int mine = 0;
#pragma unroll 1
                for (int k = 0; k < 16; ++k) {
                    const int v = row16_max(SK_(0));
                    if (l15 == k) mine = v;
                    const bool won = (SK_(0) == v);
#pragma unroll
                    for (int nt = 0; nt < 7; ++nt) SK_(nt) = won ? SK_(nt + 1) : SK_(nt);
                    SK_(7) = won ? (int)0x80000000 : SK_(7);
                }
#undef CE_
#undef SK_
                tk[c][rt][r] = mine;
            }
    }
    int ci_[4], cj_[4]; bool cv_[4];
    ci_[0] = 0; cj_[0] = l15; cv_[0] = true;
    ci_[1] = l15 < 8 ? 1 : (l15 < 13 ? 2 : 3); cj_[1] = l15 < 8 ? l15 : (l15 < 13 ? l15 - 8 : l15 - 13); cv_[1] = true;
    ci_[2] = l15 == 0 ? 3 : (l15 < 4 ? 4 : (l15 < 6 ? 5 : (l15 < 8 ? 6 : (l15 < 10 ? 7 : l15 - 2))));
    cj_[2] = l15 == 0 ? 3 : (l15 < 4 ? l15 - 1 : (l15 < 6 ? l15 - 4 : (l15 < 8 ? l15 - 6 : (l15 < 10 ? l15 - 8 : 0)))); cv_[2] = true;
    ci_[3] = 14 + (l15 & 1); cj_[3] = 0; cv_[3] = l15 < 2;
#pragma unroll
    for (int rt = 0; rt < 2; ++rt)
#pragma unroll
        for (int r = 0; r < 4; ++r) {
            int ck[4];
#pragma unroll
            for (int q = 0; q < 4; ++q) {
                const float s0 = ord2f(bperm_i((lane & 48) + ci_[q], tk[0][rt][r]) & ~127), s1 = ord2f(bperm_i((lane & 48) + cj_[q], tk[1][rt][r]) & ~127);
                ck[q] = cv_[q] ? ((f2ord(s0 + s1) & ~255) | (255 - (16 * ci_[q] + cj_[q]))) : (int)0x80000000;
            }
            int mine = 0;
            for (int k = 0; k < 16; ++k) {
                int v = max(max(ck[0], ck[1]), max(ck[2], ck[3]));
                v = row16_max(v);
                if (l15 == k) mine = v;
#pragma unroll
                for (int q = 0; q < 4; ++q) ck[q] = (ck[q] == v) ? (int)0x80000000 : ck[q];
            }
            const int pos = 255 - (mine & 255), ci = pos >> 4, cj = pos & 15;
            const int i0 = 127 - (bperm_i((lane & 48) + ci, tk[0][rt][r]) & 127), i1 = 127 - (bperm_i((lane & 48) + cj, tk[1][rt][r]) & 127);
            const float bv = ord2f(mine & ~255), b0 = ord2f(bperm_i(lane & 48, mine) & ~255);
            const float ex = __expf(bv - b0), sum = row16_sum(ex);
            const size_t o = (size_t)(pm * 256 + 32 * wid + 16 * rt + 4 * g + r) * 128 + pn * 16 + l15;
            PIDX[o] = i0 * 128 + i1; PG[o] = ex * rcpf_(sum);
        }
}

#define XB_TMO      128
#define XB_XCNT(j)  (256  + 64 * (j))
#define XB_XSUB(j)  (1280 + 64 * (j))
#define XB_XGEN(j)  (2304 + 64 * (j))
#define XB_TOP      3328
#define XB_TOPGEN   3392
#define XCD_BAR_WORDS 3456
#define XB_SPIN_CAP (1u << 18)
__device__ __forceinline__ unsigned xb_ld(unsigned* p)              { return __hip_atomic_load(p, __ATOMIC_RELAXED, __HIP_MEMORY_SCOPE_AGENT); }
__device__ __forceinline__ unsigned xb_add(unsigned* p, unsigned v) { return __hip_atomic_fetch_add(p, v, __ATOMIC_RELAXED, __HIP_MEMORY_SCOPE_AGENT); }
__device__ __forceinline__ unsigned xb_xcc_id() { return (unsigned)__builtin_amdgcn_s_getreg((3 << 11) | 20) & 0xFu; }
#define XB_SPIN(cond, bar) do { unsigned _sp = 0; while (cond) { __builtin_amdgcn_s_sleep(1); \
    if ((++_sp & 255u) == 0u) { if (xb_ld(&(bar)[XB_TMO])) break; if (_sp > XB_SPIN_CAP) { atomicAdd(&(bar)[XB_TMO], 1u); break; } } } } while (0)
struct XcdBarrier { unsigned* bar; unsigned x; volatile LAS unsigned* st; };
__device__ __forceinline__ XcdBarrier xcd_barrier_post(unsigned* bar, volatile LAS unsigned* st) {
    XcdBarrier b; b.bar = bar; b.x = xb_xcc_id(); b.st = st;
    if (threadIdx.x == 0) (void)xb_add(&bar[XB_XCNT(b.x)], 1u);
    return b;
}
__device__ __forceinline__ void xcd_barrier_complete(unsigned* bar, unsigned x, unsigned& nloc, unsigned& nx) {
    const unsigned G = gridDim.x * gridDim.y * gridDim.z;
    unsigned sum, cnt, mine, sp = 0u;
    for (;;) {
        sum = 0u; cnt = 0u; mine = 0u;
#pragma unroll
        for (unsigned j = 0; j < 16; ++j) { const unsigned c = xb_ld(&bar[XB_XCNT(j)]); sum += c; cnt += (c > 0u) ? 1u : 0u; mine = (j == x) ? c : mine; }
        if (sum == G) break;
        __builtin_amdgcn_s_sleep(1);
        if ((++sp & 255u) == 0u) { if (xb_ld(&bar[XB_TMO])) break; if (sp > XB_SPIN_CAP) { atomicAdd(&bar[XB_TMO], 1u); break; } }
    }
    nloc = mine > 0u ? mine : 1u; nx = cnt > 0u ? cnt : 1u;
}
__device__ __forceinline__ void xcd_barrier(const XcdBarrier& b, int wave_s) {
    asm volatile("s_waitcnt vmcnt(0)" ::: "memory");
    __syncthreads();
    if (wave_s == 0 && lane_id_fresh() == 0) {
        unsigned* bar = b.bar;
        __builtin_amdgcn_s_waitcnt(0);
        unsigned nloc = b.st[0], nx = b.st[1];
        if (nloc == 0u) { xcd_barrier_complete(bar, b.x, nloc, nx); b.st[0] = nloc; b.st[1] = nx; }
        const unsigned old = xb_add(&bar[XB_XSUB(b.x)], 1u);
        const unsigned gen = old / nloc;
        if (old + 1u == (gen + 1u) * nloc) {
            __builtin_amdgcn_fence(__ATOMIC_RELEASE, "agent");
            asm volatile("s_waitcnt vmcnt(0)" ::: "memory");
            const unsigned og = xb_add(&bar[XB_TOP], 1u);
            const unsigned tg = og / nx;
            if (og + 1u == (tg + 1u) * nx) xb_add(&bar[XB_TOPGEN], 1u);
            else XB_SPIN(xb_ld(&bar[XB_TOPGEN]) == tg, bar);
            __builtin_amdgcn_fence(__ATOMIC_ACQUIRE, "agent");
            xb_add(&bar[XB_XGEN(b.x)], 1u);
            asm volatile("s_waitcnt vmcnt(0)" ::: "memory");
        } else {
            XB_SPIN(xb_ld(&bar[XB_XGEN(b.x)]) == gen, bar);
            __builtin_amdgcn_fence(__ATOMIC_ACQUIRE, "agent");
            asm volatile("s_waitcnt vmcnt(0)" ::: "memory");
        }
    }
    __syncthreads();
}

constexpr int RING_BYTES = 131072, MISC_OFF = RING_BYTES + 320, LDS_BYTES = 147456;
struct Args { const float* in[28]; float* out; unsigned char* ws; int ph_lo, ph_hi; };
enum { I_X = 0, I_P, I_POS, I_LN_MIX, I_W_IN, I_DIFF_LAMBDA, I_DIFF_NORM, I_HGRN_LB, I_HGRN_NORM, I_MLA_QN, I_MLA_KVN, I_MLA_WUQ, I_MLA_WUKV, I_CONV_W, I_CONV_B, I_GATE_B,
       I_MLSTM_NORM, I_GROUP_GAIN, I_W_OUT, I_LN_FFN, I_PEER_WQ, I_PEER_SUBKEYS, I_PEER_U, I_PEER_V, I_LN_PLE, I_PLE_WGATE, I_PLE_WPROJ, I_LN_FINAL };

struct Frame {
    LAS unsigned char* lds; unsigned char* ws; const Args* a;
    int tid, lane, wave, G, gw, ngw, bid;
};

__device__ __forceinline__ int cmap_win(int n) {
    if (n < ZC_MKR) return n;
    if (n < ZC_LQ) { const int j = n - ZC_MKR; return ZC_MKR + (j >> 1) + 32 * (j & 1); }
    if (n < ZC_LO) return n;
    if (n < ZC_LI) return 5320 + (n - ZC_LO);
    if (n < ZC_LF) return 5312 + (n - ZC_LI);
    if (n < IN_COLS) return 5316 + (n - ZC_LF);
    return -1;
}
__device__ __forceinline__ int cmap_uq(int n) { const int hd = n / 192, r = n % 192; if (r < 128) return n; const int j = r - 128; return hd * 192 + 128 + (j >> 1) + 32 * (j & 1); }

template <int MAP>
__device__ __forceinline__ void transpose_item(const float* W, int K, int Nsrc, int Ndst, const float* gain, bf16_t* WT, LAS float* scr_, int item, int lane) {
    LAS unsigned char* scr = (LAS unsigned char*)scr_;
    const int nblk = Ndst / 64, kb = item / nblk, nb = item % nblk, k0 = 64 * kb, n0 = 64 * nb;
    const int nq = (lane & 15) * 4, kr = lane >> 4;
    if (MAP == 0 || (MAP == 1 && (n0 + 64 <= ZC_MKR || (n0 >= ZC_LQ && n0 + 64 <= ZC_LO)))) {
        f32x4 tv[16]; float gk[16];
#pragma unroll
        for (int i = 0; i < 16; ++i) tv[i] = __builtin_nontemporal_load((const f32x4*)(W + (size_t)(k0 + kr + 4 * i) * Nsrc + n0 + nq));
        if (gain) {
#pragma unroll
            for (int i = 0; i < 16; ++i) gk[i] = gain[k0 + kr + 4 * i];
        } else {
#pragma unroll
            for (int i = 0; i < 16; ++i) gk[i] = 1.f;
        }
#pragma unroll
        for (int i = 0; i < 16; ++i) { const int kk = kr + 4 * i; const f32x4 v = tv[i] * gk[i];
#pragma unroll
            for (int e = 0; e < 4; ++e) *(LAS bf16_t*)(scr + (nq + e) * 144 + kk * 2) = (bf16_t)f2bf(v[e]); }
    } else {
        int src[4];
#pragma unroll
        for (int e = 0; e < 4; ++e) src[e] = (MAP == 1) ? cmap_win(n0 + nq + e) : cmap_uq(n0 + nq + e);
        const int s0 = src[0] > 0 ? src[0] : 0, s1 = src[1] > 0 ? src[1] : 0, s2 = src[2] > 0 ? src[2] : 0, s3 = src[3] > 0 ? src[3] : 0;
        float ts[16][4], gk[16];
#pragma unroll
        for (int i = 0; i < 16; ++i) { const float* wr = W + (size_t)(k0 + kr + 4 * i) * Nsrc; ts[i][0] = wr[s0]; ts[i][1] = wr[s1]; ts[i][2] = wr[s2]; ts[i][3] = wr[s3]; }
        if (gain) {
#pragma unroll
            for (int i = 0; i < 16; ++i) gk[i] = gain[k0 + kr + 4 * i];
        } else {
#pragma unroll
            for (int i = 0; i < 16; ++i) gk[i] = 1.f;
        }
#pragma unroll
        for (int i = 0; i < 16; ++i) { const int kk = kr + 4 * i;
#pragma unroll
            for (int e = 0; e < 4; ++e) { const float v = (src[e] >= 0) ? ts[i][e] * gk[i] : 0.f; *(LAS bf16_t*)(scr + (nq + e) * 144 + kk * 2) = (bf16_t)f2bf(v); } }
    }
    asm volatile("s_waitcnt lgkmcnt(0)" ::: "memory");
#pragma unroll
    for (int j = 0; j < 8; ++j) { const int n = (lane >> 3) + 8 * j, c = lane & 7; *(u32x4*)(WT + (size_t)(n0 + n) * K + k0 + 8 * c) = *(const LAS u32x4*)(scr + n * 144 + c * 16); }
    asm volatile("s_waitcnt lgkmcnt(0)" ::: "memory");
}

constexpr int CV_TAB = 4096, CV_WIN = CV_TAB + 736, CV_WOUT = CV_WIN + 256, CV_WQ = CV_WOUT + 256, CV_WG = CV_WQ + 256, CV_WP = CV_WG + 32, CV_UQ = CV_WP + 18, CV_UKV = CV_UQ + 16,
              CV_P = CV_UKV + 128, NCONV = CV_P + 16;
__device__ __forceinline__ bool conv_early(int item) { return (item >= CV_TAB && item < CV_WIN) || (item >= CV_WP && item < CV_UKV); }
__device__ __forceinline__ void convert_item(Frame& F, int l, int item, int lane) {
    const Args& a = *F.a; unsigned char* ws = F.ws;
    LAS float* scr = (LAS float*)(F.lds + F.wave * 16384);
    if (item < CV_TAB) {
        const int tab = item >> 11, r0 = l * NEXP + (item & 2047) * 8;
        const float* SRC = a.in[tab ? I_PEER_V : I_PEER_U]; unsigned char* DST = ws + (tab ? WS_VB : WS_UB); float* SC = (float*)(ws + (tab ? WS_SV : WS_SU));
        const float* gF = a.in[I_LN_FFN] + l * D;
        f32x4 gv[8];
#pragma unroll
        for (int q = 0; q < 8; ++q) { gv[q] = (f32x4){1.f, 1.f, 1.f, 1.f}; if (tab == 0) gv[q] = *(const f32x4*)(gF + q * 256 + lane * 4); }
        float mysc = 1.f;
        f32x4 nx[2][8];
#pragma unroll
        for (int k = 0; k < 2; ++k)
#pragma unroll
            for (int q = 0; q < 8; ++q) nx[k][q] = __builtin_nontemporal_load((const f32x4*)(SRC + (size_t)(r0 + k) * D + q * 256 + lane * 4));
#pragma unroll
        for (int rr = 0; rr < 8; ++rr) {
            const int row = r0 + rr; f32x4 v[8]; float am = 0.f;
#pragma unroll
            for (int q = 0; q < 8; ++q) v[q] = nx[rr & 1][q];
            if (rr + 2 < 8) {
#pragma unroll
                for (int q = 0; q < 8; ++q) nx[rr & 1][q] = __builtin_nontemporal_load((const f32x4*)(SRC + (size_t)(row + 2) * D + q * 256 + lane * 4));
            }
#pragma unroll
            for (int q = 0; q < 8; ++q) {
                v[q] *= gv[q];
                am = fmaxf(am, fmaxf(fmaxf(fabsf(v[q][0]), fabsf(v[q][1])), fmaxf(fabsf(v[q][2]), fabsf(v[q][3]))));
            }
            am = wave_max(am);
            const float sc = am > 0.f ? am * (1.f / 6.f) : 1.f, inv = 1.f / sc;
            u32x4 pk;
#pragma unroll
            for (int q2 = 0; q2 < 4; ++q2) { unsigned w = 0;
                w = __builtin_amdgcn_cvt_scalef32_pk_fp4_f32(w, v[2 * q2][0] * inv, v[2 * q2][1] * inv, 1.0f, 0);
                w = __builtin_amdgcn_cvt_scalef32_pk_fp4_f32(w, v[2 * q2][2] * inv, v[2 * q2][3] * inv, 1.0f, 1);
                w = __builtin_amdgcn_cvt_scalef32_pk_fp4_f32(w, v[2 * q2 + 1][0] * inv, v[2 * q2 + 1][1] * inv, 1.0f, 2);
                w = __builtin_amdgcn_cvt_scalef32_pk_fp4_f32(w, v[2 * q2 + 1][2] * inv, v[2 * q2 + 1][3] * inv, 1.0f, 3);
                pk[q2] = w; }
            *(u32x4*)(DST + (size_t)row * VROW + lane * 16) = pk;
            mysc = (lane == rr) ? sc : mysc;
        }
        if (lane < 8) SC[r0 + lane] = mysc;
        return;
    }
#define CV_TR(MAP, base, WI, GI, K_, NS_, ND_, WSOFF) do { const int i0_ = (item - (base)) * 4; const float* W_ = a.in[WI] + (size_t)l * (K_) * (NS_); const float* g_ = (GI) >= 0 ? a.in[(GI) >= 0 ? (GI) : 0] + l * (K_) : nullptr; \
        bf16_t* WT_ = (bf16_t*)(ws + (WSOFF)) + (size_t)l * (ND_) * (K_); _Pragma("unroll 1") for (int j_ = 0; j_ < 4; ++j_) if (i0_ + j_ < ((K_) / 64) * ((ND_) / 64)) transpose_item<MAP>(W_, K_, NS_, ND_, g_, WT_, scr, i0_ + j_, lane); } while (0)
    if (item < CV_WIN) { CV_TR(1, CV_TAB, I_W_IN, I_LN_MIX, D, IN_COLS, NZ, WS_WIN); return; }
    if (item < CV_WOUT) { CV_TR(0, CV_WIN, I_W_OUT, I_GROUP_GAIN, D, D, D, WS_WOUT); return; }
    if (item < CV_WQ) { CV_TR(0, CV_WOUT, I_PEER_WQ, I_LN_FFN, D, D, D, WS_WQ); return; }
    if (item < CV_WG) { CV_TR(0, CV_WQ, I_PLE_WGATE, I_LN_PLE, D, D, D, WS_WG); return; }
    if (item < CV_WP) { CV_TR(0, CV_WG, I_PLE_WPROJ, -1, PLE, D, D, WS_WP); return; }
    if (item < CV_UQ) { CV_TR(2, CV_WP, I_MLA_WUQ, I_MLA_QN, 384, 768, 768, WS_WUQ); return; }
    if (item < CV_UKV) { CV_TR(0, CV_UQ, I_MLA_WUKV, I_MLA_KVN, 256, 1024, 1024, WS_WUKV); return; }
#undef CV_TR
    if (item < CV_P) {
        const size_t e0 = (size_t)l * T * PLE + (size_t)(item - CV_UKV) * 16384; const float* Pp = a.in[I_P]; bf16_t* PB = (bf16_t*)(ws + WS_PB);
#pragma unroll 4
        for (int i = 0; i < 32; ++i) { const size_t e = e0 + (size_t)i * 512 + lane * 8; const f32x4 v0 = *(const f32x4*)(Pp + e), v1 = *(const f32x4*)(Pp + e + 4);
            u32x4 w; w.x = pk2(v0[0], v0[1]); w.y = pk2(v0[2], v0[3]); w.z = pk2(v1[0], v1[1]); w.w = pk2(v1[2], v1[3]); *(u32x4*)(PB + e) = w; }
        return;
    }
    {
        const size_t e0 = (size_t)l * 8 * 2 * 128 * 128 + (size_t)(item - CV_P) * 16384; const float* sk = a.in[I_PEER_SUBKEYS]; bf16_t* skb = (bf16_t*)(ws + WS_SKB);
#pragma unroll 4
        for (int i = 0; i < 32; ++i) { const size_t e = e0 + (size_t)i * 512 + lane * 8; const f32x4 v0 = *(const f32x4*)(sk + e), v1 = *(const f32x4*)(sk + e + 4);
            u32x4 w; w.x = pk2(v0[0], v0[1]); w.y = pk2(v0[2], v0[3]); w.z = pk2(v1[0], v1[1]); w.w = pk2(v1[2], v1[3]); *(u32x4*)(skb + e) = w; }
    }
}
__device__ __forceinline__ void convert_layers(Frame& F, int l0, int l1, int gw, int NGW, bool early_only) {
    const int lane = lane_id_fresh();
    for (int l = l0; l < l1; ++l)
#pragma unroll 1
        for (int it = gw; it < NCONV; it += NGW) if (!early_only || conv_early(it)) convert_item(F, l, it, lane);
}
__device__ __forceinline__ void convert_layer_queue(Frame& F, int l, unsigned* ctr) {
    const int lane = lane_id_fresh();
#pragma unroll 1
    for (;;) {
        unsigned it = 0;
        if (lane == 0) it = __hip_atomic_fetch_add(ctr, 1u, __ATOMIC_RELAXED, __HIP_MEMORY_SCOPE_AGENT);
        it = __builtin_amdgcn_readfirstlane(it);
        if (it >= (unsigned)NCONV) break;
        const int ll = conv_early((int)it) ? l + 1 : l;
        if (ll < DEPTH) convert_item(F, ll, (int)it, lane);
    }
}

__device__ __forceinline__ void prologue(Frame& F) {
    const Args& a = *F.a; unsigned char* ws = F.ws;
    const int gw = F.gw, NGW = F.ngw, lane = F.lane;
    const size_t gt = (size_t)blockIdx.x * NTHREADS + F.tid, GT = (size_t)F.G * NTHREADS;
    if (F.G == 256) convert_layers(F, 0, 1, gw, NGW, true);
    else convert_layers(F, 0, DEPTH, gw, NGW, false);
    {
        const float* X = a.in[I_X]; bf16_t* HB = (bf16_t*)(ws + WS_HB); u64* ssq = (u64*)(ws + WS_CTL + CTL_SSQA);
        for (int t = gw; t < T; t += NGW) {
            float s2 = 0.f;
#pragma unroll
            for (int c = 0; c < 4; ++c) {
                const size_t o = (size_t)t * D + c * 512 + lane * 8;
                const f32x4 v0 = *(const f32x4*)(X + o), v1 = *(const f32x4*)(X + o + 4);
                u32x4 w; w.x = pk2(v0[0], v0[1]); w.y = pk2(v0[2], v0[3]); w.z = pk2(v1[0], v1[1]); w.w = pk2(v1[2], v1[3]);
                *(u32x4*)(HB + o) = w;
                s2 += v0[0] * v0[0] + v0[1] * v0[1] + v0[2] * v0[2] + v0[3] * v0[3] + v1[0] * v1[0] + v1[1] * v1[1] + v1[2] * v1[2] + v1[3] * v1[3];
            }
            s2 = wave_sum(s2);
            if (lane == 0) ssq[t] = (u64)(s2 * 16777216.f);
        }
    }
    {
        const int* pos = (const int*)a.in[I_POS]; float* cs = (float*)(ws + WS_CS);
        for (size_t i = gt; i < (size_t)T * 32; i += GT) {
            const int t = (int)(i / 32), j = (int)(i % 32);
            const float inv = powf(10000.0f, -(float)j / 32.0f);
            const float ang = (float)pos[t] * inv;
            const double rev = (double)ang * 0.15915494309189535;
            const float fr = (float)(rev - rint(rev));
            cs[i * 2] = __builtin_amdgcn_cosf(fr); cs[i * 2 + 1] = __builtin_amdgcn_sinf(fr);
        }
    }
    {
        float* prm = (float*)(ws + WS_PRM);
#define PRM_COPY(IDX, OFF, N) do { const float* src_ = a.in[IDX]; for (size_t i = gt; i < (size_t)DEPTH * (N); i += GT) { const int l_ = (int)(i / (N)), o_ = (int)(i % (N)); prm[l_ * PRM_L + (OFF) + o_] = src_[i]; } } while (0)
        PRM_COPY(I_CONV_W, PRM_CW, 2048); PRM_COPY(I_CONV_B, PRM_CB, 512); PRM_COPY(I_GATE_B, PRM_GB, 8); PRM_COPY(I_DIFF_LAMBDA, PRM_DL, 256);
        PRM_COPY(I_DIFF_NORM, PRM_DN, 512); PRM_COPY(I_HGRN_NORM, PRM_HN, 512); PRM_COPY(I_MLSTM_NORM, PRM_MN, 512);
#undef PRM_COPY
        for (size_t i = gt; i < (size_t)D; i += GT) prm[PRM_FIN + i] = a.in[I_LN_FINAL][i];
    }
    if (blockIdx.x == 0) {
        const float* lg = a.in[I_HGRN_LB]; float* lbs = (float*)(ws + WS_LBS);
        for (int c = F.tid; c < 512; c += NTHREADS) {
            float v[DEPTH], mx = -1e30f;
#pragma unroll
            for (int l = 0; l < DEPTH; ++l) { v[l] = lg[l * 512 + c]; mx = fmaxf(mx, v[l]); }
            float s = 0.f;
#pragma unroll
            for (int l = 0; l < DEPTH; ++l) { v[l] = expf(v[l] - mx); s += v[l]; }
            float cum = 0.f; float first = 0.f;
#pragma unroll
            for (int l = 0; l < DEPTH; ++l) { cum += v[l] / s; if (l == 0) first = cum; lbs[l * 512 + c] = cum - first; }
        }
    }
}

__device__ __forceinline__ void mix_prep(Frame& F, int l) {
    unsigned char* ws = F.ws;
    const bf16_t* Z = (const bf16_t*)(ws + WS_Z);
    const size_t gt = (size_t)F.bid * NTHREADS + F.tid, GT = (size_t)F.G * NTHREADS;
    bf16_t* KR = (bf16_t*)(ws + WS_KRM); const float* cs = (const float*)(ws + WS_CS);
    for (size_t i = gt; i < (size_t)T * 32; i += GT) {
        const int t = (int)(i / 32), j = (int)(i % 32);
        const float x1 = bf2f(Z[(size_t)t * NZ + ZC_MKR + 2 * j]), x2 = bf2f(Z[(size_t)t * NZ + ZC_MKR + 2 * j + 1]);
        const float c = cs[i * 2], sn = cs[i * 2 + 1];
        *(unsigned*)(KR + (size_t)t * 64 + 2 * j) = pk2(x1 * c - x2 * sn, x2 * c + x1 * sn);
    }
}

typedef float f32x16 __attribute__((ext_vector_type(16)));
typedef short s16x4 __attribute__((ext_vector_type(4)));
__device__ __forceinline__ int crow(int r, int hi) { return (r & 3) + 8 * (r >> 2) + 4 * hi; }
template <int OFF> __device__ __forceinline__ s16x4 tr_read(unsigned addr) { s16x4 r; asm volatile("ds_read_b64_tr_b16 %0, %1 offset:%2" : "=&v"(r) : "v"(addr), "i"(OFF) : "memory"); return r; }
constexpr int ATT_SV = 320;
template <int D0, int BLK, int KS> __device__ __forceinline__ bf16x8 v_frag(unsigned vaddr) {
    const s16x4 lo = tr_read<(32 * BLK + 16 * KS) * ATT_SV + 64 * D0>(vaddr), hi = tr_read<(32 * BLK + 16 * KS + 8) * ATT_SV + 64 * D0>(vaddr);
    return (bf16x8){lo[0], lo[1], lo[2], lo[3], hi[0], hi[1], hi[2], hi[3]};
}
__device__ __forceinline__ bf16x8 pack8(const f32x16& p, int base) {
    u32x4 w; w.x = pk2(p[base + 0], p[base + 1]); w.y = pk2(p[base + 2], p[base + 3]); w.z = pk2(p[base + 4], p[base + 5]); w.w = pk2(p[base + 6], p[base + 7]);
    return __builtin_bit_cast(bf16x8, w);
}
struct VFrags { bf16x8 a00, a01, a10, a11; };
template <int D0> __device__ __forceinline__ VFrags v_frags(unsigned vaddr) { VFrags f; f.a00 = v_frag<D0, 0, 0>(vaddr); f.a01 = v_frag<D0, 0, 1>(vaddr); f.a10 = v_frag<D0, 1, 0>(vaddr); f.a11 = v_frag<D0, 1, 1>(vaddr); return f; }
__device__ __forceinline__ void pv_mma(f32x16& o, const VFrags& f, bf16x8 p00, bf16x8 p01, bf16x8 p10, bf16x8 p11) {
    o = __builtin_amdgcn_mfma_f32_32x32x16_bf16(f.a00, p00, o, 0, 0, 0);
    o = __builtin_amdgcn_mfma_f32_32x32x16_bf16(f.a01, p01, o, 0, 0, 0);
    o = __builtin_amdgcn_mfma_f32_32x32x16_bf16(f.a10, p10, o, 0, 0, 0);
    o = __builtin_amdgcn_mfma_f32_32x32x16_bf16(f.a11, p11, o, 0, 0, 0);
}
__device__ __forceinline__ void pv_all(f32x16 (&o)[4], unsigned vaddr, bf16x8 p00, bf16x8 p01, bf16x8 p10, bf16x8 p11) {
    const VFrags f0 = v_frags<0>(vaddr); const VFrags f1 = v_frags<1>(vaddr);
    asm volatile("s_waitcnt lgkmcnt(8)" ::: "memory"); __builtin_amdgcn_sched_barrier(0);
    pv_mma(o[0], f0, p00, p01, p10, p11);
    __builtin_amdgcn_sched_barrier(0);
    const VFrags f2 = v_frags<2>(vaddr);
    asm volatile("s_waitcnt lgkmcnt(8)" ::: "memory"); __builtin_amdgcn_sched_barrier(0);
    pv_mma(o[1], f1, p00, p01, p10, p11);
    __builtin_amdgcn_sched_barrier(0);
    const VFrags f3 = v_frags<3>(vaddr);
    asm volatile("s_waitcnt lgkmcnt(8)" ::: "memory"); __builtin_amdgcn_sched_barrier(0);
    pv_mma(o[2], f2, p00, p01, p10, p11);
    asm volatile("s_waitcnt lgkmcnt(0)" ::: "memory"); __builtin_amdgcn_sched_barrier(0);
    pv_mma(o[3], f3, p00, p01, p10, p11);
}
template <int MODE>
__device__ __forceinline__ void attn_unit(Frame& F, int l, int b, int h, int qb) {
    constexpr int DK = MODE ? 192 : 64, NS = DK / 16, SK = DK * 2 + 16, KBYTES = 64 * SK, VBYTES = 64 * ATT_SV, BUFB = KBYTES + VBYTES, KCH = DK / 8, NKC = (64 * KCH) / 512;
    constexpr int NMAP = MODE ? 1 : 2;
    constexpr float SCALE = MODE ? 0.07216878364870322f : 0.125f, C = SCALE * 1.4426950408889634f;
    unsigned char* ws = F.ws;
    const bf16_t* Z = (const bf16_t*)(ws + WS_Z); const bf16_t* QM = (const bf16_t*)(ws + WS_QM); const bf16_t* KVM = (const bf16_t*)(ws + WS_KVM); const bf16_t* KRM = (const bf16_t*)(ws + WS_KRM);
    bf16_t* Y = (bf16_t*)(ws + WS_Y);
    const int w = F.wave, lane = lane_id_fresh(), tid = w * 64 + lane, r32 = lane & 31, hi = lane >> 5;
    const int q0 = qb * 256, qw = q0 + 32 * w, ntiles = 4 * (qb + 1);
    const size_t rowb = (size_t)b * SEQ;
    const unsigned lds0 = (unsigned)(uintptr_t)F.lds;
    const unsigned kaddr = lds0 + r32 * SK + 16 * hi;
    const unsigned vaddr = lds0 + KBYTES + (((lane & 15) >> 2) + 4 * hi) * ATT_SV + (16 * ((lane >> 4) & 1) + 4 * (lane & 3)) * 2;
    float* O1 = (float*)(ws + WS_O1) + (rowb + qw + r32) * 512 + h * 128 + 4 * hi;
    for (int mp = 0; mp < NMAP; ++mp) {
        bf16x8 qf[NS];
        {
            const bf16_t* qp = MODE ? QM + (rowb + qw + r32) * 768 + h * 192 + 8 * hi : Z + (rowb + qw + r32) * NZ + ZC_DQ + h * 128 + mp * 64 + 8 * hi;
#pragma unroll
            for (int s = 0; s < NS; ++s) qf[s] = *(const bf16x8*)(qp + 16 * s);
            if (MODE == 1) {
                const float* csq = (const float*)(ws + WS_CS) + (rowb + qw + r32) * 64 + 8 * hi;
#pragma unroll
                for (int s = 8; s < NS; ++s) {
                    const f32x4 ca = *(const f32x4*)(csq + 16 * (s - 8)), cb = *(const f32x4*)(csq + 16 * (s - 8) + 4);
                    const u32x4 w = __builtin_bit_cast(u32x4, qf[s]); u32x4 o;
                    { const float x1 = bflo(w[0]), x2 = bfhi(w[0]); o[0] = pk2(x1 * ca[0] - x2 * ca[1], x2 * ca[0] + x1 * ca[1]); }
                    { const float x1 = bflo(w[1]), x2 = bfhi(w[1]); o[1] = pk2(x1 * ca[2] - x2 * ca[3], x2 * ca[2] + x1 * ca[3]); }
                    { const float x1 = bflo(w[2]), x2 = bfhi(w[2]); o[2] = pk2(x1 * cb[0] - x2 * cb[1], x2 * cb[0] + x1 * cb[1]); }
                    { const float x1 = bflo(w[3]), x2 = bfhi(w[3]); o[3] = pk2(x1 * cb[2] - x2 * cb[3], x2 * cb[2] + x1 * cb[3]); }
                    qf[s] = __builtin_bit_cast(bf16x8, o);
                }
            }
        }
        f32x16 o[4];
#pragma unroll
        for (int d = 0; d < 4; ++d) o[d] = (f32x16){};
        float m_run = -1e30f, l_run = 0.f;
        u32x4 kst[NKC], vst[2];
#define ATT_LOAD(j) do { const int k0_ = 64 * (j); \
            _Pragma("unroll") for (int i_ = 0; i_ < NKC; ++i_) { const int c_ = tid + 512 * i_, row_ = c_ / KCH, cc_ = c_ % KCH; \
                const bf16_t* src_ = MODE ? (cc_ < 16 ? KVM + (rowb + k0_ + row_) * 1024 + h * 256 + cc_ * 8 : KRM + (rowb + k0_ + row_) * 64 + (cc_ - 16) * 8) \
                                          : Z + (rowb + k0_ + row_) * NZ + ZC_DK + h * 128 + mp * 64 + cc_ * 8; \
                kst[i_] = *(const u32x4*)src_; } \
            _Pragma("unroll") for (int i_ = 0; i_ < 2; ++i_) { const int c_ = tid + 512 * i_, row_ = c_ >> 4, cc_ = c_ & 15; \
                const bf16_t* src_ = MODE ? KVM + (rowb + k0_ + row_) * 1024 + h * 256 + 128 + cc_ * 8 : Z + (rowb + k0_ + row_) * NZ + ZC_DV + h * 128 + cc_ * 8; \
                vst[i_] = *(const u32x4*)src_; } } while (0)
#define ATT_WRITE(buf) do { \
            _Pragma("unroll") for (int i_ = 0; i_ < NKC; ++i_) { const int c_ = tid + 512 * i_, row_ = c_ / KCH, cc_ = c_ % KCH; *(LAS u32x4*)(F.lds + (buf) * BUFB + row_ * SK + cc_ * 16) = kst[i_]; } \
            _Pragma("unroll") for (int i_ = 0; i_ < 2; ++i_) { const int c_ = tid + 512 * i_, row_ = c_ >> 4, cc_ = c_ & 15; *(LAS u32x4*)(F.lds + (buf) * BUFB + KBYTES + row_ * ATT_SV + cc_ * 16) = vst[i_]; } } while (0)
        ATT_LOAD(0); ATT_WRITE(0);
        __builtin_amdgcn_s_waitcnt(0x0F70);
        __syncthreads();
        for (int j = 0; j < ntiles; ++j) {
            const int k0 = 64 * j; const unsigned bo = (unsigned)(j & 1) * BUFB;
            if (j + 1 < ntiles) ATT_LOAD(j + 1);
            if (k0 <= qw + 31) {
                f32x16 p0 = (f32x16){}, p1 = (f32x16){};
                {
                    bf16x8 ka[NS], kb[NS];
#pragma unroll
                    for (int s = 0; s < NS; ++s) { ka[s] = *(const LAS bf16x8*)(uintptr_t)(kaddr + bo + 32 * s); kb[s] = *(const LAS bf16x8*)(uintptr_t)(kaddr + bo + 32 * SK + 32 * s); }
#pragma unroll
                    for (int s = 0; s < NS; ++s) { p0 = __builtin_amdgcn_mfma_f32_32x32x16_bf16(ka[s], qf[s], p0, 0, 0, 0); p1 = __builtin_amdgcn_mfma_f32_32x32x16_bf16(kb[s], qf[s], p1, 0, 0, 0); }
                    __builtin_amdgcn_sched_group_barrier(0x100, 6, 0);
#pragma unroll
                    for (int s = 0; s < NS - 3; ++s) { __builtin_amdgcn_sched_group_barrier(0x008, 2, 0); __builtin_amdgcn_sched_group_barrier(0x100, 2, 0); }
                    __builtin_amdgcn_sched_group_barrier(0x008, 6, 0);
                }
                if (k0 + 63 > qw) {
                    const int qi = qw + r32;
#pragma unroll
                    for (int r = 0; r < 16; ++r) { const int key = k0 + crow(r, hi); if (key > qi) p0[r] = -1e30f; if (key + 32 > qi) p1[r] = -1e30f; }
                }
                float pmax = p0[0];
#pragma unroll
                for (int r = 1; r < 16; ++r) pmax = fmaxf(pmax, p0[r]);
#pragma unroll
                for (int r = 0; r < 16; ++r) pmax = fmaxf(pmax, p1[r]);
                pmax = fmaxf(pmax, bperm_f(lane ^ 32, pmax));
                const float mn = fmaxf(m_run, pmax), alpha = __builtin_amdgcn_exp2f((m_run - mn) * C), mnC = -mn * C; m_run = mn;
                float ps = 0.f;
#pragma unroll
                for (int r = 0; r < 16; ++r) { p0[r] = __builtin_amdgcn_exp2f(fmaf(p0[r], C, mnC)); p1[r] = __builtin_amdgcn_exp2f(fmaf(p1[r], C, mnC)); ps += p0[r] + p1[r]; }
                ps += bperm_f(lane ^ 32, ps);
                l_run = l_run * alpha + ps;
                if (!__all(alpha == 1.f)) {
#pragma unroll
                    for (int d = 0; d < 4; ++d) o[d] *= alpha;
                }
                const bf16x8 p00 = pack8(p0, 0), p01 = pack8(p0, 8), p10 = pack8(p1, 0), p11 = pack8(p1, 8);
                asm volatile("s_waitcnt lgkmcnt(0)" ::: "memory");
                pv_all(o, vaddr + bo, p00, p01, p10, p11);
            }
            if (j + 1 < ntiles) ATT_WRITE((j + 1) & 1);
            __syncthreads();
        }
#undef ATT_LOAD
#undef ATT_WRITE
        const float il = rcpf_(l_run);
        if (MODE == 0 && mp == 0) {
#pragma unroll
            for (int d = 0; d < 4; ++d)
#pragma unroll
                for (int r4 = 0; r4 < 4; ++r4) *(f32x4*)(O1 + 32 * d + 8 * r4) = (f32x4){o[d][4 * r4] * il, o[d][4 * r4 + 1] * il, o[d][4 * r4 + 2] * il, o[d][4 * r4 + 3] * il};
        } else {
            const size_t yrow = (rowb + qw + r32) * D + (MODE ? 1024 : 0) + h * 128 + 4 * hi;
            if (MODE == 0) {
                const float* lv = (const float*)(ws + WS_PRM) + l * PRM_L + PRM_DL;
                const float s01 = wave_sum(lv[lane] * lv[64 + lane]), s23 = wave_sum(lv[128 + lane] * lv[192 + lane]);
                const float lam_init = 0.8f - 0.6f * __expf(-0.3f * (float)l);
                const float lam = __expf(s01) - __expf(s23) + lam_init;
                const float il2 = lam * il; float ss = 0.f;
#pragma unroll
                for (int d = 0; d < 4; ++d)
#pragma unroll
                    for (int r4 = 0; r4 < 4; ++r4) { const f32x4 a1 = *(const f32x4*)(O1 + 32 * d + 8 * r4);
#pragma unroll
                        for (int e = 0; e < 4; ++e) { const float x = a1[e] - o[d][4 * r4 + e] * il2; o[d][4 * r4 + e] = x; ss += x * x; } }
                ss += bperm_f(lane ^ 32, ss);
                const float rn = rsqrtf(ss * (1.f / 128.f) + EPS) * (1.f - lam_init);
                const float* g = (const float*)(ws + WS_PRM) + l * PRM_L + PRM_DN + h * 128 + 4 * hi;
#pragma unroll
                for (int d = 0; d < 4; ++d)
#pragma unroll
                    for (int r4 = 0; r4 < 4; ++r4) {
                        const f32x4 gg = *(const f32x4*)(g + 32 * d + 8 * r4);
                        u32x2 wv; wv.x = pk2(o[d][4 * r4] * rn * gg[0], o[d][4 * r4 + 1] * rn * gg[1]); wv.y = pk2(o[d][4 * r4 + 2] * rn * gg[2], o[d][4 * r4 + 3] * rn * gg[3]);
                        *(u32x2*)(Y + yrow + 32 * d + 8 * r4) = wv;
                    }
            } else {
#pragma unroll
                for (int d = 0; d < 4; ++d)
#pragma unroll
                    for (int r4 = 0; r4 < 4; ++r4) {
                        u32x2 wv; wv.x = pk2(o[d][4 * r4] * il, o[d][4 * r4 + 1] * il); wv.y = pk2(o[d][4 * r4 + 2] * il, o[d][4 * r4 + 3] * il);
                        *(u32x2*)(Y + yrow + 32 * d + 8 * r4) = wv;
                    }
            }
        }
    }
}
__device__ __forceinline__ void attn_fast(Frame& F, int l) {
    unsigned* actr = (unsigned*)(F.ws + WS_CTL + CTL_CVQ + 4096) + 64 * l;
    volatile LAS unsigned* slot = (volatile LAS unsigned*)(F.lds + MISC_OFF) + 24;
#pragma unroll 1
    for (;;) {
        __syncthreads();
        if (F.tid == 0) *slot = __hip_atomic_fetch_add(actr, 1u, __ATOMIC_RELAXED, __HIP_MEMORY_SCOPE_AGENT);
        __syncthreads();
        const int u = __builtin_amdgcn_readfirstlane((int)*slot);
        if (u >= 256) break;
        const int qb = 7 - (u >> 5), mode = (u >> 4) & 1, b = (u >> 2) & 3, h = u & 3;
        if (mode == 0) attn_unit<0>(F, l, b, h, qb); else attn_unit<1>(F, l, b, h, qb);
    }
}

typedef float f32x4_t __attribute__((ext_vector_type(4)));
template <int KIND>
__device__ __forceinline__ void scan_unit(Frame& F, int l, int b, int h, int seg) {
    constexpr int DK = KIND ? 64 : 128, NKS = DK / 32, NDT = DK / 16, SQ = DK * 2 + 16, SA = 144;
    constexpr int L_QT = 0, L_KT = 64 * SQ, L_KTT = 128 * SQ, L_VT = L_KTT + DK * SA, L_AT = L_VT + 128 * SA, L_ST = L_AT + 64 * SA, L_TAB = L_ST + 128 * SQ;
    constexpr int T_ER = L_TAB, T_EC = T_ER + 512, T_PS = T_EC + 512, T_QS = T_PS + 2048, T_KS = T_QS + 256, T_MT = T_KS + 256, T_NP = T_MT + 256, T_SC = T_NP + 256, T_DEN = T_SC + 64, T_BS = T_DEN + 8 * 256;
    static_assert(T_BS + 256 <= RING_BYTES, "scan LDS");
    unsigned char* ws = F.ws;
    const bf16_t* Z = (const bf16_t*)(ws + WS_Z);
    float* OUT = (float*)(ws + (KIND ? WS_OL : WS_OG));
    const float* prm = (const float*)(ws + WS_PRM) + l * PRM_L;
    LAS unsigned char* lds = F.lds;
    const int w = F.wave, lane = lane_id_fresh(), tid = w * 64 + lane, l15 = lane & 15, g = lane >> 4;
    const int ch = tid & 127, part = tid >> 7, i0 = 16 * part;
    if (w == 2 || w == 3) { const int rt = (w == 2) ? 0 : 2;
#pragma unroll
        for (int r = 0; r < 4; ++r) *(LAS bf16_t*)(lds + L_AT + (16 * rt + 4 * g + r) * SA + (16 * (rt + 1) + l15) * 2) = 0; }
    f32x4 st[NDT];
#pragma unroll
    for (int d = 0; d < NDT; ++d) st[d] = (f32x4){0.f, 0.f, 0.f, 0.f};
    float m_prev = 0.f, np_reg = 0.f, colsum = 0.f, bseg = 0.f;
    float cumlog = 0.f;
    const int bh = b * 4 + h;
    bf16_t* QTS = (bf16_t*)(ws + (KIND ? WS_QTL : WS_QTG)) + (size_t)bh * SEQ * DK;
    float* SCL = (float*)(ws + WS_SCL) + (size_t)bh * SEQ * 4;
    const float lb = KIND ? 0.f : ((const float*)(ws + WS_LBS))[l * 512 + h * 128 + ch];
    unsigned zA[16], zB[16], vr[16], gA = 0, gB = 0;
#define SCAN_LOAD(cc) do { const size_t r0_ = (size_t)b * SEQ + 64 * (cc); \
        if (KIND == 0) { const bf16_t* zr_ = Z + (r0_ + i0) * NZ + h * 128 + ch; \
            _Pragma("unroll") for (int j = 0; j < 16; ++j) { zA[j] = zr_[j * NZ + ZC_GF]; zB[j] = zr_[j * NZ + ZC_GQ]; } } \
        else { const int cidx_ = (ch < 64) ? h * 64 + ch : 256 + h * 64 + (ch - 64); const bf16_t* zc_ = Z + (r0_ + i0) * NZ + ZC_LQ + cidx_; \
            _Pragma("unroll") for (int j = 0; j < 16; ++j) zA[j] = zc_[j * NZ]; \
            if (!((cc) == 0 && part == 0)) { zB[0] = zc_[-3 * NZ]; zB[1] = zc_[-2 * NZ]; zB[2] = zc_[-1 * NZ]; } \
            if (w == 0) { const bf16_t* zg_ = Z + (r0_ + lane) * NZ + h; gA = zg_[ZC_LI]; gB = zg_[ZC_LF]; } } \
        { const bf16_t* zv_ = Z + (r0_ + i0) * NZ + (KIND ? ZC_LV : ZC_GV) + h * 128 + ch; \
            _Pragma("unroll") for (int j = 0; j < 16; ++j) vr[j] = zv_[j * NZ]; } } while (0)
    SCAN_LOAD(seg * SEGC);
    float cw0 = 0.f, cw1 = 0.f, cw2 = 0.f, cw3 = 0.f, cbias = 0.f, gbi = 0.f, gbf = 0.f;
    if (KIND == 1) { const int cidx = (ch < 64) ? h * 64 + ch : 256 + h * 64 + (ch - 64);
        cw0 = prm[PRM_CW + cidx]; cw1 = prm[PRM_CW + 512 + cidx]; cw2 = prm[PRM_CW + 1024 + cidx]; cw3 = prm[PRM_CW + 1536 + cidx]; cbias = prm[PRM_CB + cidx]; gbi = prm[PRM_GB + h]; gbf = prm[PRM_GB + 4 + h]; }
#pragma unroll 1
    for (int c = seg * SEGC; c < (seg + 1) * SEGC; ++c) {
        const size_t row0 = (size_t)b * SEQ + 64 * c;
        float qv[16], kv[16], lf[16];
        if (KIND == 0) {
            float run = 0.f;
#pragma unroll
            for (int j = 0; j < 16; ++j) {
                const float zf = fmaxf(bf2f((bf16_t)zA[j]), -30.f), zq = bf2f((bf16_t)zB[j]);
                const float ez = __expf(-zf), sg = rcpf_(1.f + ez), sgn = ez * sg;
                run += __logf(lb + (1.f - lb) * sg); lf[j] = run; qv[j] = zq * 0.08838834764831845f; kv[j] = (1.f - lb) * sgn;
            }
            *(LAS float*)(lds + T_PS + (part * 128 + ch) * 4) = run;
        } else {
            const float w0 = cw0, w1 = cw1, w2 = cw2, w3 = cw3, cb = cbias;
            const bool first = (c == 0 && part == 0);
            float x0 = first ? 0.f : bf2f((bf16_t)zB[0]), x1 = first ? 0.f : bf2f((bf16_t)zB[1]), x2 = first ? 0.f : bf2f((bf16_t)zB[2]);
#pragma unroll
            for (int j = 0; j < 16; ++j) {
                const float x3 = bf2f((bf16_t)zA[j]);
                float v = cb + x0 * w0 + x1 * w1 + x2 * w2 + x3 * w3; v = v * rcpf_(1.f + __expf(-v));
                qv[j] = (ch < 64) ? v * 0.125f : v; x0 = x1; x1 = x2; x2 = x3;
            }
            if (w == 0) {
                const float li = bf2f((bf16_t)gA) + gbi, zf = bf2f((bf16_t)gB) + gbf;
                const float lfv = fminf(zf, 0.f) - __logf(1.f + __expf(-fabsf(zf)));
                float bb = lfv;
#pragma unroll
                for (int o = 1; o < 64; o <<= 1) { const float t_ = bperm_f(lane - o, bb); if (lane >= o) bb += t_; }
                const float a_ = li - bb; float cm = a_;
#pragma unroll
                for (int o = 1; o < 64; o <<= 1) { const float t_ = bperm_f(lane - o, cm); if (lane >= o) cm = fmaxf(cm, t_); }
                const float M = fmaxf(m_prev, cm), MC = rdlane_f(M, 63), bC = rdlane_f(bb, 63);
                *(LAS float*)(lds + T_QS + lane * 4) = __expf(MC - M); *(LAS float*)(lds + T_KS + lane * 4) = __expf(a_ - MC); *(LAS float*)(lds + T_MT + lane * 4) = bb + M;
                *(LAS float*)(lds + T_BS + lane * 4) = bseg + bb;
                bseg += bC;
                const float cs = __expf(m_prev - MC);
                np_reg = cs * (np_reg + colsum);
                *(LAS float*)(lds + T_NP + lane * 4) = np_reg;
                if (lane == 0) *(LAS float*)(lds + T_SC) = cs;
                m_prev = bC + MC;
            }
        }
        __syncthreads();
        {
            unsigned ktt[8];
            *(LAS u32x4*)(lds + L_VT + ch * SA + i0 * 2) = (u32x4){vr[0] | (vr[1] << 16), vr[2] | (vr[3] << 16), vr[4] | (vr[5] << 16), vr[6] | (vr[7] << 16)};
            *(LAS u32x4*)(lds + L_VT + ch * SA + i0 * 2 + 16) = (u32x4){vr[8] | (vr[9] << 16), vr[10] | (vr[11] << 16), vr[12] | (vr[13] << 16), vr[14] | (vr[15] << 16)};
            if (KIND == 0) {
                const float p0 = *(LAS float*)(lds + T_PS + ch * 4), p1 = *(LAS float*)(lds + T_PS + (128 + ch) * 4), p2 = *(LAS float*)(lds + T_PS + (256 + ch) * 4), p3 = *(LAS float*)(lds + T_PS + (384 + ch) * 4);
                const float r_ = p0 + p1, off = (part > 0 ? p0 : 0.f) + (part > 1 ? p1 : 0.f) + (part > 2 ? p2 : 0.f);
                if (part == 0) { *(LAS float*)(lds + T_ER + ch * 4) = __expf(r_); *(LAS float*)(lds + T_EC + ch * 4) = __expf(p2 + p3); }
                const float eseg = __expf(r_ + cumlog);
                bf16_t* qg_ = QTS + (size_t)(64 * c + i0) * DK + ch;
                cumlog += (p0 + p1) + (p2 + p3);
#pragma unroll
                for (int j = 0; j < 16; ++j) {
                    const float x = fminf(fmaxf(off + lf[j] - r_, -80.f), 80.f);
                    const float qt = qv[j] * __expf(x), kt = kv[j] * __expf(-x);
                    *(LAS bf16_t*)(lds + L_QT + (i0 + j) * SQ + ch * 2) = (bf16_t)f2bf(qt);
                    qg_[j * DK] = (bf16_t)f2bf(qt * eseg);
                    const unsigned kb_ = f2bf(kt);
                    *(LAS bf16_t*)(lds + L_KT + (i0 + j) * SQ + ch * 2) = (bf16_t)kb_;
                    if (j & 1) ktt[j >> 1] |= kb_ << 16; else ktt[j >> 1] = kb_;
                }
                *(LAS u32x4*)(lds + L_KTT + ch * SA + i0 * 2) = (u32x4){ktt[0], ktt[1], ktt[2], ktt[3]};
                *(LAS u32x4*)(lds + L_KTT + ch * SA + i0 * 2 + 16) = (u32x4){ktt[4], ktt[5], ktt[6], ktt[7]};
            } else {
#pragma unroll
                for (int j = 0; j < 16; ++j) {
                    const float fs = *(LAS float*)(lds + ((ch < 64) ? T_QS : T_KS) + (i0 + j) * 4);
                    const unsigned vb_ = f2bf(qv[j] * fs);
                    if (ch < 64) { *(LAS bf16_t*)(lds + L_QT + (i0 + j) * SQ + ch * 2) = (bf16_t)vb_; QTS[(size_t)(64 * c + i0 + j) * DK + ch] = (bf16_t)f2bf(qv[j]); }
                    else *(LAS bf16_t*)(lds + L_KT + (i0 + j) * SQ + (ch - 64) * 2) = (bf16_t)vb_;
                    if (j & 1) ktt[j >> 1] |= vb_ << 16; else ktt[j >> 1] = vb_;
                }
                if (ch >= 64) {
                    *(LAS u32x4*)(lds + L_KTT + (ch - 64) * SA + i0 * 2) = (u32x4){ktt[0], ktt[1], ktt[2], ktt[3]};
                    *(LAS u32x4*)(lds + L_KTT + (ch - 64) * SA + i0 * 2 + 16) = (u32x4){ktt[4], ktt[5], ktt[6], ktt[7]};
                }
            }
        }
        __syncthreads();
        for (int ti = w; ti < 10; ti += 8) {
            const int rt = (int)((0x3333222110ull >> (4 * ti)) & 15), ct = (int)((0x3210210100ull >> (4 * ti)) & 15);
            f32x4 acc = (f32x4){0.f, 0.f, 0.f, 0.f};
#pragma unroll
            for (int ks = 0; ks < NKS; ++ks) {
                const bf16x8 af = *(const LAS bf16x8*)(lds + L_QT + (16 * rt + l15) * SQ + (32 * ks + 8 * g) * 2), bfr = *(const LAS bf16x8*)(lds + L_KT + (16 * ct + l15) * SQ + (32 * ks + 8 * g) * 2);
                acc = __builtin_amdgcn_mfma_f32_16x16x32_bf16(af, bfr, acc, 0, 0, 0);
            }
#pragma unroll
            for (int r = 0; r < 4; ++r) { const int t_ = 16 * rt + 4 * g + r, s_ = 16 * ct + l15; *(LAS bf16_t*)(lds + L_AT + t_ * SA + s_ * 2) = (bf16_t)f2bf(s_ <= t_ ? acc[r] : 0.f); }
        }
        {
            const float cs = KIND ? *(LAS float*)(lds + T_SC) : 1.f;
#pragma unroll
            for (int d = 0; d < NDT; ++d) {
                if (KIND == 0) st[d] *= *(const LAS f32x4*)(lds + T_ER + (16 * d + 4 * g) * 4); else st[d] *= cs;
                u32x2 pk; pk.x = pk2(st[d][0], st[d][1]); pk.y = pk2(st[d][2], st[d][3]);
                *(LAS u32x2*)(lds + L_ST + (16 * w + l15) * SQ + (16 * d + 4 * g) * 2) = pk;
            }
        }
        __syncthreads();
        { const int cn_ = (c + 1 < SEQ / 64) ? c + 1 : c; SCAN_LOAD(cn_); }
        __builtin_amdgcn_sched_barrier(0);
        bf16x8 sfr[NKS], vfr[2];
#pragma unroll
        for (int ks = 0; ks < NKS; ++ks) sfr[ks] = *(const LAS bf16x8*)(lds + L_ST + (16 * w + l15) * SQ + (32 * ks + 8 * g) * 2);
#pragma unroll
        for (int ks = 0; ks < 2; ++ks) vfr[ks] = *(const LAS bf16x8*)(lds + L_VT + (16 * w + l15) * SA + (32 * ks + 8 * g) * 2);
        if (KIND == 1) {
            float dn = 0.f;
#pragma unroll
            for (int d8 = 0; d8 < 8; ++d8) { const u32x4 qw_ = *(const LAS u32x4*)(lds + L_QT + lane * SQ + d8 * 16); const f32x4 n0 = *(const LAS f32x4*)(lds + T_NP + d8 * 32), n1 = *(const LAS f32x4*)(lds + T_NP + d8 * 32 + 16);
                dn += bflo(qw_[0]) * n0[0] + bfhi(qw_[0]) * n0[1] + bflo(qw_[1]) * n0[2] + bfhi(qw_[1]) * n0[3] + bflo(qw_[2]) * n1[0] + bfhi(qw_[2]) * n1[1] + bflo(qw_[3]) * n1[2] + bfhi(qw_[3]) * n1[3]; }
#pragma unroll
            for (int s8 = 0; s8 < 8; ++s8) { const u32x4 aw_ = *(const LAS u32x4*)(lds + L_AT + lane * SA + s8 * 16);
#pragma unroll
                for (int e = 0; e < 4; ++e) { const int s_ = 8 * s8 + 2 * e; dn += (s_ <= lane ? bflo(aw_[e]) : 0.f) + (s_ + 1 <= lane ? bfhi(aw_[e]) : 0.f); } }
            *(LAS float*)(lds + T_DEN + (w * 64 + lane) * 4) = dn;
            *(f32x4*)(SCL + (size_t)(64 * c + lane) * 4) = (f32x4){dn, *(LAS float*)(lds + T_MT + lane * 4), *(LAS float*)(lds + T_BS + lane * 4), 0.f};
            if (w == 0) {
                float cs_ = 0.f;
                for (int s_ = 0; s_ < 64; ++s_) cs_ += bf2f(*(const LAS bf16_t*)(lds + L_KT + s_ * SQ + lane * 2));
                colsum = cs_;
            }
        }
#pragma unroll
        for (int rt = 0; rt < 4; ++rt) {
            f32x4 o = (f32x4){0.f, 0.f, 0.f, 0.f};
#pragma unroll
            for (int ks = 0; ks < NKS; ++ks) o = __builtin_amdgcn_mfma_f32_16x16x32_bf16(*(const LAS bf16x8*)(lds + L_QT + (16 * rt + l15) * SQ + (32 * ks + 8 * g) * 2), sfr[ks], o, 0, 0, 0);
#pragma unroll
            for (int ks = 0; ks < 2; ++ks) if (2 * ks <= rt) o = __builtin_amdgcn_mfma_f32_16x16x32_bf16(*(const LAS bf16x8*)(lds + L_AT + (16 * rt + l15) * SA + (32 * ks + 8 * g) * 2), vfr[ks], o, 0, 0, 0);
            float* op = OUT + (row0 + 16 * rt + 4 * g) * 512 + h * 128 + 16 * w + l15;
            if (KIND == 1) {
                const f32x4 dn = *(const LAS f32x4*)(lds + T_DEN + (w * 64 + 16 * rt + 4 * g) * 4), mt = *(const LAS f32x4*)(lds + T_MT + (16 * rt + 4 * g) * 4);
#pragma unroll
                for (int r = 0; r < 4; ++r) op[r * 512] = (seg > 0) ? o[r] : o[r] * rcpf_(fmaxf(fabsf(dn[r]), __expf(-mt[r])));
            } else {
#pragma unroll
                for (int r = 0; r < 4; ++r) op[r * 512] = o[r];
            }
        }
#pragma unroll
        for (int d = 0; d < NDT; ++d) {
#pragma unroll
            for (int ks = 0; ks < 2; ++ks) st[d] = __builtin_amdgcn_mfma_f32_16x16x32_bf16(*(const LAS bf16x8*)(lds + L_KTT + (16 * d + l15) * SA + (32 * ks + 8 * g) * 2), vfr[ks], st[d], 0, 0, 0);
            if (KIND == 0) st[d] *= *(const LAS f32x4*)(lds + T_EC + (16 * d + 4 * g) * 4);
        }
        __syncthreads();
    }
#undef SCAN_LOAD
    if (seg < NSEG - 1) {
        float* SIF = (float*)(ws + WS_SIF) + (size_t)((KIND * 16 + bh) * NSEG) * 16384;
        bf16_t* SIB = (bf16_t*)(ws + WS_SIB) + (size_t)((KIND * 16 + bh) * NSEG) * 16384;
        float* SIM = (float*)(ws + WS_SIM) + (size_t)(bh * NSEG) * 128;
        unsigned* flg = (unsigned*)(ws + WS_CTL + CTL_SEGF) + (size_t)(((l * 2 + KIND) * 16 + bh) * NSEG) * 16;
        if (KIND == 0 && part == 0) *(LAS float*)(lds + T_PS + ch * 4) = cumlog;
        if (seg > 0) {
            if (w == 0) { unsigned spins = 0; while (__builtin_amdgcn_readfirstlane(__hip_atomic_load(flg + seg * 16, __ATOMIC_RELAXED, __HIP_MEMORY_SCOPE_AGENT)) == 0u && ++spins < (1u << 22)) __builtin_amdgcn_s_sleep(2); }
            __syncthreads();
            __builtin_amdgcn_fence(__ATOMIC_ACQUIRE, "agent");
        }
        if (KIND == 1 && w == 0) {
            const float n_loc = np_reg + colsum; float m_new = m_prev, al_ = 1.f, be_ = 0.f, n_init = 0.f;
            if (seg > 0) { const float m_init = SIM[seg * 128 + 64]; n_init = SIM[seg * 128 + lane]; m_new = fmaxf(m_prev, bseg + m_init); al_ = __expf(m_prev - m_new); be_ = __expf(bseg + m_init - m_new); }
            __hip_atomic_store(SIM + (seg + 1) * 128 + lane, al_ * n_loc + be_ * n_init, __ATOMIC_RELAXED, __HIP_MEMORY_SCOPE_AGENT);
            if (lane == 0) { __hip_atomic_store(SIM + (seg + 1) * 128 + 64, m_new, __ATOMIC_RELAXED, __HIP_MEMORY_SCOPE_AGENT); if (seg > 0) { *(LAS float*)(lds + T_SC) = al_; *(LAS float*)(lds + T_SC + 4) = be_; } }
        }
        __syncthreads();
        float al_ = 1.f, be_ = 0.f;
        if (KIND == 1 && seg > 0) { al_ = *(LAS float*)(lds + T_SC); be_ = *(LAS float*)(lds + T_SC + 4); }
#pragma unroll
        for (int d = 0; d < NDT; ++d) {
            f32x4 val = st[d];
            if (seg > 0) {
                const f32x4 prev = *(const f32x4*)(SIF + (size_t)seg * 16384 + (16 * w + l15) * 128 + 16 * d + 4 * g);
                if (KIND == 0) { const f32x4 cl_ = *(const LAS f32x4*)(lds + T_PS + (16 * d + 4 * g) * 4);
#pragma unroll
                    for (int r = 0; r < 4; ++r) val[r] += __expf(cl_[r]) * prev[r]; }
                else val = al_ * val + be_ * prev;
            }
            const size_t o_ = (size_t)(seg + 1) * 16384 + (16 * w + l15) * 128 + 16 * d + 4 * g;
            __hip_atomic_store((u64*)(SIF + o_), (u64)__builtin_bit_cast(unsigned, val[0]) | ((u64)__builtin_bit_cast(unsigned, val[1]) << 32), __ATOMIC_RELAXED, __HIP_MEMORY_SCOPE_AGENT);
            __hip_atomic_store((u64*)(SIF + o_ + 2), (u64)__builtin_bit_cast(unsigned, val[2]) | ((u64)__builtin_bit_cast(unsigned, val[3]) << 32), __ATOMIC_RELAXED, __HIP_MEMORY_SCOPE_AGENT);
            __hip_atomic_store((u64*)(SIB + o_), (u64)pk2(val[0], val[1]) | ((u64)pk2(val[2], val[3]) << 32), __ATOMIC_RELAXED, __HIP_MEMORY_SCOPE_AGENT);
        }
        asm volatile("s_waitcnt vmcnt(0)" ::: "memory");
        __syncthreads();
        if (tid == 0) __hip_atomic_store(flg + (seg + 1) * 16, 1u, __ATOMIC_RELAXED, __HIP_MEMORY_SCOPE_AGENT);
    }
}

template <int KIND>
__device__ __forceinline__ void norm_unit(Frame& F, int l, int b, int h, int rb, int seg) {
    constexpr int DK = KIND ? 64 : 128, NKS = DK / 32;
    unsigned char* ws = F.ws;
    const int lane = lane_id_fresh(), l15 = lane & 15, g = lane >> 4, bh = b * 4 + h;
    const size_t trow = (size_t)b * SEQ + 32 * rb;
    const float* prm = (const float*)(ws + WS_PRM) + l * PRM_L + (KIND ? PRM_MN : PRM_HN) + h * 128 + 4 * g;
    const bf16_t* Zg = (const bf16_t*)(ws + WS_Z) + (trow + l15) * NZ + (KIND ? ZC_LO : ZC_GG) + h * 128 + 4 * g;
    const float* OUT = (const float*)(ws + (KIND ? WS_OL : WS_OG)) + (trow + l15) * 512 + h * 128 + 4 * g;
    bf16_t* Y = (bf16_t*)(ws + WS_Y) + (trow + l15) * D + (KIND ? 1536 : 512) + h * 128 + 4 * g;
    f32x4 acc[2][8];
#pragma unroll
    for (int rt = 0; rt < 2; ++rt)
#pragma unroll
        for (int vt = 0; vt < 8; ++vt) acc[rt][vt] = (f32x4){0.f, 0.f, 0.f, 0.f};
    float ea[2] = {1.f, 1.f}, eb[2] = {0.f, 0.f}, inv[2] = {1.f, 1.f};
    f32x4 ov[2][8];
#pragma unroll
    for (int rt = 0; rt < 2; ++rt)
#pragma unroll
        for (int vt = 0; vt < 8; ++vt) ov[rt][vt] = *(const f32x4*)(OUT + (size_t)(16 * rt) * 512 + 16 * vt);
    __builtin_amdgcn_sched_barrier(0);
    if (seg > 0) {
        const bf16_t* SIB = (const bf16_t*)(ws + WS_SIB) + (size_t)((KIND * 16 + bh) * NSEG + seg) * 16384;
        const bf16_t* QTS = (const bf16_t*)(ws + (KIND ? WS_QTL : WS_QTG)) + ((size_t)bh * SEQ + 32 * rb + l15) * DK + 8 * g;
        bf16x8 qf[2][NKS];
#pragma unroll
        for (int rt = 0; rt < 2; ++rt)
#pragma unroll
            for (int ks = 0; ks < NKS; ++ks) qf[rt][ks] = *(const bf16x8*)(QTS + (size_t)(16 * rt) * DK + 32 * ks);
#pragma unroll
        for (int v2 = 0; v2 < 8; v2 += 2) {
            bf16x8 af[2][NKS];
#pragma unroll
            for (int vv = 0; vv < 2; ++vv)
#pragma unroll
                for (int ks = 0; ks < NKS; ++ks) af[vv][ks] = *(const bf16x8*)(SIB + (16 * (v2 + vv) + l15) * 128 + 32 * ks + 8 * g);
            __builtin_amdgcn_sched_barrier(0);
#pragma unroll
            for (int vv = 0; vv < 2; ++vv)
#pragma unroll
                for (int ks = 0; ks < NKS; ++ks)
#pragma unroll
                    for (int rt = 0; rt < 2; ++rt) acc[rt][v2 + vv] = __builtin_amdgcn_mfma_f32_16x16x32_bf16(af[vv][ks], qf[rt][ks], acc[rt][v2 + vv], 0, 0, 0);
        }
        if (KIND == 1) {
            const float* SIM = (const float*)(ws + WS_SIM) + (size_t)(bh * NSEG + seg) * 128;
            const float m_init = SIM[64];
            f32x4 nq[2] = {(f32x4){0.f, 0.f, 0.f, 0.f}, (f32x4){0.f, 0.f, 0.f, 0.f}};
#pragma unroll
            for (int ks = 0; ks < NKS; ++ks) { const f32x4 n0 = *(const f32x4*)(SIM + 32 * ks + 8 * g), n1 = *(const f32x4*)(SIM + 32 * ks + 8 * g + 4);
                const u32x4 nw = (u32x4){pk2(n0[0], n0[1]), pk2(n0[2], n0[3]), pk2(n1[0], n1[1]), pk2(n1[2], n1[3])}; const bf16x8 nfr = __builtin_bit_cast(bf16x8, nw);
#pragma unroll
                for (int rt = 0; rt < 2; ++rt) nq[rt] = __builtin_amdgcn_mfma_f32_16x16x32_bf16(nfr, qf[rt][ks], nq[rt], 0, 0, 0); }
#pragma unroll
            for (int rt = 0; rt < 2; ++rt) {
                const f32x4 sc = *(const f32x4*)((const float*)(ws + WS_SCL) + ((size_t)bh * SEQ + 32 * rb + 16 * rt + l15) * 4);
                const float mi = sc[2] + m_init, mp = fmaxf(sc[1], mi); ea[rt] = __expf(sc[1] - mp); eb[rt] = __expf(mi - mp);
                inv[rt] = rcpf_(fmaxf(fabsf(sc[0] * ea[rt] + nq[rt][0] * eb[rt]), __expf(-mp)));
            }
        }
    }
    u32x2 zv[2][8]; f32x4 gnv[8];
#pragma unroll
    for (int vt = 0; vt < 8; ++vt) { gnv[vt] = *(const f32x4*)(prm + 16 * vt);
#pragma unroll
        for (int rt = 0; rt < 2; ++rt) zv[rt][vt] = *(const u32x2*)(Zg + (size_t)(16 * rt) * NZ + 16 * vt); }
    __builtin_amdgcn_sched_barrier(0);
#pragma unroll
    for (int rt = 0; rt < 2; ++rt) {
        float ss = 0.f;
#pragma unroll
        for (int vt = 0; vt < 8; ++vt) {
            const f32x4 o = ov[rt][vt];
            if (KIND == 0) acc[rt][vt] += o; else acc[rt][vt] = (o * ea[rt] + acc[rt][vt] * eb[rt]) * inv[rt];
            ss += acc[rt][vt][0] * acc[rt][vt][0] + acc[rt][vt][1] * acc[rt][vt][1] + acc[rt][vt][2] * acc[rt][vt][2] + acc[rt][vt][3] * acc[rt][vt][3];
        }
        ss += bperm_f(lane ^ 16, ss); ss += bperm_f(lane ^ 32, ss);
        const float r = rsqrtf(ss * (1.f / 128.f) + EPS);
#pragma unroll
        for (int vt = 0; vt < 8; ++vt) {
            const u32x2 zw = zv[rt][vt]; const f32x4 gn = gnv[vt];
            const float z0 = bflo(zw[0]), z1 = bfhi(zw[0]), z2 = bflo(zw[1]), z3 = bfhi(zw[1]);
            const float s0 = sigmoidf_(z0), s1 = sigmoidf_(z1), s2 = sigmoidf_(z2), s3 = sigmoidf_(z3);
            const f32x4 a = acc[rt][vt];
            u32x2 wv; wv.x = pk2(a[0] * r * gn[0] * (KIND ? s0 : z0 * s0), a[1] * r * gn[1] * (KIND ? s1 : z1 * s1)); wv.y = pk2(a[2] * r * gn[2] * (KIND ? s2 : z2 * s2), a[3] * r * gn[3] * (KIND ? s3 : z3 * s3));
            *(u32x2*)(Y + (size_t)(16 * rt) * D + 16 * vt) = wv;
        }
    }
}
__device__ __forceinline__ void scan_norm(Frame& F, int l) {
#pragma unroll 1
    for (int u = F.bid; u < 256; u += F.G) {
        const int b = u >> 6, rb = u & 63, seg = rb / (64 / NSEG), h = F.wave >> 1;
        if (F.wave & 1) norm_unit<1>(F, l, b, h, rb, seg); else norm_unit<0>(F, l, b, h, rb, seg);
    }
}

__device__ __forceinline__ v32f_t ld_row6(const unsigned char* rowp, int lane) {
    const u32x4 a = *(const u32x4*)(rowp + lane * 16); const u32x2 b = *(const u32x2*)(rowp + 1024 + lane * 8);
    const v6u_t p = (v6u_t){a[0], a[1], a[2], a[3], b[0], b[1]};
    return __builtin_amdgcn_cvt_scalef32_pk32_f32_fp6(p, 1.0f);
}
__device__ __forceinline__ float sw32_add(float a, float b) { asm volatile("s_nop 1\n\tv_permlane32_swap_b32 %0, %1\n\ts_nop 1" : "+v"(a), "+v"(b)); return a + b; }
__device__ __forceinline__ float sw16_add(float a, float b) { asm volatile("s_nop 1\n\tv_permlane16_swap_b32 %0, %1\n\ts_nop 1" : "+v"(a), "+v"(b)); return a + b; }
__device__ __forceinline__ float reduce8(const float (&p)[8], int lane) {
    const float q0 = sw16_add(sw32_add(p[0], p[1]), sw32_add(p[2], p[3])), q1 = sw16_add(sw32_add(p[4], p[5]), sw32_add(p[6], p[7]));
    const float t0 = q0 + DPP_F(q0, 0x128), t1 = q1 + DPP_F(q1, 0x128);
    float t = (lane & 8) ? t1 : t0;
    t += DPP_F(t, 0xB1); t += DPP_F(t, 0x4E); t += DPP_F(t, 0x141);
    return t;
}
__device__ __forceinline__ void peer_gather(Frame& F, int l) {
    constexpr int NF = 16;
    unsigned char* ws = F.ws;
    const unsigned char* U4 = ws + WS_UB + (size_t)l * NEXP * VROW; const unsigned char* V4 = ws + WS_VB + (size_t)l * NEXP * VROW;
    const float* SU = (const float*)(ws + WS_SU) + l * NEXP; const float* SV = (const float*)(ws + WS_SV) + l * NEXP;
    const int* PIDX = (const int*)(ws + WS_PIDX); const float* PG = (const float*)(ws + WS_PGATE);
    bf16_t* HB = (bf16_t*)(ws + WS_HB) + (size_t)(l & 1) * T * D;
    const u64* ssqB = (const u64*)(ws + WS_CTL + CTL_SSQB) + l * T; float* ssqC = (float*)(ws + WS_CTL + CTL_SSQC) + l * T;
    const int lane = F.lane;
    LAS float* cl = (LAS float*)(F.lds + F.wave * 512);
    int emap;
    { float lab[8];
#pragma unroll
      for (int k = 0; k < 8; ++k) lab[k] = (float)k * (1.f / 64.f);
      emap = (int)(reduce8(lab, lane) + 0.5f); }
    for (int t = F.gw; t < T; t += F.ngw) {
        float x[32];
#pragma unroll
        for (int q = 0; q < 8; ++q) { const u32x2 w = *(const u32x2*)(HB + (size_t)t * D + q * 256 + lane * 4);
            x[4 * q] = bflo(w[0]); x[4 * q + 1] = bfhi(w[0]); x[4 * q + 2] = bflo(w[1]); x[4 * q + 3] = bfhi(w[1]); }
        const float rs = rsqrtf(ssq_get(ssqB + t) * (1.f / D) + EPS);
        const int myidx0 = PIDX[(size_t)t * 128 + lane], myidx1 = PIDX[(size_t)t * 128 + 64 + lane];
        const float mys0 = SU[myidx0] * rs, mys1 = SU[myidx1] * rs;
        const float myg0 = PG[(size_t)t * 128 + lane] * SV[myidx0], myg1 = PG[(size_t)t * 128 + 64 + lane] * SV[myidx1];
#pragma unroll 1
        for (int e0 = 0; e0 < 128; e0 += NF) {
            u32x4 uw[NF];
#pragma unroll
            for (int k = 0; k < NF; ++k) { const int e = e0 + k; const int idx = __builtin_amdgcn_readlane(e < 64 ? myidx0 : myidx1, e & 63); uw[k] = *(const u32x4*)(U4 + (size_t)idx * VROW + lane * 16); }
#pragma unroll
            for (int b8 = 0; b8 < NF / 8; ++b8) {
                float part[8];
#pragma unroll
                for (int k = 0; k < 8; ++k) {
                    const int kk = b8 * 8 + k; f32x2_t sa = (f32x2_t){0.f, 0.f}, sb = (f32x2_t){0.f, 0.f};
#pragma unroll
                    for (int q2 = 0; q2 < 4; ++q2) {
                        const f32x2_t d0 = __builtin_amdgcn_cvt_scalef32_pk_f32_fp4(uw[kk][q2], 1.0f, 0), d1 = __builtin_amdgcn_cvt_scalef32_pk_f32_fp4(uw[kk][q2], 1.0f, 1);
                        const f32x2_t d2 = __builtin_amdgcn_cvt_scalef32_pk_f32_fp4(uw[kk][q2], 1.0f, 2), d3 = __builtin_amdgcn_cvt_scalef32_pk_f32_fp4(uw[kk][q2], 1.0f, 3);
                        sa = __builtin_elementwise_fma((f32x2_t){x[8 * q2], x[8 * q2 + 1]}, d0, sa); sb = __builtin_elementwise_fma((f32x2_t){x[8 * q2 + 2], x[8 * q2 + 3]}, d1, sb);
                        sa = __builtin_elementwise_fma((f32x2_t){x[8 * q2 + 4], x[8 * q2 + 5]}, d2, sa); sb = __builtin_elementwise_fma((f32x2_t){x[8 * q2 + 6], x[8 * q2 + 7]}, d3, sb);
                    }
                    const f32x2_t st_ = sa + sb; const float s_ = st_[0] + st_[1];
                    part[k] = s_;
                    if (kk + 1 < NF) asm volatile("" : "+v"(uw[kk + 1]) : "v"(s_));
                }
                const float dot = reduce8(part, lane);
                const int eb = e0 + b8 * 8 + emap;
                const float pre = dot * bperm_f(eb & 63, e0 < 64 ? mys0 : mys1);
                const float act = 0.5f * pre * (1.f + erff(pre * 0.7071067811865476f));
                const float cf = act * bperm_f(eb & 63, e0 < 64 ? myg0 : myg1);
                if ((lane & 7) == 0) cl[eb] = cf;
            }
        }
        asm volatile("s_waitcnt lgkmcnt(0)" ::: "memory");
        const float c0 = cl[lane], c1 = cl[64 + lane];
        float y[32];
#pragma unroll
        for (int i = 0; i < 32; ++i) y[i] = 0.f;
#pragma unroll 1
        for (int e0 = 0; e0 < 128; e0 += NF) {
            u32x4 vw[NF];
#pragma unroll
            for (int k = 0; k < NF; ++k) { const int e = e0 + k; const int idx = __builtin_amdgcn_readlane(e < 64 ? myidx0 : myidx1, e & 63); vw[k] = *(const u32x4*)(V4 + (size_t)idx * VROW + lane * 16); }
#pragma unroll
            for (int k = 0; k < NF; ++k) {
                const int e = e0 + k; const float ce = rdlane_f(e < 64 ? c0 : c1, e & 63);
#pragma unroll
                for (int q2 = 0; q2 < 4; ++q2) {
                    const f32x2_t d0 = __builtin_amdgcn_cvt_scalef32_pk_f32_fp4(vw[k][q2], 1.0f, 0), d1 = __builtin_amdgcn_cvt_scalef32_pk_f32_fp4(vw[k][q2], 1.0f, 1);
                    const f32x2_t d2 = __builtin_amdgcn_cvt_scalef32_pk_f32_fp4(vw[k][q2], 1.0f, 2), d3 = __builtin_amdgcn_cvt_scalef32_pk_f32_fp4(vw[k][q2], 1.0f, 3);
                    y[8 * q2] += ce * d0[0]; y[8 * q2 + 1] += ce * d0[1]; y[8 * q2 + 2] += ce * d1[0]; y[8 * q2 + 3] += ce * d1[1];
                    y[8 * q2 + 4] += ce * d2[0]; y[8 * q2 + 5] += ce * d2[1]; y[8 * q2 + 6] += ce * d3[0]; y[8 * q2 + 7] += ce * d3[1];
                }
                if (k + 1 < NF) asm volatile("" : "+v"(vw[k + 1]) : "v"(y[0]), "v"(y[31]));
            }
        }
        float s2 = 0.f;
#pragma unroll
        for (int q = 0; q < 8; ++q) {
            const float v0 = x[4 * q] + y[4 * q], v1 = x[4 * q + 1] + y[4 * q + 1], v2 = x[4 * q + 2] + y[4 * q + 2], v3 = x[4 * q + 3] + y[4 * q + 3];
            *(u32x2*)(HB + (size_t)t * D + q * 256 + lane * 4) = (u32x2){pk2(v0, v1), pk2(v2, v3)};
            s2 += v0 * v0 + v1 * v1 + v2 * v2 + v3 * v3;
        }
        s2 = wave_sum(s2);
        if (lane == 0) ssqC[t] = s2;
    }
}

__device__ __forceinline__ void final_norm(Frame& F) {
    const Args& a = *F.a; unsigned char* ws = F.ws;
    const bf16_t* HB = (const bf16_t*)(ws + WS_HB) + (size_t)(DEPTH & 1) * T * D; const u64* ssq = (const u64*)(ws + WS_CTL + CTL_SSQA) + 4 * T; const float* g = (const float*)(ws + WS_PRM) + PRM_FIN;
    const int lane = F.lane;
    for (int t = F.gw; t < T; t += F.ngw) {
        const float rs = rsqrtf(ssq_get(ssq + t) * (1.f / D) + EPS);
#pragma unroll
        for (int c = 0; c < 4; ++c) { const size_t o = (size_t)t * D + c * 512 + lane * 8; const u32x4 hw = *(const u32x4*)(HB + o); const f32x4 g0 = *(const f32x4*)(g + c * 512 + lane * 8), g1 = *(const f32x4*)(g + c * 512 + lane * 8 + 4);
            *(f32x4*)(a.out + o) = (f32x4){bflo(hw[0]), bfhi(hw[0]), bflo(hw[1]), bfhi(hw[1])} * rs * g0; *(f32x4*)(a.out + o + 4) = (f32x4){bflo(hw[2]), bfhi(hw[2]), bflo(hw[3]), bfhi(hw[3])} * rs * g1; }
    }
}

constexpr int PH_PER_LAYER = 10, N_PHASES = 2 + DEPTH * PH_PER_LAYER;
template <int PH>
__device__ __forceinline__ void run_phase(Frame& F0, int l) {
    Frame F = F0; { int bid_ = blockIdx.x, wv_ = F0.wave; asm volatile("" : "+s"(bid_), "+s"(wv_));
      F.bid = bid_; F.wave = wv_; F.lane = lane_id_fresh(); F.tid = wv_ * 64 + F.lane; F.gw = bid_ * NWAVES + wv_;
      size_t z_ = 0; asm volatile("" : "+s"(z_)); F.ws = F0.ws + z_; }
    unsigned char* ws = F.ws;
    bf16_t* const HBc = (bf16_t*)(ws + WS_HB) + (size_t)(l & 1) * T * D; bf16_t* const HBn = (bf16_t*)(ws + WS_HB) + (size_t)((l + 1) & 1) * T * D;
    if constexpr (PH == 100) prologue(F);
    if constexpr (PH == 101) final_norm(F);
    if constexpr (PH == 0) {
        pg8::Gemm g{HBc, (const bf16_t*)(ws + WS_WIN) + (size_t)l * NZ * D, T, NZ, D, D, D}; pg8::StaticOrder S; S.init(T, NZ, F.G, F.bid);
        EpiZ E{(bf16_t*)(ws + WS_Z), (const u64*)(ws + WS_CTL + CTL_SSQA) + l * T, (u64*)(ws + WS_CTL + CTL_MQS) + l * T, (u64*)(ws + WS_CTL + CTL_MKVS) + l * T};
        pg8::gemm_phase<EpiZ, pg8::StaticOrder, true, true>(F.lds, g, S, E, F.wave);
    }
    if constexpr (PH == 1) {
        mix_prep(F, l);
        { pg8::Gemm g{(const bf16_t*)(ws + WS_Z) + ZC_MCQ, (const bf16_t*)(ws + WS_WUQ) + (size_t)l * 768 * 384, T, 768, 384, NZ, 384}; pg8::StaticOrder S; S.init(T, 768, F.G, F.bid);
          EpiBf16s E{(bf16_t*)(ws + WS_QM), 768, (const u64*)(ws + WS_CTL + CTL_MQS) + l * T, 1.f / 384.f};
          pg8::gemm_phase<EpiBf16s, pg8::StaticOrder, true, true>(F.lds, g, S, E, F.wave); }
        __syncthreads();
        { pg8::Gemm g{(const bf16_t*)(ws + WS_Z) + ZC_MCKV, (const bf16_t*)(ws + WS_WUKV) + (size_t)l * 1024 * 256, T, 1024, 256, NZ, 256}; pg8::StaticOrder S; S.init(T, 1024, F.G, (int)((F.bid + 128) % F.G));
          EpiBf16s E{(bf16_t*)(ws + WS_KVM), 1024, (const u64*)(ws + WS_CTL + CTL_MKVS) + l * T, 1.f / 256.f};
          pg8::gemm_phase<EpiBf16s, pg8::StaticOrder, true, true>(F.lds, g, S, E, F.wave); }
    }
    if constexpr (PH == 3) {
        if (F.bid < 32 * NSEG) { const int bhs = F.bid % (16 * NSEG), b = bhs / (4 * NSEG), h = (bhs / NSEG) & 3, seg = bhs % NSEG; if (F.bid < 16 * NSEG) scan_unit<0>(F, l, b, h, seg); else scan_unit<1>(F, l, b, h, seg); }
        {
            const bool conv_first = F.bid >= 256 - NCONVWG;
#pragma unroll 1
            for (int pass = 0; pass < 2; ++pass) {
                if (pass == 1 || conv_first) { __syncthreads(); convert_layer_queue(F, l, (unsigned*)(ws + WS_CTL + CTL_CVQ) + 64 * l); }
                if (pass == 0) attn_fast(F, l);
            }
        }
    }
    if constexpr (PH == 4) scan_norm(F, l);
    if constexpr (PH == 5) {
        pg8::Gemm g{(const bf16_t*)(ws + WS_Y), (const bf16_t*)(ws + WS_WOUT) + (size_t)l * D * D, T, D, D, D, D}; pg8::StaticOrder S; S.init(T, D, F.G, F.bid);
        EpiRes E{HBc, (u64*)(ws + WS_CTL + CTL_SSQB) + l * T};
        pg8::gemm_phase<EpiRes, pg8::StaticOrder, true, true>(F.lds, g, S, E, F.wave);
    }
    if constexpr (PH == 6) {
        { pg8::Gemm g{HBc, (const bf16_t*)(ws + WS_WQ) + (size_t)l * D * D, T, D, D, D, D}; pg8::StaticOrder S; S.init(T, D, F.G, F.bid);
          EpiBf16s E{(bf16_t*)(ws + WS_QB), D, (const u64*)(ws + WS_CTL + CTL_SSQB) + l * T, 1.f / D};
          pg8::gemm_phase<EpiBf16s, pg8::StaticOrder, true, true>(F.lds, g, S, E, F.wave);
          pg8::Unit u;
          if (S.next(0, u)) {
              asm volatile("s_waitcnt vmcnt(0)" ::: "memory"); __syncthreads();
              __builtin_amdgcn_fence(__ATOMIC_ACQUIRE, "agent"); asm volatile("s_waitcnt vmcnt(0)" ::: "memory");
              peer_topk_mfma(F.lds, F.wave, (const bf16_t*)(ws + WS_QB), (const bf16_t*)(ws + WS_SKB) + (size_t)l * 8 * 2 * 128 * 128, (int*)(ws + WS_PIDX), (float*)(ws + WS_PGATE), u.pm, u.pn);
          } }
        __syncthreads();
        { pg8::Gemm g{(const bf16_t*)(ws + WS_PB) + (size_t)l * T * PLE, (const bf16_t*)(ws + WS_WP) + (size_t)l * D * PLE, T, D, PLE, PLE, PLE}; pg8::StaticOrder S; S.init(T, D, F.G, F.bid);
          EpiBf16s E{(bf16_t*)(ws + WS_PR), D, nullptr, 0.f};
          pg8::gemm_phase<EpiBf16s, pg8::StaticOrder, true, true>(F.lds, g, S, E, F.wave); }
    }
    if constexpr (PH == 8) peer_gather(F, l);
    if constexpr (PH == 9) {
        pg8::Gemm g{HBc, (const bf16_t*)(ws + WS_WG) + (size_t)l * D * D, T, D, D, D, D}; pg8::StaticOrder S; S.init(T, D, F.G, F.bid);
        EpiPle E{HBc, HBn, (const bf16_t*)(ws + WS_PR), (const float*)(ws + WS_CTL + CTL_SSQC) + l * T, (u64*)(ws + WS_CTL + CTL_SSQA) + (l + 1) * T};
        pg8::gemm_phase<EpiPle, pg8::StaticOrder, true, true>(F.lds, g, S, E, F.wave);
    }
}
__global__ void __launch_bounds__(NTHREADS, 2) mega(Args args) {
    extern __shared__ __attribute__((aligned(16))) unsigned char lds_raw[];
    Frame F; F.lds = (LAS unsigned char*)lds_raw; F.ws = args.ws; F.a = &args;
    F.tid = threadIdx.x; F.lane = F.tid & 63; F.wave = __builtin_amdgcn_readfirstlane(F.tid >> 6); F.G = gridDim.x;
    F.gw = blockIdx.x * NWAVES + F.wave; F.ngw = F.G * NWAVES; F.bid = blockIdx.x;
    volatile LAS unsigned* misc = (volatile LAS unsigned*)(F.lds + MISC_OFF);
    if (F.tid < 32) misc[F.tid] = 0u;
    __syncthreads();
    (void)xcd_barrier_post((unsigned*)(args.ws + WS_CTL + CTL_BAR), misc + 8);
#define GRID_BAR() do { XcdBarrier b_; b_.bar = (unsigned*)(args.ws + WS_CTL + CTL_BAR); b_.x = xb_xcc_id(); b_.st = (volatile LAS unsigned*)(F.lds + MISC_OFF) + 8; xcd_barrier(b_, F.wave); } while (0)
    run_phase<100>(F, 0); GRID_BAR();
    for (int l = 0; l < DEPTH; ++l) {
        run_phase<0>(F, l); GRID_BAR();
        run_phase<1>(F, l); GRID_BAR();
        run_phase<3>(F, l); GRID_BAR();
        run_phase<4>(F, l); GRID_BAR();
        run_phase<5>(F, l); GRID_BAR();
        run_phase<6>(F, l); GRID_BAR();
        run_phase<8>(F, l); GRID_BAR();
        run_phase<9>(F, l); GRID_BAR();
    }
    run_phase<101>(F, 0);
#undef GRID_BAR
}

extern "C" void kernel_launch(void* const* d_in, const int* in_sizes, int n_in, void* d_out, int out_size, void* d_ws, size_t ws_size, hipStream_t stream) {
    static int grid = 0;
    if (grid == 0) {
        if (n_in != 28 || out_size != T * D || ws_size < WS_END) { fprintf(stderr, "kernel_launch: unexpected shapes (n_in %d out %d ws %zu need %zu)\n", n_in, out_size, ws_size, (size_t)WS_END); grid = -1; return; }
        if (hipFuncSetAttribute((const void*)mega, hipFuncAttributeMaxDynamicSharedMemorySize, LDS_BYTES) != hipSuccess) { fprintf(stderr, "kernel_launch: hipFuncSetAttribute failed\n"); grid = -1; return; }
        int dev = 0, cus = 0, per_cu = 0; (void)hipGetDevice(&dev); (void)hipDeviceGetAttribute(&cus, hipDeviceAttributeMultiprocessorCount, dev);
        if (hipOccupancyMaxActiveBlocksPerMultiprocessor(&per_cu, (const void*)mega, NTHREADS, LDS_BYTES) != hipSuccess || per_cu < 1) { fprintf(stderr, "kernel_launch: occupancy query says %d blocks per CU\n", per_cu); (void)hipGetLastError(); }
        grid = cus > 0 ? cus : 256;
    }
    if (grid < 0) return;
    (void)hipMemsetAsync((char*)d_ws + WS_CTL, 0, CTL_BYTES, stream);
    Args a{};
    for (int i = 0; i < 28; ++i) a.in[i] = (const float*)d_in[i];
    a.out = (float*)d_out; a.ws = (unsigned char*)d_ws;
    hipLaunchKernelGGL(mega, dim3(grid), dim3(NTHREADS), LDS_BYTES, stream, a);
}
```

```cpp
#include <hip/hip_runtime.h>
#include <cstdio>
#include <cstdint>

#define GAS __attribute__((address_space(1)))
#define LAS __attribute__((address_space(3)))
typedef unsigned short bf16_t;
typedef short bf16x8 __attribute__((ext_vector_type(8)));
typedef float f32x4 __attribute__((ext_vector_type(4)));
typedef unsigned u32x4 __attribute__((ext_vector_type(4)));
typedef unsigned u32x2 __attribute__((ext_vector_type(2)));
typedef float f32x2_t __attribute__((ext_vector_type(2)));
typedef float v16f_t __attribute__((ext_vector_type(16)));
typedef float v32f_t __attribute__((ext_vector_type(32)));
typedef unsigned v6u_t __attribute__((ext_vector_type(6)));
constexpr int EROW = 1536;
constexpr int VROW = 1024;

constexpr int D = 2048, BATCH = 4, SEQ = 2048, T = BATCH * SEQ, DEPTH = 4, PLE = 256;
constexpr int IN_COLS = 5832, NZ = 5888;
constexpr int ZC_DQ = 0, ZC_DK = 512, ZC_DV = 1024, ZC_GQ = 1536, ZC_GF = 2048, ZC_GV = 2560, ZC_GG = 3072, ZC_MCQ = 3584, ZC_MCKV = 3968, ZC_MKR = 4224,
              ZC_LQ = 4288, ZC_LK = 4544, ZC_LV = 4800, ZC_LO = 5312, ZC_LI = 5824, ZC_LF = 5828;
constexpr int NEXP = 16384;
constexpr float EPS = 1e-6f;
constexpr int NWAVES = 8, NTHREADS = 512;

constexpr size_t MiB = 1u << 20;
constexpr size_t al(size_t x) { return (x + 255) & ~(size_t)255; }
constexpr size_t WS_CTL = 0, CTL_BYTES = 2 * MiB;
constexpr size_t CTL_BAR = 0;
constexpr size_t CTL_CVQ = 32 * 1024;
constexpr size_t CTL_SSQA = 64 * 1024;
constexpr size_t CTL_SSQB = CTL_SSQA + 5 * T * 8;
constexpr size_t CTL_MQS = CTL_SSQB + 4 * T * 8;
constexpr size_t CTL_MKVS = CTL_MQS + 4 * T * 8;
constexpr size_t CTL_SSQC = CTL_MKVS + 4 * T * 8;
static_assert(CTL_SSQC + 4 * T * 4 <= 1536 * 1024, "ctl");
constexpr size_t WS_WIN = CTL_BYTES;
constexpr size_t WS_WOUT = WS_WIN + al((size_t)DEPTH * NZ * D * 2);
constexpr size_t WS_WQ = WS_WOUT + al((size_t)DEPTH * D * D * 2);
constexpr size_t WS_WG = WS_WQ + al((size_t)DEPTH * D * D * 2);
constexpr size_t WS_WP = WS_WG + al((size_t)DEPTH * D * D * 2);
constexpr size_t WS_WUQ = WS_WP + al((size_t)DEPTH * D * PLE * 2);
constexpr size_t WS_WUKV = WS_WUQ + al((size_t)DEPTH * 768 * 384 * 2);
constexpr size_t WS_UB = WS_WUKV + al((size_t)DEPTH * 1024 * 256 * 2);
constexpr size_t WS_VB = WS_UB + al((size_t)DEPTH * NEXP * D * 2);
constexpr size_t WS_PB = WS_VB + al((size_t)DEPTH * NEXP * D * 2);
constexpr size_t WS_CS = WS_PB + al((size_t)DEPTH * T * PLE * 2);
constexpr size_t WS_LBS = WS_CS + al((size_t)T * 32 * 2 * 4);
constexpr size_t WS_H = WS_LBS + al((size_t)DEPTH * 512 * 4);
constexpr size_t WS_HB = WS_H + al((size_t)T * D * 4);
constexpr size_t WS_Z = WS_HB + 2 * al((size_t)T * D * 2);
constexpr size_t WS_QM = WS_Z + al((size_t)T * NZ * 2);
constexpr size_t WS_KVM = WS_QM + al((size_t)T * 768 * 2);
constexpr size_t WS_KRM = WS_KVM + al((size_t)T * 1024 * 2);
constexpr size_t WS_Y = WS_KRM + al((size_t)T * 64 * 2);
constexpr size_t WS_QP = WS_Y + al((size_t)T * D * 2);
constexpr size_t WS_QB = WS_QP;
constexpr size_t WS_PR = WS_QP + al((size_t)T * D * 4);
constexpr size_t WS_PIDX = WS_PR + al((size_t)T * D * 4);
constexpr size_t WS_PGATE = WS_PIDX + al((size_t)T * 128 * 4);
constexpr size_t WS_GQ = WS_PGATE + al((size_t)T * 128 * 4);
constexpr size_t WS_GK = WS_GQ + al((size_t)T * 512 * 4);
constexpr size_t WS_GF = WS_GK + al((size_t)T * 512 * 4);
constexpr size_t WS_OG = WS_GF + al((size_t)T * 512 * 4);
constexpr size_t WS_LQK = WS_OG + al((size_t)T * 512 * 4);
constexpr size_t WS_LIF = WS_LQK + al((size_t)T * 512 * 4);
constexpr size_t WS_OL = WS_LIF + al((size_t)T * 8 * 4);
constexpr size_t WS_O1 = WS_OL + al((size_t)T * 512 * 4);
constexpr size_t WS_PRM = WS_O1 + al((size_t)T * 512 * 4);
constexpr int PRM_L = 4608, PRM_CW = 0, PRM_CB = 2048, PRM_GB = 2560, PRM_DL = 2576, PRM_DN = 2832, PRM_HN = 3344, PRM_MN = 3856, PRM_FIN = DEPTH * PRM_L;
constexpr size_t WS_SKB = WS_PRM + al((size_t)(PRM_FIN + D) * 4);
constexpr size_t WS_SU = WS_SKB + al((size_t)DEPTH * 8 * 2 * 128 * 128 * 2);
constexpr size_t WS_SV = WS_SU + al((size_t)DEPTH * NEXP * 4);
constexpr int NSEG = 2, SEGC = SEQ / 64 / NSEG, NCONVWG = 64;
constexpr size_t WS_QTG = WS_SV + al((size_t)DEPTH * NEXP * 4);
constexpr size_t WS_QTL = WS_QTG + al((size_t)16 * SEQ * 128 * 2);
constexpr size_t WS_SCL = WS_QTL + al((size_t)16 * SEQ * 64 * 2);
constexpr size_t WS_SIB = WS_SCL + al((size_t)16 * SEQ * 4 * 4);
constexpr size_t WS_SIF = WS_SIB + al((size_t)2 * 16 * NSEG * 128 * 128 * 2);
constexpr size_t WS_SIM = WS_SIF + al((size_t)2 * 16 * NSEG * 128 * 128 * 4);
constexpr size_t WS_END = WS_SIM + al((size_t)16 * NSEG * 128 * 4);
constexpr size_t CTL_SEGF = 1536 * 1024;
static_assert(CTL_SEGF + DEPTH * 2 * 16 * NSEG * 64 <= CTL_BYTES, "ctl segf");

typedef float f32x2v_t __attribute__((ext_vector_type(2)));
typedef __bf16 bf16x2v_t __attribute__((ext_vector_type(2)));
__device__ __forceinline__ unsigned pk2(float lo, float hi) { const bf16x2v_t r = __builtin_convertvector((f32x2v_t){lo, hi}, bf16x2v_t); return __builtin_bit_cast(unsigned, r); }
__device__ __forceinline__ unsigned f2bf(float f) { return pk2(f, 0.f) & 0xffffu; }
__device__ __forceinline__ float bf2f(unsigned short b) { return __builtin_bit_cast(float, ((unsigned)b) << 16); }
__device__ __forceinline__ float bflo(unsigned w) { return __builtin_bit_cast(float, w << 16); }
__device__ __forceinline__ float bfhi(unsigned w) { return __builtin_bit_cast(float, w & 0xffff0000u); }
#define DPP_F(v, ctrl) __builtin_bit_cast(float, __builtin_amdgcn_update_dpp(0, __builtin_bit_cast(int, (v)), (ctrl), 0xF, 0xF, false))
__device__ __forceinline__ float rdlane_f(float v, int l) { return __builtin_bit_cast(float, __builtin_amdgcn_readlane(__builtin_bit_cast(int, v), l)); }
__device__ __forceinline__ float wave_sum(float v) {
    v += DPP_F(v, 0xB1); v += DPP_F(v, 0x4E); v += DPP_F(v, 0x141); v += DPP_F(v, 0x140);
    return (rdlane_f(v, 0) + rdlane_f(v, 16)) + (rdlane_f(v, 32) + rdlane_f(v, 48));
}
__device__ __forceinline__ float wave_max(float v) {
    v = fmaxf(v, DPP_F(v, 0xB1)); v = fmaxf(v, DPP_F(v, 0x4E)); v = fmaxf(v, DPP_F(v, 0x141)); v = fmaxf(v, DPP_F(v, 0x140));
    return fmaxf(fmaxf(rdlane_f(v, 0), rdlane_f(v, 16)), fmaxf(rdlane_f(v, 32), rdlane_f(v, 48)));
}
__device__ __forceinline__ int bperm_i(int src, int v) { return __builtin_amdgcn_ds_bpermute(src << 2, v); }
__device__ __forceinline__ float bperm_f(int src, float v) { return __builtin_bit_cast(float, __builtin_amdgcn_ds_bpermute(src << 2, __builtin_bit_cast(int, v))); }
typedef unsigned long long u64;
__device__ __forceinline__ int lane_id_fresh() { int l; asm volatile("v_mbcnt_lo_u32_b32 %0, -1, 0\n\tv_mbcnt_hi_u32_b32 %0, -1, %0" : "=v"(l)); return l; }
__device__ __forceinline__ void ssq_add(u64* p, float s) { atomicAdd(p, (u64)(s * 16777216.f)); }
__device__ __forceinline__ float ssq_get(const u64* p) { return (float)(*p) * (1.f / 16777216.f); }
__device__ __forceinline__ float rcpf_(float x) { return __builtin_amdgcn_rcpf(x); }
__device__ __forceinline__ float sigmoidf_(float x) { return rcpf_(1.f + __expf(-x)); }

namespace pg8 {
constexpr int BM = 256, BK = 64, HALF = 128, HTB = HALF * BK * 2, STAGE_BYTES = 8 * HTB, NXCD = 8, WGM = 8;
__host__ __device__ __forceinline__ int lds_byte(int r, int c) { const int st = (r >> 4) * 2 + (c >> 5), rr = r & 15, cc = c & 31, ob = rr * 64 + cc * 2; return st * 1024 + (ob ^ (((ob >> 9) & 1) << 5)); }
__host__ __device__ __forceinline__ void stage_rc(int b, int& R, int& C) { const int st = b / 1024, sb = b % 1024, swz = sb ^ (((sb >> 9) & 1) << 5); R = (st >> 1) * 16 + swz / 64; C = (st & 1) * 32 + (swz % 64) / 2; }
__host__ __device__ __forceinline__ int perm32(int rho) { const int n = rho >> 4, i = rho & 15; return 8 * (i >> 2) + 4 * n + (i & 3); }
struct Unit { int pm, pn; };
struct Gemm { const bf16_t* A; const bf16_t* Bt; int M, N, K, lda, ldb; };
struct StaticOrder {
    int nM, nN, nwg, G, c;
    __host__ __device__ void init(int M, int N, int G_, int c_) { nM = M / BM; nN = N / BM; nwg = nM * nN; G = G_; c = c_; }
    __host__ __device__ bool next(int i, Unit& u) const {
        const long L = (long)i * G + c; if (L >= nwg) return false;
        int wgid = (int)L; { const int q = nwg / NXCD, r = nwg % NXCD, xcd = wgid % NXCD, off = wgid / NXCD; wgid = (xcd < r ? xcd * (q + 1) : r * (q + 1) + (xcd - r) * q) + off; }
        const int nig = WGM * nN, gid = wgid / nig, fm = gid * WGM, gsz = (nM - fm) < WGM ? (nM - fm) : WGM;
        u.pm = fm + ((wgid % nig) % gsz); u.pn = (wgid % nig) / gsz; return true;
    }
    __device__ __forceinline__ void a_ready(const Unit&) const {}
    __device__ __forceinline__ void done(const Unit&) const {}
};
template <class Epi, class Sched, bool ALIGN_EPI = false, bool SP2 = false>
__device__ __forceinline__ void gemm_phase(LAS unsigned char* lds, const Gemm g, const Sched& S, const Epi& E, int wave_s) {
    const int tid = wave_s * 64 + lane_id_fresh(), wid = wave_s, lane = tid & 63, wr = wid >> 2, wc = wid & 3, fr = lane & 15, fq = lane >> 4;
    const int K = g.K, nt = K / BK;
    unsigned voffA[2], voffB[2];
#pragma unroll
    for (int i = 0; i < 2; ++i) { int R, C; stage_rc(tid * 16 + i * 8192, R, C); const int Rb = Epi::PERM ? ((R & ~31) + perm32(R & 31)) : R;
        voffA[i] = (unsigned)(R * g.lda + C) * 2u; voffB[i] = (unsigned)(Rb * g.ldb + C) * 2u; }
    const size_t kstep = (size_t)(BK * 2);
    const size_t hstepA = (size_t)HALF * g.lda * 2, hstepB = (size_t)HALF * g.ldb * 2;
    const size_t tstepA = 2 * hstepA, tstepB = 2 * hstepB;
    const unsigned ldsw = (unsigned)wid * 1024u;
    const int aoff = lds_byte(wr * 64 + fr, fq * 8), boff = lds_byte(wc * 32 + fr, fq * 8);
#define PG8_SA(b, h) (((b) * 2 + (h)) * HTB)
#define PG8_SB(b, h) ((4 + (b) * 2 + (h)) * HTB)
#define PG8_STAGE(bufoff, gbase, voff) do { _Pragma("unroll") for (int _i = 0; _i < 2; ++_i) \
        __builtin_amdgcn_global_load_lds((const unsigned*)((const char*)(gbase) + (voff)[_i]), (LAS unsigned*)(lds + (bufoff) + ldsw + _i * 8192), 16, 0, 0); } while (0)
#define PG8_LDA(dst, b, h) do { _Pragma("unroll") for (int m = 0; m < 4; ++m) _Pragma("unroll") for (int k = 0; k < 2; ++k) dst[m][k] = *(const LAS bf16x8*)(lds + PG8_SA(b, h) + aoff + m * 2048 + k * 1024); } while (0)
#define PG8_LDB(dst, b, h) do { _Pragma("unroll") for (int n = 0; n < 2; ++n) _Pragma("unroll") for (int k = 0; k < 2; ++k) dst[n][k] = *(const LAS bf16x8*)(lds + PG8_SB(b, h) + boff + n * 2048 + k * 1024); } while (0)
#define PG8_MMA(ai, bj, At, Bt) do { __builtin_amdgcn_s_setprio(1); _Pragma("unroll") for (int m = 0; m < 4; ++m) _Pragma("unroll") for (int n = 0; n < 2; ++n) _Pragma("unroll") for (int k = 0; k < 2; ++k) \
        acc[ai][bj][m][n] = __builtin_amdgcn_mfma_f32_16x16x32_bf16(Bt[n][k], At[m][k], acc[ai][bj][m][n], 0, 0, 0); __builtin_amdgcn_s_setprio(0); } while (0)
#define PG8_WAIT_V(n) asm volatile("s_waitcnt vmcnt(" #n ")" ::: "memory")
#define PG8_WAIT_L(n) asm volatile("s_waitcnt lgkmcnt(" #n ")" ::: "memory")
#define PG8_BAR __builtin_amdgcn_s_barrier()
#define PG8_SCHED __builtin_amdgcn_sched_barrier(0)
    Unit cur, nxt; int ui = 0;
    if (!S.next(0, cur)) return;
    f32x4 acc[2][2][4][2];
#pragma unroll
    for (int a = 0; a < 2; ++a)
#pragma unroll
        for (int b = 0; b < 2; ++b)
#pragma unroll
            for (int m = 0; m < 4; ++m)
#pragma unroll
                for (int n = 0; n < 2; ++n) acc[a][b][m][n] = (f32x4){0.f, 0.f, 0.f, 0.f};
    bf16x8 At[4][2], B0[2][2], B1[2][2];
    const char* cA = (const char*)g.A + (size_t)cur.pm * tstepA; const char* cB = (const char*)g.Bt + (size_t)cur.pn * tstepB;
    S.a_ready(cur);
    if constexpr (SP2) {
        PG8_STAGE(PG8_SB(0, 0), cB, voffB); PG8_STAGE(PG8_SB(0, 1), cB + hstepB, voffB); PG8_STAGE(PG8_SA(0, 0), cA, voffA); PG8_STAGE(PG8_SA(0, 1), cA + hstepA, voffA);
        if (wr == 1) PG8_BAR;
        PG8_WAIT_V(2); PG8_BAR;
        PG8_STAGE(PG8_SB(1, 0), cB + kstep, voffB); PG8_STAGE(PG8_SA(1, 0), cA + kstep, voffA); PG8_STAGE(PG8_SB(1, 1), cB + hstepB + kstep, voffB);
        PG8_WAIT_V(6); PG8_BAR;
    } else {
        PG8_STAGE(PG8_SB(0, 0), cB, voffB); PG8_STAGE(PG8_SA(0, 0), cA, voffA); PG8_STAGE(PG8_SB(0, 1), cB + hstepB, voffB); PG8_STAGE(PG8_SA(0, 1), cA + hstepA, voffA);
        if (wr == 1) PG8_BAR;
        PG8_WAIT_V(4); PG8_BAR;
        PG8_STAGE(PG8_SB(1, 0), cB + kstep, voffB); PG8_STAGE(PG8_SA(1, 0), cA + kstep, voffA); PG8_STAGE(PG8_SB(1, 1), cB + hstepB + kstep, voffB);
        PG8_WAIT_V(6); PG8_BAR;
    }
    for (;;) {
        const bool has_next = S.next(ui + 1, nxt);
        const char* nA = has_next ? (const char*)g.A + (size_t)nxt.pm * tstepA : cA; const char* nB = has_next ? (const char*)g.Bt + (size_t)nxt.pn * tstepB : cB;
        for (int t = 0; t < nt; t += 2) {
            const bool last = (t == nt - 2);
            const char* a1 = cA + (size_t)(t + 1) * kstep;
            const char* a2 = last ? nA : cA + (size_t)(t + 2) * kstep; const char* b2 = last ? nB : cB + (size_t)(t + 2) * kstep;
            const char* a3 = a2 + kstep; const char* b3 = b2 + kstep;
            if (last && has_next) S.a_ready(nxt);
            if constexpr (SP2) {
            PG8_LDB(B0, 0, 0); PG8_LDB(B1, 0, 1); PG8_SCHED; PG8_LDA(At, 0, 0); PG8_STAGE(PG8_SA(1, 1), a1 + hstepA, voffA);
            PG8_WAIT_V(8); PG8_WAIT_L(0); PG8_BAR; PG8_MMA(0, 0, At, B0); PG8_MMA(0, 1, At, B1); PG8_BAR; PG8_SCHED;
            PG8_LDA(At, 0, 1); PG8_STAGE(PG8_SB(0, 0), b2, voffB); PG8_STAGE(PG8_SB(0, 1), b2 + hstepB, voffB); PG8_STAGE(PG8_SA(0, 0), a2, voffA);
            PG8_WAIT_V(8); PG8_WAIT_L(0); PG8_BAR; PG8_MMA(1, 0, At, B0); PG8_MMA(1, 1, At, B1); PG8_BAR; PG8_SCHED;
            PG8_LDB(B0, 1, 0); PG8_LDB(B1, 1, 1); PG8_SCHED; PG8_LDA(At, 1, 0); PG8_STAGE(PG8_SA(0, 1), a2 + hstepA, voffA);
            PG8_WAIT_V(8); PG8_WAIT_L(0); PG8_BAR; PG8_MMA(0, 0, At, B0); PG8_MMA(0, 1, At, B1); PG8_BAR; PG8_SCHED;
            PG8_LDA(At, 1, 1); PG8_STAGE(PG8_SB(1, 0), b3, voffB); PG8_STAGE(PG8_SB(1, 1), b3 + hstepB, voffB); PG8_STAGE(PG8_SA(1, 0), a3, voffA);
            PG8_WAIT_V(8); PG8_WAIT_L(0); PG8_BAR; PG8_MMA(1, 0, At, B0); PG8_MMA(1, 1, At, B1); PG8_BAR; PG8_SCHED;
            } else {
            PG8_LDB(B0, 0, 0); PG8_SCHED; PG8_LDA(At, 0, 0); PG8_STAGE(PG8_SA(1, 1), a1 + hstepA, voffA);
            PG8_WAIT_L(8); PG8_BAR; PG8_WAIT_L(0); PG8_MMA(0, 0, At, B0); PG8_BAR; PG8_SCHED;
            PG8_LDB(B1, 0, 1); PG8_STAGE(PG8_SB(0, 0), b2, voffB);
            PG8_BAR; PG8_WAIT_L(0); PG8_MMA(0, 1, At, B1); PG8_BAR;
            PG8_LDA(At, 0, 1); PG8_STAGE(PG8_SA(0, 0), a2, voffA);
            PG8_BAR; PG8_WAIT_L(0); PG8_MMA(1, 0, At, B0); PG8_BAR; PG8_SCHED;
            PG8_STAGE(PG8_SB(0, 1), b2 + hstepB, voffB);
            PG8_WAIT_V(6); PG8_BAR; PG8_MMA(1, 1, At, B1); PG8_BAR;
            PG8_LDB(B0, 1, 0); PG8_SCHED; PG8_LDA(At, 1, 0); PG8_STAGE(PG8_SA(0, 1), a2 + hstepA, voffA);
            PG8_WAIT_L(8); PG8_BAR; PG8_WAIT_L(0); PG8_MMA(0, 0, At, B0); PG8_BAR; PG8_SCHED;
            PG8_LDB(B1, 1, 1); PG8_STAGE(PG8_SB(1, 0), b3, voffB);
            PG8_BAR; PG8_WAIT_L(0); PG8_MMA(0, 1, At, B1); PG8_BAR;
            PG8_LDA(At, 1, 1); PG8_STAGE(PG8_SA(1, 0), a3, voffA);
            PG8_BAR; PG8_WAIT_L(0); PG8_MMA(1, 0, At, B0); PG8_BAR; PG8_SCHED;
            PG8_STAGE(PG8_SB(1, 1), b3 + hstepB, voffB);
            PG8_WAIT_V(6); PG8_BAR; PG8_MMA(1, 1, At, B1); PG8_BAR;
            }
        }
        if constexpr (ALIGN_EPI) { if (wr == 0) PG8_BAR; }
        if constexpr (!Epi::AFTER_DRAIN) { E(acc, cur, wr, wc, fr, fq); S.done(cur); }
        if (!has_next) break;
#pragma unroll
        for (int a = 0; a < 2; ++a)
#pragma unroll
            for (int b = 0; b < 2; ++b)
#pragma unroll
                for (int m = 0; m < 4; ++m)
#pragma unroll
                    for (int n = 0; n < 2; ++n) acc[a][b][m][n] = (f32x4){0.f, 0.f, 0.f, 0.f};
        cur = nxt; cA = nA; cB = nB; ++ui;
        if constexpr (ALIGN_EPI) { if (wr == 1) PG8_BAR; }
    }
    PG8_WAIT_V(0);
    if constexpr (!ALIGN_EPI) { if (wr == 0) PG8_BAR; }
    PG8_BAR;
    if constexpr (Epi::AFTER_DRAIN) { E.fused(acc, cur, wr, wc, fr, fq, lds, wid, lane); S.done(cur); }
#undef PG8_SA
#undef PG8_SB
#undef PG8_STAGE
#undef PG8_LDA
#undef PG8_LDB
#undef PG8_MMA
#undef PG8_WAIT_V
#undef PG8_WAIT_L
#undef PG8_BAR
#undef PG8_SCHED
}
}

#define EPI_ROWS(ai, m) (u.pm * 256 + (ai) * 128 + wr * 64 + (m) * 16 + fr)
#define EPI_COL0 (u.pn * 256 + wc * 32 + 8 * fq)
typedef const f32x4 (&AccT)[2][2][4][2];

__device__ __forceinline__ float fq_sum(float v, int lane) { v += bperm_f(lane ^ 16, v); v += bperm_f(lane ^ 32, v); return v; }

struct EpiZ {
    static constexpr bool PERM = true, AFTER_DRAIN = false;
    bf16_t* Z; const u64* ssq; u64* mqs; u64* mkvs;
    __device__ __forceinline__ void operator()(AccT acc, const pg8::Unit& u, int wr, int wc, int fr, int fq) const {
        const int col0 = EPI_COL0;
#pragma unroll
        for (int ai = 0; ai < 2; ++ai)
#pragma unroll
            for (int m = 0; m < 4; ++m) {
                const int row = EPI_ROWS(ai, m); const float rs = rsqrtf(ssq_get(ssq + row) * (1.f / D) + EPS);
                float sq = 0.f, skv = 0.f;
#pragma unroll
                for (int bj = 0; bj < 2; ++bj) {
                    const f32x4 v0 = acc[ai][bj][m][0] * rs, v1 = acc[ai][bj][m][1] * rs;
                    u32x4 w; w.x = pk2(v0[0], v0[1]); w.y = pk2(v0[2], v0[3]); w.z = pk2(v1[0], v1[1]); w.w = pk2(v1[2], v1[3]);
                    *(u32x4*)(Z + (size_t)row * NZ + col0 + bj * 128) = w;
                    const float s2 = v0[0] * v0[0] + v0[1] * v0[1] + v0[2] * v0[2] + v0[3] * v0[3] + v1[0] * v1[0] + v1[1] * v1[1] + v1[2] * v1[2] + v1[3] * v1[3];
                    const int cb = u.pn * 256 + bj * 128;
                    if (cb >= ZC_MCQ && cb < ZC_MCKV) sq += s2;
                    if (cb >= ZC_MCKV && cb < ZC_MKR) skv += s2;
                }
                if (u.pn >= 14 && u.pn <= 16) {
                    sq = fq_sum(sq, fr + 16 * fq); skv = fq_sum(skv, fr + 16 * fq);
                    if (fq == 0) { if (u.pn <= 15) ssq_add(mqs + row, sq); if (u.pn >= 15) ssq_add(mkvs + row, skv); }
                }
            }
    }
};
struct EpiBf16s {
    static constexpr bool PERM = true, AFTER_DRAIN = false;
    bf16_t* O; int ldo; const u64* ssq; float inv_n;
    __device__ __forceinline__ void operator()(AccT acc, const pg8::Unit& u, int wr, int wc, int fr, int fq) const {
        const int col0 = EPI_COL0;
#pragma unroll
        for (int ai = 0; ai < 2; ++ai)
#pragma unroll
            for (int m = 0; m < 4; ++m) {
                const int row = EPI_ROWS(ai, m); const float rs = ssq ? rsqrtf(ssq_get(ssq + row) * inv_n + EPS) : 1.f;
#pragma unroll
                for (int bj = 0; bj < 2; ++bj) {
                    const f32x4 v0 = acc[ai][bj][m][0] * rs, v1 = acc[ai][bj][m][1] * rs;
                    u32x4 w; w.x = pk2(v0[0], v0[1]); w.y = pk2(v0[2], v0[3]); w.z = pk2(v1[0], v1[1]); w.w = pk2(v1[2], v1[3]);
                    *(u32x4*)(O + (size_t)row * ldo + col0 + bj * 128) = w;
                }
            }
    }
};
struct EpiRes {
    static constexpr bool PERM = true, AFTER_DRAIN = false;
    bf16_t* HB; u64* ssq;
    __device__ __forceinline__ void operator()(AccT acc, const pg8::Unit& u, int wr, int wc, int fr, int fq) const {
        const int col0 = EPI_COL0;
#pragma unroll
        for (int ai = 0; ai < 2; ++ai)
#pragma unroll
            for (int m = 0; m < 4; ++m) {
                const int row = EPI_ROWS(ai, m); float s2 = 0.f;
#pragma unroll
                for (int bj = 0; bj < 2; ++bj) {
                    bf16_t* hp = HB + (size_t)row * D + col0 + bj * 128;
                    const u32x4 hw = *(const u32x4*)hp;
                    const f32x4 v0 = (f32x4){bflo(hw[0]), bfhi(hw[0]), bflo(hw[1]), bfhi(hw[1])} + acc[ai][bj][m][0], v1 = (f32x4){bflo(hw[2]), bfhi(hw[2]), bflo(hw[3]), bfhi(hw[3])} + acc[ai][bj][m][1];
                    u32x4 w; w.x = pk2(v0[0], v0[1]); w.y = pk2(v0[2], v0[3]); w.z = pk2(v1[0], v1[1]); w.w = pk2(v1[2], v1[3]);
                    *(u32x4*)hp = w;
                    s2 += v0[0] * v0[0] + v0[1] * v0[1] + v0[2] * v0[2] + v0[3] * v0[3] + v1[0] * v1[0] + v1[1] * v1[1] + v1[2] * v1[2] + v1[3] * v1[3];
                }
                s2 = fq_sum(s2, fr + 16 * fq);
                if (fq == 0) ssq_add(ssq + row, s2);
            }
    }
};
struct EpiF32s {
    static constexpr bool PERM = true, AFTER_DRAIN = false;
    float* C; const u64* ssq;
    __device__ __forceinline__ void operator()(AccT acc, const pg8::Unit& u, int wr, int wc, int fr, int fq) const {
        const int col0 = EPI_COL0;
#pragma unroll
        for (int ai = 0; ai < 2; ++ai)
#pragma unroll
            for (int m = 0; m < 4; ++m) {
                const int row = EPI_ROWS(ai, m); const float rs = ssq ? rsqrtf(ssq_get(ssq + row) * (1.f / D) + EPS) : 1.f;
#pragma unroll
                for (int bj = 0; bj < 2; ++bj) {
                    float* cp = C + (size_t)row * D + col0 + bj * 128;
                    *(f32x4*)cp = acc[ai][bj][m][0] * rs; *(f32x4*)(cp + 4) = acc[ai][bj][m][1] * rs;
                }
            }
    }
};
struct EpiPle {
    static constexpr bool PERM = true, AFTER_DRAIN = false;
    const bf16_t* HBin; bf16_t* HBout; const bf16_t* PR; const float* ssq_in; u64* ssq_out;
    __device__ __forceinline__ void operator()(AccT acc, const pg8::Unit& u, int wr, int wc, int fr, int fq) const {
        const int col0 = EPI_COL0;
#pragma unroll
        for (int ai = 0; ai < 2; ++ai)
#pragma unroll
            for (int m = 0; m < 4; ++m) {
                const int row = EPI_ROWS(ai, m); const float rs = rsqrtf(ssq_in[row] * (1.f / D) + EPS); float s2 = 0.f;
#pragma unroll
                for (int bj = 0; bj < 2; ++bj) {
                    const size_t o = (size_t)row * D + col0 + bj * 128;
                    const u32x4 hw = *(const u32x4*)(HBin + o), pw = *(const u32x4*)(PR + o);
                    f32x4 v0 = (f32x4){bflo(hw[0]), bfhi(hw[0]), bflo(hw[1]), bfhi(hw[1])}, v1 = (f32x4){bflo(hw[2]), bfhi(hw[2]), bflo(hw[3]), bfhi(hw[3])};
                    const f32x4 p0 = (f32x4){bflo(pw[0]), bfhi(pw[0]), bflo(pw[1]), bfhi(pw[1])}, p1 = (f32x4){bflo(pw[2]), bfhi(pw[2]), bflo(pw[3]), bfhi(pw[3])};
#pragma unroll
                    for (int j = 0; j < 4; ++j) { v0[j] += sigmoidf_(acc[ai][bj][m][0][j] * rs) * p0[j]; v1[j] += sigmoidf_(acc[ai][bj][m][1][j] * rs) * p1[j]; }
                    u32x4 w; w.x = pk2(v0[0], v0[1]); w.y = pk2(v0[2], v0[3]); w.z = pk2(v1[0], v1[1]); w.w = pk2(v1[2], v1[3]);
                    *(u32x4*)(HBout + o) = w;
                    s2 += v0[0] * v0[0] + v0[1] * v0[1] + v0[2] * v0[2] + v0[3] * v0[3] + v1[0] * v1[0] + v1[1] * v1[1] + v1[2] * v1[2] + v1[3] * v1[3];
                }
                s2 = fq_sum(s2, fr + 16 * fq);
                if (fq == 0) ssq_add(ssq_out + row, s2);
            }
    }
};

__device__ __forceinline__ int f2ord(float f) { const int b = __builtin_bit_cast(int, f); return b >= 0 ? b : (b ^ 0x7FFFFFFF); }
__device__ __forceinline__ float ord2f(int k) { const int b = k >= 0 ? k : (k ^ 0x7FFFFFFF); return __builtin_bit_cast(float, b); }
__device__ __forceinline__ int row16_max(int v) {
    asm("s_nop 1\n\tv_max_i32_dpp %0, %0, %0 quad_perm:[1,0,3,2] row_mask:0xf bank_mask:0xf\n\ts_nop 1\n\tv_max_i32_dpp %0, %0, %0 quad_perm:[2,3,0,1] row_mask:0xf bank_mask:0xf\n\t"
        "s_nop 1\n\tv_max_i32_dpp %0, %0, %0 row_half_mirror row_mask:0xf bank_mask:0xf\n\ts_nop 1\n\tv_max_i32_dpp %0, %0, %0 row_mirror row_mask:0xf bank_mask:0xf" : "+v"(v));
    return v;
}
__device__ __forceinline__ float row16_sum(float v) {
    v += __builtin_bit_cast(float, __builtin_amdgcn_update_dpp(0, __builtin_bit_cast(int, v), 0xB1, 0xF, 0xF, false)); v += __builtin_bit_cast(float, __builtin_amdgcn_update_dpp(0, __builtin_bit_cast(int, v), 0x4E, 0xF, 0xF, false));
    v += __builtin_bit_cast(float, __builtin_amdgcn_update_dpp(0, __builtin_bit_cast(int, v), 0x141, 0xF, 0xF, false)); v += __builtin_bit_cast(float, __builtin_amdgcn_update_dpp(0, __builtin_bit_cast(int, v), 0x140, 0xF, 0xF, false));
    return v;
}
__device__ __forceinline__ void peer_topk_mfma(LAS unsigned char* lds, int wid, const bf16_t* QB, const bf16_t* SKB, int* PIDX, float* PG, int pm, int pn) {
    constexpr int SQL = 272, L_SK = 0;
    const int lane = lane_id_fresh(), tid = wid * 64 + lane, l15 = lane & 15, g = lane >> 4;
    int tk[2][2][4];
#pragma unroll
    for (int c = 0; c < 2; ++c) {
        const bf16_t* sk = SKB + ((size_t)(pn * 2 + c) * 128) * 128;
#pragma unroll
        for (int i = 0; i < 4; ++i) { const int id = tid + 512 * i, n = id >> 4, dc = id & 15; *(LAS u32x4*)(lds + L_SK + n * SQL + dc * 16) = *(const u32x4*)(sk + n * 128 + dc * 8); }
        bf16x8 af[2][4];
#pragma unroll
        for (int rt = 0; rt < 2; ++rt)
#pragma unroll
            for (int ks = 0; ks < 4; ++ks) af[rt][ks] = *(const bf16x8*)(QB + (size_t)(pm * 256 + 32 * wid + 16 * rt + l15) * D + pn * 256 + c * 128 + 32 * ks + 8 * g);
        __syncthreads();
        int key[2][8][4];
#pragma unroll
        for (int nt = 0; nt < 8; ++nt) {
            f32x4 sc0 = (f32x4){0.f, 0.f, 0.f, 0.f}, sc1 = (f32x4){0.f, 0.f, 0.f, 0.f};
#pragma unroll
            for (int ks = 0; ks < 4; ++ks) {
                const bf16x8 bfr = *(const LAS bf16x8*)(lds + L_SK + (16 * nt + l15) * SQL + (32 * ks + 8 * g) * 2);
                sc0 = __builtin_amdgcn_mfma_f32_16x16x32_bf16(af[0][ks], bfr, sc0, 0, 0, 0);
                sc1 = __builtin_amdgcn_mfma_f32_16x16x32_bf16(af[1][ks], bfr, sc1, 0, 0, 0);
            }
#pragma unroll
            for (int r = 0; r < 4; ++r) { key[0][nt][r] = (f2ord(sc0[r]) & ~127) | (127 - (16 * nt + l15)); key[1][nt][r] = (f2ord(sc1[r]) & ~127) | (127 - (16 * nt + l15)); }
        }
        __syncthreads();
#pragma unroll
        for (int rt = 0; rt < 2; ++rt)
#pragma unroll
            for (int r = 0; r < 4; ++r) {
#define SK_(i) key[rt][i][r]
#define CE_(i, j) do { const int hi_ = max(SK_(i), SK_(j)), lo_ = min(SK_(i), SK_(j)); SK_(i) = hi_; SK_(j) = lo_; } while (0)
                CE_(0, 1); CE_(2, 3); CE_(4, 5); CE_(6, 7); CE_(0, 2); CE_(1, 3); CE_(4, 6); CE_(5, 7); CE_(1, 2); CE_(5, 6);
                CE_(0, 4); CE_(1, 5); CE_(2, 6); CE_(3, 7); CE_(2, 4); CE_(3, 5); CE_(1, 2); CE_(3, 4); CE_(5, 6);
                int mine = 0;
#pragma unroll 1
                for (int k = 0; k < 16; ++k) {
                    const int v = row16_max(SK_(0));
                    if (l15 == k) mine = v;
                    const bool won = (SK_(0) == v);
#pragma unroll
                    for (int nt = 0; nt < 7; ++nt) SK_(nt) = won ? SK_(nt + 1) : SK_(nt);
                    SK_(7) = won ? (int)0x80000000 : SK_(7);
                }
#undef CE_
#undef SK_
                tk[c][rt][r] = mine;
            }
    }
    int ci_[4], cj_[4]; bool cv_[4];
    ci_[0] = 0; cj_[0] = l15; cv_[0] = true;
    ci_[1] = l15 < 8 ? 1 : (l15 < 13 ? 2 : 3); cj_[1] = l15 < 8 ? l15 : (l15 < 13 ? l15 - 8 : l15 - 13); cv_[1] = true;
    ci_[2] = l15 == 0 ? 3 : (l15 < 4 ? 4 : (l15 < 6 ? 5 : (l15 < 8 ? 6 : (l15 < 10 ? 7 : l15 - 2))));
    cj_[2] = l15 == 0 ? 3 : (l15 < 4 ? l15 - 1 : (l15 < 6 ? l15 - 4 : (l15 < 8 ? l15 - 6 : (l15 < 10 ? l15 - 8 : 0)))); cv_[2] = true;
    ci_[3] = 14 + (l15 & 1); cj_[3] = 0; cv_[3] = l15 < 2;
#pragma unroll
    for (int rt = 0; rt < 2; ++rt)
#pragma unroll
        for (int r = 0; r < 4; ++r) {
            int ck[4];
#pragma unroll
            for (int q = 0; q < 4; ++q) {
                const float s0 = ord2f(bperm_i((lane & 48) + ci_[q], tk[0][rt][r]) & ~127), s1 = ord2f(bperm_i((lane & 48) + cj_[q], tk[1][rt][r]) & ~127);
                ck[q] = cv_[q] ? ((f2ord(s0 + s1) & ~255) | (255 - (16 * ci_[q] + cj_[q]))) : (int)0x80000000;
            }
            int mine = 0;
            for (int k = 0; k < 16; ++k) {
                int v = max(max(ck[0], ck[1]), max(ck[2], ck[3]));
                v = row16_max(v);
                if (l15 == k) mine = v;
#pragma unroll
                for (int q = 0; q < 4; ++q) ck[q] = (ck[q] == v) ? (int)0x80000000 : ck[q];
            }
            const int pos = 255 - (mine & 255), ci = pos >> 4, cj = pos & 15;
            const int i0 = 127 - (bperm_i((lane & 48) + ci, tk[0][rt][r]) & 127), i1 = 127 - (bperm_i((lane & 48) + cj, tk[1][rt][r]) & 127);
            const float bv = ord2f(mine & ~255), b0 = ord2f(bperm_i(lane & 48, mine) & ~255);
            const float ex = __expf(bv - b0), sum = row16_sum(ex);
            const size_t o = (size_t)(pm * 256 + 32 * wid + 16 * rt + 4 * g + r) * 128 + pn * 16 + l15;
            PIDX[o] = i0 * 128 + i1; PG[o] = ex * rcpf_(sum);
        }
}

#define XB_TMO      128
#define XB_XCNT(j)  (256  + 64 * (j))
#define XB_XSUB(j)  (1280 + 64 * (j))
#define XB_XGEN(j)  (2304 + 64 * (j))
#define XB_TOP      3328
#define XB_TOPGEN   3392
#define XCD_BAR_WORDS 3456
#define XB_SPIN_CAP (1u << 18)
__device__ __forceinline__ unsigned xb_ld(unsigned* p)              { return __hip_atomic_load(p, __ATOMIC_RELAXED, __HIP_MEMORY_SCOPE_AGENT); }
__device__ __forceinline__ unsigned xb_add(unsigned* p, unsigned v) { return __hip_atomic_fetch_add(p, v, __ATOMIC_RELAXED, __HIP_MEMORY_SCOPE_AGENT); }
__device__ __forceinline__ unsigned xb_xcc_id() { return (unsigned)__builtin_amdgcn_s_getreg((3 << 11) | 20) & 0xFu; }
#define XB_SPIN(cond, bar) do { unsigned _sp = 0; while (cond) { __builtin_amdgcn_s_sleep(1); \
    if ((++_sp & 255u) == 0u) { if (xb_ld(&(bar)[XB_TMO])) break; if (_sp > XB_SPIN_CAP) { atomicAdd(&(bar)[XB_TMO], 1u); break; } } } } while (0)
struct XcdBarrier { unsigned* bar; unsigned x; volatile LAS unsigned* st; };
__device__ __forceinline__ XcdBarrier xcd_barrier_post(unsigned* bar, volatile LAS unsigned* st) {
    XcdBarrier b; b.bar = bar; b.x = xb_xcc_id(); b.st = st;
    if (threadIdx.x == 0) (void)xb_add(&bar[XB_XCNT(b.x)], 1u);
    return b;
}
__device__ __forceinline__ void xcd_barrier_complete(unsigned* bar, unsigned x, unsigned& nloc, unsigned& nx) {
    const unsigned G = gridDim.x * gridDim.y * gridDim.z;
    unsigned sum, cnt, mine, sp = 0u;
    for (;;) {
        sum = 0u; cnt = 0u; mine = 0u;
#pragma unroll
        for (unsigned j = 0; j < 16; ++j) { const unsigned c = xb_ld(&bar[XB_XCNT(j)]); sum += c; cnt += (c > 0u) ? 1u : 0u; mine = (j == x) ? c : mine; }
        if (sum == G) break;
        __builtin_amdgcn_s_sleep(1);
        if ((++sp & 255u) == 0u) { if (xb_ld(&bar[XB_TMO])) break; if (sp > XB_SPIN_CAP) { atomicAdd(&bar[XB_TMO], 1u); break; } }
    }
    nloc = mine > 0u ? mine : 1u; nx = cnt > 0u ? cnt : 1u;
}
__device__ __forceinline__ void xcd_barrier(const XcdBarrier& b, int wave_s) {
    asm volatile("s_waitcnt vmcnt(0)" ::: "memory");
    __syncthreads();
    if (wave_s == 0 && lane_id_fresh() == 0) {
        unsigned* bar = b.bar;
        __builtin_amdgcn_s_waitcnt(0);
        unsigned nloc = b.st[0], nx = b.st[1];
        if (nloc == 0u) { xcd_barrier_complete(bar, b.x, nloc, nx); b.st[0] = nloc; b.st[1] = nx; }
        const unsigned old = xb_add(&bar[XB_XSUB(b.x)], 1u);
        const unsigned gen = old / nloc;
        if (old + 1u == (gen + 1u) * nloc) {
            __builtin_amdgcn_fence(__ATOMIC_RELEASE, "agent");
            asm volatile("s_waitcnt vmcnt(0)" ::: "memory");
            const unsigned og = xb_add(&bar[XB_TOP], 1u);
            const unsigned tg = og / nx;
            if (og + 1u == (tg + 1u) * nx) xb_add(&bar[XB_TOPGEN], 1u);
            else XB_SPIN(xb_ld(&bar[XB_TOPGEN]) == tg, bar);
            __builtin_amdgcn_fence(__ATOMIC_ACQUIRE, "agent");
            xb_add(&bar[XB_XGEN(b.x)], 1u);
            asm volatile("s_waitcnt vmcnt(0)" ::: "memory");
        } else {
            XB_SPIN(xb_ld(&bar[XB_XGEN(b.x)]) == gen, bar);
            __builtin_amdgcn_fence(__ATOMIC_ACQUIRE, "agent");
            asm volatile("s_waitcnt vmcnt(0)" ::: "memory");
        }
    }
    __syncthreads();
}

constexpr int RING_BYTES = 131072, MISC_OFF = RING_BYTES + 320, LDS_BYTES = 147456;
struct Args { const float* in[28]; float* out; unsigned char* ws; int ph_lo, ph_hi; };
enum { I_X = 0, I_P, I_POS, I_LN_MIX, I_W_IN, I_DIFF_LAMBDA, I_DIFF_NORM, I_HGRN_LB, I_HGRN_NORM, I_MLA_QN, I_MLA_KVN, I_MLA_WUQ, I_MLA_WUKV, I_CONV_W, I_CONV_B, I_GATE_B,
       I_MLSTM_NORM, I_GROUP_GAIN, I_W_OUT, I_LN_FFN, I_PEER_WQ, I_PEER_SUBKEYS, I_PEER_U, I_PEER_V, I_LN_PLE, I_PLE_WGATE, I_PLE_WPROJ, I_LN_FINAL };

struct Frame {
    LAS unsigned char* lds; unsigned char* ws; const Args* a;
    int tid, lane, wave, G, gw, ngw, bid;
};

__device__ __forceinline__ int cmap_win(int n) {
    if (n < ZC_MKR) return n;
    if (n < ZC_LQ) { const int j = n - ZC_MKR; return ZC_MKR + (j >> 1) + 32 * (j & 1); }
    if (n < ZC_LO) return n;
    if (n < ZC_LI) return 5320 + (n - ZC_LO);
    if (n < ZC_LF) return 5312 + (n - ZC_LI);
    if (n < IN_COLS) return 5316 + (n - ZC_LF);
    return -1;
}
__device__ __forceinline__ int cmap_uq(int n) { const int hd = n / 192, r = n % 192; if (r < 128) return n; const int j = r - 128; return hd * 192 + 128 + (j >> 1) + 32 * (j & 1); }

template <int MAP>
__device__ __forceinline__ void transpose_item(const float* W, int K, int Nsrc, int Ndst, const float* gain, bf16_t* WT, LAS float* scr_, int item, int lane) {
    LAS unsigned char* scr = (LAS unsigned char*)scr_;
    const int nblk = Ndst / 64, kb = item / nblk, nb = item % nblk, k0 = 64 * kb, n0 = 64 * nb;
    const int nq = (lane & 15) * 4, kr = lane >> 4;
    if (MAP == 0 || (MAP == 1 && (n0 + 64 <= ZC_MKR || (n0 >= ZC_LQ && n0 + 64 <= ZC_LO)))) {
        f32x4 tv[16]; float gk[16];
#pragma unroll
        for (int i = 0; i < 16; ++i) tv[i] = __builtin_nontemporal_load((const f32x4*)(W + (size_t)(k0 + kr + 4 * i) * Nsrc + n0 + nq));
        if (gain) {
#pragma unroll
            for (int i = 0; i < 16; ++i) gk[i] = gain[k0 + kr + 4 * i];
        } else {
#pragma unroll
            for (int i = 0; i < 16; ++i) gk[i] = 1.f;
        }
#pragma unroll
        for (int i = 0; i < 16; ++i) { const int kk = kr + 4 * i; const f32x4 v = tv[i] * gk[i];
#pragma unroll
            for (int e = 0; e < 4; ++e) *(LAS bf16_t*)(scr + (nq + e) * 144 + kk * 2) = (bf16_t)f2bf(v[e]); }
    } else {
        int src[4];
#pragma unroll
        for (int e = 0; e < 4; ++e) src[e] = (MAP == 1) ? cmap_win(n0 + nq + e) : cmap_uq(n0 + nq + e);
        const int s0 = src[0] > 0 ? src[0] : 0, s1 = src[1] > 0 ? src[1] : 0, s2 = src[2] > 0 ? src[2] : 0, s3 = src[3] > 0 ? src[3] : 0;
        float ts[16][4], gk[16];
#pragma unroll
        for (int i = 0; i < 16; ++i) { const float* wr = W + (size_t)(k0 + kr + 4 * i) * Nsrc; ts[i][0] = wr[s0]; ts[i][1] = wr[s1]; ts[i][2] = wr[s2]; ts[i][3] = wr[s3]; }
        if (gain) {
#pragma unroll
            for (int i = 0; i < 16; ++i) gk[i] = gain[k0 + kr + 4 * i];
        } else {
#pragma unroll
            for (int i = 0; i < 16; ++i) gk[i] = 1.f;
        }
#pragma unroll
        for (int i = 0; i < 16; ++i) { const int kk = kr + 4 * i;
#pragma unroll
            for (int e = 0; e < 4; ++e) { const float v = (src[e] >= 0) ? ts[i][e] * gk[i] : 0.f; *(LAS bf16_t*)(scr + (nq + e) * 144 + kk * 2) = (bf16_t)f2bf(v); } }
    }
    asm volatile("s_waitcnt lgkmcnt(0)" ::: "memory");
#pragma unroll
    for (int j = 0; j < 8; ++j) { const int n = (lane >> 3) + 8 * j, c = lane & 7; *(u32x4*)(WT + (size_t)(n0 + n) * K + k0 + 8 * c) = *(const LAS u32x4*)(scr + n * 144 + c * 16); }
    asm volatile("s_waitcnt lgkmcnt(0)" ::: "memory");
}

constexpr int CV_TAB = 4096, CV_WIN = CV_TAB + 736, CV_WOUT = CV_WIN + 256, CV_WQ = CV_WOUT + 256, CV_WG = CV_WQ + 256, CV_WP = CV_WG + 32, CV_UQ = CV_WP + 18, CV_UKV = CV_UQ + 16,
              CV_P = CV_UKV + 128, NCONV = CV_P + 16;
__device__ __forceinline__ bool conv_early(int item) { return (item >= CV_TAB && item < CV_WIN) || (item >= CV_WP && item < CV_UKV); }
__device__ __forceinline__ void convert_item(Frame& F, int l, int item, int lane) {
    const Args& a = *F.a; unsigned char* ws = F.ws;
    LAS float* scr = (LAS float*)(F.lds + F.wave * 16384);
    if (item < CV_TAB) {
        const int tab = item >> 11, r0 = l * NEXP + (item & 2047) * 8;
        const float* SRC = a.in[tab ? I_PEER_V : I_PEER_U]; unsigned char* DST = ws + (tab ? WS_VB : WS_UB); float* SC = (float*)(ws + (tab ? WS_SV : WS_SU));
        const float* gF = a.in[I_LN_FFN] + l * D;
        f32x4 gv[8];
#pragma unroll
        for (int q = 0; q < 8; ++q) { gv[q] = (f32x4){1.f, 1.f, 1.f, 1.f}; if (tab == 0) gv[q] = *(const f32x4*)(gF + q * 256 + lane * 4); }
        float mysc = 1.f;
        f32x4 nx[2][8];
#pragma unroll
        for (int k = 0; k < 2; ++k)
#pragma unroll
            for (int q = 0; q < 8; ++q) nx[k][q] = __builtin_nontemporal_load((const f32x4*)(SRC + (size_t)(r0 + k) * D + q * 256 + lane * 4));
#pragma unroll
        for (int rr = 0; rr < 8; ++rr) {
            const int row = r0 + rr; f32x4 v[8]; float am = 0.f;
#pragma unroll
            for (int q = 0; q < 8; ++q) v[q] = nx[rr & 1][q];
            if (rr + 2 < 8) {
#pragma unroll
                for (int q = 0; q < 8; ++q) nx[rr & 1][q] = __builtin_nontemporal_load((const f32x4*)(SRC + (size_t)(row + 2) * D + q * 256 + lane * 4));
            }
#pragma unroll
            for (int q = 0; q < 8; ++q) {
                v[q] *= gv[q];
                am = fmaxf(am, fmaxf(fmaxf(fabsf(v[q][0]), fabsf(v[q][1])), fmaxf(fabsf(v[q][2]), fabsf(v[q][3]))));
            }
            am = wave_max(am);
            const float sc = am > 0.f ? am * (1.f / 6.f) : 1.f, inv = 1.f / sc;
            u32x4 pk;
#pragma unroll
            for (int q2 = 0; q2 < 4; ++q2) { unsigned w = 0;
                w = __builtin_amdgcn_cvt_scalef32_pk_fp4_f32(w, v[2 * q2][0] * inv, v[2 * q2][1] * inv, 1.0f, 0);
                w = __builtin_amdgcn_cvt_scalef32_pk_fp4_f32(w, v[2 * q2][2] * inv, v[2 * q2][3] * inv, 1.0f, 1);
                w = __builtin_amdgcn_cvt_scalef32_pk_fp4_f32(w, v[2 * q2 + 1][0] * inv, v[2 * q2 + 1][1] * inv, 1.0f, 2);
                w = __builtin_amdgcn_cvt_scalef32_pk_fp4_f32(w, v[2 * q2 + 1][2] * inv, v[2 * q2 + 1][3] * inv, 1.0f, 3);
                pk[q2] = w; }
            *(u32x4*)(DST + (size_t)row * VROW + lane * 16) = pk;
            mysc = (lane == rr) ? sc : mysc;
        }
        if (lane < 8) SC[r0 + lane] = mysc;
        return;
    }
#define CV_TR(MAP, base, WI, GI, K_, NS_, ND_, WSOFF) do { const int i0_ = (item - (base)) * 4; const float* W_ = a.in[WI] + (size_t)l * (K_) * (NS_); const float* g_ = (GI) >= 0 ? a.in[(GI) >= 0 ? (GI) : 0] + l * (K_) : nullptr; \
        bf16_t* WT_ = (bf16_t*)(ws + (WSOFF)) + (size_t)l * (ND_) * (K_); _Pragma("unroll 1") for (int j_ = 0; j_ < 4; ++j_) if (i0_ + j_ < ((K_) / 64) * ((ND_) / 64)) transpose_item<MAP>(W_, K_, NS_, ND_, g_, WT_, scr, i0_ + j_, lane); } while (0)
    if (item < CV_WIN) { CV_TR(1, CV_TAB, I_W_IN, I_LN_MIX, D, IN_COLS, NZ, WS_WIN); return; }
    if (item < CV_WOUT) { CV_TR(0, CV_WIN, I_W_OUT, I_GROUP_GAIN, D, D, D, WS_WOUT); return; }
    if (item < CV_WQ) { CV_TR(0, CV_WOUT, I_PEER_WQ, I_LN_FFN, D, D, D, WS_WQ); return; }
    if (item < CV_WG) { CV_TR(0, CV_WQ, I_PLE_WGATE, I_LN_PLE, D, D, D, WS_WG); return; }
    if (item < CV_WP) { CV_TR(0, CV_WG, I_PLE_WPROJ, -1, PLE, D, D, WS_WP); return; }
    if (item < CV_UQ) { CV_TR(2, CV_WP, I_MLA_WUQ, I_MLA_QN, 384, 768, 768, WS_WUQ); return; }
    if (item < CV_UKV) { CV_TR(0, CV_UQ, I_MLA_WUKV, I_MLA_KVN, 256, 1024, 1024, WS_WUKV); return; }
#undef CV_TR
    if (item < CV_P) {
        const size_t e0 = (size_t)l * T * PLE + (size_t)(item - CV_UKV) * 16384; const float* Pp = a.in[I_P]; bf16_t* PB = (bf16_t*)(ws + WS_PB);
#pragma unroll 4
        for (int i = 0; i < 32; ++i) { const size_t e = e0 + (size_t)i * 512 + lane * 8; const f32x4 v0 = *(const f32x4*)(Pp + e), v1 = *(const f32x4*)(Pp + e + 4);
            u32x4 w; w.x = pk2(v0[0], v0[1]); w.y = pk2(v0[2], v0[3]); w.z = pk2(v1[0], v1[1]); w.w = pk2(v1[2], v1[3]); *(u32x4*)(PB + e) = w; }
        return;
    }
    {
        const size_t e0 = (size_t)l * 8 * 2 * 128 * 128 + (size_t)(item - CV_P) * 16384; const float* sk = a.in[I_PEER_SUBKEYS]; bf16_t* skb = (bf16_t*)(ws + WS_SKB);
#pragma unroll 4
        for (int i = 0; i < 32; ++i) { const size_t e = e0 + (size_t)i * 512 + lane * 8; const f32x4 v0 = *(const f32x4*)(sk + e), v1 = *(const f32x4*)(sk + e + 4);
            u32x4 w; w.x = pk2(v0[0], v0[1]); w.y = pk2(v0[2], v0[3]); w.z = pk2(v1[0], v1[1]); w.w = pk2(v1[2], v1[3]); *(u32x4*)(skb + e) = w; }
    }
}
__device__ __forceinline__ void convert_layers(Frame& F, int l0, int l1, int gw, int NGW, bool early_only) {
    const int lane = lane_id_fresh();
    for (int l = l0; l < l1; ++l)
#pragma unroll 1
        for (int it = gw; it < NCONV; it += NGW) if (!early_only || conv_early(it)) convert_item(F, l, it, lane);
}
__device__ __forceinline__ void convert_layer_queue(Frame& F, int l, unsigned* ctr) {
    const int lane = lane_id_fresh();
#pragma unroll 1
    for (;;) {
        unsigned it = 0;
        if (lane == 0) it = __hip_atomic_fetch_add(ctr, 1u, __ATOMIC_RELAXED, __HIP_MEMORY_SCOPE_AGENT);
        it = __builtin_amdgcn_readfirstlane(it);
        if (it >= (unsigned)NCONV) break;
        const int ll = conv_early((int)it) ? l + 1 : l;
        if (ll < DEPTH) convert_item(F, ll, (int)it, lane);
    }
}

__device__ __forceinline__ void prologue(Frame& F) {
    const Args& a = *F.a; unsigned char* ws = F.ws;
    const int gw = F.gw, NGW = F.ngw, lane = F.lane;
    const size_t gt = (size_t)blockIdx.x * NTHREADS + F.tid, GT = (size_t)F.G * NTHREADS;
    if (F.G == 256) convert_layers(F, 0, 1, gw, NGW, true);
    else convert_layers(F, 0, DEPTH, gw, NGW, false);
    {
        const float* X = a.in[I_X]; bf16_t* HB = (bf16_t*)(ws + WS_HB); u64* ssq = (u64*)(ws + WS_CTL + CTL_SSQA);
        for (int t = gw; t < T; t += NGW) {
            float s2 = 0.f;
#pragma unroll
            for (int c = 0; c < 4; ++c) {
                const size_t o = (size_t)t * D + c * 512 + lane * 8;
                const f32x4 v0 = *(const f32x4*)(X + o), v1 = *(const f32x4*)(X + o + 4);
                u32x4 w; w.x = pk2(v0[0], v0[1]); w.y = pk2(v0[2], v0[3]); w.z = pk2(v1[0], v1[1]); w.w = pk2(v1[2], v1[3]);
                *(u32x4*)(HB + o) = w;
                s2 += v0[0] * v0[0] + v0[1] * v0[1] + v0[2] * v0[2] + v0[3] * v0[3] + v1[0] * v1[0] + v1[1] * v1[1] + v1[2] * v1[2] + v1[3] * v1[3];
            }
            s2 = wave_sum(s2);
            if (lane == 0) ssq[t] = (u64)(s2 * 16777216.f);
        }
    }
    {
        const int* pos = (const int*)a.in[I_POS]; float* cs = (float*)(ws + WS_CS);
        for (size_t i = gt; i < (size_t)T * 32; i += GT) {
            const int t = (int)(i / 32), j = (int)(i % 32);
            const float inv = powf(10000.0f, -(float)j / 32.0f);
            const float ang = (float)pos[t] * inv;
            const double rev = (double)ang * 0.15915494309189535;
            const float fr = (float)(rev - rint(rev));
            cs[i * 2] = __builtin_amdgcn_cosf(fr); cs[i * 2 + 1] = __builtin_amdgcn_sinf(fr);
        }
    }
    {
        float* prm = (float*)(ws + WS_PRM);
#define PRM_COPY(IDX, OFF, N) do { const float* src_ = a.in[IDX]; for (size_t i = gt; i < (size_t)DEPTH * (N); i += GT) { const int l_ = (int)(i / (N)), o_ = (int)(i % (N)); prm[l_ * PRM_L + (OFF) + o_] = src_[i]; } } while (0)
        PRM_COPY(I_CONV_W, PRM_CW, 2048); PRM_COPY(I_CONV_B, PRM_CB, 512); PRM_COPY(I_GATE_B, PRM_GB, 8); PRM_COPY(I_DIFF_LAMBDA, PRM_DL, 256);
        PRM_COPY(I_DIFF_NORM, PRM_DN, 512); PRM_COPY(I_HGRN_NORM, PRM_HN, 512); PRM_COPY(I_MLSTM_NORM, PRM_MN, 512);
#undef PRM_COPY
        for (size_t i = gt; i < (size_t)D; i += GT) prm[PRM_FIN + i] = a.in[I_LN_FINAL][i];
    }
    if (blockIdx.x == 0) {
        const float* lg = a.in[I_HGRN_LB]; float* lbs = (float*)(ws + WS_LBS);
        for (int c = F.tid; c < 512; c += NTHREADS) {
            float v[DEPTH], mx = -1e30f;
#pragma unroll
            for (int l = 0; l < DEPTH; ++l) { v[l] = lg[l * 512 + c]; mx = fmaxf(mx, v[l]); }
            float s = 0.f;
#pragma unroll
            for (int l = 0; l < DEPTH; ++l) { v[l] = expf(v[l] - mx); s += v[l]; }
            float cum = 0.f; float first = 0.f;
#pragma unroll
            for (int l = 0; l < DEPTH; ++l) { cum += v[l] / s; if (l == 0) first = cum; lbs[l * 512 + c] = cum - first; }
        }
    }
}

__device__ __forceinline__ void mix_prep(Frame& F, int l) {
    unsigned char* ws = F.ws;
    const bf16_t* Z = (const bf16_t*)(ws + WS_Z);
    const size_t gt = (size_t)F.bid * NTHREADS + F.tid, GT = (size_t)F.G * NTHREADS;
    bf16_t* KR = (bf16_t*)(ws + WS_KRM); const float* cs = (const float*)(ws + WS_CS);
    for (size_t i = gt; i < (size_t)T * 32; i += GT) {
        const int t = (int)(i / 32), j = (int)(i % 32);
        const float x1 = bf2f(Z[(size_t)t * NZ + ZC_MKR + 2 * j]), x2 = bf2f(Z[(size_t)t * NZ + ZC_MKR + 2 * j + 1]);
        const float c = cs[i * 2], sn = cs[i * 2 + 1];
        *(unsigned*)(KR + (size_t)t * 64 + 2 * j) = pk2(x1 * c - x2 * sn, x2 * c + x1 * sn);
    }
}

typedef float f32x16 __attribute__((ext_vector_type(16)));
__device__ __forceinline__ float xhalf_max(float x) { float a = x, b = x; asm volatile("s_nop 1\n\tv_permlane32_swap_b32 %0, %1\n\ts_nop 1" : "+v"(a), "+v"(b)); return fmaxf(a, b); }
__device__ __forceinline__ float xhalf_sum(float x) { float a = x, b = x; asm volatile("s_nop 1\n\tv_permlane32_swap_b32 %0, %1\n\ts_nop 1" : "+v"(a), "+v"(b)); return a + b; }
typedef short s16x4 __attribute__((ext_vector_type(4)));
__device__ __forceinline__ int crow(int r, int hi) { return (r & 3) + 8 * (r >> 2) + 4 * hi; }
template <int OFF> __device__ __forceinline__ s16x4 tr_read(unsigned addr) { s16x4 r; asm volatile("ds_read_b64_tr_b16 %0, %1 offset:%2" : "=&v"(r) : "v"(addr), "i"(OFF) : "memory"); return r; }
constexpr int ATT_SV = 320;
template <int D0, int BLK, int KS> __device__ __forceinline__ bf16x8 v_frag(unsigned vaddr) {
    const s16x4 lo = tr_read<(32 * BLK + 16 * KS) * ATT_SV + 64 * D0>(vaddr), hi = tr_read<(32 * BLK + 16 * KS + 8) * ATT_SV + 64 * D0>(vaddr);
    return (bf16x8){lo[0], lo[1], lo[2], lo[3], hi[0], hi[1], hi[2], hi[3]};
}
__device__ __forceinline__ bf16x8 pack8(const f32x16& p, int base) {
    u32x4 w; w.x = pk2(p[base + 0], p[base + 1]); w.y = pk2(p[base + 2], p[base + 3]); w.z = pk2(p[base + 4], p[base + 5]); w.w = pk2(p[base + 6], p[base + 7]);
    return __builtin_bit_cast(bf16x8, w);
}
struct VFrags { bf16x8 a00, a01, a10, a11; };
template <int D0> __device__ __forceinline__ VFrags v_frags(unsigned vaddr) { VFrags f; f.a00 = v_frag<D0, 0, 0>(vaddr); f.a01 = v_frag<D0, 0, 1>(vaddr); f.a10 = v_frag<D0, 1, 0>(vaddr); f.a11 = v_frag<D0, 1, 1>(vaddr); return f; }
__device__ __forceinline__ void pv_mma(f32x16& o, const VFrags& f, bf16x8 p00, bf16x8 p01, bf16x8 p10, bf16x8 p11) {
    o = __builtin_amdgcn_mfma_f32_32x32x16_bf16(f.a00, p00, o, 0, 0, 0);
    o = __builtin_amdgcn_mfma_f32_32x32x16_bf16(f.a01, p01, o, 0, 0, 0);
    o = __builtin_amdgcn_mfma_f32_32x32x16_bf16(f.a10, p10, o, 0, 0, 0);
    o = __builtin_amdgcn_mfma_f32_32x32x16_bf16(f.a11, p11, o, 0, 0, 0);
}
__device__ __forceinline__ void pv_all(f32x16 (&o)[4], unsigned vaddr, bf16x8 p00, bf16x8 p01, bf16x8 p10, bf16x8 p11) {
    const VFrags f0 = v_frags<0>(vaddr); const VFrags f1 = v_frags<1>(vaddr);
    asm volatile("s_waitcnt lgkmcnt(8)" ::: "memory"); __builtin_amdgcn_sched_barrier(0);
    pv_mma(o[0], f0, p00, p01, p10, p11);
    __builtin_amdgcn_sched_barrier(0);
    const VFrags f2 = v_frags<2>(vaddr);
    asm volatile("s_waitcnt lgkmcnt(8)" ::: "memory"); __builtin_amdgcn_sched_barrier(0);
    pv_mma(o[1], f1, p00, p01, p10, p11);
    __builtin_amdgcn_sched_barrier(0);
    const VFrags f3 = v_frags<3>(vaddr);
    asm volatile("s_waitcnt lgkmcnt(8)" ::: "memory"); __builtin_amdgcn_sched_barrier(0);
    pv_mma(o[2], f2, p00, p01, p10, p11);
    asm volatile("s_waitcnt lgkmcnt(0)" ::: "memory"); __builtin_amdgcn_sched_barrier(0);
    pv_mma(o[3], f3, p00, p01, p10, p11);
}
template <int MODE>
__device__ __forceinline__ void attn_unit(Frame& F, int l, int b, int h, int qb) {
    constexpr int DK = MODE ? 192 : 64, NS = DK / 16, SK = DK * 2 + 16, KBYTES = 64 * SK, VBYTES = 64 * ATT_SV, BUFB = KBYTES + VBYTES, KCH = DK / 8, NKC = (64 * KCH) / 512;
    constexpr int NMAP = MODE ? 1 : 2;
    constexpr float SCALE = MODE ? 0.07216878364870322f : 0.125f, C = SCALE * 1.4426950408889634f;
    unsigned char* ws = F.ws;
    const bf16_t* Z = (const bf16_t*)(ws + WS_Z); const bf16_t* QM = (const bf16_t*)(ws + WS_QM); const bf16_t* KVM = (const bf16_t*)(ws + WS_KVM); const bf16_t* KRM = (const bf16_t*)(ws + WS_KRM);
    bf16_t* Y = (bf16_t*)(ws + WS_Y);
    const int w = F.wave, lane = lane_id_fresh(), tid = w * 64 + lane, r32 = lane & 31, hi = lane >> 5;
    const int q0 = qb * 256, qw = q0 + 32 * w, ntiles = 4 * (qb + 1);
    const size_t rowb = (size_t)b * SEQ;
    const unsigned lds0 = (unsigned)(uintptr_t)F.lds;
    const unsigned kaddr = lds0 + r32 * SK + 16 * hi;
    const unsigned vaddr = lds0 + KBYTES + (((lane & 15) >> 2) + 4 * hi) * ATT_SV + (16 * ((lane >> 4) & 1) + 4 * (lane & 3)) * 2;
    float* O1 = (float*)(ws + WS_O1) + (rowb + qw + r32) * 512 + h * 128 + 4 * hi;
    for (int mp = 0; mp < NMAP; ++mp) {
        bf16x8 qf[NS];
        {
            const bf16_t* qp = MODE ? QM + (rowb + qw + r32) * 768 + h * 192 + 8 * hi : Z + (rowb + qw + r32) * NZ + ZC_DQ + h * 128 + mp * 64 + 8 * hi;
#pragma unroll
            for (int s = 0; s < NS; ++s) qf[s] = *(const bf16x8*)(qp + 16 * s);
            if (MODE == 1) {
                const float* csq = (const float*)(ws + WS_CS) + (rowb + qw + r32) * 64 + 8 * hi;
#pragma unroll
                for (int s = 8; s < NS; ++s) {
                    const f32x4 ca = *(const f32x4*)(csq + 16 * (s - 8)), cb = *(const f32x4*)(csq + 16 * (s - 8) + 4);
                    const u32x4 w = __builtin_bit_cast(u32x4, qf[s]); u32x4 o;
                    { const float x1 = bflo(w[0]), x2 = bfhi(w[0]); o[0] = pk2(x1 * ca[0] - x2 * ca[1], x2 * ca[0] + x1 * ca[1]); }
                    { const float x1 = bflo(w[1]), x2 = bfhi(w[1]); o[1] = pk2(x1 * ca[2] - x2 * ca[3], x2 * ca[2] + x1 * ca[3]); }
                    { const float x1 = bflo(w[2]), x2 = bfhi(w[2]); o[2] = pk2(x1 * cb[0] - x2 * cb[1], x2 * cb[0] + x1 * cb[1]); }
                    { const float x1 = bflo(w[3]), x2 = bfhi(w[3]); o[3] = pk2(x1 * cb[2] - x2 * cb[3], x2 * cb[2] + x1 * cb[3]); }
                    qf[s] = __builtin_bit_cast(bf16x8, o);
                }
            }
        }
        f32x16 o[4];
#pragma unroll
        for (int d = 0; d < 4; ++d) o[d] = (f32x16){};
        float m_run = -1e30f, l_run = 0.f;
        u32x4 kst[NKC], vst[2];
#define ATT_LOAD(j) do { const int k0_ = 64 * (j); \
            _Pragma("unroll") for (int i_ = 0; i_ < NKC; ++i_) { const int c_ = tid + 512 * i_, row_ = c_ / KCH, cc_ = c_ % KCH; \
                const bf16_t* src_ = MODE ? (cc_ < 16 ? KVM + (rowb + k0_ + row_) * 1024 + h * 256 + cc_ * 8 : KRM + (rowb + k0_ + row_) * 64 + (cc_ - 16) * 8) \
                                          : Z + (rowb + k0_ + row_) * NZ + ZC_DK + h * 128 + mp * 64 + cc_ * 8; \
                kst[i_] = *(const u32x4*)src_; } \
            _Pragma("unroll") for (int i_ = 0; i_ < 2; ++i_) { const int c_ = tid + 512 * i_, row_ = c_ >> 4, cc_ = c_ & 15; \
                const bf16_t* src_ = MODE ? KVM + (rowb + k0_ + row_) * 1024 + h * 256 + 128 + cc_ * 8 : Z + (rowb + k0_ + row_) * NZ + ZC_DV + h * 128 + cc_ * 8; \
                vst[i_] = *(const u32x4*)src_; } } while (0)
#define ATT_WRITE(buf) do { \
            _Pragma("unroll") for (int i_ = 0; i_ < NKC; ++i_) { const int c_ = tid + 512 * i_, row_ = c_ / KCH, cc_ = c_ % KCH; *(LAS u32x4*)(F.lds + (buf) * BUFB + row_ * SK + cc_ * 16) = kst[i_]; } \
            _Pragma("unroll") for (int i_ = 0; i_ < 2; ++i_) { const int c_ = tid + 512 * i_, row_ = c_ >> 4, cc_ = c_ & 15; *(LAS u32x4*)(F.lds + (buf) * BUFB + KBYTES + row_ * ATT_SV + cc_ * 16) = vst[i_]; } } while (0)
        ATT_LOAD(0); ATT_WRITE(0);
        __builtin_amdgcn_s_waitcnt(0x0F70);
        __syncthreads();
        for (int j = 0; j < ntiles; ++j) {
            const int k0 = 64 * j; const unsigned bo = (unsigned)(j & 1) * BUFB;
            if (j + 1 < ntiles) ATT_LOAD(j + 1);
            if (k0 <= qw + 31) {
                f32x16 p0 = (f32x16){}, p1 = (f32x16){};
                {
                    bf16x8 ka[NS], kb[NS];
#pragma unroll
                    for (int s = 0; s < NS; ++s) { ka[s] = *(const LAS bf16x8*)(uintptr_t)(kaddr + bo + 32 * s); kb[s] = *(const LAS bf16x8*)(uintptr_t)(kaddr + bo + 32 * SK + 32 * s); }
#pragma unroll
                    for (int s = 0; s < NS; ++s) { p0 = __builtin_amdgcn_mfma_f32_32x32x16_bf16(ka[s], qf[s], p0, 0, 0, 0); p1 = __builtin_amdgcn_mfma_f32_32x32x16_bf16(kb[s], qf[s], p1, 0, 0, 0); }
                    __builtin_amdgcn_sched_group_barrier(0x100, 6, 0);
#pragma unroll
                    for (int s = 0; s < NS - 3; ++s) { __builtin_amdgcn_sched_group_barrier(0x008, 2, 0); __builtin_amdgcn_sched_group_barrier(0x100, 2, 0); }
                    __builtin_amdgcn_sched_group_barrier(0x008, 6, 0);
                }
                if (k0 + 63 > qw) {
                    const int qi = qw + r32;
#pragma unroll
                    for (int r = 0; r < 16; ++r) { const int key = k0 + crow(r, hi); if (key > qi) p0[r] = -1e30f; if (key + 32 > qi) p1[r] = -1e30f; }
                }
                float pmax = p0[0];
#pragma unroll
                for (int r = 1; r < 16; ++r) pmax = fmaxf(pmax, p0[r]);
#pragma unroll
                for (int r = 0; r < 16; ++r) pmax = fmaxf(pmax, p1[r]);
                pmax = xhalf_max(pmax);
                const float mn = fmaxf(m_run, pmax), alpha = __builtin_amdgcn_exp2f((m_run - mn) * C), mnC = -mn * C; m_run = mn;
                float ps;
                {
                    const f32x2_t C2v = (f32x2_t){C, C}, M2v = (f32x2_t){mnC, mnC}; f32x2_t sa = (f32x2_t){0.f, 0.f}, sb = (f32x2_t){0.f, 0.f};
#pragma unroll
                    for (int r = 0; r < 16; r += 2) {
                        const f32x2_t a0 = __builtin_elementwise_fma((f32x2_t){p0[r], p0[r + 1]}, C2v, M2v), a1 = __builtin_elementwise_fma((f32x2_t){p1[r], p1[r + 1]}, C2v, M2v);
                        p0[r] = __builtin_amdgcn_exp2f(a0[0]); p0[r + 1] = __builtin_amdgcn_exp2f(a0[1]); p1[r] = __builtin_amdgcn_exp2f(a1[0]); p1[r + 1] = __builtin_amdgcn_exp2f(a1[1]);
                        sa += (f32x2_t){p0[r], p0[r + 1]}; sb += (f32x2_t){p1[r], p1[r + 1]};
                    }
                    const f32x2_t st_ = sa + sb; ps = st_[0] + st_[1];
                }
                ps = xhalf_sum(ps);
                l_run = l_run * alpha + ps;
                if (!__all(alpha == 1.f)) {
#pragma unroll
                    for (int d = 0; d < 4; ++d) o[d] *= alpha;
                }
                const bf16x8 p00 = pack8(p0, 0), p01 = pack8(p0, 8), p10 = pack8(p1, 0), p11 = pack8(p1, 8);
                asm volatile("s_waitcnt lgkmcnt(0)" ::: "memory");
                pv_all(o, vaddr + bo, p00, p01, p10, p11);
            }
            if (j + 1 < ntiles) ATT_WRITE((j + 1) & 1);
            __syncthreads();
        }
#undef ATT_LOAD
#undef ATT_WRITE
        const float il = rcpf_(l_run);
        if (MODE == 0 && mp == 0) {
#pragma unroll
            for (int d = 0; d < 4; ++d)
#pragma unroll
                for (int r4 = 0; r4 < 4; ++r4) *(f32x4*)(O1 + 32 * d + 8 * r4) = (f32x4){o[d][4 * r4] * il, o[d][4 * r4 + 1] * il, o[d][4 * r4 + 2] * il, o[d][4 * r4 + 3] * il};
        } else {
            const size_t yrow = (rowb + qw + r32) * D + (MODE ? 1024 : 0) + h * 128 + 4 * hi;
            if (MODE == 0) {
                const float* lv = (const float*)(ws + WS_PRM) + l * PRM_L + PRM_DL;
                const float s01 = wave_sum(lv[lane] * lv[64 + lane]), s23 = wave_sum(lv[128 + lane] * lv[192 + lane]);
                const float lam_init = 0.8f - 0.6f * __expf(-0.3f * (float)l);
                const float lam = __expf(s01) - __expf(s23) + lam_init;
                const float il2 = lam * il; float ss = 0.f;
#pragma unroll
                for (int d = 0; d < 4; ++d)
#pragma unroll
                    for (int r4 = 0; r4 < 4; ++r4) { const f32x4 a1 = *(const f32x4*)(O1 + 32 * d + 8 * r4);
#pragma unroll
                        for (int e = 0; e < 4; ++e) { const float x = a1[e] - o[d][4 * r4 + e] * il2; o[d][4 * r4 + e] = x; ss += x * x; } }
                ss += bperm_f(lane ^ 32, ss);
                const float rn = rsqrtf(ss * (1.f / 128.f) + EPS) * (1.f - lam_init);
                const float* g = (const float*)(ws + WS_PRM) + l * PRM_L + PRM_DN + h * 128 + 4 * hi;
#pragma unroll
                for (int d = 0; d < 4; ++d)
#pragma unroll
                    for (int r4 = 0; r4 < 4; ++r4) {
                        const f32x4 gg = *(const f32x4*)(g + 32 * d + 8 * r4);
                        u32x2 wv; wv.x = pk2(o[d][4 * r4] * rn * gg[0], o[d][4 * r4 + 1] * rn * gg[1]); wv.y = pk2(o[d][4 * r4 + 2] * rn * gg[2], o[d][4 * r4 + 3] * rn * gg[3]);
                        *(u32x2*)(Y + yrow + 32 * d + 8 * r4) = wv;
                    }
            } else {
#pragma unroll
                for (int d = 0; d < 4; ++d)
#pragma unroll
                    for (int r4 = 0; r4 < 4; ++r4) {
                        u32x2 wv; wv.x = pk2(o[d][4 * r4] * il, o[d][4 * r4 + 1] * il); wv.y = pk2(o[d][4 * r4 + 2] * il, o[d][4 * r4 + 3] * il);
                        *(u32x2*)(Y + yrow + 32 * d + 8 * r4) = wv;
                    }
            }
        }
    }
}
__device__ __forceinline__ void attn_fast(Frame& F, int l) {
    unsigned* actr = (unsigned*)(F.ws + WS_CTL + CTL_CVQ + 4096) + 64 * l;
    volatile LAS unsigned* slot = (volatile LAS unsigned*)(F.lds + MISC_OFF) + 24;
#pragma unroll 1
    for (;;) {
        __syncthreads();
        if (F.tid == 0) *slot = __hip_atomic_fetch_add(actr, 1u, __ATOMIC_RELAXED, __HIP_MEMORY_SCOPE_AGENT);
        __syncthreads();
        const int u = __builtin_amdgcn_readfirstlane((int)*slot);
        if (u >= 256) break;
        const int qb = 7 - (u >> 5), mode = (u >> 4) & 1, b = (u >> 2) & 3, h = u & 3;
        if (mode == 0) attn_unit<0>(F, l, b, h, qb); else attn_unit<1>(F, l, b, h, qb);
    }
}

typedef float f32x4_t __attribute__((ext_vector_type(4)));
template <int KIND>
__device__ __forceinline__ void scan_unit(Frame& F, int l, int b, int h, int seg) {
    constexpr int DK = KIND ? 64 : 128, NKS = DK / 32, NDT = DK / 16, SQ = DK * 2 + 16, SA = 144;
    constexpr int L_QT = 0, L_KT = 64 * SQ, L_KTT = 128 * SQ, L_VT = L_KTT + DK * SA, L_AT = L_VT + 128 * SA, L_ST = L_AT + 64 * SA, L_TAB = L_ST + 128 * SQ;
    constexpr int T_ER = L_TAB, T_EC = T_ER + 512, T_PS = T_EC + 512, T_QS = T_PS + 2048, T_KS = T_QS + 256, T_MT = T_KS + 256, T_NP = T_MT + 256, T_SC = T_NP + 256, T_DEN = T_SC + 64, T_BS = T_DEN + 8 * 256;
    static_assert(T_BS + 256 <= RING_BYTES, "scan LDS");
    unsigned char* ws = F.ws;
    const bf16_t* Z = (const bf16_t*)(ws + WS_Z);
    float* OUT = (float*)(ws + (KIND ? WS_OL : WS_OG));
    const float* prm = (const float*)(ws + WS_PRM) + l * PRM_L;
    LAS unsigned char* lds = F.lds;
    const int w = F.wave, lane = lane_id_fresh(), tid = w * 64 + lane, l15 = lane & 15, g = lane >> 4;
    const int ch = tid & 127, part = tid >> 7, i0 = 16 * part;
    if (w == 2 || w == 3) { const int rt = (w == 2) ? 0 : 2;
#pragma unroll
        for (int r = 0; r < 4; ++r) *(LAS bf16_t*)(lds + L_AT + (16 * rt + 4 * g + r) * SA + (16 * (rt + 1) + l15) * 2) = 0; }
    f32x4 st[NDT];
#pragma unroll
    for (int d = 0; d < NDT; ++d) st[d] = (f32x4){0.f, 0.f, 0.f, 0.f};
    float m_prev = 0.f, np_reg = 0.f, colsum = 0.f, bseg = 0.f;
    float cumlog = 0.f;
    const int bh = b * 4 + h;
    bf16_t* QTS = (bf16_t*)(ws + (KIND ? WS_QTL : WS_QTG)) + (size_t)bh * SEQ * DK;
    float* SCL = (float*)(ws + WS_SCL) + (size_t)bh * SEQ * 4;
    const float lb = KIND ? 0.f : ((const float*)(ws + WS_LBS))[l * 512 + h * 128 + ch];
    unsigned zA[16], zB[16], vr[16], gA = 0, gB = 0;
#define SCAN_LOAD(cc) do { const size_t r0_ = (size_t)b * SEQ + 64 * (cc); \
        if (KIND == 0) { const bf16_t* zr_ = Z + (r0_ + i0) * NZ + h * 128 + ch; \
            _Pragma("unroll") for (int j = 0; j < 16; ++j) { zA[j] = zr_[j * NZ + ZC_GF]; zB[j] = zr_[j * NZ + ZC_GQ]; } } \
        else { const int cidx_ = (ch < 64) ? h * 64 + ch : 256 + h * 64 + (ch - 64); const bf16_t* zc_ = Z + (r0_ + i0) * NZ + ZC_LQ + cidx_; \
            _Pragma("unroll") for (int j = 0; j < 16; ++j) zA[j] = zc_[j * NZ]; \
            if (!((cc) == 0 && part == 0)) { zB[0] = zc_[-3 * NZ]; zB[1] = zc_[-2 * NZ]; zB[2] = zc_[-1 * NZ]; } \
            if (w == 0) { const bf16_t* zg_ = Z + (r0_ + lane) * NZ + h; gA = zg_[ZC_LI]; gB = zg_[ZC_LF]; } } \
        { const bf16_t* zv_ = Z + (r0_ + i0) * NZ + (KIND ? ZC_LV : ZC_GV) + h * 128 + ch; \
            _Pragma("unroll") for (int j = 0; j < 16; ++j) vr[j] = zv_[j * NZ]; } } while (0)
    SCAN_LOAD(seg * SEGC);
    float cw0 = 0.f, cw1 = 0.f, cw2 = 0.f, cw3 = 0.f, cbias = 0.f, gbi = 0.f, gbf = 0.f;
    if (KIND == 1) { const int cidx = (ch < 64) ? h * 64 + ch : 256 + h * 64 + (ch - 64);
        cw0 = prm[PRM_CW + cidx]; cw1 = prm[PRM_CW + 512 + cidx]; cw2 = prm[PRM_CW + 1024 + cidx]; cw3 = prm[PRM_CW + 1536 + cidx]; cbias = prm[PRM_CB + cidx]; gbi = prm[PRM_GB + h]; gbf = prm[PRM_GB + 4 + h]; }
#pragma unroll 1
    for (int c = seg * SEGC; c < (seg + 1) * SEGC; ++c) {
        const size_t row0 = (size_t)b * SEQ + 64 * c;
        float qv[16], kv[16], lf[16];
        if (KIND == 0) {
            float run = 0.f;
#pragma unroll
            for (int j = 0; j < 16; ++j) {
                const float zf = fmaxf(bf2f((bf16_t)zA[j]), -30.f), zq = bf2f((bf16_t)zB[j]);
                const float ez = __expf(-zf), sg = rcpf_(1.f + ez), sgn = ez * sg;
                run += __logf(lb + (1.f - lb) * sg); lf[j] = run; qv[j] = zq * 0.08838834764831845f; kv[j] = (1.f - lb) * sgn;
            }
            *(LAS float*)(lds + T_PS + (part * 128 + ch) * 4) = run;
        } else {
            const float w0 = cw0, w1 = cw1, w2 = cw2, w3 = cw3, cb = cbias;
            const bool first = (c == 0 && part == 0);
            float x0 = first ? 0.f : bf2f((bf16_t)zB[0]), x1 = first ? 0.f : bf2f((bf16_t)zB[1]), x2 = first ? 0.f : bf2f((bf16_t)zB[2]);
#pragma unroll
            for (int j = 0; j < 16; ++j) {
                const float x3 = bf2f((bf16_t)zA[j]);
                float v = cb + x0 * w0 + x1 * w1 + x2 * w2 + x3 * w3; v = v * rcpf_(1.f + __expf(-v));
                qv[j] = (ch < 64) ? v * 0.125f : v; x0 = x1; x1 = x2; x2 = x3;
            }
            if (w == 0) {
                const float li = bf2f((bf16_t)gA) + gbi, zf = bf2f((bf16_t)gB) + gbf;
                const float lfv = fminf(zf, 0.f) - __logf(1.f + __expf(-fabsf(zf)));
                float bb = lfv;
#pragma unroll
                for (int o = 1; o < 64; o <<= 1) { const float t_ = bperm_f(lane - o, bb); if (lane >= o) bb += t_; }
                const float a_ = li - bb; float cm = a_;
#pragma unroll
                for (int o = 1; o < 64; o <<= 1) { const float t_ = bperm_f(lane - o, cm); if (lane >= o) cm = fmaxf(cm, t_); }
                const float M = fmaxf(m_prev, cm), MC = rdlane_f(M, 63), bC = rdlane_f(bb, 63);
                *(LAS float*)(lds + T_QS + lane * 4) = __expf(MC - M); *(LAS float*)(lds + T_KS + lane * 4) = __expf(a_ - MC); *(LAS float*)(lds + T_MT + lane * 4) = bb + M;
                *(LAS float*)(lds + T_BS + lane * 4) = bseg + bb;
                bseg += bC;
                const float cs = __expf(m_prev - MC);
                np_reg = cs * (np_reg + colsum);
                *(LAS float*)(lds + T_NP + lane * 4) = np_reg;
                if (lane == 0) *(LAS float*)(lds + T_SC) = cs;
                m_prev = bC + MC;
            }
        }
        __syncthreads();
        {
            unsigned ktt[8];
            *(LAS u32x4*)(lds + L_VT + ch * SA + i0 * 2) = (u32x4){vr[0] | (vr[1] << 16), vr[2] | (vr[3] << 16), vr[4] | (vr[5] << 16), vr[6] | (vr[7] << 16)};
            *(LAS u32x4*)(lds + L_VT + ch * SA + i0 * 2 + 16) = (u32x4){vr[8] | (vr[9] << 16), vr[10] | (vr[11] << 16), vr[12] | (vr[13] << 16), vr[14] | (vr[15] << 16)};
            if (KIND == 0) {
                const float p0 = *(LAS float*)(lds + T_PS + ch * 4), p1 = *(LAS float*)(lds + T_PS + (128 + ch) * 4), p2 = *(LAS float*)(lds + T_PS + (256 + ch) * 4), p3 = *(LAS float*)(lds + T_PS + (384 + ch) * 4);
                const float r_ = p0 + p1, off = (part > 0 ? p0 : 0.f) + (part > 1 ? p1 : 0.f) + (part > 2 ? p2 : 0.f);
                if (part == 0) { *(LAS float*)(lds + T_ER + ch * 4) = __expf(r_); *(LAS float*)(lds + T_EC + ch * 4) = __expf(p2 + p3); }
                const float eseg = __expf(r_ + cumlog);
                bf16_t* qg_ = QTS + (size_t)(64 * c + i0) * DK + ch;
                cumlog += (p0 + p1) + (p2 + p3);
#pragma unroll
                for (int j = 0; j < 16; ++j) {
                    const float x = fminf(fmaxf(off + lf[j] - r_, -80.f), 80.f);
                    const float qt = qv[j] * __expf(x), kt = kv[j] * __expf(-x);
                    *(LAS bf16_t*)(lds + L_QT + (i0 + j) * SQ + ch * 2) = (bf16_t)f2bf(qt);
                    qg_[j * DK] = (bf16_t)f2bf(qt * eseg);
                    const unsigned kb_ = f2bf(kt);
                    *(LAS bf16_t*)(lds + L_KT + (i0 + j) * SQ + ch * 2) = (bf16_t)kb_;
                    if (j & 1) ktt[j >> 1] |= kb_ << 16; else ktt[j >> 1] = kb_;
                }
                *(LAS u32x4*)(lds + L_KTT + ch * SA + i0 * 2) = (u32x4){ktt[0], ktt[1], ktt[2], ktt[3]};
                *(LAS u32x4*)(lds + L_KTT + ch * SA + i0 * 2 + 16) = (u32x4){ktt[4], ktt[5], ktt[6], ktt[7]};
            } else {
#pragma unroll
                for (int j = 0; j < 16; ++j) {
                    const float fs = *(LAS float*)(lds + ((ch < 64) ? T_QS : T_KS) + (i0 + j) * 4);
                    const unsigned vb_ = f2bf(qv[j] * fs);
                    if (ch < 64) { *(LAS bf16_t*)(lds + L_QT + (i0 + j) * SQ + ch * 2) = (bf16_t)vb_; QTS[(size_t)(64 * c + i0 + j) * DK + ch] = (bf16_t)f2bf(qv[j]); }
                    else *(LAS bf16_t*)(lds + L_KT + (i0 + j) * SQ + (ch - 64) * 2) = (bf16_t)vb_;
                    if (j & 1) ktt[j >> 1] |= vb_ << 16; else ktt[j >> 1] = vb_;
                }
                if (ch >= 64) {
                    *(LAS u32x4*)(lds + L_KTT + (ch - 64) * SA + i0 * 2) = (u32x4){ktt[0], ktt[1], ktt[2], ktt[3]};
                    *(LAS u32x4*)(lds + L_KTT + (ch - 64) * SA + i0 * 2 + 16) = (u32x4){ktt[4], ktt[5], ktt[6], ktt[7]};
                }
            }
        }
        __syncthreads();
        for (int ti = w; ti < 10; ti += 8) {
            const int rt = (int)((0x3333222110ull >> (4 * ti)) & 15), ct = (int)((0x3210210100ull >> (4 * ti)) & 15);
            f32x4 acc = (f32x4){0.f, 0.f, 0.f, 0.f};
#pragma unroll
            for (int ks = 0; ks < NKS; ++ks) {
                const bf16x8 af = *(const LAS bf16x8*)(lds + L_QT + (16 * rt + l15) * SQ + (32 * ks + 8 * g) * 2), bfr = *(const LAS bf16x8*)(lds + L_KT + (16 * ct + l15) * SQ + (32 * ks + 8 * g) * 2);
                acc = __builtin_amdgcn_mfma_f32_16x16x32_bf16(af, bfr, acc, 0, 0, 0);
            }
#pragma unroll
            for (int r = 0; r < 4; ++r) { const int t_ = 16 * rt + 4 * g + r, s_ = 16 * ct + l15; *(LAS bf16_t*)(lds + L_AT + t_ * SA + s_ * 2) = (bf16_t)f2bf(s_ <= t_ ? acc[r] : 0.f); }
        }
        {
            const float cs = KIND ? *(LAS float*)(lds + T_SC) : 1.f;
#pragma unroll
            for (int d = 0; d < NDT; ++d) {
                if (KIND == 0) st[d] *= *(const LAS f32x4*)(lds + T_ER + (16 * d + 4 * g) * 4); else st[d] *= cs;
                u32x2 pk; pk.x = pk2(st[d][0], st[d][1]); pk.y = pk2(st[d][2], st[d][3]);
                *(LAS u32x2*)(lds + L_ST + (16 * w + l15) * SQ + (16 * d + 4 * g) * 2) = pk;
            }
        }
        __syncthreads();
        { const int cn_ = (c + 1 < SEQ / 64) ? c + 1 : c; SCAN_LOAD(cn_); }
        __builtin_amdgcn_sched_barrier(0);
        bf16x8 sfr[NKS], vfr[2];
#pragma unroll
        for (int ks = 0; ks < NKS; ++ks) sfr[ks] = *(const LAS bf16x8*)(lds + L_ST + (16 * w + l15) * SQ + (32 * ks + 8 * g) * 2);
#pragma unroll
        for (int ks = 0; ks < 2; ++ks) vfr[ks] = *(const LAS bf16x8*)(lds + L_VT + (16 * w + l15) * SA + (32 * ks + 8 * g) * 2);
        if (KIND == 1) {
            float dn = 0.f;
#pragma unroll
            for (int d8 = 0; d8 < 8; ++d8) { const u32x4 qw_ = *(const LAS u32x4*)(lds + L_QT + lane * SQ + d8 * 16); const f32x4 n0 = *(const LAS f32x4*)(lds + T_NP + d8 * 32), n1 = *(const LAS f32x4*)(lds + T_NP + d8 * 32 + 16);
                dn += bflo(qw_[0]) * n0[0] + bfhi(qw_[0]) * n0[1] + bflo(qw_[1]) * n0[2] + bfhi(qw_[1]) * n0[3] + bflo(qw_[2]) * n1[0] + bfhi(qw_[2]) * n1[1] + bflo(qw_[3]) * n1[2] + bfhi(qw_[3]) * n1[3]; }
#pragma unroll
            for (int s8 = 0; s8 < 8; ++s8) { const u32x4 aw_ = *(const LAS u32x4*)(lds + L_AT + lane * SA + s8 * 16);
#pragma unroll
                for (int e = 0; e < 4; ++e) { const int s_ = 8 * s8 + 2 * e; dn += (s_ <= lane ? bflo(aw_[e]) : 0.f) + (s_ + 1 <= lane ? bfhi(aw_[e]) : 0.f); } }
            *(LAS float*)(lds + T_DEN + (w * 64 + lane) * 4) = dn;
            *(f32x4*)(SCL + (size_t)(64 * c + lane) * 4) = (f32x4){dn, *(LAS float*)(lds + T_MT + lane * 4), *(LAS float*)(lds + T_BS + lane * 4), 0.f};
            if (w == 0) {
                float cs_ = 0.f;
                for (int s_ = 0; s_ < 64; ++s_) cs_ += bf2f(*(const LAS bf16_t*)(lds + L_KT + s_ * SQ + lane * 2));
                colsum = cs_;
            }
        }
#pragma unroll
        for (int rt = 0; rt < 4; ++rt) {
            f32x4 o = (f32x4){0.f, 0.f, 0.f, 0.f};
#pragma unroll
            for (int ks = 0; ks < NKS; ++ks) o = __builtin_amdgcn_mfma_f32_16x16x32_bf16(*(const LAS bf16x8*)(lds + L_QT + (16 * rt + l15) * SQ + (32 * ks + 8 * g) * 2), sfr[ks], o, 0, 0, 0);
#pragma unroll
            for (int ks = 0; ks < 2; ++ks) if (2 * ks <= rt) o = __builtin_amdgcn_mfma_f32_16x16x32_bf16(*(const LAS bf16x8*)(lds + L_AT + (16 * rt + l15) * SA + (32 * ks + 8 * g) * 2), vfr[ks], o, 0, 0, 0);
            float* op = OUT + (row0 + 16 * rt + 4 * g) * 512 + h * 128 + 16 * w + l15;
            if (KIND == 1) {
                const f32x4 dn = *(const LAS f32x4*)(lds + T_DEN + (w * 64 + 16 * rt + 4 * g) * 4), mt = *(const LAS f32x4*)(lds + T_MT + (16 * rt + 4 * g) * 4);
#pragma unroll
                for (int r = 0; r < 4; ++r) op[r * 512] = (seg > 0) ? o[r] : o[r] * rcpf_(fmaxf(fabsf(dn[r]), __expf(-mt[r])));
            } else {
#pragma unroll
                for (int r = 0; r < 4; ++r) op[r * 512] = o[r];
            }
        }
#pragma unroll
        for (int d = 0; d < NDT; ++d) {
#pragma unroll
            for (int ks = 0; ks < 2; ++ks) st[d] = __builtin_amdgcn_mfma_f32_16x16x32_bf16(*(const LAS bf16x8*)(lds + L_KTT + (16 * d + l15) * SA + (32 * ks + 8 * g) * 2), vfr[ks], st[d], 0, 0, 0);
            if (KIND == 0) st[d] *= *(const LAS f32x4*)(lds + T_EC + (16 * d + 4 * g) * 4);
        }
        __syncthreads();
    }
#undef SCAN_LOAD
    if (seg < NSEG - 1) {
        float* SIF = (float*)(ws + WS_SIF) + (size_t)((KIND * 16 + bh) * NSEG) * 16384;
        bf16_t* SIB = (bf16_t*)(ws + WS_SIB) + (size_t)((KIND * 16 + bh) * NSEG) * 16384;
        float* SIM = (float*)(ws + WS_SIM) + (size_t)(bh * NSEG) * 128;
        unsigned* flg = (unsigned*)(ws + WS_CTL + CTL_SEGF) + (size_t)(((l * 2 + KIND) * 16 + bh) * NSEG) * 16;
        if (KIND == 0 && part == 0) *(LAS float*)(lds + T_PS + ch * 4) = cumlog;
        if (seg > 0) {
            if (w == 0) { unsigned spins = 0; while (__builtin_amdgcn_readfirstlane(__hip_atomic_load(flg + seg * 16, __ATOMIC_RELAXED, __HIP_MEMORY_SCOPE_AGENT)) == 0u && ++spins < (1u << 22)) __builtin_amdgcn_s_sleep(2); }
            __syncthreads();
            __builtin_amdgcn_fence(__ATOMIC_ACQUIRE, "agent");
        }
        if (KIND == 1 && w == 0) {
            const float n_loc = np_reg + colsum; float m_new = m_prev, al_ = 1.f, be_ = 0.f, n_init = 0.f;
            if (seg > 0) { const float m_init = SIM[seg * 128 + 64]; n_init = SIM[seg * 128 + lane]; m_new = fmaxf(m_prev, bseg + m_init); al_ = __expf(m_prev - m_new); be_ = __expf(bseg + m_init - m_new); }
            __hip_atomic_store(SIM + (seg + 1) * 128 + lane, al_ * n_loc + be_ * n_init, __ATOMIC_RELAXED, __HIP_MEMORY_SCOPE_AGENT);
            if (lane == 0) { __hip_atomic_store(SIM + (seg + 1) * 128 + 64, m_new, __ATOMIC_RELAXED, __HIP_MEMORY_SCOPE_AGENT); if (seg > 0) { *(LAS float*)(lds + T_SC) = al_; *(LAS float*)(lds + T_SC + 4) = be_; } }
        }
        __syncthreads();
        float al_ = 1.f, be_ = 0.f;
        if (KIND == 1 && seg > 0) { al_ = *(LAS float*)(lds + T_SC); be_ = *(LAS float*)(lds + T_SC + 4); }
#pragma unroll
        for (int d = 0; d < NDT; ++d) {
            f32x4 val = st[d];
            if (seg > 0) {
                const f32x4 prev = *(const f32x4*)(SIF + (size_t)seg * 16384 + (16 * w + l15) * 128 + 16 * d + 4 * g);
                if (KIND == 0) { const f32x4 cl_ = *(const LAS f32x4*)(lds + T_PS + (16 * d + 4 * g) * 4);
#pragma unroll
                    for (int r = 0; r < 4; ++r) val[r] += __expf(cl_[r]) * prev[r]; }
                else val = al_ * val + be_ * prev;
            }
            const size_t o_ = (size_t)(seg + 1) * 16384 + (16 * w + l15) * 128 + 16 * d + 4 * g;
            __hip_atomic_store((u64*)(SIF + o_), (u64)__builtin_bit_cast(unsigned, val[0]) | ((u64)__builtin_bit_cast(unsigned, val[1]) << 32), __ATOMIC_RELAXED, __HIP_MEMORY_SCOPE_AGENT);
            __hip_atomic_store((u64*)(SIF + o_ + 2), (u64)__builtin_bit_cast(unsigned, val[2]) | ((u64)__builtin_bit_cast(unsigned, val[3]) << 32), __ATOMIC_RELAXED, __HIP_MEMORY_SCOPE_AGENT);
            __hip_atomic_store((u64*)(SIB + o_), (u64)pk2(val[0], val[1]) | ((u64)pk2(val[2], val[3]) << 32), __ATOMIC_RELAXED, __HIP_MEMORY_SCOPE_AGENT);
        }
        asm volatile("s_waitcnt vmcnt(0)" ::: "memory");
        __syncthreads();
        if (tid == 0) __hip_atomic_store(flg + (seg + 1) * 16, 1u, __ATOMIC_RELAXED, __HIP_MEMORY_SCOPE_AGENT);
    }
}

template <int KIND>
__device__ __forceinline__ void norm_unit(Frame& F, int l, int b, int h, int rb, int seg) {
    constexpr int DK = KIND ? 64 : 128, NKS = DK / 32;
    unsigned char* ws = F.ws;
    const int lane = lane_id_fresh(), l15 = lane & 15, g = lane >> 4, bh = b * 4 + h;
    const size_t trow = (size_t)b * SEQ + 32 * rb;
    const float* prm = (const float*)(ws + WS_PRM) + l * PRM_L + (KIND ? PRM_MN : PRM_HN) + h * 128 + 4 * g;
    const bf16_t* Zg = (const bf16_t*)(ws + WS_Z) + (trow + l15) * NZ + (KIND ? ZC_LO : ZC_GG) + h * 128 + 4 * g;
    const float* OUT = (const float*)(ws + (KIND ? WS_OL : WS_OG)) + (trow + l15) * 512 + h * 128 + 4 * g;
    bf16_t* Y = (bf16_t*)(ws + WS_Y) + (trow + l15) * D + (KIND ? 1536 : 512) + h * 128 + 4 * g;
    f32x4 acc[2][8];
#pragma unroll
    for (int rt = 0; rt < 2; ++rt)
#pragma unroll
        for (int vt = 0; vt < 8; ++vt) acc[rt][vt] = (f32x4){0.f, 0.f, 0.f, 0.f};
    float ea[2] = {1.f, 1.f}, eb[2] = {0.f, 0.f}, inv[2] = {1.f, 1.f};
    f32x4 ov[2][8];
#pragma unroll
    for (int rt = 0; rt < 2; ++rt)
#pragma unroll
        for (int vt = 0; vt < 8; ++vt) ov[rt][vt] = *(const f32x4*)(OUT + (size_t)(16 * rt) * 512 + 16 * vt);
    __builtin_amdgcn_sched_barrier(0);
    if (seg > 0) {
        const bf16_t* SIB = (const bf16_t*)(ws + WS_SIB) + (size_t)((KIND * 16 + bh) * NSEG + seg) * 16384;
        const bf16_t* QTS = (const bf16_t*)(ws + (KIND ? WS_QTL : WS_QTG)) + ((size_t)bh * SEQ + 32 * rb + l15) * DK + 8 * g;
        bf16x8 qf[2][NKS];
#pragma unroll
        for (int rt = 0; rt < 2; ++rt)
#pragma unroll
            for (int ks = 0; ks < NKS; ++ks) qf[rt][ks] = *(const bf16x8*)(QTS + (size_t)(16 * rt) * DK + 32 * ks);
#pragma unroll
        for (int v2 = 0; v2 < 8; v2 += 2) {
            bf16x8 af[2][NKS];
#pragma unroll
            for (int vv = 0; vv < 2; ++vv)
#pragma unroll
                for (int ks = 0; ks < NKS; ++ks) af[vv][ks] = *(const bf16x8*)(SIB + (16 * (v2 + vv) + l15) * 128 + 32 * ks + 8 * g);
            __builtin_amdgcn_sched_barrier(0);
#pragma unroll
            for (int vv = 0; vv < 2; ++vv)
#pragma unroll
                for (int ks = 0; ks < NKS; ++ks)
#pragma unroll
                    for (int rt = 0; rt < 2; ++rt) acc[rt][v2 + vv] = __builtin_amdgcn_mfma_f32_16x16x32_bf16(af[vv][ks], qf[rt][ks], acc[rt][v2 + vv], 0, 0, 0);
        }
        if (KIND == 1) {
            const float* SIM = (const float*)(ws + WS_SIM) + (size_t)(bh * NSEG + seg) * 128;
            const float m_init = SIM[64];
            f32x4 nq[2] = {(f32x4){0.f, 0.f, 0.f, 0.f}, (f32x4){0.f, 0.f, 0.f, 0.f}};
#pragma unroll
            for (int ks = 0; ks < NKS; ++ks) { const f32x4 n0 = *(const f32x4*)(SIM + 32 * ks + 8 * g), n1 = *(const f32x4*)(SIM + 32 * ks + 8 * g + 4);
                const u32x4 nw = (u32x4){pk2(n0[0], n0[1]), pk2(n0[2], n0[3]), pk2(n1[0], n1[1]), pk2(n1[2], n1[3])}; const bf16x8 nfr = __builtin_bit_cast(bf16x8, nw);
#pragma unroll
                for (int rt = 0; rt < 2; ++rt) nq[rt] = __builtin_amdgcn_mfma_f32_16x16x32_bf16(nfr, qf[rt][ks], nq[rt], 0, 0, 0); }
#pragma unroll
            for (int rt = 0; rt < 2; ++rt) {
                const f32x4 sc = *(const f32x4*)((const float*)(ws + WS_SCL) + ((size_t)bh * SEQ + 32 * rb + 16 * rt + l15) * 4);
                const float mi = sc[2] + m_init, mp = fmaxf(sc[1], mi); ea[rt] = __expf(sc[1] - mp); eb[rt] = __expf(mi - mp);
                inv[rt] = rcpf_(fmaxf(fabsf(sc[0] * ea[rt] + nq[rt][0] * eb[rt]), __expf(-mp)));
            }
        }
    }
    u32x2 zv[2][8]; f32x4 gnv[8];
#pragma unroll
    for (int vt = 0; vt < 8; ++vt) { gnv[vt] = *(const f32x4*)(prm + 16 * vt);
#pragma unroll
        for (int rt = 0; rt < 2; ++rt) zv[rt][vt] = *(const u32x2*)(Zg + (size_t)(16 * rt) * NZ + 16 * vt); }
    __builtin_amdgcn_sched_barrier(0);
#pragma unroll
    for (int rt = 0; rt < 2; ++rt) {
        float ss = 0.f;
#pragma unroll
        for (int vt = 0; vt < 8; ++vt) {
            const f32x4 o = ov[rt][vt];
            if (KIND == 0) acc[rt][vt] += o; else acc[rt][vt] = (o * ea[rt] + acc[rt][vt] * eb[rt]) * inv[rt];
            ss += acc[rt][vt][0] * acc[rt][vt][0] + acc[rt][vt][1] * acc[rt][vt][1] + acc[rt][vt][2] * acc[rt][vt][2] + acc[rt][vt][3] * acc[rt][vt][3];
        }
        ss += bperm_f(lane ^ 16, ss); ss += bperm_f(lane ^ 32, ss);
        const float r = rsqrtf(ss * (1.f / 128.f) + EPS);
#pragma unroll
        for (int vt = 0; vt < 8; ++vt) {
            const u32x2 zw = zv[rt][vt]; const f32x4 gn = gnv[vt];
            const float z0 = bflo(zw[0]), z1 = bfhi(zw[0]), z2 = bflo(zw[1]), z3 = bfhi(zw[1]);
            const float s0 = sigmoidf_(z0), s1 = sigmoidf_(z1), s2 = sigmoidf_(z2), s3 = sigmoidf_(z3);
            const f32x4 a = acc[rt][vt];
            u32x2 wv; wv.x = pk2(a[0] * r * gn[0] * (KIND ? s0 : z0 * s0), a[1] * r * gn[1] * (KIND ? s1 : z1 * s1)); wv.y = pk2(a[2] * r * gn[2] * (KIND ? s2 : z2 * s2), a[3] * r * gn[3] * (KIND ? s3 : z3 * s3));
            *(u32x2*)(Y + (size_t)(16 * rt) * D + 16 * vt) = wv;
        }
    }
}
__device__ __forceinline__ void scan_norm(Frame& F, int l) {
#pragma unroll 1
    for (int u = F.bid; u < 256; u += F.G) {
        const int b = u >> 6, rb = u & 63, seg = rb / (64 / NSEG), h = F.wave >> 1;
        if (F.wave & 1) norm_unit<1>(F, l, b, h, rb, seg); else norm_unit<0>(F, l, b, h, rb, seg);
    }
}

__device__ __forceinline__ v32f_t ld_row6(const unsigned char* rowp, int lane) {
    const u32x4 a = *(const u32x4*)(rowp + lane * 16); const u32x2 b = *(const u32x2*)(rowp + 1024 + lane * 8);
    const v6u_t p = (v6u_t){a[0], a[1], a[2], a[3], b[0], b[1]};
    return __builtin_amdgcn_cvt_scalef32_pk32_f32_fp6(p, 1.0f);
}
__device__ __forceinline__ float sw32_add(float a, float b) { asm volatile("s_nop 1\n\tv_permlane32_swap_b32 %0, %1\n\ts_nop 1" : "+v"(a), "+v"(b)); return a + b; }
__device__ __forceinline__ float sw16_add(float a, float b) { asm volatile("s_nop 1\n\tv_permlane16_swap_b32 %0, %1\n\ts_nop 1" : "+v"(a), "+v"(b)); return a + b; }
__device__ __forceinline__ float reduce8(const float (&p)[8], int lane) {
    const float q0 = sw16_add(sw32_add(p[0], p[1]), sw32_add(p[2], p[3])), q1 = sw16_add(sw32_add(p[4], p[5]), sw32_add(p[6], p[7]));
    const float t0 = q0 + DPP_F(q0, 0x128), t1 = q1 + DPP_F(q1, 0x128);
    float t = (lane & 8) ? t1 : t0;
    t += DPP_F(t, 0xB1); t += DPP_F(t, 0x4E); t += DPP_F(t, 0x141);
    return t;
}
__device__ __forceinline__ void peer_gather(Frame& F, int l) {
    constexpr int NF = 16;
    unsigned char* ws = F.ws;
    const unsigned char* U4 = ws + WS_UB + (size_t)l * NEXP * VROW; const unsigned char* V4 = ws + WS_VB + (size_t)l * NEXP * VROW;
    const float* SU = (const float*)(ws + WS_SU) + l * NEXP; const float* SV = (const float*)(ws + WS_SV) + l * NEXP;
    const int* PIDX = (const int*)(ws + WS_PIDX); const float* PG = (const float*)(ws + WS_PGATE);
    bf16_t* HB = (bf16_t*)(ws + WS_HB) + (size_t)(l & 1) * T * D;
    const u64* ssqB = (const u64*)(ws + WS_CTL + CTL_SSQB) + l * T; float* ssqC = (float*)(ws + WS_CTL + CTL_SSQC) + l * T;
    const int lane = F.lane;
    LAS float* cl = (LAS float*)(F.lds + F.wave * 512);
    int emap;
    { float lab[8];
#pragma unroll
      for (int k = 0; k < 8; ++k) lab[k] = (float)k * (1.f / 64.f);
      emap = (int)(reduce8(lab, lane) + 0.5f); }
    for (int t = F.gw; t < T; t += F.ngw) {
        float x[32];
#pragma unroll
        for (int q = 0; q < 8; ++q) { const u32x2 w = *(const u32x2*)(HB + (size_t)t * D + q * 256 + lane * 4);
            x[4 * q] = bflo(w[0]); x[4 * q + 1] = bfhi(w[0]); x[4 * q + 2] = bflo(w[1]); x[4 * q + 3] = bfhi(w[1]); }
        const float rs = rsqrtf(ssq_get(ssqB + t) * (1.f / D) + EPS);
        const int myidx0 = PIDX[(size_t)t * 128 + lane], myidx1 = PIDX[(size_t)t * 128 + 64 + lane];
        const float mys0 = SU[myidx0] * rs, mys1 = SU[myidx1] * rs;
        const float myg0 = PG[(size_t)t * 128 + lane] * SV[myidx0], myg1 = PG[(size_t)t * 128 + 64 + lane] * SV[myidx1];
#pragma unroll 1
        for (int e0 = 0; e0 < 128; e0 += NF) {
            u32x4 uw[NF];
#pragma unroll
            for (int k = 0; k < NF; ++k) { const int e = e0 + k; const int idx = __builtin_amdgcn_readlane(e < 64 ? myidx0 : myidx1, e & 63); uw[k] = *(const u32x4*)(U4 + (size_t)idx * VROW + lane * 16); }
#pragma unroll
            for (int b8 = 0; b8 < NF / 8; ++b8) {
                float part[8];
#pragma unroll
                for (int k = 0; k < 8; ++k) {
                    const int kk = b8 * 8 + k; f32x2_t sa = (f32x2_t){0.f, 0.f}, sb = (f32x2_t){0.f, 0.f};
#pragma unroll
                    for (int q2 = 0; q2 < 4; ++q2) {
                        const f32x2_t d0 = __builtin_amdgcn_cvt_scalef32_pk_f32_fp4(uw[kk][q2], 1.0f, 0), d1 = __builtin_amdgcn_cvt_scalef32_pk_f32_fp4(uw[kk][q2], 1.0f, 1);
                        const f32x2_t d2 = __builtin_amdgcn_cvt_scalef32_pk_f32_fp4(uw[kk][q2], 1.0f, 2), d3 = __builtin_amdgcn_cvt_scalef32_pk_f32_fp4(uw[kk][q2], 1.0f, 3);
                        sa = __builtin_elementwise_fma((f32x2_t){x[8 * q2], x[8 * q2 + 1]}, d0, sa); sb = __builtin_elementwise_fma((f32x2_t){x[8 * q2 + 2], x[8 * q2 + 3]}, d1, sb);
                        sa = __builtin_elementwise_fma((f32x2_t){x[8 * q2 + 4], x[8 * q2 + 5]}, d2, sa); sb = __builtin_elementwise_fma((f32x2_t){x[8 * q2 + 6], x[8 * q2 + 7]}, d3, sb);
                    }
                    const f32x2_t st_ = sa + sb; const float s_ = st_[0] + st_[1];
                    part[k] = s_;
                    if (kk + 1 < NF) asm volatile("" : "+v"(uw[kk + 1]) : "v"(s_));
                }
                const float dot = reduce8(part, lane);
                const int eb = e0 + b8 * 8 + emap;
                const float pre = dot * bperm_f(eb & 63, e0 < 64 ? mys0 : mys1);
                const float act = 0.5f * pre * (1.f + erff(pre * 0.7071067811865476f));
                const float cf = act * bperm_f(eb & 63, e0 < 64 ? myg0 : myg1);
                if ((lane & 7) == 0) cl[eb] = cf;
            }
        }
        asm volatile("s_waitcnt lgkmcnt(0)" ::: "memory");
        const float c0 = cl[lane], c1 = cl[64 + lane];
        float y[32];
#pragma unroll
        for (int i = 0; i < 32; ++i) y[i] = 0.f;
#pragma unroll 1
        for (int e0 = 0; e0 < 128; e0 += NF) {
            u32x4 vw[NF];
#pragma unroll
            for (int k = 0; k < NF; ++k) { const int e = e0 + k; const int idx = __builtin_amdgcn_readlane(e < 64 ? myidx0 : myidx1, e & 63); vw[k] = *(const u32x4*)(V4 + (size_t)idx * VROW + lane * 16); }
#pragma unroll
            for (int k = 0; k < NF; ++k) {
                const int e = e0 + k; const float ce = rdlane_f(e < 64 ? c0 : c1, e & 63);
#pragma unroll
                for (int q2 = 0; q2 < 4; ++q2) {
                    const f32x2_t d0 = __builtin_amdgcn_cvt_scalef32_pk_f32_fp4(vw[k][q2], 1.0f, 0), d1 = __builtin_amdgcn_cvt_scalef32_pk_f32_fp4(vw[k][q2], 1.0f, 1);
                    const f32x2_t d2 = __builtin_amdgcn_cvt_scalef32_pk_f32_fp4(vw[k][q2], 1.0f, 2), d3 = __builtin_amdgcn_cvt_scalef32_pk_f32_fp4(vw[k][q2], 1.0f, 3);
                    y[8 * q2] += ce * d0[0]; y[8 * q2 + 1] += ce * d0[1]; y[8 * q2 + 2] += ce * d1[0]; y[8 * q2 + 3] += ce * d1[1];
                    y[8 * q2 + 4] += ce * d2[0]; y[8 * q2 + 5] += ce * d2[1]; y[8 * q2 + 6] += ce * d3[0]; y[8 * q2 + 7] += ce * d3[1];
                }
                if (k + 1 < NF) asm volatile("" : "+v"(vw[k + 1]) : "v"(y[0]), "v"(y[31]));
            }
        }
        float s2 = 0.f;
#pragma unroll
        for (int q = 0; q < 8; ++q) {
            const float v0 = x[4 * q] + y[4 * q], v1 = x[4 * q + 1] + y[4 * q + 1], v2 = x[4 * q + 2] + y[4 * q + 2], v3 = x[4 * q + 3] + y[4 * q + 3];
            *(u32x2*)(HB + (size_t)t * D + q * 256 + lane * 4) = (u32x2){pk2(v0, v1), pk2(v2, v3)};
            s2 += v0 * v0 + v1 * v1 + v2 * v2 + v3 * v3;
        }
        s2 = wave_sum(s2);
        if (lane == 0) ssqC[t] = s2;
    }
}

__device__ __forceinline__ void final_norm(Frame& F) {
    const Args& a = *F.a; unsigned char* ws = F.ws;
    const bf16_t* HB = (const bf16_t*)(ws + WS_HB) + (size_t)(DEPTH & 1) * T * D; const u64* ssq = (const u64*)(ws + WS_CTL + CTL_SSQA) + 4 * T; const float* g = (const float*)(ws + WS_PRM) + PRM_FIN;
    const int lane = F.lane;
    for (int t = F.gw; t < T; t += F.ngw) {
        const float rs = rsqrtf(ssq_get(ssq + t) * (1.f / D) + EPS);
#pragma unroll
        for (int c = 0; c < 4; ++c) { const size_t o = (size_t)t * D + c * 512 + lane * 8; const u32x4 hw = *(const u32x4*)(HB + o); const f32x4 g0 = *(const f32x4*)(g + c * 512 + lane * 8), g1 = *(const f32x4*)(g + c * 512 + lane * 8 + 4);
            *(f32x4*)(a.out + o) = (f32x4){bflo(hw[0]), bfhi(hw[0]), bflo(hw[1]), bfhi(hw[1])} * rs * g0; *(f32x4*)(a.out + o + 4) = (f32x4){bflo(hw[2]), bfhi(hw[2]), bflo(hw[3]), bfhi(hw[3])} * rs * g1; }
    }
}

constexpr int PH_PER_LAYER = 10, N_PHASES = 2 + DEPTH * PH_PER_LAYER;
template <int PH>
__device__ __forceinline__ void run_phase(Frame& F0, int l) {
    Frame F = F0; { int bid_ = blockIdx.x, wv_ = F0.wave; asm volatile("" : "+s"(bid_), "+s"(wv_));
      F.bid = bid_; F.wave = wv_; F.lane = lane_id_fresh(); F.tid = wv_ * 64 + F.lane; F.gw = bid_ * NWAVES + wv_;
      size_t z_ = 0; asm volatile("" : "+s"(z_)); F.ws = F0.ws + z_; }
    unsigned char* ws = F.ws;
    bf16_t* const HBc = (bf16_t*)(ws + WS_HB) + (size_t)(l & 1) * T * D; bf16_t* const HBn = (bf16_t*)(ws + WS_HB) + (size_t)((l + 1) & 1) * T * D;
    if constexpr (PH == 100) prologue(F);
    if constexpr (PH == 101) final_norm(F);
    if constexpr (PH == 0) {
        pg8::Gemm g{HBc, (const bf16_t*)(ws + WS_WIN) + (size_t)l * NZ * D, T, NZ, D, D, D}; pg8::StaticOrder S; S.init(T, NZ, F.G, F.bid);
        EpiZ E{(bf16_t*)(ws + WS_Z), (const u64*)(ws + WS_CTL + CTL_SSQA) + l * T, (u64*)(ws + WS_CTL + CTL_MQS) + l * T, (u64*)(ws + WS_CTL + CTL_MKVS) + l * T};
        pg8::gemm_phase<EpiZ, pg8::StaticOrder, true, true>(F.lds, g, S, E, F.wave);
    }
    if constexpr (PH == 1) {
        mix_prep(F, l);
        { pg8::Gemm g{(const bf16_t*)(ws + WS_Z) + ZC_MCQ, (const bf16_t*)(ws + WS_WUQ) + (size_t)l * 768 * 384, T, 768, 384, NZ, 384}; pg8::StaticOrder S; S.init(T, 768, F.G, F.bid);
          EpiBf16s E{(bf16_t*)(ws + WS_QM), 768, (const u64*)(ws + WS_CTL + CTL_MQS) + l * T, 1.f / 384.f};
          pg8::gemm_phase<EpiBf16s, pg8::StaticOrder, true, true>(F.lds, g, S, E, F.wave); }
        __syncthreads();
        { pg8::Gemm g{(const bf16_t*)(ws + WS_Z) + ZC_MCKV, (const bf16_t*)(ws + WS_WUKV) + (size_t)l * 1024 * 256, T, 1024, 256, NZ, 256}; pg8::StaticOrder S; S.init(T, 1024, F.G, (int)((F.bid + 128) % F.G));
          EpiBf16s E{(bf16_t*)(ws + WS_KVM), 1024, (const u64*)(ws + WS_CTL + CTL_MKVS) + l * T, 1.f / 256.f};
          pg8::gemm_phase<EpiBf16s, pg8::StaticOrder, true, true>(F.lds, g, S, E, F.wave); }
    }
    if constexpr (PH == 3) {
        if (F.bid < 32 * NSEG) { const int bhs = F.bid % (16 * NSEG), b = bhs / (4 * NSEG), h = (bhs / NSEG) & 3, seg = bhs % NSEG; if (F.bid < 16 * NSEG) scan_unit<0>(F, l, b, h, seg); else scan_unit<1>(F, l, b, h, seg); }
        {
            const bool conv_first = F.bid >= 256 - NCONVWG;
#pragma unroll 1
            for (int pass = 0; pass < 2; ++pass) {
                if (pass == 1 || conv_first) { __syncthreads(); convert_layer_queue(F, l, (unsigned*)(ws + WS_CTL + CTL_CVQ) + 64 * l); }
                if (pass == 0) attn_fast(F, l);
            }
        }
    }
    if constexpr (PH == 4) scan_norm(F, l);
    if constexpr (PH == 5) {
        pg8::Gemm g{(const bf16_t*)(ws + WS_Y), (const bf16_t*)(ws + WS_WOUT) + (size_t)l * D * D, T, D, D, D, D}; pg8::StaticOrder S; S.init(T, D, F.G, F.bid);
        EpiRes E{HBc, (u64*)(ws + WS_CTL + CTL_SSQB) + l * T};
        pg8::gemm_phase<EpiRes, pg8::StaticOrder, true, true>(F.lds, g, S, E, F.wave);
    }
    if constexpr (PH == 6) {
        { pg8::Gemm g{HBc, (const bf16_t*)(ws + WS_WQ) + (size_t)l * D * D, T, D, D, D, D}; pg8::StaticOrder S; S.init(T, D, F.G, F.bid);
          EpiBf16s E{(bf16_t*)(ws + WS_QB), D, (const u64*)(ws + WS_CTL + CTL_SSQB) + l * T, 1.f / D};
          pg8::gemm_phase<EpiBf16s, pg8::StaticOrder, true, true>(F.lds, g, S, E, F.wave);
          pg8::Unit u;
          if (S.next(0, u)) {
              asm volatile("s_waitcnt vmcnt(0)" ::: "memory"); __syncthreads();
              __builtin_amdgcn_fence(__ATOMIC_ACQUIRE, "agent"); asm volatile("s_waitcnt vmcnt(0)" ::: "memory");
              peer_topk_mfma(F.lds, F.wave, (const bf16_t*)(ws + WS_QB), (const bf16_t*)(ws + WS_SKB) + (size_t)l * 8 * 2 * 128 * 128, (int*)(ws + WS_PIDX), (float*)(ws + WS_PGATE), u.pm, u.pn);
          } }
        __syncthreads();
        { pg8::Gemm g{(const bf16_t*)(ws + WS_PB) + (size_t)l * T * PLE, (const bf16_t*)(ws + WS_WP) + (size_t)l * D * PLE, T, D, PLE, PLE, PLE}; pg8::StaticOrder S; S.init(T, D, F.G, F.bid);
          EpiBf16s E{(bf16_t*)(ws + WS_PR), D, nullptr, 0.f};
          pg8::gemm_phase<EpiBf16s, pg8::StaticOrder, true, true>(F.lds, g, S, E, F.wave); }
    }
    if constexpr (PH == 8) peer_gather(F, l);
    if constexpr (PH == 9) {
        pg8::Gemm g{HBc, (const bf16_t*)(ws + WS_WG) + (size_t)l * D * D, T, D, D, D, D}; pg8::StaticOrder S; S.init(T, D, F.G, F.bid);
        EpiPle E{HBc, HBn, (const bf16_t*)(ws + WS_PR), (const float*)(ws + WS_CTL + CTL_SSQC) + l * T, (u64*)(ws + WS_CTL + CTL_SSQA) + (l + 1) * T};
        pg8::gemm_phase<EpiPle, pg8::StaticOrder, true, true>(F.lds, g, S, E, F.wave);
    }
}
__global__ void __launch_bounds__(NTHREADS, 2) mega(Args args) {
    extern __shared__ __attribute__((aligned(16))) unsigned char lds_raw[];
    Frame F; F.lds = (LAS unsigned char*)lds_raw; F.ws = args.ws; F.a = &args;
    F.tid = threadIdx.x; F.lane = F.tid & 63; F.wave = __builtin_amdgcn_readfirstlane(F.tid >> 6); F.G = gridDim.x;
    F.gw = blockIdx.x * NWAVES + F.wave; F.ngw = F.G * NWAVES; F.bid = blockIdx.x;
    volatile LAS unsigned* misc = (volatile LAS unsigned*)(F.lds + MISC_OFF);
    if (F.tid < 32) misc[F.tid] = 0u;
    __syncthreads();
    (void)xcd_barrier_post((unsigned*)(args.ws + WS_CTL + CTL_BAR), misc + 8);
#define GRID_BAR() do { XcdBarrier b_; b_.bar = (unsigned*)(args.ws + WS_CTL + CTL_BAR); b_.x = xb_xcc_id(); b_.st = (volatile LAS unsigned*)(F.lds + MISC_OFF) + 8; xcd_barrier(b_, F.wave); } while (0)
    run_phase<100>(F, 0); GRID_BAR();
    for (int l = 0; l < DEPTH; ++l) {
        run_phase<0>(F, l); GRID_BAR();
        run_phase<1>(F, l); GRID_BAR();
        run_phase<3>(F, l); GRID_BAR();
        run_phase<4>(F, l); GRID_BAR();
        run_phase<5>(F, l); GRID_BAR();
        run_phase<6>(F, l); GRID_BAR();
        run_phase<8>(F, l); GRID_BAR();
        run_phase<9>(F, l); GRID_BAR();
    }
    run_phase<101>(F, 0);
#undef GRID_BAR
}

extern "C" void kernel_launch(void* const* d_in, const int* in_sizes, int n_in, void* d_out, int out_size, void* d_ws, size_t ws_size, hipStream_t stream) {
    static int grid = 0;
    if (grid == 0) {
        if (n_in != 28 || out_size != T * D || ws_size < WS_END) { fprintf(stderr, "kernel_launch: unexpected shapes (n_in %d out %d ws %zu need %zu)\n", n_in, out_size, ws_size, (size_t)WS_END); grid = -1; return; }
        if (hipFuncSetAttribute((const void*)mega, hipFuncAttributeMaxDynamicSharedMemorySize, LDS_BYTES) != hipSuccess) { fprintf(stderr, "kernel_launch: hipFuncSetAttribute failed\n"); grid = -1; return; }
        int dev = 0, cus = 0, per_cu = 0; (void)hipGetDevice(&dev); (void)hipDeviceGetAttribute(&cus, hipDeviceAttributeMultiprocessorCount, dev);
        if (hipOccupancyMaxActiveBlocksPerMultiprocessor(&per_cu, (const void*)mega, NTHREADS, LDS_BYTES) != hipSuccess || per_cu < 1) { fprintf(stderr, "kernel_launch: occupancy query says %d blocks per CU\n", per_cu); (void)hipGetLastError(); }
        grid = cus > 0 ? cus : 256;
    }
    if (grid < 0) return;
    (void)hipMemsetAsync((char*)d_ws + WS_CTL, 0, CTL_BYTES, stream);
    Args a{};
    for (int i = 0; i < 28; ++i) a.in[i] = (const float*)d_in[i];
    a.out = (float*)d_out; a.ws = (unsigned char*)d_ws;
    hipLaunchKernelGGL(mega, dim3(grid), dim3(NTHREADS), LDS_BYTES, stream, a);
}
```
